# Optimizing an MI355X kernel written in HIP

```python
import math
import jax, jax.numpy as jnp
from jax import lax
import numpy as np

D_MODEL = 1024
BATCH = 2
SEQ = 8192
DEPTH = 4

MEM_LEN = 256
D_RNN = D_MODEL
LRU_BLOCKS = 8
LRU_BW = D_RNN // LRU_BLOCKS
CONV_W = 4
LRU_C = 8.0
N_HEADS = 16
HEAD_DIM = 64
N_KV = 4
GROUP = N_HEADS // N_KV
NSA_W = N_HEADS * HEAD_DIM
KV_W = N_KV * HEAD_DIM
CMP_STRIDE = 16
CMP_LEN = 2 * CMP_STRIDE
CMP_HIDDEN = 4 * HEAD_DIM
SEL_LEN = 64
N_SELECT = 16
WINDOW = 512
Q_BLOCK = 128
MEM_HEADS = 4
MEM_HEAD_DIM = D_MODEL // MEM_HEADS
MEM_W = MEM_HEADS * MEM_HEAD_DIM
D_FF = 4 * D_MODEL
ROPE_THETA = 10000.0
EPS = 1e-6
NEG = -1e30
FORCE = 1e4

IN_SPLITS = (D_RNN, D_RNN, NSA_W, 6 * KV_W, 3 * N_HEADS, MEM_W, 3 * D_MODEL)
D_IN = sum(IN_SPLITS)
IN_OFFSETS = tuple(int(v) for v in np.cumsum(IN_SPLITS)[:-1])

kernel_name = "hybrid_rglru_nsa_memory_block"


def rmsnorm(x, g):
    xf = x.astype(jnp.float32)
    y = xf * lax.rsqrt(jnp.mean(xf * xf, axis=-1, keepdims=True) + EPS)
    return (y * g.astype(jnp.float32)).astype(x.dtype)


def rope(x, pos):
    hd = x.shape[-1]
    half = hd // 2
    inv = ROPE_THETA ** (-jnp.arange(half, dtype=jnp.float32) * 2.0 / hd)
    ang = pos.astype(jnp.float32)[..., None] * inv
    cos = jnp.cos(ang)[:, :, None, :]
    sin = jnp.sin(ang)[:, :, None, :]
    xf = x.astype(jnp.float32)
    x1, x2 = xf[..., :half], xf[..., half:]
    return jnp.concatenate([x1 * cos - x2 * sin, x2 * cos + x1 * sin], axis=-1).astype(x.dtype)


def masked_softmax(sc, mask):
    sc = jnp.where(mask, sc.astype(jnp.float32), NEG)
    m = jnp.max(sc, axis=-1, keepdims=True)
    p = jnp.where(mask, jnp.exp(sc - m), 0.0)
    return p / jnp.maximum(jnp.sum(p, axis=-1, keepdims=True), 1e-30)


def block_diag_linear(x, w, b):
    B_, S_, C = x.shape
    xb = x.reshape(B_, S_, LRU_BLOCKS, LRU_BW)
    return (jnp.einsum('bsnc,ncd->bsnd', xb, w) + b).reshape(B_, S_, C)


def rglru_branch(xr, yr, conv_w, conv_b, wr, br, wi, bi, lam):
    xc = lax.conv_general_dilated(
        xr, conv_w[:, None, :], window_strides=(1,), padding=[(CONV_W - 1, 0)],
        dimension_numbers=('NWC', 'WIO', 'NWC'), feature_group_count=D_RNN) + conv_b
    r = jax.nn.sigmoid(block_diag_linear(xc, wr, br))
    i = jax.nn.sigmoid(block_diag_linear(xc, wi, bi))
    log_a = -LRU_C * jax.nn.softplus(-lam.astype(jnp.float32)) * r.astype(jnp.float32)
    a = jnp.exp(log_a)
    b = jnp.sqrt(-jnp.expm1(2.0 * log_a)) * (i * xc).astype(jnp.float32)

    def combine(left, right):
        a1, b1 = left
        a2, b2 = right
        return a1 * a2, a2 * b1 + b2

    _, h = lax.associative_scan(combine, (a, b), axis=1)
    return h.astype(xr.dtype) * jax.nn.gelu(yr)


def nsa_branch(q, kv, gates, positions, cmp_pe, cmp_w1, cmp_b1, cmp_w2):
    B_, S_, _ = q.shape
    n_cmp = S_ // CMP_STRIDE - 1
    n_sel = S_ // SEL_LEN
    top_n = min(N_SELECT, n_sel)
    n_qblk = S_ // Q_BLOCK
    scale = HEAD_DIM ** -0.5

    q = rope(q.reshape(B_, S_, N_HEADS, HEAD_DIM), positions)
    q = q.reshape(B_, S_, N_KV, GROUP, HEAD_DIM).transpose(0, 2, 3, 1, 4)
    kv = kv.reshape(B_, S_, 6, N_KV, HEAD_DIM)
    k_c, v_c, k_s, v_s, k_w, v_w = [kv[:, :, j] for j in range(6)]

    def compress(t, j):
        chunks = t.reshape(B_, S_ // CMP_STRIDE, CMP_STRIDE, N_KV, HEAD_DIM)
        blocks = jnp.concatenate([chunks[:, :-1], chunks[:, 1:]], axis=2)
        blocks = blocks + cmp_pe[j][None, None, :, None, :]
        flat = blocks.transpose(0, 1, 3, 2, 4).reshape(B_, n_cmp, N_KV, CMP_LEN * HEAD_DIM)
        hid = jax.nn.gelu(flat @ cmp_w1[j] + cmp_b1[j])
        return hid @ cmp_w2[j]

    cmp_end = jnp.arange(n_cmp) * CMP_STRIDE + CMP_LEN - 1
    k_cmp = rope(compress(k_c, 0), positions[:, cmp_end]).transpose(0, 2, 1, 3)
    v_cmp = compress(v_c, 1).transpose(0, 2, 1, 3)

    k_sel = rope(k_s, positions).transpose(0, 2, 1, 3).reshape(B_, N_KV, n_sel, SEL_LEN, HEAD_DIM)
    v_sel = v_s.transpose(0, 2, 1, 3).reshape(B_, N_KV, n_sel, SEL_LEN, HEAD_DIM)
    c0 = jnp.arange(n_cmp)[:, None] * CMP_STRIDE
    s0 = jnp.arange(n_sel)[None, :] * SEL_LEN
    overlap = jnp.clip(jnp.minimum(c0 + CMP_LEN, s0 + SEL_LEN) - jnp.maximum(c0, s0), 0, None).astype(jnp.float32) / CMP_LEN

    pad = ((0, 0), (0, 0), (WINDOW, 0), (0, 0))
    k_win = jnp.pad(rope(k_w, positions).transpose(0, 2, 1, 3), pad)
    v_win = jnp.pad(v_w.transpose(0, 2, 1, 3), pad)

    g = jax.nn.sigmoid(gates.astype(jnp.float32)).reshape(B_, S_, N_KV, GROUP, 3).transpose(0, 2, 3, 1, 4)
    bi = jnp.arange(B_)[:, None, None, None]
    gi = jnp.arange(N_KV)[None, :, None, None]
    blk = jnp.arange(n_sel)

    def one_block(i):
        s = i * Q_BLOCK
        t = s + jnp.arange(Q_BLOCK)
        qb = lax.dynamic_slice_in_dim(q, s, Q_BLOCK, axis=3)
        gb = lax.dynamic_slice_in_dim(g, s, Q_BLOCK, axis=3)
        sc = jnp.einsum('bgrqd,bgcd->bgrqc', qb, k_cmp) * scale
        p_c = masked_softmax(sc, cmp_end[None, :] <= t[:, None])
        o_c = jnp.einsum('bgrqc,bgcd->bgrqd', p_c.astype(v_cmp.dtype), v_cmp)
        imp = jnp.einsum('bgrqc,cj->bgqj', p_c, overlap)
        forced = (blk[None, :] == 0) | (blk[None, :] == (t // SEL_LEN)[:, None])
        causal_blk = blk[None, :] * SEL_LEN <= t[:, None]
        imp = jnp.where(forced, FORCE, jnp.where(causal_blk, imp, -FORCE))
        _, idx = lax.top_k(imp, top_n)
        k_g = k_sel[bi, gi, idx].reshape(B_, N_KV, Q_BLOCK, top_n * SEL_LEN, HEAD_DIM)
        v_g = v_sel[bi, gi, idx].reshape(B_, N_KV, Q_BLOCK, top_n * SEL_LEN, HEAD_DIM)
        kpos = (idx[..., None] * SEL_LEN + jnp.arange(SEL_LEN)).reshape(B_, N_KV, Q_BLOCK, top_n * SEL_LEN)
        sc = jnp.einsum('bgrqd,bgqkd->bgrqk', qb, k_g) * scale
        p_s = masked_softmax(sc, (kpos <= t[:, None])[:, :, None])
        o_s = jnp.einsum('bgrqk,bgqkd->bgrqd', p_s.astype(v_g.dtype), v_g)
        k_wb = lax.dynamic_slice_in_dim(k_win, s, Q_BLOCK + WINDOW, axis=2)
        v_wb = lax.dynamic_slice_in_dim(v_win, s, Q_BLOCK + WINDOW, axis=2)
        wpos = s - WINDOW + jnp.arange(Q_BLOCK + WINDOW)
        wmask = (wpos[None, :] <= t[:, None]) & (wpos[None, :] > t[:, None] - WINDOW) & (wpos[None, :] >= 0)
        sc = jnp.einsum('bgrqd,bgkd->bgrqk', qb, k_wb) * scale
        p_w = masked_softmax(sc, wmask)
        o_w = jnp.einsum('bgrqk,bgkd->bgrqd', p_w.astype(v_wb.dtype), v_wb)
        o = gb[..., 0:1] * o_c + gb[..., 1:2] * o_s + gb[..., 2:3] * o_w
        return o.astype(q.dtype)

    out = lax.map(one_block, jnp.arange(n_qblk))
    return out.transpose(1, 0, 4, 2, 3, 5).reshape(B_, S_, NSA_W)


def memory_branch(qm, mem, ln_g, w_kv):
    B_, S_, _ = qm.shape
    M_ = mem.shape[1]
    kv = (rmsnorm(mem, ln_g) @ w_kv).reshape(B_, M_, 2, MEM_HEADS, MEM_HEAD_DIM)
    k, v = kv[:, :, 0], kv[:, :, 1]
    q = qm.reshape(B_, S_, MEM_HEADS, MEM_HEAD_DIM)
    sc = jnp.einsum('bshd,bmhd->bhsm', q, k) * (MEM_HEAD_DIM ** -0.5)
    p = jax.nn.softmax(sc.astype(jnp.float32), axis=-1)
    o = jnp.einsum('bhsm,bmhd->bshd', p.astype(v.dtype), v)
    return o.reshape(B_, S_, MEM_W)


def setup_inputs(seed: int = 0) -> dict:
    key = jax.random.key(seed)
    ks = iter(jax.random.split(key, 40))
    f32 = jnp.float32

    def nrm(shape, fan_in):
        return jax.random.normal(next(ks), shape, f32) * (fan_in ** -0.5)

    def gain(shape):
        return 1.0 + 0.05 * jax.random.normal(next(ks), shape, f32)

    def small(shape, s=0.02):
        return s * jax.random.normal(next(ks), shape, f32)

    x = jax.random.normal(next(ks), (BATCH, SEQ, D_MODEL), f32)
    mem = jax.random.normal(next(ks), (BATCH, MEM_LEN, D_MODEL), f32)
    positions = jnp.broadcast_to(jnp.arange(SEQ, dtype=jnp.int32)[None, :], (BATCH, SEQ))
    u = jax.random.uniform(next(ks), (DEPTH, D_RNN), f32, minval=0.9, maxval=0.999)
    sa = u ** (1.0 / LRU_C)
    lru_lambda = jnp.log(sa) - jnp.log1p(-sa)
    return {
        "x": x,
        "mem": mem,
        "positions": positions,
        "ln_mix_pre": gain((DEPTH, D_MODEL)),
        "w_in": nrm((DEPTH, D_MODEL, D_IN), D_MODEL),
        "conv_w": nrm((DEPTH, CONV_W, D_RNN), CONV_W),
        "conv_b": small((DEPTH, D_RNN)),
        "lru_wr": nrm((DEPTH, LRU_BLOCKS, LRU_BW, LRU_BW), LRU_BW),
        "lru_br": small((DEPTH, LRU_BLOCKS, LRU_BW)),
        "lru_wi": nrm((DEPTH, LRU_BLOCKS, LRU_BW, LRU_BW), LRU_BW),
        "lru_bi": small((DEPTH, LRU_BLOCKS, LRU_BW)),
        "lru_lambda": lru_lambda,
        "cmp_pe": small((DEPTH, 2, CMP_LEN, HEAD_DIM), 0.1),
        "cmp_w1": nrm((DEPTH, 2, CMP_LEN * HEAD_DIM, CMP_HIDDEN), CMP_LEN * HEAD_DIM),
        "cmp_b1": small((DEPTH, 2, CMP_HIDDEN)),
        "cmp_w2": nrm((DEPTH, 2, CMP_HIDDEN, HEAD_DIM), CMP_HIDDEN),
        "ln_mem": gain((DEPTH, D_MODEL)),
        "w_mem_kv": nrm((DEPTH, D_MODEL, 2 * MEM_W), D_MODEL),
        "w_br_rnn": nrm((DEPTH, D_RNN, D_MODEL), D_RNN),
        "w_br_nsa": nrm((DEPTH, NSA_W, D_MODEL), NSA_W),
        "w_br_mem": nrm((DEPTH, MEM_W, D_MODEL), MEM_W),
        "w_out": nrm((DEPTH, D_MODEL, D_MODEL), D_MODEL),
        "ln_mix_post": gain((DEPTH, D_MODEL)),
        "ln_mlp_pre": gain((DEPTH, D_MODEL)),
        "mlp_w1": nrm((DEPTH, D_MODEL, D_FF), D_MODEL),
        "mlp_w2": nrm((DEPTH, D_FF, D_MODEL), D_FF),
        "ln_mlp_post": gain((DEPTH, D_MODEL)),
    }


def reference(x, mem, positions, ln_mix_pre, w_in, conv_w, conv_b, lru_wr, lru_br, lru_wi, lru_bi,
              lru_lambda, cmp_pe, cmp_w1, cmp_b1, cmp_w2, ln_mem, w_mem_kv, w_br_rnn, w_br_nsa,
              w_br_mem, w_out, ln_mix_post, ln_mlp_pre, mlp_w1, mlp_w2, ln_mlp_post):
    for l in range(DEPTH):
        h = rmsnorm(x, ln_mix_pre[l])
        proj = h @ w_in[l]
        xr, yr, q, kv, g_nsa, qm, g_merge = jnp.split(proj, IN_OFFSETS, axis=-1)
        o_a = rglru_branch(xr, yr, conv_w[l], conv_b[l], lru_wr[l], lru_br[l],
                           lru_wi[l], lru_bi[l], lru_lambda[l])
        o_b = nsa_branch(q, kv, g_nsa, positions, cmp_pe[l], cmp_w1[l], cmp_b1[l], cmp_w2[l])
        o_c = memory_branch(qm, mem, ln_mem[l], w_mem_kv[l])
        ga, gb, gc = jnp.split(jax.nn.sigmoid(g_merge), 3, axis=-1)
        merged = ga * (o_a @ w_br_rnn[l]) + gb * (o_b @ w_br_nsa[l]) + gc * (o_c @ w_br_mem[l])
        x = x + rmsnorm(merged @ w_out[l], ln_mix_post[l])
        h = rmsnorm(x, ln_mlp_pre[l])
        x = x + rmsnorm(jnp.square(jax.nn.relu(h @ mlp_w1[l])) @ mlp_w2[l], ln_mlp_post[l])
    return x
```

```cpp
#include <hip/hip_runtime.h>
#include <hip/hip_cooperative_groups.h>
#include <cstdint>
#include <cstdio>
namespace cg = cooperative_groups;

#define LAS __attribute__((address_space(3)))
#define DI __device__ __forceinline__
typedef unsigned short bf16_t;
typedef short bf16x8 __attribute__((ext_vector_type(8)));
typedef short s16x4 __attribute__((ext_vector_type(4)));
typedef float f32x4 __attribute__((ext_vector_type(4)));
typedef float f32x16 __attribute__((ext_vector_type(16)));
typedef float f32x2 __attribute__((ext_vector_type(2)));
typedef unsigned u32x4 __attribute__((ext_vector_type(4)));
typedef unsigned u32x2 __attribute__((ext_vector_type(2)));
typedef __bf16 bf16x2v __attribute__((ext_vector_type(2)));
typedef unsigned long long u64;

constexpr int T_ = 16384, S_ = 8192, D_ = 1024, FF_ = 4096, LDP = 8960, NLAYER = 4;
constexpr int C_XR = 0, C_YR = 1024, C_Q = 2048, C_KC = 3072, C_VC = 3328, C_KS = 3584, C_VS = 3840, C_KW = 4096, C_VW = 4352,
              C_QM = 4608, C_GM = 5632, C_GN = 8704;
constexpr float EPS = 1e-6f;
constexpr float LOG2E = 1.4426950408889634f;

constexpr size_t al256(size_t x) { return (x + 255) & ~(size_t)255; }
constexpr size_t WS_PROJ = 0;
constexpr size_t WS_WIN = al256(WS_PROJ + (size_t)(T_ + 64) * LDP * 2);
constexpr size_t WS_WMKV = WS_WIN + (size_t)LDP * 1024 * 2;
constexpr size_t WS_WBRA = WS_WMKV + (size_t)2048 * 1024 * 2;
constexpr size_t WS_WBRB = WS_WBRA + (size_t)1024 * 1024 * 2;
constexpr size_t WS_WBRC = WS_WBRB + (size_t)1024 * 1024 * 2;
constexpr size_t WS_WOUT = WS_WBRC + (size_t)1024 * 1024 * 2;
constexpr size_t WS_WM1 = WS_WOUT + (size_t)1024 * 1024 * 2;
constexpr size_t WS_WM2 = WS_WM1 + (size_t)4096 * 1024 * 2;
constexpr size_t WS_WC1 = WS_WM2 + (size_t)4096 * 1024 * 2;
constexpr size_t WS_WC2 = WS_WC1 + (size_t)2 * 256 * 2048 * 2;
constexpr size_t WS_WLRU = WS_WC2 + (size_t)2 * 256 * 256 * 2;
constexpr size_t WS_H = WS_WLRU + (size_t)2048 * 128 * 2;
constexpr size_t WS_VTS = WS_H + (size_t)T_ * 1024 * 2;
constexpr size_t WS_VTW = WS_VTS + (size_t)8 * 64 * S_ * 2;
constexpr size_t WS_XC = WS_VTW + (size_t)8 * 64 * S_ * 2;
constexpr size_t WS_RI = WS_XC + (size_t)T_ * 1024 * 2;
constexpr size_t WS_HID = WS_RI + (size_t)T_ * 2048 * 2;
constexpr size_t WS_CRAW = WS_HID + (size_t)8192 * 256 * 2;
constexpr size_t WS_KCMP = WS_CRAW + (size_t)8192 * 64 * 4;
constexpr size_t WS_VTCMP = WS_KCMP + (size_t)8 * 512 * 64 * 2;
constexpr size_t WS_MEMN = WS_VTCMP + (size_t)8 * 512 * 64 * 2;
constexpr size_t WS_KMEM = WS_MEMN + (size_t)512 * 1024 * 2;
constexpr size_t WS_VTMEM = WS_KMEM + (size_t)512 * 1024 * 2;
constexpr size_t WS_SCA = WS_VTMEM + (size_t)512 * 1024 * 2;
constexpr size_t WS_SCH = WS_SCA + (size_t)2 * 128 * 1024 * 4;
constexpr size_t WS_CBP = WS_SCH + (size_t)2 * 128 * 1024 * 4;
constexpr size_t WS_CBIAS = WS_CBP + (size_t)16 * 512 * 4;
constexpr size_t WS_END = WS_CBIAS + 512 * 4;

constexpr int LDS_BYTES = 139264;

DI unsigned f2bf(float f) { unsigned u = __builtin_bit_cast(unsigned, f); return (u + 0x7fffu + ((u >> 16) & 1u)) >> 16; }
DI unsigned pk2(float lo, float hi) { f32x2 f = {lo, hi}; bf16x2v r = __builtin_convertvector(f, bf16x2v); return __builtin_bit_cast(unsigned, r); }
DI float bf2f(unsigned short b) { return __builtin_bit_cast(float, (unsigned)b << 16); }
DI float bflo(unsigned w) { return __builtin_bit_cast(float, w << 16); }
DI float bfhi(unsigned w) { return __builtin_bit_cast(float, w & 0xffff0000u); }
DI float fexp2(float x) { return __builtin_amdgcn_exp2f(x); }
DI float sigmoidf_(float x) { return 1.0f / (1.0f + fexp2(-x * LOG2E)); }
DI float gelu_tanh(float x) { const float z = 0.7978845608028654f * (x + 0.044715f * x * x * x); return x / (1.0f + fexp2(-2.0f * LOG2E * z)); }
DI float shx(float v, int mask, int lane) { return __builtin_bit_cast(float, __builtin_amdgcn_ds_bpermute((lane ^ mask) << 2, __builtin_bit_cast(int, v))); }
DI u64 shx64(u64 v, int mask, int lane) { const int a = (lane ^ mask) << 2; const unsigned lo = (unsigned)__builtin_amdgcn_ds_bpermute(a, (int)(unsigned)v), hi = (unsigned)__builtin_amdgcn_ds_bpermute(a, (int)(unsigned)(v >> 32)); return ((u64)hi << 32) | lo; }
DI int opaque_s(int v) { asm volatile("" : "+s"(v)); return v; }
DI float wave_sum(float v, int lane) {
#pragma unroll
    for (int o = 1; o < 64; o <<= 1) v += shx(v, o, lane);
    return v;
}

namespace pg8 {
constexpr int BM = 256, BK = 64, HALF = 128, HTB = HALF * BK * 2, STAGE_BYTES = 8 * HTB, NXCD = 8, WGM = 8;
__host__ __device__ __forceinline__ int lds_byte(int r, int c) { const int st = (r >> 4) * 2 + (c >> 5), rr = r & 15, cc = c & 31, ob = rr * 64 + cc * 2; return st * 1024 + (ob ^ (((ob >> 9) & 1) << 5)); }
__host__ __device__ __forceinline__ void stage_rc(int b, int& R, int& C) { const int st = b / 1024, sb = b % 1024, swz = sb ^ (((sb >> 9) & 1) << 5); R = (st >> 1) * 16 + swz / 64; C = (st & 1) * 32 + (swz % 64) / 2; }
__host__ __device__ __forceinline__ int perm32(int rho) { const int n = rho >> 4, i = rho & 15; return 8 * (i >> 2) + 4 * n + (i & 3); }

struct Unit { int pm, pn; unsigned aoff, boff; };
struct Gemm { const bf16_t* A; const bf16_t* Bt; int lda, ldb, K, kstepA, kstepB; };

struct Sched {
    int nM, nN, G, c, kind, mdiv; unsigned a0, sAm, sAn, b0, sBn, sBb;
    DI bool next(int i, Unit& u) const {
        const long L = (long)i * G + c; const int nwg = nM * nN; if (L >= nwg) return false;
        int wgid = (int)L; { const int q = nwg / NXCD, r = nwg % NXCD, xcd = wgid % NXCD, off = wgid / NXCD; wgid = (xcd < r ? xcd * (q + 1) : r * (q + 1) + (xcd - r) * q) + off; }
        const int nig = WGM * nN, gid = wgid / nig, fm = gid * WGM, gsz = (nM - fm) < WGM ? (nM - fm) : WGM;
        const int pm = fm + ((wgid % nig) % gsz), pn = (wgid % nig) / gsz;
        u.pm = pm; u.pn = pn;
        if (kind == 1) {
            const int j = pm >> 4, b = (pm >> 3) & 1, g = (pm >> 1) & 3, ch = pm & 1;
            u.aoff = (unsigned)(((b * S_ + ch * 4096) * LDP + C_KC + j * 256 + g * 64) * 2); u.boff = (unsigned)(j * 256 * 2048 * 2);
        } else { const unsigned bb = (unsigned)(pm / mdiv); u.aoff = a0 + (unsigned)pm * sAm + (unsigned)pn * sAn; u.boff = b0 + (unsigned)pn * sBn + bb * sBb; }
        return true;
    }
};

DI unsigned cvt_pk_bf16(float lo, float hi) { return pk2(lo, hi); }

struct EpiBf16 {
    static constexpr bool PERM = true;
    bf16_t* O; int ldc; int act; float scale; const float* bias; int oc0;
    DI void operator()(const f32x4 (&acc)[2][2][4][2], const Unit& u, int wr, int wc, int fr, int fq) const {
        const int row0 = u.pm * 256 + wr * 64 + fr, col0 = oc0 + u.pn * 256 + wc * 32 + 8 * fq, bc0 = (u.pm >> 4) * 256 + wc * 32 + 8 * fq;
#pragma unroll
        for (int ai = 0; ai < 2; ++ai)
#pragma unroll
            for (int m = 0; m < 4; ++m) { bf16_t* rowp = O + (size_t)(row0 + ai * HALF + m * 16) * ldc + col0;
#pragma unroll
                for (int bj = 0; bj < 2; ++bj) { f32x4 v0 = acc[ai][bj][m][0], v1 = acc[ai][bj][m][1];
                    if (act == 0) { v0 = v0 * scale; v1 = v1 * scale; }
                    else if (act == 1) {
#pragma unroll
                        for (int e = 0; e < 4; ++e) { const float a = fmaxf(v0[e], 0.f), b = fmaxf(v1[e], 0.f); v0[e] = a * a; v1[e] = b * b; } }
                    else { const f32x4 b0 = *(const f32x4*)(bias + bc0 + bj * HALF), b1 = *(const f32x4*)(bias + bc0 + bj * HALF + 4);
#pragma unroll
                        for (int e = 0; e < 4; ++e) { v0[e] = gelu_tanh(v0[e] + b0[e]); v1[e] = gelu_tanh(v1[e] + b1[e]); } }
                    u32x4 w; w.x = cvt_pk_bf16(v0[0], v0[1]); w.y = cvt_pk_bf16(v0[2], v0[3]); w.z = cvt_pk_bf16(v1[0], v1[1]); w.w = cvt_pk_bf16(v1[2], v1[3]);
                    *(u32x4*)(rowp + bj * HALF) = w; } }
    }
};
struct EpiF32 {
    static constexpr bool PERM = false;
    float* O; int ldc; int ncol;
    DI void operator()(const f32x4 (&acc)[2][2][4][2], const Unit& u, int wr, int wc, int fr, int fq) const {
        const int row0 = u.pm * 256 + wr * 64 + fr, col0 = u.pn * 256 + wc * 32 + 4 * fq;
#pragma unroll
        for (int ai = 0; ai < 2; ++ai)
#pragma unroll
            for (int m = 0; m < 4; ++m) { float* rowp = O + (size_t)(row0 + ai * HALF + m * 16) * ldc;
#pragma unroll
                for (int bj = 0; bj < 2; ++bj)
#pragma unroll
                    for (int n = 0; n < 2; ++n) { const int c = col0 + bj * HALF + n * 16; if (c < ncol) *(f32x4*)(rowp + c) = acc[ai][bj][m][n]; } }
    }
};
struct EpiMerge {
    static constexpr bool PERM = false;
    const bf16_t* gate; int ldg; float* M; bf16_t* Hout; int mode;
    DI void operator()(const f32x4 (&acc)[2][2][4][2], const Unit& u, int wr, int wc, int fr, int fq) const {
        const int row0 = u.pm * 256 + wr * 64 + fr, col0 = u.pn * 256 + wc * 32 + 4 * fq;
#pragma unroll
        for (int ai = 0; ai < 2; ++ai)
#pragma unroll
            for (int m = 0; m < 4; ++m) { const size_t r = (size_t)(row0 + ai * HALF + m * 16);
#pragma unroll
                for (int bj = 0; bj < 2; ++bj)
#pragma unroll
                    for (int n = 0; n < 2; ++n) { const int c = col0 + bj * HALF + n * 16;
                        const u32x2 gw = *(const u32x2*)(gate + r * ldg + c);
                        f32x4 g; g[0] = sigmoidf_(bflo(gw.x)); g[1] = sigmoidf_(bfhi(gw.x)); g[2] = sigmoidf_(bflo(gw.y)); g[3] = sigmoidf_(bfhi(gw.y));
                        f32x4 v = acc[ai][bj][m][n] * g;
                        float* mp = M + r * 1024 + c;
                        if (mode != 0) v = v + *(const f32x4*)mp;
                        if (mode != 2) *(f32x4*)mp = v;
                        else { u32x2 w; w.x = cvt_pk_bf16(v[0], v[1]); w.y = cvt_pk_bf16(v[2], v[3]); *(u32x2*)(Hout + r * 1024 + c) = w; } } }
    }
};

template <class Epi>
DI void gemm_phase(LAS unsigned char* lds, const Gemm g, const Sched& S, const Epi& E) {
    int tid = threadIdx.x; asm volatile("" : "+v"(tid));
    const int wid = __builtin_amdgcn_readfirstlane(tid >> 6), lane = tid & 63, wr = wid >> 2, wc = wid & 3, fr = lane & 15, fq = lane >> 4;
    const int nt = opaque_s(g.K / BK);
    unsigned voffA[2], voffB[2];
#pragma unroll
    for (int i = 0; i < 2; ++i) { int R, C; stage_rc(tid * 16 + i * 8192, R, C); const int Rb = Epi::PERM ? ((R & ~31) + perm32(R & 31)) : R;
        voffA[i] = (unsigned)(R * g.lda + C) * 2u; voffB[i] = (unsigned)(Rb * g.ldb + C) * 2u; }
    const size_t kstepA = (size_t)g.kstepA, kstepB = (size_t)g.kstepB;
    const size_t hstepA = (size_t)HALF * g.lda * 2, hstepB = (size_t)HALF * g.ldb * 2;
    const unsigned ldsw = (unsigned)wid * 1024u;
    const int aoff = lds_byte(wr * 64 + fr, fq * 8), boff = lds_byte(wc * 32 + fr, fq * 8);
#define PG8_SA(b, h) (((b) * 2 + (h)) * HTB)
#define PG8_SB(b, h) ((4 + (b) * 2 + (h)) * HTB)
#define PG8_STAGE(bufoff, gbase, voff) do { _Pragma("unroll") for (int _i = 0; _i < 2; ++_i) \
        __builtin_amdgcn_global_load_lds((const unsigned*)((const char*)(gbase) + (voff)[_i]), (LAS unsigned*)(lds + (bufoff) + ldsw + _i * 8192), 16, 0, 0); } while (0)
#define PG8_LDA(dst, b, h) do { _Pragma("unroll") for (int m = 0; m < 4; ++m) _Pragma("unroll") for (int k = 0; k < 2; ++k) dst[m][k] = *(const LAS bf16x8*)(lds + PG8_SA(b, h) + aoff + m * 2048 + k * 1024); } while (0)
#define PG8_LDB(dst, b, h) do { _Pragma("unroll") for (int n = 0; n < 2; ++n) _Pragma("unroll") for (int k = 0; k < 2; ++k) dst[n][k] = *(const LAS bf16x8*)(lds + PG8_SB(b, h) + boff + n * 2048 + k * 1024); } while (0)
#define PG8_MMA(ai, bj, At, Bt) do { __builtin_amdgcn_s_setprio(1); _Pragma("unroll") for (int m = 0; m < 4; ++m) _Pragma("unroll") for (int n = 0; n < 2; ++n) _Pragma("unroll") for (int k = 0; k < 2; ++k) \
        acc[ai][bj][m][n] = __builtin_amdgcn_mfma_f32_16x16x32_bf16(Bt[n][k], At[m][k], acc[ai][bj][m][n], 0, 0, 0); __builtin_amdgcn_s_setprio(0); } while (0)
#define PG8_WAIT_V(n) asm volatile("s_waitcnt vmcnt(" #n ")" ::: "memory")
#define PG8_WAIT_L(n) asm volatile("s_waitcnt lgkmcnt(" #n ")" ::: "memory")
#define PG8_BAR __builtin_amdgcn_s_barrier()
#define PG8_SCHED __builtin_amdgcn_sched_barrier(0)
    Unit cur, nxt; int ui = 0;
    if (!S.next(0, cur)) return;
    f32x4 acc[2][2][4][2];
#pragma unroll
    for (int a = 0; a < 2; ++a)
#pragma unroll
        for (int b = 0; b < 2; ++b)
#pragma unroll
            for (int m = 0; m < 4; ++m)
#pragma unroll
                for (int n = 0; n < 2; ++n) acc[a][b][m][n] = (f32x4){0.f, 0.f, 0.f, 0.f};
    bf16x8 At[4][2], B0[2][2], B1[2][2];
    const char* cA = (const char*)g.A + cur.aoff; const char* cB = (const char*)g.Bt + cur.boff;
    PG8_STAGE(PG8_SB(0, 0), cB, voffB); PG8_STAGE(PG8_SB(0, 1), cB + hstepB, voffB); PG8_STAGE(PG8_SA(0, 0), cA, voffA); PG8_STAGE(PG8_SA(0, 1), cA + hstepA, voffA);
    if (wr == 1) PG8_BAR;
    PG8_WAIT_V(2); PG8_BAR;
    PG8_STAGE(PG8_SB(1, 0), cB + kstepB, voffB); PG8_STAGE(PG8_SA(1, 0), cA + kstepA, voffA); PG8_STAGE(PG8_SB(1, 1), cB + hstepB + kstepB, voffB);
    PG8_WAIT_V(6); PG8_BAR;
    for (;;) {
        const bool has_next = S.next(ui + 1, nxt);
        const char* nA = has_next ? (const char*)g.A + nxt.aoff : cA; const char* nB = has_next ? (const char*)g.Bt + nxt.boff : cB;
        for (int t = 0; t < nt; t += 2) {
            const bool last = (t == nt - 2);
            const char* a1 = cA + (size_t)(t + 1) * kstepA;
            const char* a2 = last ? nA : cA + (size_t)(t + 2) * kstepA; const char* b2 = last ? nB : cB + (size_t)(t + 2) * kstepB;
            const char* a3 = a2 + kstepA; const char* b3 = b2 + kstepB;
            PG8_LDB(B0, 0, 0); PG8_LDB(B1, 0, 1); PG8_SCHED; PG8_LDA(At, 0, 0); PG8_STAGE(PG8_SA(1, 1), a1 + hstepA, voffA);
            PG8_WAIT_V(8); PG8_WAIT_L(0); PG8_BAR; PG8_MMA(0, 0, At, B0); PG8_MMA(0, 1, At, B1); PG8_BAR; PG8_SCHED;
            PG8_LDA(At, 0, 1); PG8_STAGE(PG8_SB(0, 0), b2, voffB); PG8_STAGE(PG8_SB(0, 1), b2 + hstepB, voffB); PG8_STAGE(PG8_SA(0, 0), a2, voffA);
            PG8_WAIT_V(8); PG8_WAIT_L(0); PG8_BAR; PG8_MMA(1, 0, At, B0); PG8_MMA(1, 1, At, B1); PG8_BAR; PG8_SCHED;
            PG8_LDB(B0, 1, 0); PG8_LDB(B1, 1, 1); PG8_SCHED; PG8_LDA(At, 1, 0); PG8_STAGE(PG8_SA(0, 1), a2 + hstepA, voffA);
            PG8_WAIT_V(8); PG8_WAIT_L(0); PG8_BAR; PG8_MMA(0, 0, At, B0); PG8_MMA(0, 1, At, B1); PG8_BAR; PG8_SCHED;
            PG8_LDA(At, 1, 1); PG8_STAGE(PG8_SB(1, 0), b3, voffB); PG8_STAGE(PG8_SB(1, 1), b3 + hstepB, voffB); PG8_STAGE(PG8_SA(1, 0), a3, voffA);
            PG8_WAIT_V(8); PG8_WAIT_L(0); PG8_BAR; PG8_MMA(1, 0, At, B0); PG8_MMA(1, 1, At, B1); PG8_BAR; PG8_SCHED;
        }
        if (wr == 0) PG8_BAR;
        E(acc, cur, wr, wc, fr, fq);
        if (!has_next) break;
#pragma unroll
        for (int a = 0; a < 2; ++a)
#pragma unroll
            for (int b = 0; b < 2; ++b)
#pragma unroll
                for (int m = 0; m < 4; ++m)
#pragma unroll
                    for (int n = 0; n < 2; ++n) acc[a][b][m][n] = (f32x4){0.f, 0.f, 0.f, 0.f};
        cur = nxt; cA = nA; cB = nB; ++ui;
        if (wr == 1) PG8_BAR;
    }
    PG8_WAIT_V(0);
    PG8_BAR;
#undef PG8_SA
#undef PG8_SB
#undef PG8_STAGE
#undef PG8_LDA
#undef PG8_LDB
#undef PG8_MMA
#undef PG8_WAIT_V
#undef PG8_WAIT_L
#undef PG8_BAR
#undef PG8_SCHED
}
}

struct Params {
    const float* x; const float* mem; const int* pos;
    const float* ln_mix_pre; const float* w_in; const float* conv_w; const float* conv_b;
    const float* lru_wr; const float* lru_br; const float* lru_wi; const float* lru_bi; const float* lru_lambda;
    const float* cmp_pe; const float* cmp_w1; const float* cmp_b1; const float* cmp_w2;
    const float* ln_mem; const float* w_mem_kv; const float* w_br_rnn; const float* w_br_nsa; const float* w_br_mem; const float* w_out;
    const float* ln_mix_post; const float* ln_mlp_pre; const float* mlp_w1; const float* mlp_w2; const float* ln_mlp_post;
    float* out; unsigned char* ws;
};
typedef const __attribute__((address_space(4))) Params* PP;
#define PPOPAQ() asm volatile("" : "+s"(pp))

DI void tr_item(const float* W, int ldw, int srccol, int valid, int k0, bf16_t* WT, int ldt, int drow0, LAS float* scr, int lane) {
    const int c32 = lane & 31;
#pragma unroll 8
    for (int i = 0; i < 32; ++i) { const int kk = 2 * i + (lane >> 5); float v = 0.f; if (c32 < valid) v = W[(size_t)(k0 + kk) * ldw + srccol + c32]; scr[kk * 33 + c32] = v; }
    __builtin_amdgcn_s_waitcnt(0xc07f); asm volatile("s_waitcnt lgkmcnt(0)" ::: "memory");
    const int c = lane & 7;
#pragma unroll
    for (int j = 0; j < 4; ++j) { const int n = (lane >> 3) + 8 * j; const LAS float* s = scr + (8 * c) * 33 + n;
        u32x4 o; o.x = pk2(s[0 * 33], s[1 * 33]); o.y = pk2(s[2 * 33], s[3 * 33]); o.z = pk2(s[4 * 33], s[5 * 33]); o.w = pk2(s[6 * 33], s[7 * 33]);
        *(u32x4*)(WT + (size_t)(drow0 + n) * ldt + k0 + 8 * c) = o; }
    asm volatile("s_waitcnt lgkmcnt(0)" ::: "memory");
}

DI void prep_phase(PP pp, int l, LAS unsigned char* lds) {
    PPOPAQ();
    int tid = threadIdx.x; asm volatile("" : "+v"(tid));
    const int lane = tid & 63, wave = __builtin_amdgcn_readfirstlane(tid >> 6);
    const int G_ = opaque_s((int)gridDim.x), bx_ = opaque_s((int)blockIdx.x);
    const int gw = bx_ * 8 + wave, NGW = G_ * 8, gtid = bx_ * 512 + tid, NT = G_ * 512;
    (void)lane; (void)wave; (void)gw; (void)NGW; (void)gtid; (void)NT;
    LAS float* scr = (LAS float*)(lds + wave * 8704);
    unsigned char* ws = pp->ws;
    const float* w_in = pp->w_in + (size_t)l * 1024 * 8752;
    constexpr int I_IN = 16 * 280, I_MKV = 16 * 64, I_BR = 16 * 32, I_M1 = 16 * 128, I_M2 = 64 * 32, I_C1 = 2 * 32 * 8, I_C2 = 2 * 4 * 8, I_LRU = 2 * 8 * 2 * 4;
    constexpr int NITEMS = I_IN + I_MKV + 4 * I_BR + I_M1 + I_M2 + I_C1 + I_C2 + I_LRU;
    for (int it = gw; it < NITEMS; it += NGW) {
        int r = it;
        if (r < I_IN) { const int kb = r / 280, nb = r % 280, n0 = 32 * nb; int src, valid = 32;
            if (n0 < 4608) src = n0; else if (n0 < 5632) src = n0 - 4608 + 4656; else if (n0 < 8704) src = n0 - 5632 + 5680;
            else { src = n0 - 8704 + 4608; valid = 48 - (n0 - 8704); valid = valid < 0 ? 0 : (valid > 32 ? 32 : valid); if (valid == 0) src = 0; }
            tr_item(w_in, 8752, src, valid, 64 * kb, (bf16_t*)(ws + WS_WIN), 1024, n0, scr, lane); continue; } r -= I_IN;
        if (r < I_MKV) { tr_item(pp->w_mem_kv + (size_t)l * 1024 * 2048, 2048, 32 * (r % 64), 32, 64 * (r / 64), (bf16_t*)(ws + WS_WMKV), 1024, 32 * (r % 64), scr, lane); continue; } r -= I_MKV;
        if (r < I_BR) { tr_item(pp->w_br_rnn + (size_t)l * 1024 * 1024, 1024, 32 * (r % 32), 32, 64 * (r / 32), (bf16_t*)(ws + WS_WBRA), 1024, 32 * (r % 32), scr, lane); continue; } r -= I_BR;
        if (r < I_BR) { tr_item(pp->w_br_nsa + (size_t)l * 1024 * 1024, 1024, 32 * (r % 32), 32, 64 * (r / 32), (bf16_t*)(ws + WS_WBRB), 1024, 32 * (r % 32), scr, lane); continue; } r -= I_BR;
        if (r < I_BR) { tr_item(pp->w_br_mem + (size_t)l * 1024 * 1024, 1024, 32 * (r % 32), 32, 64 * (r / 32), (bf16_t*)(ws + WS_WBRC), 1024, 32 * (r % 32), scr, lane); continue; } r -= I_BR;
        if (r < I_BR) { tr_item(pp->w_out + (size_t)l * 1024 * 1024, 1024, 32 * (r % 32), 32, 64 * (r / 32), (bf16_t*)(ws + WS_WOUT), 1024, 32 * (r % 32), scr, lane); continue; } r -= I_BR;
        if (r < I_M1) { tr_item(pp->mlp_w1 + (size_t)l * 1024 * 4096, 4096, 32 * (r % 128), 32, 64 * (r / 128), (bf16_t*)(ws + WS_WM1), 1024, 32 * (r % 128), scr, lane); continue; } r -= I_M1;
        if (r < I_M2) { tr_item(pp->mlp_w2 + (size_t)l * 4096 * 1024, 1024, 32 * (r % 32), 32, 64 * (r / 32), (bf16_t*)(ws + WS_WM2), 4096, 32 * (r % 32), scr, lane); continue; } r -= I_M2;
        if (r < I_C1) { const int j = r / 256, q = r % 256;
            tr_item(pp->cmp_w1 + ((size_t)l * 2 + j) * 2048 * 256, 256, 32 * (q % 8), 32, 64 * (q / 8), (bf16_t*)(ws + WS_WC1) + (size_t)j * 256 * 2048, 2048, 32 * (q % 8), scr, lane); continue; } r -= I_C1;
        if (r < I_C2) { const int j = r / 32, q = r % 32; const int n0 = 32 * (q % 8);
            tr_item(pp->cmp_w2 + ((size_t)l * 2 + j) * 256 * 64, 64, n0 < 64 ? n0 : 0, n0 < 64 ? 32 : 0, 64 * (q / 8), (bf16_t*)(ws + WS_WC2) + (size_t)j * 256 * 256, 256, n0, scr, lane); continue; } r -= I_C2;
        { const int ri = r / 64, q = r % 64, blk = q / 8, q2 = q % 8;
            const float* W = (ri == 0 ? pp->lru_wr : pp->lru_wi) + ((size_t)l * 8 + blk) * 128 * 128;
            tr_item(W, 128, 32 * (q2 % 4), 32, 64 * (q2 / 4), (bf16_t*)(ws + WS_WLRU), 128, blk * 256 + ri * 128 + 32 * (q2 % 4), scr, lane); }
    }
    for (int m = gw; m < 512; m += NGW) {
        const f32x4* xr = (const f32x4*)(pp->mem + (size_t)m * 1024) + lane; const f32x4* gr = (const f32x4*)(pp->ln_mem + (size_t)l * 1024) + lane;
        f32x4 v[4]; float s = 0.f;
#pragma unroll
        for (int j = 0; j < 4; ++j) { v[j] = xr[64 * j]; s += (v[j].x * v[j].x + v[j].y * v[j].y) + (v[j].z * v[j].z + v[j].w * v[j].w); }
        const float rs = 1.0f / sqrtf(wave_sum(s, lane) * (1.f / 1024.f) + EPS);
        u32x2* o8 = (u32x2*)((bf16_t*)(ws + WS_MEMN) + (size_t)m * 1024) + lane;
#pragma unroll
        for (int j = 0; j < 4; ++j) { const f32x4 g = gr[64 * j]; u32x2 w; w.x = pk2(v[j].x * rs * g.x, v[j].y * rs * g.y); w.y = pk2(v[j].z * rs * g.z, v[j].w * rs * g.w); o8[64 * j] = w; }
    }
    {
        const int gt = gw * 64 + lane;
        if (gt < 16 * 512) { const int prt = gt / 512, jn = gt % 512, j = jn / 256, n = jn % 256;
            const float* w1 = pp->cmp_w1 + ((size_t)l * 2 + j) * 2048 * 256 + n; const float* pe = pp->cmp_pe + ((size_t)l * 2 + j) * 2048;
            float s = 0.f;
            for (int k = prt * 128; k < prt * 128 + 128; ++k) s += pe[k] * w1[(size_t)k * 256];
            ((float*)(ws + WS_CBP))[gt] = s; }
    }
}

DI void row_phase(const float* xin, const float* y, const float* gpost, float* xout, const float* gnext, bf16_t* hout) {
    int tid = threadIdx.x; asm volatile("" : "+v"(tid));
    const int lane = tid & 63, wave = __builtin_amdgcn_readfirstlane(tid >> 6);
    const int G_ = opaque_s((int)gridDim.x), bx_ = opaque_s((int)blockIdx.x);
    const int gw = bx_ * 8 + wave, NGW = G_ * 8, gtid = bx_ * 512 + tid, NT = G_ * 512;
    (void)lane; (void)wave; (void)gw; (void)NGW; (void)gtid; (void)NT;
    for (int m = gw; m < T_; m += NGW) {
        const f32x4* xr = (const f32x4*)(xin + (size_t)m * 1024) + lane;
        f32x4 v[4];
#pragma unroll
        for (int j = 0; j < 4; ++j) v[j] = xr[64 * j];
        if (y) {
            const f32x4* yr = (const f32x4*)(y + (size_t)m * 1024) + lane; const f32x4* gr = (const f32x4*)gpost + lane;
            f32x4 w[4]; float s = 0.f;
#pragma unroll
            for (int j = 0; j < 4; ++j) { w[j] = yr[64 * j]; s += (w[j].x * w[j].x + w[j].y * w[j].y) + (w[j].z * w[j].z + w[j].w * w[j].w); }
            const float rs = 1.0f / sqrtf(wave_sum(s, lane) * (1.f / 1024.f) + EPS);
            f32x4* xo = (f32x4*)(xout + (size_t)m * 1024) + lane;
#pragma unroll
            for (int j = 0; j < 4; ++j) { v[j] = v[j] + w[j] * rs * gr[64 * j]; xo[64 * j] = v[j]; }
        }
        if (hout) {
            float s = 0.f;
#pragma unroll
            for (int j = 0; j < 4; ++j) s += (v[j].x * v[j].x + v[j].y * v[j].y) + (v[j].z * v[j].z + v[j].w * v[j].w);
            const float rs = 1.0f / sqrtf(wave_sum(s, lane) * (1.f / 1024.f) + EPS);
            const f32x4* gr = (const f32x4*)gnext + lane; u32x2* o8 = (u32x2*)(hout + (size_t)m * 1024) + lane;
#pragma unroll
            for (int j = 0; j < 4; ++j) { const f32x4 g = gr[64 * j]; u32x2 w; w.x = pk2(v[j].x * rs * g.x, v[j].y * rs * g.y); w.y = pk2(v[j].z * rs * g.z, v[j].w * rs * g.w); o8[64 * j] = w; }
        }
    }
}

DI void rope8(u32x4& lo, u32x4& hi, float pos, int d0, float scale) {
    unsigned* pl = (unsigned*)&lo; unsigned* ph = (unsigned*)&hi;
    float x1[8], x2[8];
#pragma unroll
    for (int e = 0; e < 4; ++e) { x1[2 * e] = bflo(pl[e]); x1[2 * e + 1] = bfhi(pl[e]); x2[2 * e] = bflo(ph[e]); x2[2 * e + 1] = bfhi(ph[e]); }
#pragma unroll
    for (int e = 0; e < 8; ++e) {
        const float inv = fexp2(-(float)(d0 + e) * 0.41524101186092029f);
        const float ang = pos * inv;
        const double rev = (double)ang * 0.15915494309189535; const float fr = (float)(rev - __builtin_rint(rev));
        const float sn = __builtin_amdgcn_sinf(fr), cs = __builtin_amdgcn_cosf(fr);
        const float a = (x1[e] * cs - x2[e] * sn) * scale, b = (x2[e] * cs + x1[e] * sn) * scale; x1[e] = a; x2[e] = b;
    }
#pragma unroll
    for (int e = 0; e < 4; ++e) { pl[e] = pk2(x1[2 * e], x1[2 * e + 1]); ph[e] = pk2(x2[2 * e], x2[2 * e + 1]); }
}

DI void postproj_phase(PP pp, int l) {
    PPOPAQ();
    int tid = threadIdx.x; asm volatile("" : "+v"(tid));
    const int lane = tid & 63, wave = __builtin_amdgcn_readfirstlane(tid >> 6);
    const int G_ = opaque_s((int)gridDim.x), bx_ = opaque_s((int)blockIdx.x);
    const int gw = bx_ * 8 + wave, NGW = G_ * 8, gtid = bx_ * 512 + tid, NT = G_ * 512;
    (void)lane; (void)wave; (void)gw; (void)NGW; (void)gtid; (void)NT;
    unsigned char* ws = pp->ws; bf16_t* PROJ = (bf16_t*)(ws + WS_PROJ);
    {
        const float* cw = pp->conv_w + (size_t)l * 4 * 1024; const float* cb = pp->conv_b + (size_t)l * 1024; bf16_t* XC = (bf16_t*)(ws + WS_XC);
        for (int i = gtid; i < T_ * 128; i += NT) { const int t = i >> 7, c8 = (i & 127) * 8, ts = t & (S_ - 1);
            float acc[8];
#pragma unroll
            for (int e = 0; e < 8; ++e) acc[e] = cb[c8 + e];
#pragma unroll
            for (int w = 0; w < 4; ++w) { if (ts - 3 + w >= 0) { const u32x4 xv = *(const u32x4*)(PROJ + (size_t)(t - 3 + w) * LDP + C_XR + c8); const unsigned* xp = (const unsigned*)&xv;
                    const f32x4 k0 = *(const f32x4*)(cw + w * 1024 + c8), k1 = *(const f32x4*)(cw + w * 1024 + c8 + 4);
                    acc[0] += k0.x * bflo(xp[0]); acc[1] += k0.y * bfhi(xp[0]); acc[2] += k0.z * bflo(xp[1]); acc[3] += k0.w * bfhi(xp[1]);
                    acc[4] += k1.x * bflo(xp[2]); acc[5] += k1.y * bfhi(xp[2]); acc[6] += k1.z * bflo(xp[3]); acc[7] += k1.w * bfhi(xp[3]); } }
            u32x4 o; o.x = pk2(acc[0], acc[1]); o.y = pk2(acc[2], acc[3]); o.z = pk2(acc[4], acc[5]); o.w = pk2(acc[6], acc[7]);
            *(u32x4*)(XC + (size_t)t * 1024 + c8) = o; }
    }
    for (int i = gtid; i < T_ * 24 * 4; i += NT) { const int t = i / 96, r = i % 96, hd = r >> 2, d0 = (r & 3) * 8;
        int col; float sc = 1.0f;
        if (hd < 16) { col = C_Q + hd * 64; sc = 0.125f * LOG2E; } else if (hd < 20) col = C_KS + (hd - 16) * 64; else col = C_KW + (hd - 20) * 64;
        bf16_t* base = PROJ + (size_t)t * LDP + col + d0;
        u32x4 lo = *(const u32x4*)base, hi = *(const u32x4*)(base + 32);
        rope8(lo, hi, (float)pp->pos[t], d0, sc);
        *(u32x4*)base = lo; *(u32x4*)(base + 32) = hi; }
    for (int i = gtid; i < 2 * 2 * 4 * 1024 * 64; i += NT) { const int d = i & 63, t8 = (i >> 6) & 1023, g = (i >> 16) & 3, b = (i >> 18) & 1, which = i >> 19;
        const bf16_t* src = PROJ + (size_t)(b * S_ + t8 * 8) * LDP + (which ? C_VW : C_VS) + g * 64 + d;
        unsigned short v[8];
#pragma unroll
        for (int e = 0; e < 8; ++e) v[e] = src[(size_t)e * LDP];
        u32x4 o; o.x = v[0] | ((unsigned)v[1] << 16); o.y = v[2] | ((unsigned)v[3] << 16); o.z = v[4] | ((unsigned)v[5] << 16); o.w = v[6] | ((unsigned)v[7] << 16);
        *(u32x4*)((bf16_t*)(ws + (which ? WS_VTW : WS_VTS)) + ((size_t)(b * 4 + g) * 64 + d) * S_ + t8 * 8) = o; }
    if (gtid < 512) { const float* part = (const float*)(ws + WS_CBP); float s = pp->cmp_b1[(size_t)l * 512 + gtid];
        for (int q = 0; q < 16; ++q) s += part[q * 512 + gtid];
        ((float*)(ws + WS_CBIAS))[gtid] = s; }
}

DI void lru_ab(float rp, float ip, float xc, float cl, float& a, float& bb) {
    const float la = cl * sigmoidf_(rp);
    a = fexp2(la * LOG2E);
    const float x2 = 2.0f * la;
    float om;
    if (x2 > -0.1f) om = -x2 * (1.0f + x2 * (0.5f + x2 * (0.16666667f + x2 * (0.041666668f + x2 * 0.0083333338f)))); else om = 1.0f - a * a;
    bb = sqrtf(om) * sigmoidf_(ip) * xc;
}
DI void scan_phase(PP pp, int l, int pass) {
    PPOPAQ();
    int tid = threadIdx.x; asm volatile("" : "+v"(tid));
    const int lane = tid & 63, wave = __builtin_amdgcn_readfirstlane(tid >> 6);
    const int G_ = opaque_s((int)gridDim.x), bx_ = opaque_s((int)blockIdx.x);
    const int gw = bx_ * 8 + wave, NGW = G_ * 8, gtid = bx_ * 512 + tid, NT = G_ * 512;
    (void)lane; (void)wave; (void)gw; (void)NGW; (void)gtid; (void)NT;
    unsigned char* ws = pp->ws; const bf16_t* RI = (const bf16_t*)(ws + WS_RI); bf16_t* XC = (bf16_t*)(ws + WS_XC); const bf16_t* PROJ = (const bf16_t*)(ws + WS_PROJ);
    float* SA = (float*)(ws + WS_SCA); float* SH = (float*)(ws + WS_SCH);
    for (int u = bx_; u < 512; u += G_) { const int hh = u & 1, k = (u >> 1) & 127, b = u >> 8;
        const int ch = hh * 512 + tid, blk = ch >> 7, cc = ch & 127, rcol = blk * 256 + cc;
        const float lam = pp->lru_lambda[(size_t)l * 1024 + ch];
        const float sp = (-lam > 20.f) ? -lam : log1pf(__expf(-lam));
        const float cl = -8.0f * sp, br = pp->lru_br[(size_t)l * 1024 + ch], bi = pp->lru_bi[(size_t)l * 1024 + ch];
        const size_t row0 = (size_t)b * S_ + k * 64;
        if (pass == 0) {
            float A = 1.f, H = 0.f;
#pragma unroll 4
            for (int s = 0; s < 64; ++s) { const size_t row = row0 + s; float a, bb;
                lru_ab(bf2f(RI[row * 2048 + rcol]) + br, bf2f(RI[row * 2048 + rcol + 128]) + bi, bf2f(XC[row * 1024 + ch]), cl, a, bb);
                A *= a; H = a * H + bb; }
            SA[((size_t)b * 128 + k) * 1024 + ch] = A; SH[((size_t)b * 128 + k) * 1024 + ch] = H;
        } else {
            float h = 0.f;
            for (int q = 0; q < k; ++q) h = SA[((size_t)b * 128 + q) * 1024 + ch] * h + SH[((size_t)b * 128 + q) * 1024 + ch];
#pragma unroll 4
            for (int s = 0; s < 64; ++s) { const size_t row = row0 + s; float a, bb;
                lru_ab(bf2f(RI[row * 2048 + rcol]) + br, bf2f(RI[row * 2048 + rcol + 128]) + bi, bf2f(XC[row * 1024 + ch]), cl, a, bb);
                h = a * h + bb;
                const float yr = bf2f(PROJ[row * LDP + C_YR + ch]);
                XC[row * 1024 + ch] = (bf16_t)f2bf(h * gelu_tanh(yr)); }
        }
    }
}

DI void memsoftmax_phase(PP pp) {
    PPOPAQ();
    int tid = threadIdx.x; asm volatile("" : "+v"(tid));
    const int lane = tid & 63, wave = __builtin_amdgcn_readfirstlane(tid >> 6);
    const int G_ = opaque_s((int)gridDim.x), bx_ = opaque_s((int)blockIdx.x);
    const int gw = bx_ * 8 + wave, NGW = G_ * 8, gtid = bx_ * 512 + tid, NT = G_ * 512;
    (void)lane; (void)wave; (void)gw; (void)NGW; (void)gtid; (void)NT;
    bf16_t* SP = (bf16_t*)(pp->ws + WS_H);
    for (int m = gw; m < T_; m += NGW) {
        u32x4* ptr = (u32x4*)(SP + (size_t)m * 1024 + lane * 16);
        u32x4 a = ptr[0], b = ptr[1]; const unsigned* pa = (const unsigned*)&a; const unsigned* pb = (const unsigned*)&b;
        float v[16];
#pragma unroll
        for (int e = 0; e < 4; ++e) { v[2 * e] = bflo(pa[e]); v[2 * e + 1] = bfhi(pa[e]); v[8 + 2 * e] = bflo(pb[e]); v[8 + 2 * e + 1] = bfhi(pb[e]); }
        float mx = v[0];
#pragma unroll
        for (int e = 1; e < 16; ++e) mx = fmaxf(mx, v[e]);
#pragma unroll
        for (int o = 1; o < 16; o <<= 1) mx = fmaxf(mx, shx(mx, o, lane));
        float s = 0.f;
#pragma unroll
        for (int e = 0; e < 16; ++e) { v[e] = fexp2(v[e] - mx); s += v[e]; }
#pragma unroll
        for (int o = 1; o < 16; o <<= 1) s += shx(s, o, lane);
        const float inv = 1.0f / s;
        u32x4 oa, ob; unsigned* qa = (unsigned*)&oa; unsigned* qb = (unsigned*)&ob;
#pragma unroll
        for (int e = 0; e < 4; ++e) { qa[e] = pk2(v[2 * e] * inv, v[2 * e + 1] * inv); qb[e] = pk2(v[8 + 2 * e] * inv, v[8 + 2 * e + 1] * inv); }
        ptr[0] = oa; ptr[1] = ob;
    }
}

DI void cmpfinal_phase(PP pp) {
    PPOPAQ();
    int tid = threadIdx.x; asm volatile("" : "+v"(tid));
    const int lane = tid & 63, wave = __builtin_amdgcn_readfirstlane(tid >> 6);
    const int G_ = opaque_s((int)gridDim.x), bx_ = opaque_s((int)blockIdx.x);
    const int gw = bx_ * 8 + wave, NGW = G_ * 8, gtid = bx_ * 512 + tid, NT = G_ * 512;
    (void)lane; (void)wave; (void)gw; (void)NGW; (void)gtid; (void)NT;
    unsigned char* ws = pp->ws; const float* CR = (const float*)(ws + WS_CRAW);
    for (int i = gtid; i < 2 * 4 * 512 * 32; i += NT) { const int d = i & 31, c = (i >> 5) & 511, bg = i >> 14, b = bg >> 2;
        const float* src = CR + ((size_t)bg * 512 + c) * 64; float x1 = src[d], x2 = src[d + 32];
        float o1 = 0.f, o2 = 0.f;
        if (c < 511) { const float pos = (float)pp->pos[b * S_ + 16 * c + 31]; const float inv = fexp2(-(float)d * 0.41524101186092029f); const float ang = pos * inv;
            const double rev = (double)ang * 0.15915494309189535; const float fr = (float)(rev - __builtin_rint(rev));
            const float sn = __builtin_amdgcn_sinf(fr), cs = __builtin_amdgcn_cosf(fr); o1 = x1 * cs - x2 * sn; o2 = x2 * cs + x1 * sn; }
        bf16_t* dst = (bf16_t*)(ws + WS_KCMP) + ((size_t)bg * 512 + c) * 64; dst[d] = (bf16_t)f2bf(o1); dst[d + 32] = (bf16_t)f2bf(o2); }
    for (int i = gtid; i < 2 * 4 * 64 * 512; i += NT) { const int c = i & 511, d = (i >> 9) & 63, bg = i >> 15;
        const float v = (c < 511) ? CR[((size_t)(8 + bg) * 512 + c) * 64 + d] : 0.f;
        ((bf16_t*)(ws + WS_VTCMP))[((size_t)bg * 64 + d) * 512 + c] = (bf16_t)f2bf(v); }
}

constexpr int KSTR = 144, VSTR = 136;
constexpr int L_K = 0, L_V = 2 * 64 * KSTR, L_IMP = L_V + 2 * 64 * VSTR, IMPSTR = 132, L_SEL = L_IMP + 64 * IMPSTR * 4, L_ATT_END = L_SEL + 64 * 16;
DI int crow(int r, int hi) { return (r & 3) + 8 * (r >> 2) + 4 * hi; }

struct TileSrc { const bf16_t* K; int kstr; const bf16_t* Vt; int vstr; };

template <int MODE>
DI void attn_loop(LAS unsigned char* lds, const TileSrc src, int j0, int j1, const bf16x8 (&qf)[4], f32x16 (&o)[2], float& m_run, float& l_run,
                  int tl, int t, int tb, u64 selLo, u64 selHi, int tid, int wave, int lane) {
    const int n = lane & 31, hh = lane >> 5;
    const int lrow = tid >> 3, lchunk = tid & 7;
    u32x4 kreg, vreg;
    kreg = *(const u32x4*)(src.K + (size_t)(64 * j0 + lrow) * src.kstr + lchunk * 8);
    vreg = *(const u32x4*)(src.Vt + (size_t)lrow * src.vstr + 64 * j0 + lchunk * 8);
    float carry = 0.f;
    int buf = 0;
    for (int j = j0; j <= j1; ++j) {
        LAS unsigned char* Kl = lds + L_K + buf * 64 * KSTR; LAS unsigned char* Vl = lds + L_V + buf * 64 * VSTR;
        *(LAS u32x4*)(Kl + lrow * KSTR + lchunk * 16) = kreg;
        *(LAS u32x2*)(Vl + lrow * VSTR + lchunk * 16) = (u32x2){vreg.x, vreg.y}; *(LAS u32x2*)(Vl + lrow * VSTR + lchunk * 16 + 8) = (u32x2){vreg.z, vreg.w};
        __syncthreads();
        if (j < j1) { kreg = *(const u32x4*)(src.K + (size_t)(64 * (j + 1) + lrow) * src.kstr + lchunk * 8);
                      vreg = *(const u32x4*)(src.Vt + (size_t)lrow * src.vstr + 64 * (j + 1) + lchunk * 8); }
        buf ^= 1;
        bool active = true;
        if (MODE == 2) { const bool bit = ((j < 64 ? selLo : selHi) >> (j & 63)) & 1ull; active = __ballot(bit) != 0ull; }
        if (!active) continue;
        f32x16 s[2];
#pragma unroll
        for (int u = 0; u < 2; ++u) {
#pragma unroll
            for (int e = 0; e < 16; ++e) s[u][e] = 0.f;
#pragma unroll
            for (int ks = 0; ks < 4; ++ks) { const bf16x8 kf = *(const LAS bf16x8*)(Kl + (32 * u + n) * KSTR + (ks * 16 + 8 * hh) * 2);
                s[u] = __builtin_amdgcn_mfma_f32_32x32x16_bf16(kf, qf[ks], s[u], 0, 0, 0); }
        }
        const float NEGINF = -__builtin_inff();
        if (MODE <= 1) { const int cmax = min(510, (t - 31) >> 4);
#pragma unroll
            for (int u = 0; u < 2; ++u)
#pragma unroll
                for (int e = 0; e < 16; ++e) { const int c = 64 * j + 32 * u + crow(e, hh); if (c > cmax) s[u][e] = NEGINF; }
        } else if (MODE == 2) { const bool bit = ((j < 64 ? selLo : selHi) >> (j & 63)) & 1ull; const int lim = (j == tb) ? tl : 64;
#pragma unroll
            for (int u = 0; u < 2; ++u)
#pragma unroll
                for (int e = 0; e < 16; ++e) { const int kk = 32 * u + crow(e, hh); if (!bit || kk > lim) s[u][e] = NEGINF; }
        } else {
#pragma unroll
            for (int u = 0; u < 2; ++u)
#pragma unroll
                for (int e = 0; e < 16; ++e) { const int df = t - (64 * j + 32 * u + crow(e, hh)); if ((unsigned)df >= 512u) s[u][e] = NEGINF; }
        }
        if (MODE == 1) {
            const float msafe = (m_run == NEGINF) ? 0.f : m_run;
#pragma unroll
            for (int u = 0; u < 2; ++u)
#pragma unroll
                for (int e = 0; e < 16; ++e) s[u][e] = fexp2(s[u][e] - msafe) * l_run;
            if (tb >= 16) {
                float w1[8], w2[8], pw2[8];
#pragma unroll
                for (int u = 0; u < 2; ++u)
#pragma unroll
                    for (int gi = 0; gi < 4; ++gi) { const float p0 = s[u][4 * gi], p1 = s[u][4 * gi + 1], p2 = s[u][4 * gi + 2], p3 = s[u][4 * gi + 3];
                        w1[u * 4 + gi] = p0 + p1 + p2 + 0.5f * p3; w2[u * 4 + gi] = 0.5f * p3; }
#pragma unroll
                for (int q = 0; q < 8; ++q) pw2[q] = shx(w2[q], 32, lane);
                float tot[8];
#pragma unroll
                for (int q = 0; q < 8; ++q) { const float prev = (q == 0) ? carry : pw2[q > 0 ? q - 1 : 0]; tot[q] = w1[q] + (hh ? pw2[q] : prev); }
                carry = pw2[7];
#pragma unroll
                for (int q = 0; q < 8; ++q) { float v = tot[q]; v += shx(v, 1, lane); v += shx(v, 2, lane); tot[q] = v; }
                if ((n & 3) == 0) { LAS float* imp = (LAS float*)(lds + L_IMP) + (8 * wave + (n >> 2)) * IMPSTR;
#pragma unroll
                    for (int q = 0; q < 8; ++q) { const int jj = 16 * j + 8 * (q >> 2) + 2 * (q & 3) + hh; if (jj < 128) imp[jj] = tot[q]; } }
            }
        } else {
            float mloc = s[0][0];
#pragma unroll
            for (int u = 0; u < 2; ++u)
#pragma unroll
                for (int e = 0; e < 16; ++e) mloc = fmaxf(mloc, s[u][e]);
            mloc = fmaxf(mloc, shx(mloc, 32, lane));
            const float mnew = fmaxf(m_run, mloc); const float msafe = (mnew == NEGINF) ? 0.f : mnew;
            const float alpha = fexp2(m_run - msafe);
            float ls = 0.f;
#pragma unroll
            for (int u = 0; u < 2; ++u)
#pragma unroll
                for (int e = 0; e < 16; ++e) { s[u][e] = fexp2(s[u][e] - msafe); ls += s[u][e]; }
            l_run = l_run * alpha + ls; m_run = mnew;
            if (MODE != 0) {
#pragma unroll
                for (int ds = 0; ds < 2; ++ds)
#pragma unroll
                    for (int e = 0; e < 16; ++e) o[ds][e] *= alpha;
            }
        }
        if (MODE != 0) {
#pragma unroll
            for (int u = 0; u < 2; ++u)
#pragma unroll
                for (int st = 0; st < 2; ++st) {
                    u32x4 pp; pp.x = pk2(s[u][8 * st], s[u][8 * st + 1]); pp.y = pk2(s[u][8 * st + 2], s[u][8 * st + 3]); pp.z = pk2(s[u][8 * st + 4], s[u][8 * st + 5]); pp.w = pk2(s[u][8 * st + 6], s[u][8 * st + 7]);
                    const bf16x8 pb = __builtin_bit_cast(bf16x8, pp);
#pragma unroll
                    for (int ds = 0; ds < 2; ++ds) { const LAS unsigned char* vp = Vl + (32 * ds + n) * VSTR + (32 * u + 16 * st + 4 * hh) * 2;
                        const u32x2 a0 = *(const LAS u32x2*)vp, a1 = *(const LAS u32x2*)(vp + 16);
                        const u32x4 av = {a0.x, a0.y, a1.x, a1.y};
                        o[ds] = __builtin_amdgcn_mfma_f32_32x32x16_bf16(__builtin_bit_cast(bf16x8, av), pb, o[ds], 0, 0, 0); }
                }
        }
    }
    __syncthreads();
}

DI void attn_phase(PP pp, LAS unsigned char* lds) {
    PPOPAQ();
    int tid = threadIdx.x; asm volatile("" : "+v"(tid));
    const int lane = tid & 63, wave = __builtin_amdgcn_readfirstlane(tid >> 6);
    const int G_ = opaque_s((int)gridDim.x), bx_ = opaque_s((int)blockIdx.x);
    const int gw = bx_ * 8 + wave, NGW = G_ * 8, gtid = bx_ * 512 + tid, NT = G_ * 512;
    (void)lane; (void)wave; (void)gw; (void)NGW; (void)gtid; (void)NT;
    unsigned char* ws = pp->ws; bf16_t* PROJ = (bf16_t*)(ws + WS_PROJ);
    const int n = lane & 31, hh = lane >> 5, G = G_;
    for (int it = 0; it < 4; ++it) {
        const int cc = (it & 1) ? (G - 1 - bx_) : bx_;
        const int rho = it * G + cc; if (rho >= 1024) continue;
        const int tb = 127 - (rho >> 3), bg = rho & 7, b = bg >> 2, g = bg & 3;
        const int t0 = 64 * tb, tl = 8 * wave + (n >> 2), r = n & 3, t = t0 + tl;
        const size_t trow = (size_t)b * S_ + t;
        bf16_t* qptr = PROJ + trow * LDP + C_Q + (4 * g + r) * 64;
        bf16x8 qf[4];
#pragma unroll
        for (int ks = 0; ks < 4; ++ks) qf[ks] = *(const bf16x8*)(qptr + ks * 16 + 8 * hh);
        const bf16_t* gp = PROJ + trow * LDP + C_GN + g * 12 + r * 3;
        const float gc = sigmoidf_(bf2f(gp[0])), gs = sigmoidf_(bf2f(gp[1])), gwn = sigmoidf_(bf2f(gp[2]));
        f32x16 otot[2], o[2];
        for (int i = tid; i < 64 * IMPSTR; i += 512) ((LAS float*)(lds + L_IMP))[i] = 0.f;
        {
            TileSrc src{(const bf16_t*)(ws + WS_KCMP) + (size_t)bg * 512 * 64, 64, (const bf16_t*)(ws + WS_VTCMP) + (size_t)bg * 64 * 512, 512};
            int nvalid = (t0 + 32) / 16 + 1; if (nvalid > 511) nvalid = 511;
            const int j1 = (nvalid - 1) >> 6;
            float m = -__builtin_inff(), l = 0.f;
            attn_loop<0>(lds, src, 0, j1, qf, o, m, l, tl, t, tb, 0ull, 0ull, tid, wave, lane);
            l += shx(l, 32, lane);
            float inv = 1.0f / fmaxf(l, 1e-30f);
#pragma unroll
            for (int ds = 0; ds < 2; ++ds)
#pragma unroll
                for (int e = 0; e < 16; ++e) o[ds][e] = 0.f;
            attn_loop<1>(lds, src, 0, j1, qf, o, m, inv, tl, t, tb, 0ull, 0ull, tid, wave, lane);
#pragma unroll
            for (int ds = 0; ds < 2; ++ds)
#pragma unroll
                for (int e = 0; e < 16; ++e) otot[ds][e] = gc * o[ds][e];
        }
        {
            const int tok = tid >> 3, prt = tid & 7;
            unsigned mk[4] = {0u, 0u, 0u, 0u};
            if (tb < 16) { mk[0] = (tb == 31) ? 0xffffffffu : ((2u << tb) - 1u); }
            else {
                const LAS float* imp = (const LAS float*)(lds + L_IMP) + tok * IMPSTR + 16 * prt;
                u64 keys[16];
#pragma unroll
                for (int e = 0; e < 16; ++e) { const int j = 16 * prt + e; const unsigned bits = __builtin_bit_cast(unsigned, imp[e]);
                    keys[e] = (j >= 1 && j <= tb - 1) ? (((u64)(bits + 1u) << 32) | (u64)(127 - j)) : 0ull; }
                mk[0] = 1u; mk[tb >> 5] |= 1u << (tb & 31);
                for (int round = 0; round < 14; ++round) {
                    u64 best = keys[0];
#pragma unroll
                    for (int e = 1; e < 16; ++e) best = keys[e] > best ? keys[e] : best;
#pragma unroll
                    for (int o2 = 1; o2 < 8; o2 <<= 1) { const u64 other = shx64(best, o2, lane); best = other > best ? other : best; }
                    if (best != 0ull) { const int jw = 127 - (int)(best & 127ull);
                        mk[0] |= (jw < 32) ? (1u << (jw & 31)) : 0u; mk[1] |= (jw >= 32 && jw < 64) ? (1u << (jw & 31)) : 0u;
                        mk[2] |= (jw >= 64 && jw < 96) ? (1u << (jw & 31)) : 0u; mk[3] |= (jw >= 96) ? (1u << (jw & 31)) : 0u; }
#pragma unroll
                    for (int e = 0; e < 16; ++e) if (keys[e] == best) keys[e] = 0ull;
                }
            }
            if (prt == 0) { LAS unsigned* sm = (LAS unsigned*)(lds + L_SEL) + tok * 4; sm[0] = mk[0]; sm[1] = mk[1]; sm[2] = mk[2]; sm[3] = mk[3]; }
            __syncthreads();
        }
        u64 selLo, selHi;
        { const LAS unsigned* sm = (const LAS unsigned*)(lds + L_SEL) + tl * 4; selLo = (u64)sm[0] | ((u64)sm[1] << 32); selHi = (u64)sm[2] | ((u64)sm[3] << 32); }
        {
            TileSrc src{PROJ + (size_t)b * S_ * LDP + C_KS + g * 64, LDP, (const bf16_t*)(ws + WS_VTS) + (size_t)bg * 64 * S_, S_};
            float m = -__builtin_inff(), l = 0.f;
#pragma unroll
            for (int ds = 0; ds < 2; ++ds)
#pragma unroll
                for (int e = 0; e < 16; ++e) o[ds][e] = 0.f;
            attn_loop<2>(lds, src, 0, tb, qf, o, m, l, tl, t, tb, selLo, selHi, tid, wave, lane);
            l += shx(l, 32, lane);
            const float f = gs / fmaxf(l, 1e-30f);
#pragma unroll
            for (int ds = 0; ds < 2; ++ds)
#pragma unroll
                for (int e = 0; e < 16; ++e) otot[ds][e] += f * o[ds][e];
        }
        {
            TileSrc src{PROJ + (size_t)b * S_ * LDP + C_KW + g * 64, LDP, (const bf16_t*)(ws + WS_VTW) + (size_t)bg * 64 * S_, S_};
            float m = -__builtin_inff(), l = 0.f;
#pragma unroll
            for (int ds = 0; ds < 2; ++ds)
#pragma unroll
                for (int e = 0; e < 16; ++e) o[ds][e] = 0.f;
            attn_loop<3>(lds, src, tb >= 8 ? tb - 8 : 0, tb, qf, o, m, l, tl, t, tb, 0ull, 0ull, tid, wave, lane);
            l += shx(l, 32, lane);
            const float f = gwn / fmaxf(l, 1e-30f);
#pragma unroll
            for (int ds = 0; ds < 2; ++ds)
#pragma unroll
                for (int e = 0; e < 16; ++e) otot[ds][e] += f * o[ds][e];
        }
#pragma unroll
        for (int ds = 0; ds < 2; ++ds)
#pragma unroll
            for (int gi = 0; gi < 4; ++gi) { u32x2 w; w.x = pk2(otot[ds][4 * gi], otot[ds][4 * gi + 1]); w.y = pk2(otot[ds][4 * gi + 2], otot[ds][4 * gi + 3]);
                *(u32x2*)(qptr + 32 * ds + 8 * gi + 4 * hh) = w; }
    }
}

__global__ void __launch_bounds__(512, 2) fwd_megakernel(Params p) {
    extern __shared__ __attribute__((aligned(16))) unsigned char lds_raw[];
    LAS unsigned char* lds = (LAS unsigned char*)lds_raw;
    cg::grid_group grid = cg::this_grid();
    const int G = gridDim.x, bx = blockIdx.x;
    PP pp = (PP)__builtin_amdgcn_kernarg_segment_ptr();
#define ws (pp->ws)
#define PROJ ((bf16_t*)(ws + WS_PROJ))
#define H ((bf16_t*)(ws + WS_H))
#define XC ((bf16_t*)(ws + WS_XC))
#define Y ((float*)(ws + WS_RI))
    const int BIG = 1 << 30;

#ifndef NO_PREP
    prep_phase(pp, 0, lds);
#endif
#ifndef NO_ROW
    row_phase(pp->x, nullptr, nullptr, nullptr, pp->ln_mix_pre, H);
#endif
    grid.sync();

    for (int l = 0; l < NLAYER; ++l) {
        PPOPAQ();
        using pg8::Gemm; using pg8::Sched; using pg8::EpiBf16; using pg8::EpiF32; using pg8::EpiMerge;
#ifndef NO_G1
        pg8::gemm_phase<EpiBf16>(lds, Gemm{H, (const bf16_t*)(ws + WS_WIN), 1024, 1024, 1024, 128, 128},
            Sched{64, 35, opaque_s(G), opaque_s(bx), 0, BIG, 0u, 256u * 1024 * 2, 0u, 0u, 256u * 1024 * 2, 0u}, EpiBf16{PROJ, LDP, 0, 1.0f, nullptr, 0});
        pg8::gemm_phase<EpiBf16>(lds, Gemm{(const bf16_t*)(ws + WS_MEMN), (const bf16_t*)(ws + WS_WMKV), 1024, 1024, 1024, 128, 128},
            Sched{2, 4, opaque_s(G), (opaque_s(bx) + 64) % opaque_s(G), 0, BIG, 0u, 256u * 1024 * 2, 0u, 0u, 256u * 1024 * 2, 0u}, EpiBf16{(bf16_t*)(ws + WS_KMEM), 1024, 0, 1.0f, nullptr, 0});
        pg8::gemm_phase<EpiBf16>(lds, Gemm{(const bf16_t*)(ws + WS_WMKV) + (size_t)1024 * 1024, (const bf16_t*)(ws + WS_MEMN), 1024, 1024, 1024, 128, 128},
            Sched{4, 2, opaque_s(G), (opaque_s(bx) + 128) % opaque_s(G), 0, BIG, 0u, 256u * 1024 * 2, 0u, 0u, 256u * 1024 * 2, 0u}, EpiBf16{(bf16_t*)(ws + WS_VTMEM), 512, 0, 1.0f, nullptr, 0});
#endif
        grid.sync();
#ifndef NO_POST
        postproj_phase(pp, l);
#endif
        grid.sync();
#ifndef NO_G1
        pg8::gemm_phase<EpiBf16>(lds, Gemm{XC, (const bf16_t*)(ws + WS_WLRU), 1024, 128, 128, 128, 128},
            Sched{64, 8, opaque_s(G), opaque_s(bx), 0, BIG, 0u, 256u * 1024 * 2, 128u * 2, 0u, 256u * 128 * 2, 0u}, EpiBf16{(bf16_t*)(ws + WS_RI), 2048, 0, 1.0f, nullptr, 0});
        pg8::gemm_phase<EpiBf16>(lds, Gemm{PROJ, (const bf16_t*)(ws + WS_WC1), 16 * LDP, 2048, 2048, LDP * 2, 128},
            Sched{32, 1, opaque_s(G), (opaque_s(bx) + 32) % opaque_s(G), 1, BIG, 0u, 0u, 0u, 0u, 0u, 0u}, EpiBf16{(bf16_t*)(ws + WS_HID), 256, 2, 1.0f, (const float*)(ws + WS_CBIAS), 0});
        pg8::gemm_phase<EpiBf16>(lds, Gemm{PROJ, (const bf16_t*)(ws + WS_KMEM), LDP, 1024, 256, 128, 128},
            Sched{64, 4, opaque_s(G), opaque_s(bx), 0, 32, (unsigned)C_QM * 2, 256u * LDP * 2, 256u * 2, 0u, 256u * 2, 256u * 1024 * 2}, EpiBf16{H, 1024, 0, 0.0625f * LOG2E, nullptr, 0});
#endif
        grid.sync();
#ifndef NO_SCAN
        scan_phase(pp, l, 0);
#endif
#ifndef NO_MSM
        memsoftmax_phase(pp);
#endif
#ifndef NO_G2
        pg8::gemm_phase<EpiF32>(lds, Gemm{(const bf16_t*)(ws + WS_HID), (const bf16_t*)(ws + WS_WC2), 256, 256, 256, 128, 128},
            Sched{32, 1, opaque_s(G), (opaque_s(bx) + 96) % opaque_s(G), 0, 16, 0u, 256u * 256 * 2, 0u, 0u, 0u, 256u * 256 * 2}, EpiF32{(float*)(ws + WS_CRAW), 64, 64});
#endif
        grid.sync();
#ifndef NO_SCAN
        scan_phase(pp, l, 1);
#endif
#ifndef NO_CMPF
        cmpfinal_phase(pp);
#endif
#ifndef NO_G1
        pg8::gemm_phase<EpiBf16>(lds, Gemm{H, (const bf16_t*)(ws + WS_VTMEM), 1024, 512, 256, 128, 128},
            Sched{64, 4, opaque_s(G), opaque_s(bx), 0, 32, 0u, 256u * 1024 * 2, 256u * 2, 0u, 256u * 512 * 2, 256u * 2}, EpiBf16{PROJ, LDP, 0, 1.0f, nullptr, C_QM});
#endif
        grid.sync();
#ifndef NO_ATT
        attn_phase(pp, lds);
#endif
        grid.sync();
#ifndef NO_G3
        pg8::gemm_phase<EpiMerge>(lds, Gemm{XC, (const bf16_t*)(ws + WS_WBRA), 1024, 1024, 1024, 128, 128},
            Sched{64, 4, opaque_s(G), opaque_s(bx), 0, BIG, 0u, 256u * 1024 * 2, 0u, 0u, 256u * 1024 * 2, 0u}, EpiMerge{PROJ + C_GM, LDP, Y, H, 0});
        pg8::gemm_phase<EpiMerge>(lds, Gemm{PROJ + C_Q, (const bf16_t*)(ws + WS_WBRB), LDP, 1024, 1024, 128, 128},
            Sched{64, 4, opaque_s(G), opaque_s(bx), 0, BIG, 0u, 256u * LDP * 2, 0u, 0u, 256u * 1024 * 2, 0u}, EpiMerge{PROJ + C_GM + 1024, LDP, Y, H, 1});
        pg8::gemm_phase<EpiMerge>(lds, Gemm{PROJ + C_QM, (const bf16_t*)(ws + WS_WBRC), LDP, 1024, 1024, 128, 128},
            Sched{64, 4, opaque_s(G), opaque_s(bx), 0, BIG, 0u, 256u * LDP * 2, 0u, 0u, 256u * 1024 * 2, 0u}, EpiMerge{PROJ + C_GM + 2048, LDP, Y, H, 2});
#endif
        grid.sync();
#ifndef NO_G2
        pg8::gemm_phase<EpiF32>(lds, Gemm{H, (const bf16_t*)(ws + WS_WOUT), 1024, 1024, 1024, 128, 128},
            Sched{64, 4, opaque_s(G), opaque_s(bx), 0, BIG, 0u, 256u * 1024 * 2, 0u, 0u, 256u * 1024 * 2, 0u}, EpiF32{Y, 1024, 1024});
#endif
        grid.sync();
#ifndef NO_ROW
        row_phase((l == 0) ? pp->x : pp->out, Y, pp->ln_mix_post + (size_t)l * 1024, pp->out, pp->ln_mlp_pre + (size_t)l * 1024, H);
#endif
        grid.sync();
#ifndef NO_G1
        pg8::gemm_phase<EpiBf16>(lds, Gemm{H, (const bf16_t*)(ws + WS_WM1), 1024, 1024, 1024, 128, 128},
            Sched{64, 16, opaque_s(G), opaque_s(bx), 0, BIG, 0u, 256u * 1024 * 2, 0u, 0u, 256u * 1024 * 2, 0u}, EpiBf16{PROJ, FF_, 1, 1.0f, nullptr, 0});
#endif
        grid.sync();
#ifndef NO_G2
        pg8::gemm_phase<EpiF32>(lds, Gemm{PROJ, (const bf16_t*)(ws + WS_WM2), FF_, FF_, FF_, 128, 128},
            Sched{64, 4, opaque_s(G), opaque_s(bx), 0, BIG, 0u, 256u * FF_ * 2, 0u, 0u, 256u * FF_ * 2, 0u}, EpiF32{Y, 1024, 1024});
#endif
        grid.sync();
#ifndef NO_ROW
        row_phase(pp->out, Y, pp->ln_mlp_post + (size_t)l * 1024, pp->out, (l + 1 < NLAYER) ? pp->ln_mix_pre + (size_t)(l + 1) * 1024 : nullptr, (l + 1 < NLAYER) ? H : nullptr);
#endif
#ifndef NO_PREP
        if (l + 1 < NLAYER) prep_phase(pp, l + 1, lds);
#endif
        grid.sync();
    }
#undef ws
#undef PROJ
#undef H
#undef XC
#undef Y
}

extern "C" void kernel_launch(void* const* d_in, const int* in_sizes, int n_in, void* d_out, int out_size, void* d_ws, size_t ws_size, hipStream_t stream) {
    static int grid = 0;
    if (grid == 0) {
        int dev = 0, cus = 0, per_cu = 0;
        hipGetDevice(&dev); hipDeviceGetAttribute(&cus, hipDeviceAttributeMultiprocessorCount, dev);
        hipFuncSetAttribute((const void*)fwd_megakernel, hipFuncAttributeMaxDynamicSharedMemorySize, LDS_BYTES);
        hipOccupancyMaxActiveBlocksPerMultiprocessor(&per_cu, (const void*)fwd_megakernel, 512, LDS_BYTES);
        if (per_cu < 1) per_cu = 1;
        (void)hipGetLastError();
        grid = cus * 1;
        if (ws_size < WS_END) { fprintf(stderr, "kernel_launch: workspace too small (%zu < %zu)\n", ws_size, (size_t)WS_END); grid = -1; }
    }
    if (grid < 0) return;
    Params p{};
    p.x = (const float*)d_in[0]; p.mem = (const float*)d_in[1]; p.pos = (const int*)d_in[2];
    p.ln_mix_pre = (const float*)d_in[3]; p.w_in = (const float*)d_in[4]; p.conv_w = (const float*)d_in[5]; p.conv_b = (const float*)d_in[6];
    p.lru_wr = (const float*)d_in[7]; p.lru_br = (const float*)d_in[8]; p.lru_wi = (const float*)d_in[9]; p.lru_bi = (const float*)d_in[10]; p.lru_lambda = (const float*)d_in[11];
    p.cmp_pe = (const float*)d_in[12]; p.cmp_w1 = (const float*)d_in[13]; p.cmp_b1 = (const float*)d_in[14]; p.cmp_w2 = (const float*)d_in[15];
    p.ln_mem = (const float*)d_in[16]; p.w_mem_kv = (const float*)d_in[17]; p.w_br_rnn = (const float*)d_in[18]; p.w_br_nsa = (const float*)d_in[19]; p.w_br_mem = (const float*)d_in[20]; p.w_out = (const float*)d_in[21];
    p.ln_mix_post = (const float*)d_in[22]; p.ln_mlp_pre = (const float*)d_in[23]; p.mlp_w1 = (const float*)d_in[24]; p.mlp_w2 = (const float*)d_in[25]; p.ln_mlp_post = (const float*)d_in[26];
    p.out = (float*)d_out; p.ws = (unsigned char*)d_ws;
    void* args[] = {&p};
    hipError_t e = hipLaunchCooperativeKernel((const void*)fwd_megakernel, dim3(grid), dim3(512), args, LDS_BYTES, stream);
    if (e != hipSuccess) fprintf(stderr, "cooperative launch failed: %s (grid %d)\n", hipGetErrorString(e), grid);
}
```

```cpp
#include <hip/hip_runtime.h>
#include <hip/hip_cooperative_groups.h>
#include <cstdint>
#include <cstdio>
namespace cg = cooperative_groups;

#define LAS __attribute__((address_space(3)))
#define DI __device__ __forceinline__
typedef unsigned short bf16_t;
typedef short bf16x8 __attribute__((ext_vector_type(8)));
typedef short s16x4 __attribute__((ext_vector_type(4)));
typedef float f32x4 __attribute__((ext_vector_type(4)));
typedef float f32x16 __attribute__((ext_vector_type(16)));
typedef float f32x2 __attribute__((ext_vector_type(2)));
typedef unsigned u32x4 __attribute__((ext_vector_type(4)));
typedef unsigned u32x2 __attribute__((ext_vector_type(2)));
typedef __bf16 bf16x2v __attribute__((ext_vector_type(2)));
typedef unsigned long long u64;

constexpr int T_ = 16384, S_ = 8192, D_ = 1024, FF_ = 4096, LDP = 8960, NLAYER = 4;
constexpr int C_XR = 0, C_YR = 1024, C_Q = 2048, C_KC = 3072, C_VC = 3328, C_KS = 3584, C_VS = 3840, C_KW = 4096, C_VW = 4352,
              C_QM = 4608, C_GM = 5632, C_GN = 8704;
constexpr float EPS = 1e-6f;
constexpr float LOG2E = 1.4426950408889634f;

constexpr size_t al256(size_t x) { return (x + 255) & ~(size_t)255; }
constexpr size_t WS_PROJ = 0;
constexpr size_t WS_WIN = al256(WS_PROJ + (size_t)(T_ + 64) * LDP * 2);
constexpr size_t WS_WMKV = WS_WIN + (size_t)LDP * 1024 * 2;
constexpr size_t WS_WBRA = WS_WMKV + (size_t)2048 * 1024 * 2;
constexpr size_t WS_WBRB = WS_WBRA + (size_t)1024 * 1024 * 2;
constexpr size_t WS_WBRC = WS_WBRB + (size_t)1024 * 1024 * 2;
constexpr size_t WS_WOUT = WS_WBRC + (size_t)1024 * 1024 * 2;
constexpr size_t WS_WM1 = WS_WOUT + (size_t)1024 * 1024 * 2;
constexpr size_t WS_WM2 = WS_WM1 + (size_t)4096 * 1024 * 2;
constexpr size_t WS_WC1 = WS_WM2 + (size_t)4096 * 1024 * 2;
constexpr size_t WS_WC2 = WS_WC1 + (size_t)2 * 256 * 2048 * 2;
constexpr size_t WS_WLRU = WS_WC2 + (size_t)2 * 256 * 256 * 2;
constexpr size_t WS_H = WS_WLRU + (size_t)2048 * 128 * 2;
constexpr size_t WS_VTS = WS_H + (size_t)T_ * 1024 * 2;
constexpr size_t WS_VTW = WS_VTS + (size_t)8 * 64 * S_ * 2;
constexpr size_t WS_XC = WS_VTW + (size_t)8 * 64 * S_ * 2;
constexpr size_t WS_RI = WS_XC + (size_t)T_ * 1024 * 2;
constexpr size_t WS_HID = WS_RI + (size_t)T_ * 2048 * 2;
constexpr size_t WS_CRAW = WS_HID + (size_t)8192 * 256 * 2;
constexpr size_t WS_KCMP = WS_CRAW + (size_t)8192 * 64 * 4;
constexpr size_t WS_VTCMP = WS_KCMP + (size_t)8 * 512 * 64 * 2;
constexpr size_t WS_MEMN = WS_VTCMP + (size_t)8 * 512 * 64 * 2;
constexpr size_t WS_KMEM = WS_MEMN + (size_t)512 * 1024 * 2;
constexpr size_t WS_VTMEM = WS_KMEM + (size_t)512 * 1024 * 2;
constexpr size_t WS_SCA = WS_VTMEM + (size_t)512 * 1024 * 2;
constexpr size_t WS_SCH = WS_SCA + (size_t)2 * 128 * 1024 * 4;
constexpr size_t WS_CBP = WS_SCH + (size_t)2 * 128 * 1024 * 4;
constexpr size_t WS_CBIAS = WS_CBP + (size_t)16 * 512 * 4;
constexpr size_t WS_BAR = al256(WS_CBIAS + 512 * 4);
constexpr size_t WS_END = WS_BAR + 16384;
constexpr int L_BARST = 135168;

#ifndef GREP
#define GREP 1
#endif
constexpr int LDS_BYTES = 139264;

DI unsigned f2bf(float f) { unsigned u = __builtin_bit_cast(unsigned, f); return (u + 0x7fffu + ((u >> 16) & 1u)) >> 16; }
DI unsigned pk2(float lo, float hi) { f32x2 f = {lo, hi}; bf16x2v r = __builtin_convertvector(f, bf16x2v); return __builtin_bit_cast(unsigned, r); }
DI float bf2f(unsigned short b) { return __builtin_bit_cast(float, (unsigned)b << 16); }
DI float bflo(unsigned w) { return __builtin_bit_cast(float, w << 16); }
DI float bfhi(unsigned w) { return __builtin_bit_cast(float, w & 0xffff0000u); }
DI float fexp2(float x) { return __builtin_amdgcn_exp2f(x); }
DI float sigmoidf_(float x) { return 1.0f / (1.0f + fexp2(-x * LOG2E)); }
DI float gelu_tanh(float x) { const float z = 0.7978845608028654f * (x + 0.044715f * x * x * x); return x / (1.0f + fexp2(-2.0f * LOG2E * z)); }
DI float shx(float v, int mask, int lane) { return __builtin_bit_cast(float, __builtin_amdgcn_ds_bpermute((lane ^ mask) << 2, __builtin_bit_cast(int, v))); }
DI u64 shx64(u64 v, int mask, int lane) { const int a = (lane ^ mask) << 2; const unsigned lo = (unsigned)__builtin_amdgcn_ds_bpermute(a, (int)(unsigned)v), hi = (unsigned)__builtin_amdgcn_ds_bpermute(a, (int)(unsigned)(v >> 32)); return ((u64)hi << 32) | lo; }
DI int opaque_s(int v) { asm volatile("" : "+s"(v)); return v; }
DI float wave_sum(float v, int lane) {
#pragma unroll
    for (int o = 1; o < 64; o <<= 1) v += shx(v, o, lane);
    return v;
}

namespace pg8 {
constexpr int BM = 256, BK = 64, HALF = 128, HTB = HALF * BK * 2, STAGE_BYTES = 8 * HTB, NXCD = 8, WGM = 8;
__host__ __device__ __forceinline__ int lds_byte(int r, int c) { const int st = (r >> 4) * 2 + (c >> 5), rr = r & 15, cc = c & 31, ob = rr * 64 + cc * 2; return st * 1024 + (ob ^ (((ob >> 9) & 1) << 5)); }
__host__ __device__ __forceinline__ void stage_rc(int b, int& R, int& C) { const int st = b / 1024, sb = b % 1024, swz = sb ^ (((sb >> 9) & 1) << 5); R = (st >> 1) * 16 + swz / 64; C = (st & 1) * 32 + (swz % 64) / 2; }
__host__ __device__ __forceinline__ int perm32(int rho) { const int n = rho >> 4, i = rho & 15; return 8 * (i >> 2) + 4 * n + (i & 3); }

struct Unit { int pm, pn; unsigned aoff, boff; };
struct Gemm { const bf16_t* A; const bf16_t* Bt; int lda, ldb, K, kstepA, kstepB; };

struct Sched {
    int nM, nN, G, c, kind, mdiv; unsigned a0, sAm, sAn, b0, sBn, sBb;
    DI bool next(int i, Unit& u) const {
        const long L = (long)i * G + c; const int nwg = nM * nN; if (L >= nwg) return false;
        int wgid = (int)L; { const int q = nwg / NXCD, r = nwg % NXCD, xcd = wgid % NXCD, off = wgid / NXCD; wgid = (xcd < r ? xcd * (q + 1) : r * (q + 1) + (xcd - r) * q) + off; }
        const int nig = WGM * nN, gid = wgid / nig, fm = gid * WGM, gsz = (nM - fm) < WGM ? (nM - fm) : WGM;
        const int pm = fm + ((wgid % nig) % gsz), pn = (wgid % nig) / gsz;
        u.pm = pm; u.pn = pn;
        if (kind == 1) {
            const int j = pm >> 4, b = (pm >> 3) & 1, g = (pm >> 1) & 3, ch = pm & 1;
            u.aoff = (unsigned)(((b * S_ + ch * 4096) * LDP + C_KC + j * 256 + g * 64) * 2); u.boff = (unsigned)(j * 256 * 2048 * 2);
        } else { const unsigned bb = (unsigned)(pm / mdiv); u.aoff = a0 + (unsigned)pm * sAm + (unsigned)pn * sAn; u.boff = b0 + (unsigned)pn * sBn + bb * sBb; }
        return true;
    }
};

DI unsigned cvt_pk_bf16(float lo, float hi) { return pk2(lo, hi); }

struct EpiBf16 {
    static constexpr bool PERM = true;
    bf16_t* O; int ldc; int act; float scale; const float* bias; int oc0;
    DI void operator()(const f32x4 (&acc)[2][2][4][2], const Unit& u, int wr, int wc, int fr, int fq) const {
        const int row0 = u.pm * 256 + wr * 64 + fr, col0 = oc0 + u.pn * 256 + wc * 32 + 8 * fq, bc0 = (u.pm >> 4) * 256 + wc * 32 + 8 * fq;
#pragma unroll
        for (int ai = 0; ai < 2; ++ai)
#pragma unroll
            for (int m = 0; m < 4; ++m) { bf16_t* rowp = O + (size_t)(row0 + ai * HALF + m * 16) * ldc + col0;
#pragma unroll
                for (int bj = 0; bj < 2; ++bj) { f32x4 v0 = acc[ai][bj][m][0], v1 = acc[ai][bj][m][1];
                    if (act == 0) { v0 = v0 * scale; v1 = v1 * scale; }
                    else if (act == 1) {
#pragma unroll
                        for (int e = 0; e < 4; ++e) { const float a = fmaxf(v0[e], 0.f), b = fmaxf(v1[e], 0.f); v0[e] = a * a; v1[e] = b * b; } }
                    else { const f32x4 b0 = *(const f32x4*)(bias + bc0 + bj * HALF), b1 = *(const f32x4*)(bias + bc0 + bj * HALF + 4);
#pragma unroll
                        for (int e = 0; e < 4; ++e) { v0[e] = gelu_tanh(v0[e] + b0[e]); v1[e] = gelu_tanh(v1[e] + b1[e]); } }
                    u32x4 w; w.x = cvt_pk_bf16(v0[0], v0[1]); w.y = cvt_pk_bf16(v0[2], v0[3]); w.z = cvt_pk_bf16(v1[0], v1[1]); w.w = cvt_pk_bf16(v1[2], v1[3]);
                    *(u32x4*)(rowp + bj * HALF) = w; } }
    }
};
struct EpiF32 {
    static constexpr bool PERM = false;
    float* O; int ldc; int ncol;
    DI void operator()(const f32x4 (&acc)[2][2][4][2], const Unit& u, int wr, int wc, int fr, int fq) const {
        const int row0 = u.pm * 256 + wr * 64 + fr, col0 = u.pn * 256 + wc * 32 + 4 * fq;
#pragma unroll
        for (int ai = 0; ai < 2; ++ai)
#pragma unroll
            for (int m = 0; m < 4; ++m) { float* rowp = O + (size_t)(row0 + ai * HALF + m * 16) * ldc;
#pragma unroll
                for (int bj = 0; bj < 2; ++bj)
#pragma unroll
                    for (int n = 0; n < 2; ++n) { const int c = col0 + bj * HALF + n * 16; if (c < ncol) *(f32x4*)(rowp + c) = acc[ai][bj][m][n]; } }
    }
};
struct EpiMerge {
    static constexpr bool PERM = false;
    const bf16_t* gate; int ldg; float* M; bf16_t* Hout; int mode;
    DI void operator()(const f32x4 (&acc)[2][2][4][2], const Unit& u, int wr, int wc, int fr, int fq) const {
        const int row0 = u.pm * 256 + wr * 64 + fr, col0 = u.pn * 256 + wc * 32 + 4 * fq;
#pragma unroll
        for (int ai = 0; ai < 2; ++ai)
#pragma unroll
            for (int m = 0; m < 4; ++m) { const size_t r = (size_t)(row0 + ai * HALF + m * 16);
#pragma unroll
                for (int bj = 0; bj < 2; ++bj)
#pragma unroll
                    for (int n = 0; n < 2; ++n) { const int c = col0 + bj * HALF + n * 16;
                        const u32x2 gw = *(const u32x2*)(gate + r * ldg + c);
                        f32x4 g; g[0] = sigmoidf_(bflo(gw.x)); g[1] = sigmoidf_(bfhi(gw.x)); g[2] = sigmoidf_(bflo(gw.y)); g[3] = sigmoidf_(bfhi(gw.y));
                        f32x4 v = acc[ai][bj][m][n] * g;
                        float* mp = M + r * 1024 + c;
                        if (mode != 0) v = v + *(const f32x4*)mp;
                        if (mode != 2) *(f32x4*)mp = v;
                        else { u32x2 w; w.x = cvt_pk_bf16(v[0], v[1]); w.y = cvt_pk_bf16(v[2], v[3]); *(u32x2*)(Hout + r * 1024 + c) = w; } } }
    }
};

template <class Epi>
DI void gemm_phase(LAS unsigned char* lds, const Gemm g, const Sched& S, const Epi& E) {
    int tid = threadIdx.x; asm volatile("" : "+v"(tid));
    const int wid = __builtin_amdgcn_readfirstlane(tid >> 6), lane = tid & 63, wr = wid >> 2, wc = wid & 3, fr = lane & 15, fq = lane >> 4;
    const int nt = opaque_s(g.K / BK);
    unsigned voffA[2], voffB[2];
#pragma unroll
    for (int i = 0; i < 2; ++i) { int R, C; stage_rc(tid * 16 + i * 8192, R, C); const int Rb = Epi::PERM ? ((R & ~31) + perm32(R & 31)) : R;
        voffA[i] = (unsigned)(R * g.lda + C) * 2u; voffB[i] = (unsigned)(Rb * g.ldb + C) * 2u; }
    const size_t kstepA = (size_t)g.kstepA, kstepB = (size_t)g.kstepB;
    const size_t hstepA = (size_t)HALF * g.lda * 2, hstepB = (size_t)HALF * g.ldb * 2;
    const unsigned ldsw = (unsigned)wid * 1024u;
    const int aoff = lds_byte(wr * 64 + fr, fq * 8), boff = lds_byte(wc * 32 + fr, fq * 8);
#define PG8_SA(b, h) (((b) * 2 + (h)) * HTB)
#define PG8_SB(b, h) ((4 + (b) * 2 + (h)) * HTB)
#define PG8_STAGE(bufoff, gbase, voff) do { _Pragma("unroll") for (int _i = 0; _i < 2; ++_i) \
        __builtin_amdgcn_global_load_lds((const unsigned*)((const char*)(gbase) + (voff)[_i]), (LAS unsigned*)(lds + (bufoff) + ldsw + _i * 8192), 16, 0, 0); } while (0)
#define PG8_LDA(dst, b, h) do { _Pragma("unroll") for (int m = 0; m < 4; ++m) _Pragma("unroll") for (int k = 0; k < 2; ++k) dst[m][k] = *(const LAS bf16x8*)(lds + PG8_SA(b, h) + aoff + m * 2048 + k * 1024); } while (0)
#define PG8_LDB(dst, b, h) do { _Pragma("unroll") for (int n = 0; n < 2; ++n) _Pragma("unroll") for (int k = 0; k < 2; ++k) dst[n][k] = *(const LAS bf16x8*)(lds + PG8_SB(b, h) + boff + n * 2048 + k * 1024); } while (0)
#define PG8_MMA(ai, bj, At, Bt) do { __builtin_amdgcn_s_setprio(1); _Pragma("unroll") for (int m = 0; m < 4; ++m) _Pragma("unroll") for (int n = 0; n < 2; ++n) _Pragma("unroll") for (int k = 0; k < 2; ++k) \
        acc[ai][bj][m][n] = __builtin_amdgcn_mfma_f32_16x16x32_bf16(Bt[n][k], At[m][k], acc[ai][bj][m][n], 0, 0, 0); __builtin_amdgcn_s_setprio(0); } while (0)
#define PG8_WAIT_V(n) asm volatile("s_waitcnt vmcnt(" #n ")" ::: "memory")
#define PG8_WAIT_L(n) asm volatile("s_waitcnt lgkmcnt(" #n ")" ::: "memory")
#define PG8_BAR __builtin_amdgcn_s_barrier()
#define PG8_SCHED __builtin_amdgcn_sched_barrier(0)
    Unit cur, nxt; int ui = 0;
    if (!S.next(0, cur)) return;
    f32x4 acc[2][2][4][2];
#pragma unroll
    for (int a = 0; a < 2; ++a)
#pragma unroll
        for (int b = 0; b < 2; ++b)
#pragma unroll
            for (int m = 0; m < 4; ++m)
#pragma unroll
                for (int n = 0; n < 2; ++n) acc[a][b][m][n] = (f32x4){0.f, 0.f, 0.f, 0.f};
    bf16x8 At[4][2], B0[2][2], B1[2][2];
    const char* cA = (const char*)g.A + cur.aoff; const char* cB = (const char*)g.Bt + cur.boff;
    PG8_STAGE(PG8_SB(0, 0), cB, voffB); PG8_STAGE(PG8_SB(0, 1), cB + hstepB, voffB); PG8_STAGE(PG8_SA(0, 0), cA, voffA); PG8_STAGE(PG8_SA(0, 1), cA + hstepA, voffA);
    if (wr == 1) PG8_BAR;
    PG8_WAIT_V(2); PG8_BAR;
    PG8_STAGE(PG8_SB(1, 0), cB + kstepB, voffB); PG8_STAGE(PG8_SA(1, 0), cA + kstepA, voffA); PG8_STAGE(PG8_SB(1, 1), cB + hstepB + kstepB, voffB);
    PG8_WAIT_V(6); PG8_BAR;
    for (;;) {
        const bool has_next = S.next(ui + 1, nxt);
        const char* nA = has_next ? (const char*)g.A + nxt.aoff : cA; const char* nB = has_next ? (const char*)g.Bt + nxt.boff : cB;
        for (int t = 0; t < nt; t += 2) {
            const bool last = (t == nt - 2);
            const char* a1 = cA + (size_t)(t + 1) * kstepA;
            const char* a2 = last ? nA : cA + (size_t)(t + 2) * kstepA; const char* b2 = last ? nB : cB + (size_t)(t + 2) * kstepB;
            const char* a3 = a2 + kstepA; const char* b3 = b2 + kstepB;
            PG8_LDB(B0, 0, 0); PG8_LDB(B1, 0, 1); PG8_SCHED; PG8_LDA(At, 0, 0); PG8_STAGE(PG8_SA(1, 1), a1 + hstepA, voffA);
            PG8_WAIT_V(8); PG8_WAIT_L(0); PG8_BAR; PG8_MMA(0, 0, At, B0); PG8_MMA(0, 1, At, B1); PG8_BAR; PG8_SCHED;
            PG8_LDA(At, 0, 1); PG8_STAGE(PG8_SB(0, 0), b2, voffB); PG8_STAGE(PG8_SB(0, 1), b2 + hstepB, voffB); PG8_STAGE(PG8_SA(0, 0), a2, voffA);
            PG8_WAIT_V(8); PG8_WAIT_L(0); PG8_BAR; PG8_MMA(1, 0, At, B0); PG8_MMA(1, 1, At, B1); PG8_BAR; PG8_SCHED;
            PG8_LDB(B0, 1, 0); PG8_LDB(B1, 1, 1); PG8_SCHED; PG8_LDA(At, 1, 0); PG8_STAGE(PG8_SA(0, 1), a2 + hstepA, voffA);
            PG8_WAIT_V(8); PG8_WAIT_L(0); PG8_BAR; PG8_MMA(0, 0, At, B0); PG8_MMA(0, 1, At, B1); PG8_BAR; PG8_SCHED;
            PG8_LDA(At, 1, 1); PG8_STAGE(PG8_SB(1, 0), b3, voffB); PG8_STAGE(PG8_SB(1, 1), b3 + hstepB, voffB); PG8_STAGE(PG8_SA(1, 0), a3, voffA);
            PG8_WAIT_V(8); PG8_WAIT_L(0); PG8_BAR; PG8_MMA(1, 0, At, B0); PG8_MMA(1, 1, At, B1); PG8_BAR; PG8_SCHED;
        }
        if (wr == 0) PG8_BAR;
        E(acc, cur, wr, wc, fr, fq);
        if (!has_next) break;
#pragma unroll
        for (int a = 0; a < 2; ++a)
#pragma unroll
            for (int b = 0; b < 2; ++b)
#pragma unroll
                for (int m = 0; m < 4; ++m)
#pragma unroll
                    for (int n = 0; n < 2; ++n) acc[a][b][m][n] = (f32x4){0.f, 0.f, 0.f, 0.f};
        cur = nxt; cA = nA; cB = nB; ++ui;
        if (wr == 1) PG8_BAR;
    }
    PG8_WAIT_V(0);
    PG8_BAR;
#undef PG8_SA
#undef PG8_SB
#undef PG8_STAGE
#undef PG8_LDA
#undef PG8_LDB
#undef PG8_MMA
#undef PG8_WAIT_V
#undef PG8_WAIT_L
#undef PG8_BAR
#undef PG8_SCHED
}
}


#define XB_TMO      128
#define XB_XCNT(j)  (256  + 64 * (j))
#define XB_XSUB(j)  (1280 + 64 * (j))
#define XB_XGEN(j)  (2304 + 64 * (j))
#define XB_TOP      3328
#define XB_TOPGEN   3392
#define XCD_BAR_WORDS 3456
#define XB_SPIN_CAP (1u << 22)
DI unsigned xb_ld(unsigned* p)              { return __hip_atomic_load(p, __ATOMIC_RELAXED, __HIP_MEMORY_SCOPE_AGENT); }
DI unsigned xb_add(unsigned* p, unsigned v) { return __hip_atomic_fetch_add(p, v, __ATOMIC_RELAXED, __HIP_MEMORY_SCOPE_AGENT); }
DI unsigned xb_xcc_id() { return (unsigned)__builtin_amdgcn_s_getreg((3 << 11) | 20) & 0xFu; }
#define XB_SPIN(cond, bar) do { unsigned _sp = 0; while (cond) { __builtin_amdgcn_s_sleep(1); \
    if ((++_sp & 255u) == 0u) { if (xb_ld(&(bar)[XB_TMO])) break; if (_sp > XB_SPIN_CAP) { atomicAdd(&(bar)[XB_TMO], 1u); break; } } } } while (0)
DI void xcd_barrier_complete(unsigned* bar, unsigned x, unsigned& nloc, unsigned& nx) {
    const unsigned G = gridDim.x * gridDim.y * gridDim.z;
    unsigned sum, cnt, mine, sp = 0u;
    for (;;) {
        sum = 0u; cnt = 0u; mine = 0u;
#pragma unroll
        for (unsigned j = 0; j < 16; ++j) { const unsigned c = xb_ld(&bar[XB_XCNT(j)]); sum += c; cnt += (c > 0u) ? 1u : 0u; mine = (j == x) ? c : mine; }
        if (sum == G) break;
        __builtin_amdgcn_s_sleep(1);
        if ((++sp & 255u) == 0u) { if (xb_ld(&bar[XB_TMO])) break; if (sp > XB_SPIN_CAP) { atomicAdd(&bar[XB_TMO], 1u); break; } }
    }
    nloc = mine > 0u ? mine : 1u; nx = cnt > 0u ? cnt : 1u;
}
DI void xcd_barrier(unsigned* bar, volatile LAS unsigned* st) {
    asm volatile("s_waitcnt vmcnt(0)" ::: "memory");
    __syncthreads();
    if (threadIdx.x == 0) {
        __builtin_amdgcn_s_waitcnt(0);
        const unsigned x = xb_xcc_id();
        unsigned nloc = st[0], nx = st[1];
        if (nloc == 0u) { xcd_barrier_complete(bar, x, nloc, nx); st[0] = nloc; st[1] = nx; }
        const unsigned old = xb_add(&bar[XB_XSUB(x)], 1u);
        const unsigned gen = old / nloc;
        if (old + 1u == (gen + 1u) * nloc) {
            __builtin_amdgcn_fence(__ATOMIC_RELEASE, "agent");
            asm volatile("s_waitcnt vmcnt(0)" ::: "memory");
            const unsigned og = xb_add(&bar[XB_TOP], 1u);
            const unsigned tg = og / nx;
            if (og + 1u == (tg + 1u) * nx) xb_add(&bar[XB_TOPGEN], 1u);
            else XB_SPIN(xb_ld(&bar[XB_TOPGEN]) == tg, bar);
            __builtin_amdgcn_fence(__ATOMIC_ACQUIRE, "agent");
            xb_add(&bar[XB_XGEN(x)], 1u);
            asm volatile("s_waitcnt vmcnt(0)" ::: "memory");
        } else {
            XB_SPIN(xb_ld(&bar[XB_XGEN(x)]) == gen, bar);
            __builtin_amdgcn_fence(__ATOMIC_ACQUIRE, "agent");
            asm volatile("s_waitcnt vmcnt(0)" ::: "memory");
        }
    }
    __syncthreads();
}

struct Params {
    const float* x; const float* mem; const int* pos;
    const float* ln_mix_pre; const float* w_in; const float* conv_w; const float* conv_b;
    const float* lru_wr; const float* lru_br; const float* lru_wi; const float* lru_bi; const float* lru_lambda;
    const float* cmp_pe; const float* cmp_w1; const float* cmp_b1; const float* cmp_w2;
    const float* ln_mem; const float* w_mem_kv; const float* w_br_rnn; const float* w_br_nsa; const float* w_br_mem; const float* w_out;
    const float* ln_mix_post; const float* ln_mlp_pre; const float* mlp_w1; const float* mlp_w2; const float* ln_mlp_post;
    float* out; unsigned char* ws;
};
typedef const __attribute__((address_space(4))) Params* PP;
#define PPOPAQ() asm volatile("" : "+s"(pp))

DI void tr_item(const float* W, int ldw, int srccol, int valid, int k0, bf16_t* WT, int ldt, int drow0, LAS float* scr, int lane) {
    const int c32 = lane & 31;
#pragma unroll 8
    for (int i = 0; i < 32; ++i) { const int kk = 2 * i + (lane >> 5); float v = 0.f; if (c32 < valid) v = W[(size_t)(k0 + kk) * ldw + srccol + c32]; scr[kk * 33 + c32] = v; }
    __builtin_amdgcn_s_waitcnt(0xc07f); asm volatile("s_waitcnt lgkmcnt(0)" ::: "memory");
    const int c = lane & 7;
#pragma unroll
    for (int j = 0; j < 4; ++j) { const int n = (lane >> 3) + 8 * j; const LAS float* s = scr + (8 * c) * 33 + n;
        u32x4 o; o.x = pk2(s[0 * 33], s[1 * 33]); o.y = pk2(s[2 * 33], s[3 * 33]); o.z = pk2(s[4 * 33], s[5 * 33]); o.w = pk2(s[6 * 33], s[7 * 33]);
        *(u32x4*)(WT + (size_t)(drow0 + n) * ldt + k0 + 8 * c) = o; }
    asm volatile("s_waitcnt lgkmcnt(0)" ::: "memory");
}

DI void prep_phase(PP pp, int l, LAS unsigned char* lds) {
    PPOPAQ();
    int tid = threadIdx.x; asm volatile("" : "+v"(tid));
    const int lane = tid & 63, wave = __builtin_amdgcn_readfirstlane(tid >> 6);
    const int G_ = opaque_s((int)gridDim.x), bx_ = opaque_s((int)blockIdx.x);
    const int gw = bx_ * 8 + wave, NGW = G_ * 8, gtid = bx_ * 512 + tid, NT = G_ * 512;
    (void)lane; (void)wave; (void)gw; (void)NGW; (void)gtid; (void)NT;
    LAS float* scr = (LAS float*)(lds + wave * 8704);
    unsigned char* ws = pp->ws;
    const float* w_in = pp->w_in + (size_t)l * 1024 * 8752;
    constexpr int I_IN = 16 * 280, I_MKV = 16 * 64, I_BR = 16 * 32, I_M1 = 16 * 128, I_M2 = 64 * 32, I_C1 = 2 * 32 * 8, I_C2 = 2 * 4 * 8, I_LRU = 2 * 8 * 2 * 4;
    constexpr int NITEMS = I_IN + I_MKV + 4 * I_BR + I_M1 + I_M2 + I_C1 + I_C2 + I_LRU;
    for (int it = gw; it < NITEMS; it += NGW) {
        int r = it;
        if (r < I_IN) { const int kb = r / 280, nb = r % 280, n0 = 32 * nb; int src, valid = 32;
            if (n0 < 4608) src = n0; else if (n0 < 5632) src = n0 - 4608 + 4656; else if (n0 < 8704) src = n0 - 5632 + 5680;
            else { src = n0 - 8704 + 4608; valid = 48 - (n0 - 8704); valid = valid < 0 ? 0 : (valid > 32 ? 32 : valid); if (valid == 0) src = 0; }
            tr_item(w_in, 8752, src, valid, 64 * kb, (bf16_t*)(ws + WS_WIN), 1024, n0, scr, lane); continue; } r -= I_IN;
        if (r < I_MKV) { tr_item(pp->w_mem_kv + (size_t)l * 1024 * 2048, 2048, 32 * (r % 64), 32, 64 * (r / 64), (bf16_t*)(ws + WS_WMKV), 1024, 32 * (r % 64), scr, lane); continue; } r -= I_MKV;
        if (r < I_BR) { tr_item(pp->w_br_rnn + (size_t)l * 1024 * 1024, 1024, 32 * (r % 32), 32, 64 * (r / 32), (bf16_t*)(ws + WS_WBRA), 1024, 32 * (r % 32), scr, lane); continue; } r -= I_BR;
        if (r < I_BR) { tr_item(pp->w_br_nsa + (size_t)l * 1024 * 1024, 1024, 32 * (r % 32), 32, 64 * (r / 32), (bf16_t*)(ws + WS_WBRB), 1024, 32 * (r % 32), scr, lane); continue; } r -= I_BR;
        if (r < I_BR) { tr_item(pp->w_br_mem + (size_t)l * 1024 * 1024, 1024, 32 * (r % 32), 32, 64 * (r / 32), (bf16_t*)(ws + WS_WBRC), 1024, 32 * (r % 32), scr, lane); continue; } r -= I_BR;
        if (r < I_BR) { tr_item(pp->w_out + (size_t)l * 1024 * 1024, 1024, 32 * (r % 32), 32, 64 * (r / 32), (bf16_t*)(ws + WS_WOUT), 1024, 32 * (r % 32), scr, lane); continue; } r -= I_BR;
        if (r < I_M1) { tr_item(pp->mlp_w1 + (size_t)l * 1024 * 4096, 4096, 32 * (r % 128), 32, 64 * (r / 128), (bf16_t*)(ws + WS_WM1), 1024, 32 * (r % 128), scr, lane); continue; } r -= I_M1;
        if (r < I_M2) { tr_item(pp->mlp_w2 + (size_t)l * 4096 * 1024, 1024, 32 * (r % 32), 32, 64 * (r / 32), (bf16_t*)(ws + WS_WM2), 4096, 32 * (r % 32), scr, lane); continue; } r -= I_M2;
        if (r < I_C1) { const int j = r / 256, q = r % 256;
            tr_item(pp->cmp_w1 + ((size_t)l * 2 + j) * 2048 * 256, 256, 32 * (q % 8), 32, 64 * (q / 8), (bf16_t*)(ws + WS_WC1) + (size_t)j * 256 * 2048, 2048, 32 * (q % 8), scr, lane); continue; } r -= I_C1;
        if (r < I_C2) { const int j = r / 32, q = r % 32; const int n0 = 32 * (q % 8);
            tr_item(pp->cmp_w2 + ((size_t)l * 2 + j) * 256 * 64, 64, n0 < 64 ? n0 : 0, n0 < 64 ? 32 : 0, 64 * (q / 8), (bf16_t*)(ws + WS_WC2) + (size_t)j * 256 * 256, 256, n0, scr, lane); continue; } r -= I_C2;
        { const int ri = r / 64, q = r % 64, blk = q / 8, q2 = q % 8;
            const float* W = (ri == 0 ? pp->lru_wr : pp->lru_wi) + ((size_t)l * 8 + blk) * 128 * 128;
            tr_item(W, 128, 32 * (q2 % 4), 32, 64 * (q2 / 4), (bf16_t*)(ws + WS_WLRU), 128, blk * 256 + ri * 128 + 32 * (q2 % 4), scr, lane); }
    }
    for (int m = gw; m < 512; m += NGW) {
        const f32x4* xr = (const f32x4*)(pp->mem + (size_t)m * 1024) + lane; const f32x4* gr = (const f32x4*)(pp->ln_mem + (size_t)l * 1024) + lane;
        f32x4 v[4]; float s = 0.f;
#pragma unroll
        for (int j = 0; j < 4; ++j) { v[j] = xr[64 * j]; s += (v[j].x * v[j].x + v[j].y * v[j].y) + (v[j].z * v[j].z + v[j].w * v[j].w); }
        const float rs = 1.0f / sqrtf(wave_sum(s, lane) * (1.f / 1024.f) + EPS);
        u32x2* o8 = (u32x2*)((bf16_t*)(ws + WS_MEMN) + (size_t)m * 1024) + lane;
#pragma unroll
        for (int j = 0; j < 4; ++j) { const f32x4 g = gr[64 * j]; u32x2 w; w.x = pk2(v[j].x * rs * g.x, v[j].y * rs * g.y); w.y = pk2(v[j].z * rs * g.z, v[j].w * rs * g.w); o8[64 * j] = w; }
    }
    {
        const int gt = gw * 64 + lane;
        if (gt < 16 * 512) { const int prt = gt / 512, jn = gt % 512, j = jn / 256, n = jn % 256;
            const float* w1 = pp->cmp_w1 + ((size_t)l * 2 + j) * 2048 * 256 + n; const float* pe = pp->cmp_pe + ((size_t)l * 2 + j) * 2048;
            float s = 0.f;
            for (int k = prt * 128; k < prt * 128 + 128; ++k) s += pe[k] * w1[(size_t)k * 256];
            ((float*)(ws + WS_CBP))[gt] = s; }
    }
}

DI void row_phase(const float* xin, const float* y, const float* gpost, float* xout, const float* gnext, bf16_t* hout) {
    int tid = threadIdx.x; asm volatile("" : "+v"(tid));
    const int lane = tid & 63, wave = __builtin_amdgcn_readfirstlane(tid >> 6);
    const int G_ = opaque_s((int)gridDim.x), bx_ = opaque_s((int)blockIdx.x);
    const int gw = bx_ * 8 + wave, NGW = G_ * 8, gtid = bx_ * 512 + tid, NT = G_ * 512;
    (void)lane; (void)wave; (void)gw; (void)NGW; (void)gtid; (void)NT;
    for (int m = gw; m < T_; m += NGW) {
        const f32x4* xr = (const f32x4*)(xin + (size_t)m * 1024) + lane;
        f32x4 v[4];
#pragma unroll
        for (int j = 0; j < 4; ++j) v[j] = xr[64 * j];
        if (y) {
            const f32x4* yr = (const f32x4*)(y + (size_t)m * 1024) + lane; const f32x4* gr = (const f32x4*)gpost + lane;
            f32x4 w[4]; float s = 0.f;
#pragma unroll
            for (int j = 0; j < 4; ++j) { w[j] = yr[64 * j]; s += (w[j].x * w[j].x + w[j].y * w[j].y) + (w[j].z * w[j].z + w[j].w * w[j].w); }
            const float rs = 1.0f / sqrtf(wave_sum(s, lane) * (1.f / 1024.f) + EPS);
            f32x4* xo = (f32x4*)(xout + (size_t)m * 1024) + lane;
#pragma unroll
            for (int j = 0; j < 4; ++j) { v[j] = v[j] + w[j] * rs * gr[64 * j]; xo[64 * j] = v[j]; }
        }
        if (hout) {
            float s = 0.f;
#pragma unroll
            for (int j = 0; j < 4; ++j) s += (v[j].x * v[j].x + v[j].y * v[j].y) + (v[j].z * v[j].z + v[j].w * v[j].w);
            const float rs = 1.0f / sqrtf(wave_sum(s, lane) * (1.f / 1024.f) + EPS);
            const f32x4* gr = (const f32x4*)gnext + lane; u32x2* o8 = (u32x2*)(hout + (size_t)m * 1024) + lane;
#pragma unroll
            for (int j = 0; j < 4; ++j) { const f32x4 g = gr[64 * j]; u32x2 w; w.x = pk2(v[j].x * rs * g.x, v[j].y * rs * g.y); w.y = pk2(v[j].z * rs * g.z, v[j].w * rs * g.w); o8[64 * j] = w; }
        }
    }
}

DI void rope8(u32x4& lo, u32x4& hi, float pos, int d0, float scale) {
    unsigned* pl = (unsigned*)&lo; unsigned* ph = (unsigned*)&hi;
    float x1[8], x2[8];
#pragma unroll
    for (int e = 0; e < 4; ++e) { x1[2 * e] = bflo(pl[e]); x1[2 * e + 1] = bfhi(pl[e]); x2[2 * e] = bflo(ph[e]); x2[2 * e + 1] = bfhi(ph[e]); }
#pragma unroll
    for (int e = 0; e < 8; ++e) {
        const float inv = fexp2(-(float)(d0 + e) * 0.41524101186092029f);
        const float ang = pos * inv;
        const double rev = (double)ang * 0.15915494309189535; const float fr = (float)(rev - __builtin_rint(rev));
        const float sn = __builtin_amdgcn_sinf(fr), cs = __builtin_amdgcn_cosf(fr);
        const float a = (x1[e] * cs - x2[e] * sn) * scale, b = (x2[e] * cs + x1[e] * sn) * scale; x1[e] = a; x2[e] = b;
    }
#pragma unroll
    for (int e = 0; e < 4; ++e) { pl[e] = pk2(x1[2 * e], x1[2 * e + 1]); ph[e] = pk2(x2[2 * e], x2[2 * e + 1]); }
}

DI void postproj_phase(PP pp, int l) {
    PPOPAQ();
    int tid = threadIdx.x; asm volatile("" : "+v"(tid));
    const int lane = tid & 63, wave = __builtin_amdgcn_readfirstlane(tid >> 6);
    const int G_ = opaque_s((int)gridDim.x), bx_ = opaque_s((int)blockIdx.x);
    const int gw = bx_ * 8 + wave, NGW = G_ * 8, gtid = bx_ * 512 + tid, NT = G_ * 512;
    (void)lane; (void)wave; (void)gw; (void)NGW; (void)gtid; (void)NT;
    unsigned char* ws = pp->ws; bf16_t* PROJ = (bf16_t*)(ws + WS_PROJ);
    {
        const float* cw = pp->conv_w + (size_t)l * 4 * 1024; const float* cb = pp->conv_b + (size_t)l * 1024; bf16_t* XC = (bf16_t*)(ws + WS_XC);
        for (int i = gtid; i < T_ * 128; i += NT) { const int t = i >> 7, c8 = (i & 127) * 8, ts = t & (S_ - 1);
            float acc[8];
#pragma unroll
            for (int e = 0; e < 8; ++e) acc[e] = cb[c8 + e];
#pragma unroll
            for (int w = 0; w < 4; ++w) { if (ts - 3 + w >= 0) { const u32x4 xv = *(const u32x4*)(PROJ + (size_t)(t - 3 + w) * LDP + C_XR + c8); const unsigned* xp = (const unsigned*)&xv;
                    const f32x4 k0 = *(const f32x4*)(cw + w * 1024 + c8), k1 = *(const f32x4*)(cw + w * 1024 + c8 + 4);
                    acc[0] += k0.x * bflo(xp[0]); acc[1] += k0.y * bfhi(xp[0]); acc[2] += k0.z * bflo(xp[1]); acc[3] += k0.w * bfhi(xp[1]);
                    acc[4] += k1.x * bflo(xp[2]); acc[5] += k1.y * bfhi(xp[2]); acc[6] += k1.z * bflo(xp[3]); acc[7] += k1.w * bfhi(xp[3]); } }
            u32x4 o; o.x = pk2(acc[0], acc[1]); o.y = pk2(acc[2], acc[3]); o.z = pk2(acc[4], acc[5]); o.w = pk2(acc[6], acc[7]);
            *(u32x4*)(XC + (size_t)t * 1024 + c8) = o; }
    }
    for (int i = gtid; i < T_ * 24 * 4; i += NT) { const int t = i / 96, r = i % 96, hd = r >> 2, d0 = (r & 3) * 8;
        int col; float sc = 1.0f;
        if (hd < 16) { col = C_Q + hd * 64; sc = 0.125f * LOG2E; } else if (hd < 20) col = C_KS + (hd - 16) * 64; else col = C_KW + (hd - 20) * 64;
        bf16_t* base = PROJ + (size_t)t * LDP + col + d0;
        u32x4 lo = *(const u32x4*)base, hi = *(const u32x4*)(base + 32);
        rope8(lo, hi, (float)pp->pos[t], d0, sc);
        *(u32x4*)base = lo; *(u32x4*)(base + 32) = hi; }
    for (int i = gtid; i < 2 * 2 * 4 * 1024 * 64; i += NT) { const int d = i & 63, t8 = (i >> 6) & 1023, g = (i >> 16) & 3, b = (i >> 18) & 1, which = i >> 19;
        const bf16_t* src = PROJ + (size_t)(b * S_ + t8 * 8) * LDP + (which ? C_VW : C_VS) + g * 64 + d;
        unsigned short v[8];
#pragma unroll
        for (int e = 0; e < 8; ++e) v[e] = src[(size_t)e * LDP];
        u32x4 o; o.x = v[0] | ((unsigned)v[1] << 16); o.y = v[2] | ((unsigned)v[3] << 16); o.z = v[4] | ((unsigned)v[5] << 16); o.w = v[6] | ((unsigned)v[7] << 16);
        *(u32x4*)((bf16_t*)(ws + (which ? WS_VTW : WS_VTS)) + ((size_t)(b * 4 + g) * 64 + d) * S_ + t8 * 8) = o; }
    if (gtid < 512) { const float* part = (const float*)(ws + WS_CBP); float s = pp->cmp_b1[(size_t)l * 512 + gtid];
        for (int q = 0; q < 16; ++q) s += part[q * 512 + gtid];
        ((float*)(ws + WS_CBIAS))[gtid] = s; }
}

DI void lru_ab(float rp, float ip, float xc, float cl, float& a, float& bb) {
    const float la = cl * sigmoidf_(rp);
    a = fexp2(la * LOG2E);
    const float x2 = 2.0f * la;
    float om;
    if (x2 > -0.1f) om = -x2 * (1.0f + x2 * (0.5f + x2 * (0.16666667f + x2 * (0.041666668f + x2 * 0.0083333338f)))); else om = 1.0f - a * a;
    bb = sqrtf(om) * sigmoidf_(ip) * xc;
}
DI void scan_phase(PP pp, int l, int pass) {
    PPOPAQ();
    int tid = threadIdx.x; asm volatile("" : "+v"(tid));
    const int lane = tid & 63, wave = __builtin_amdgcn_readfirstlane(tid >> 6);
    const int G_ = opaque_s((int)gridDim.x), bx_ = opaque_s((int)blockIdx.x);
    const int gw = bx_ * 8 + wave, NGW = G_ * 8, gtid = bx_ * 512 + tid, NT = G_ * 512;
    (void)lane; (void)wave; (void)gw; (void)NGW; (void)gtid; (void)NT;
    unsigned char* ws = pp->ws; const bf16_t* RI = (const bf16_t*)(ws + WS_RI); bf16_t* XC = (bf16_t*)(ws + WS_XC); const bf16_t* PROJ = (const bf16_t*)(ws + WS_PROJ);
    float* SA = (float*)(ws + WS_SCA); float* SH = (float*)(ws + WS_SCH);
    for (int u = bx_; u < 512; u += G_) { const int hh = u & 1, k = (u >> 1) & 127, b = u >> 8;
        const int ch = hh * 512 + tid, blk = ch >> 7, cc = ch & 127, rcol = blk * 256 + cc;
        const float lam = pp->lru_lambda[(size_t)l * 1024 + ch];
        const float sp = (-lam > 20.f) ? -lam : log1pf(__expf(-lam));
        const float cl = -8.0f * sp, br = pp->lru_br[(size_t)l * 1024 + ch], bi = pp->lru_bi[(size_t)l * 1024 + ch];
        const size_t row0 = (size_t)b * S_ + k * 64;
        if (pass == 0) {
            float A = 1.f, H = 0.f;
#pragma unroll 4
            for (int s = 0; s < 64; ++s) { const size_t row = row0 + s; float a, bb;
                lru_ab(bf2f(RI[row * 2048 + rcol]) + br, bf2f(RI[row * 2048 + rcol + 128]) + bi, bf2f(XC[row * 1024 + ch]), cl, a, bb);
                A *= a; H = a * H + bb; }
            SA[((size_t)b * 128 + k) * 1024 + ch] = A; SH[((size_t)b * 128 + k) * 1024 + ch] = H;
        } else {
            float h = 0.f;
            for (int q = 0; q < k; ++q) h = SA[((size_t)b * 128 + q) * 1024 + ch] * h + SH[((size_t)b * 128 + q) * 1024 + ch];
#pragma unroll 4
            for (int s = 0; s < 64; ++s) { const size_t row = row0 + s; float a, bb;
                lru_ab(bf2f(RI[row * 2048 + rcol]) + br, bf2f(RI[row * 2048 + rcol + 128]) + bi, bf2f(XC[row * 1024 + ch]), cl, a, bb);
                h = a * h + bb;
                const float yr = bf2f(PROJ[row * LDP + C_YR + ch]);
                XC[row * 1024 + ch] = (bf16_t)f2bf(h * gelu_tanh(yr)); }
        }
    }
}

DI void memsoftmax_phase(PP pp) {
    PPOPAQ();
    int tid = threadIdx.x; asm volatile("" : "+v"(tid));
    const int lane = tid & 63, wave = __builtin_amdgcn_readfirstlane(tid >> 6);
    const int G_ = opaque_s((int)gridDim.x), bx_ = opaque_s((int)blockIdx.x);
    const int gw = bx_ * 8 + wave, NGW = G_ * 8, gtid = bx_ * 512 + tid, NT = G_ * 512;
    (void)lane; (void)wave; (void)gw; (void)NGW; (void)gtid; (void)NT;
    bf16_t* SP = (bf16_t*)(pp->ws + WS_H);
    for (int m = gw; m < T_; m += NGW) {
        u32x4* ptr = (u32x4*)(SP + (size_t)m * 1024 + lane * 16);
        u32x4 a = ptr[0], b = ptr[1]; const unsigned* pa = (const unsigned*)&a; const unsigned* pb = (const unsigned*)&b;
        float v[16];
#pragma unroll
        for (int e = 0; e < 4; ++e) { v[2 * e] = bflo(pa[e]); v[2 * e + 1] = bfhi(pa[e]); v[8 + 2 * e] = bflo(pb[e]); v[8 + 2 * e + 1] = bfhi(pb[e]); }
        float mx = v[0];
#pragma unroll
        for (int e = 1; e < 16; ++e) mx = fmaxf(mx, v[e]);
#pragma unroll
        for (int o = 1; o < 16; o <<= 1) mx = fmaxf(mx, shx(mx, o, lane));
        float s = 0.f;
#pragma unroll
        for (int e = 0; e < 16; ++e) { v[e] = fexp2(v[e] - mx); s += v[e]; }
#pragma unroll
        for (int o = 1; o < 16; o <<= 1) s += shx(s, o, lane);
        const float inv = 1.0f / s;
        u32x4 oa, ob; unsigned* qa = (unsigned*)&oa; unsigned* qb = (unsigned*)&ob;
#pragma unroll
        for (int e = 0; e < 4; ++e) { qa[e] = pk2(v[2 * e] * inv, v[2 * e + 1] * inv); qb[e] = pk2(v[8 + 2 * e] * inv, v[8 + 2 * e + 1] * inv); }
        ptr[0] = oa; ptr[1] = ob;
    }
}

DI void cmpfinal_phase(PP pp) {
    PPOPAQ();
    int tid = threadIdx.x; asm volatile("" : "+v"(tid));
    const int lane = tid & 63, wave = __builtin_amdgcn_readfirstlane(tid >> 6);
    const int G_ = opaque_s((int)gridDim.x), bx_ = opaque_s((int)blockIdx.x);
    const int gw = bx_ * 8 + wave, NGW = G_ * 8, gtid = bx_ * 512 + tid, NT = G_ * 512;
    (void)lane; (void)wave; (void)gw; (void)NGW; (void)gtid; (void)NT;
    unsigned char* ws = pp->ws; const float* CR = (const float*)(ws + WS_CRAW);
    for (int i = gtid; i < 2 * 4 * 512 * 32; i += NT) { const int d = i & 31, c = (i >> 5) & 511, bg = i >> 14, b = bg >> 2;
        const float* src = CR + ((size_t)bg * 512 + c) * 64; float x1 = src[d], x2 = src[d + 32];
        float o1 = 0.f, o2 = 0.f;
        if (c < 511) { const float pos = (float)pp->pos[b * S_ + 16 * c + 31]; const float inv = fexp2(-(float)d * 0.41524101186092029f); const float ang = pos * inv;
            const double rev = (double)ang * 0.15915494309189535; const float fr = (float)(rev - __builtin_rint(rev));
            const float sn = __builtin_amdgcn_sinf(fr), cs = __builtin_amdgcn_cosf(fr); o1 = x1 * cs - x2 * sn; o2 = x2 * cs + x1 * sn; }
        bf16_t* dst = (bf16_t*)(ws + WS_KCMP) + ((size_t)bg * 512 + c) * 64; dst[d] = (bf16_t)f2bf(o1); dst[d + 32] = (bf16_t)f2bf(o2); }
    for (int i = gtid; i < 2 * 4 * 64 * 512; i += NT) { const int c = i & 511, d = (i >> 9) & 63, bg = i >> 15;
        const float v = (c < 511) ? CR[((size_t)(8 + bg) * 512 + c) * 64 + d] : 0.f;
        ((bf16_t*)(ws + WS_VTCMP))[((size_t)bg * 64 + d) * 512 + c] = (bf16_t)f2bf(v); }
}

constexpr int KSTR = 144, VSTR = 136;
constexpr int L_K = 0, L_V = 2 * 64 * KSTR, L_IMP = L_V + 2 * 64 * VSTR, IMPSTR = 132, L_SEL = L_IMP + 64 * IMPSTR * 4, L_ATT_END = L_SEL + 64 * 16;
DI int crow(int r, int hi) { return (r & 3) + 8 * (r >> 2) + 4 * hi; }

struct TileSrc { const bf16_t* K; int kstr; const bf16_t* Vt; int vstr; };

template <int MODE>
DI void attn_loop(LAS unsigned char* lds, const TileSrc src, int j0, int j1, const bf16x8 (&qf)[4], f32x16 (&o)[2], float& m_run, float& l_run,
                  int tl, int t, int tb, u64 selLo, u64 selHi, int tid, int wave, int lane) {
    const int n = lane & 31, hh = lane >> 5;
    const int lrow = tid >> 3, lchunk = tid & 7;
    u32x4 kreg, vreg;
    kreg = *(const u32x4*)(src.K + (size_t)(64 * j0 + lrow) * src.kstr + lchunk * 8);
    vreg = *(const u32x4*)(src.Vt + (size_t)lrow * src.vstr + 64 * j0 + lchunk * 8);
    float carry = 0.f;
    int buf = 0;
    for (int j = j0; j <= j1; ++j) {
        LAS unsigned char* Kl = lds + L_K + buf * 64 * KSTR; LAS unsigned char* Vl = lds + L_V + buf * 64 * VSTR;
        *(LAS u32x4*)(Kl + lrow * KSTR + lchunk * 16) = kreg;
        *(LAS u32x2*)(Vl + lrow * VSTR + lchunk * 16) = (u32x2){vreg.x, vreg.y}; *(LAS u32x2*)(Vl + lrow * VSTR + lchunk * 16 + 8) = (u32x2){vreg.z, vreg.w};
        __syncthreads();
        if (j < j1) { kreg = *(const u32x4*)(src.K + (size_t)(64 * (j + 1) + lrow) * src.kstr + lchunk * 8);
                      vreg = *(const u32x4*)(src.Vt + (size_t)lrow * src.vstr + 64 * (j + 1) + lchunk * 8); }
        buf ^= 1;
        bool active = true;
        if (MODE == 2) { const bool bit = ((j < 64 ? selLo : selHi) >> (j & 63)) & 1ull; active = __ballot(bit) != 0ull; }
        if (!active) continue;
        f32x16 s[2];
#pragma unroll
        for (int u = 0; u < 2; ++u) {
#pragma unroll
            for (int e = 0; e < 16; ++e) s[u][e] = 0.f;
#pragma unroll
            for (int ks = 0; ks < 4; ++ks) { const bf16x8 kf = *(const LAS bf16x8*)(Kl + (32 * u + n) * KSTR + (ks * 16 + 8 * hh) * 2);
                s[u] = __builtin_amdgcn_mfma_f32_32x32x16_bf16(kf, qf[ks], s[u], 0, 0, 0); }
        }
        const float NEGINF = -__builtin_inff();
        if (MODE <= 1) { const int cmax = min(510, (t - 31) >> 4);
#pragma unroll
            for (int u = 0; u < 2; ++u)
#pragma unroll
                for (int e = 0; e < 16; ++e) { const int c = 64 * j + 32 * u + crow(e, hh); if (c > cmax) s[u][e] = NEGINF; }
        } else if (MODE == 2) { const bool bit = ((j < 64 ? selLo : selHi) >> (j & 63)) & 1ull; const int lim = (j == tb) ? tl : 64;
#pragma unroll
            for (int u = 0; u < 2; ++u)
#pragma unroll
                for (int e = 0; e < 16; ++e) { const int kk = 32 * u + crow(e, hh); if (!bit || kk > lim) s[u][e] = NEGINF; }
        } else {
#pragma unroll
            for (int u = 0; u < 2; ++u)
#pragma unroll
                for (int e = 0; e < 16; ++e) { const int df = t - (64 * j + 32 * u + crow(e, hh)); if ((unsigned)df >= 512u) s[u][e] = NEGINF; }
        }
        if (MODE == 1) {
            const float msafe = (m_run == NEGINF) ? 0.f : m_run;
#pragma unroll
            for (int u = 0; u < 2; ++u)
#pragma unroll
                for (int e = 0; e < 16; ++e) s[u][e] = fexp2(s[u][e] - msafe) * l_run;
            if (tb >= 16) {
                float w1[8], w2[8], pw2[8];
#pragma unroll
                for (int u = 0; u < 2; ++u)
#pragma unroll
                    for (int gi = 0; gi < 4; ++gi) { const float p0 = s[u][4 * gi], p1 = s[u][4 * gi + 1], p2 = s[u][4 * gi + 2], p3 = s[u][4 * gi + 3];
                        w1[u * 4 + gi] = p0 + p1 + p2 + 0.5f * p3; w2[u * 4 + gi] = 0.5f * p3; }
#pragma unroll
                for (int q = 0; q < 8; ++q) pw2[q] = shx(w2[q], 32, lane);
                float tot[8];
#pragma unroll
                for (int q = 0; q < 8; ++q) { const float prev = (q == 0) ? carry : pw2[q > 0 ? q - 1 : 0]; tot[q] = w1[q] + (hh ? pw2[q] : prev); }
                carry = pw2[7];
#pragma unroll
                for (int q = 0; q < 8; ++q) { float v = tot[q]; v += shx(v, 1, lane); v += shx(v, 2, lane); tot[q] = v; }
                if ((n & 3) == 0) { LAS float* imp = (LAS float*)(lds + L_IMP) + (8 * wave + (n >> 2)) * IMPSTR;
#pragma unroll
                    for (int q = 0; q < 8; ++q) { const int jj = 16 * j + 8 * (q >> 2) + 2 * (q & 3) + hh; if (jj < 128) imp[jj] = tot[q]; } }
            }
        } else {
            float mloc = s[0][0];
#pragma unroll
            for (int u = 0; u < 2; ++u)
#pragma unroll
                for (int e = 0; e < 16; ++e) mloc = fmaxf(mloc, s[u][e]);
            mloc = fmaxf(mloc, shx(mloc, 32, lane));
            const float mnew = fmaxf(m_run, mloc); const float msafe = (mnew == NEGINF) ? 0.f : mnew;
            const float alpha = fexp2(m_run - msafe);
            float ls = 0.f;
#pragma unroll
            for (int u = 0; u < 2; ++u)
#pragma unroll
                for (int e = 0; e < 16; ++e) { s[u][e] = fexp2(s[u][e] - msafe); ls += s[u][e]; }
            l_run = l_run * alpha + ls; m_run = mnew;
            if (MODE != 0) {
#pragma unroll
                for (int ds = 0; ds < 2; ++ds)
#pragma unroll
                    for (int e = 0; e < 16; ++e) o[ds][e] *= alpha;
            }
        }
        if (MODE != 0) {
#pragma unroll
            for (int u = 0; u < 2; ++u)
#pragma unroll
                for (int st = 0; st < 2; ++st) {
                    u32x4 pp; pp.x = pk2(s[u][8 * st], s[u][8 * st + 1]); pp.y = pk2(s[u][8 * st + 2], s[u][8 * st + 3]); pp.z = pk2(s[u][8 * st + 4], s[u][8 * st + 5]); pp.w = pk2(s[u][8 * st + 6], s[u][8 * st + 7]);
                    const bf16x8 pb = __builtin_bit_cast(bf16x8, pp);
#pragma unroll
                    for (int ds = 0; ds < 2; ++ds) { const LAS unsigned char* vp = Vl + (32 * ds + n) * VSTR + (32 * u + 16 * st + 4 * hh) * 2;
                        const u32x2 a0 = *(const LAS u32x2*)vp, a1 = *(const LAS u32x2*)(vp + 16);
                        const u32x4 av = {a0.x, a0.y, a1.x, a1.y};
                        o[ds] = __builtin_amdgcn_mfma_f32_32x32x16_bf16(__builtin_bit_cast(bf16x8, av), pb, o[ds], 0, 0, 0); }
                }
        }
    }
    __syncthreads();
}

DI void attn_phase(PP pp, LAS unsigned char* lds, bool do_store) {
    PPOPAQ();
    int tid = threadIdx.x; asm volatile("" : "+v"(tid));
    const int lane = tid & 63, wave = __builtin_amdgcn_readfirstlane(tid >> 6);
    const int G_ = opaque_s((int)gridDim.x), bx_ = opaque_s((int)blockIdx.x);
    const int gw = bx_ * 8 + wave, NGW = G_ * 8, gtid = bx_ * 512 + tid, NT = G_ * 512;
    (void)lane; (void)wave; (void)gw; (void)NGW; (void)gtid; (void)NT;
    unsigned char* ws = pp->ws; bf16_t* PROJ = (bf16_t*)(ws + WS_PROJ);
    const int n = lane & 31, hh = lane >> 5, G = G_;
    for (int it = 0; it < 4; ++it) {
        const int cc = (it & 1) ? (G - 1 - bx_) : bx_;
        const int rho = it * G + cc; if (rho >= 1024) continue;
        const int tb = 127 - (rho >> 3), bg = rho & 7, b = bg >> 2, g = bg & 3;
        const int t0 = 64 * tb, tl = 8 * wave + (n >> 2), r = n & 3, t = t0 + tl;
        const size_t trow = (size_t)b * S_ + t;
        bf16_t* qptr = PROJ + trow * LDP + C_Q + (4 * g + r) * 64;
        bf16x8 qf[4];
#pragma unroll
        for (int ks = 0; ks < 4; ++ks) qf[ks] = *(const bf16x8*)(qptr + ks * 16 + 8 * hh);
        f32x16 otot[2], o[2];
        for (int i = tid; i < 64 * IMPSTR; i += 512) ((LAS float*)(lds + L_IMP))[i] = 0.f;
        {
            TileSrc src{(const bf16_t*)(ws + WS_KCMP) + (size_t)bg * 512 * 64, 64, (const bf16_t*)(ws + WS_VTCMP) + (size_t)bg * 64 * 512, 512};
            int nvalid = (t0 + 32) / 16 + 1; if (nvalid > 511) nvalid = 511;
            const int j1 = (nvalid - 1) >> 6;
            float m = -__builtin_inff(), l = 0.f;
            attn_loop<0>(lds, src, 0, j1, qf, o, m, l, tl, t, tb, 0ull, 0ull, tid, wave, lane);
            l += shx(l, 32, lane);
            float inv = 1.0f / fmaxf(l, 1e-30f);
#pragma unroll
            for (int ds = 0; ds < 2; ++ds)
#pragma unroll
                for (int e = 0; e < 16; ++e) o[ds][e] = 0.f;
            attn_loop<1>(lds, src, 0, j1, qf, o, m, inv, tl, t, tb, 0ull, 0ull, tid, wave, lane);
#pragma unroll
            for (int ds = 0; ds < 2; ++ds)
#pragma unroll
                for (int e = 0; e < 16; ++e) otot[ds][e] = o[ds][e];
        }
        {
            const int tok = tid >> 3, prt = tid & 7;
            unsigned mk[4] = {0u, 0u, 0u, 0u};
            if (tb < 16) { mk[0] = (tb == 31) ? 0xffffffffu : ((2u << tb) - 1u); }
            else {
                const LAS float* imp = (const LAS float*)(lds + L_IMP) + tok * IMPSTR + 16 * prt;
                u64 keys[16];
#pragma unroll
                for (int e = 0; e < 16; ++e) { const int j = 16 * prt + e; const unsigned bits = __builtin_bit_cast(unsigned, imp[e]);
                    keys[e] = (j >= 1 && j <= tb - 1) ? (((u64)(bits + 1u) << 32) | (u64)(127 - j)) : 0ull; }
                mk[0] = 1u; mk[tb >> 5] |= 1u << (tb & 31);
                for (int round = 0; round < 14; ++round) {
                    u64 best = keys[0];
#pragma unroll
                    for (int e = 1; e < 16; ++e) best = keys[e] > best ? keys[e] : best;
#pragma unroll
                    for (int o2 = 1; o2 < 8; o2 <<= 1) { const u64 other = shx64(best, o2, lane); best = other > best ? other : best; }
                    if (best != 0ull) { const int jw = 127 - (int)(best & 127ull);
                        mk[0] |= (jw < 32) ? (1u << (jw & 31)) : 0u; mk[1] |= (jw >= 32 && jw < 64) ? (1u << (jw & 31)) : 0u;
                        mk[2] |= (jw >= 64 && jw < 96) ? (1u << (jw & 31)) : 0u; mk[3] |= (jw >= 96) ? (1u << (jw & 31)) : 0u; }
#pragma unroll
                    for (int e = 0; e < 16; ++e) if (keys[e] == best) keys[e] = 0ull;
                }
            }
            if (prt == 0) { LAS unsigned* sm = (LAS unsigned*)(lds + L_SEL) + tok * 4; sm[0] = mk[0]; sm[1] = mk[1]; sm[2] = mk[2]; sm[3] = mk[3]; }
            __syncthreads();
        }
        u64 selLo, selHi;
        { const LAS unsigned* sm = (const LAS unsigned*)(lds + L_SEL) + tl * 4; selLo = (u64)sm[0] | ((u64)sm[1] << 32); selHi = (u64)sm[2] | ((u64)sm[3] << 32); }
        {
            TileSrc src{PROJ + (size_t)b * S_ * LDP + C_KS + g * 64, LDP, (const bf16_t*)(ws + WS_VTS) + (size_t)bg * 64 * S_, S_};
            float m = -__builtin_inff(), l = 0.f;
#pragma unroll
            for (int ds = 0; ds < 2; ++ds)
#pragma unroll
                for (int e = 0; e < 16; ++e) o[ds][e] = 0.f;
            attn_loop<2>(lds, src, 0, tb, qf, o, m, l, tl, t, tb, selLo, selHi, tid, wave, lane);
            l += shx(l, 32, lane);
            const float f = sigmoidf_(bf2f(PROJ[((size_t)b * S_ + t) * LDP + C_GN + g * 12 + r * 3 + 1])) / (sigmoidf_(bf2f(PROJ[((size_t)b * S_ + t) * LDP + C_GN + g * 12 + r * 3])) * fmaxf(l, 1e-30f));
#pragma unroll
            for (int ds = 0; ds < 2; ++ds)
#pragma unroll
                for (int e = 0; e < 16; ++e) otot[ds][e] += f * o[ds][e];
        }
        {
            TileSrc src{PROJ + (size_t)b * S_ * LDP + C_KW + g * 64, LDP, (const bf16_t*)(ws + WS_VTW) + (size_t)bg * 64 * S_, S_};
            float m = -__builtin_inff(), l = 0.f;
#pragma unroll
            for (int ds = 0; ds < 2; ++ds)
#pragma unroll
                for (int e = 0; e < 16; ++e) o[ds][e] = 0.f;
            attn_loop<3>(lds, src, tb >= 8 ? tb - 8 : 0, tb, qf, o, m, l, tl, t, tb, 0ull, 0ull, tid, wave, lane);
            l += shx(l, 32, lane);
            const float f = sigmoidf_(bf2f(PROJ[((size_t)b * S_ + t) * LDP + C_GN + g * 12 + r * 3 + 2])) / (sigmoidf_(bf2f(PROJ[((size_t)b * S_ + t) * LDP + C_GN + g * 12 + r * 3])) * fmaxf(l, 1e-30f));
#pragma unroll
            for (int ds = 0; ds < 2; ++ds)
#pragma unroll
                for (int e = 0; e < 16; ++e) otot[ds][e] += f * o[ds][e];
        }
        if (do_store) {
            int ln2 = lane; asm volatile("" : "+v"(ln2));
            const int n2 = ln2 & 31, h2 = ln2 >> 5, t2 = t0 + 8 * wave + (n2 >> 2), r2 = n2 & 3;
            bf16_t* rowp = PROJ + ((size_t)b * S_ + t2) * LDP;
            const float gcv = sigmoidf_(bf2f(rowp[C_GN + g * 12 + r2 * 3]));
            bf16_t* op = rowp + C_Q + (4 * g + r2) * 64 + 4 * h2;
#pragma unroll
            for (int ds = 0; ds < 2; ++ds)
#pragma unroll
                for (int gi = 0; gi < 4; ++gi) { u32x2 w; w.x = pk2(gcv * otot[ds][4 * gi], gcv * otot[ds][4 * gi + 1]); w.y = pk2(gcv * otot[ds][4 * gi + 2], gcv * otot[ds][4 * gi + 3]);
                    *(u32x2*)(op + 32 * ds + 8 * gi) = w; }
        }
    }
}

__global__ void __launch_bounds__(512, 2) fwd_megakernel(Params p) {
    extern __shared__ __attribute__((aligned(16))) unsigned char lds_raw[];
    LAS unsigned char* lds = (LAS unsigned char*)lds_raw;
    cg::grid_group grid = cg::this_grid();
    const int G = gridDim.x, bx = blockIdx.x;
    PP pp = (PP)__builtin_amdgcn_kernarg_segment_ptr();
    volatile LAS unsigned* barst = (volatile LAS unsigned*)(lds + L_BARST);
    if (threadIdx.x == 0) { barst[0] = 0u; barst[1] = 0u; (void)xb_add((unsigned*)(pp->ws + WS_BAR) + XB_XCNT(xb_xcc_id()), 1u); }
    __syncthreads();
#define GSYNC() xcd_barrier((unsigned*)(ws + WS_BAR), barst)
#define ws (pp->ws)
#define PROJ ((bf16_t*)(ws + WS_PROJ))
#define H ((bf16_t*)(ws + WS_H))
#define XC ((bf16_t*)(ws + WS_XC))
#define Y ((float*)(ws + WS_RI))
    const int BIG = 1 << 30;

#ifndef NO_PREP
    prep_phase(pp, 0, lds);
#endif
#ifndef NO_ROW
    row_phase(pp->x, nullptr, nullptr, nullptr, pp->ln_mix_pre, H);
#endif
    grid.sync();

    for (int l = 0; l < NLAYER; ++l) {
        PPOPAQ();
        using pg8::Gemm; using pg8::Sched; using pg8::EpiBf16; using pg8::EpiF32; using pg8::EpiMerge;
#ifndef NO_G1
        for (int r_ = 0; r_ < opaque_s(GREP); ++r_) {
        pg8::gemm_phase<EpiBf16>(lds, Gemm{H, (const bf16_t*)(ws + WS_WIN), 1024, 1024, 1024, 128, 128},
            Sched{64, 35, opaque_s(G), opaque_s(bx), 0, BIG, 0u, 256u * 1024 * 2, 0u, 0u, 256u * 1024 * 2, 0u}, EpiBf16{PROJ, LDP, 0, 1.0f, nullptr, 0});
        pg8::gemm_phase<EpiBf16>(lds, Gemm{(const bf16_t*)(ws + WS_MEMN), (const bf16_t*)(ws + WS_WMKV), 1024, 1024, 1024, 128, 128},
            Sched{2, 4, opaque_s(G), (opaque_s(bx) + 64) % opaque_s(G), 0, BIG, 0u, 256u * 1024 * 2, 0u, 0u, 256u * 1024 * 2, 0u}, EpiBf16{(bf16_t*)(ws + WS_KMEM), 1024, 0, 1.0f, nullptr, 0});
        pg8::gemm_phase<EpiBf16>(lds, Gemm{(const bf16_t*)(ws + WS_WMKV) + (size_t)1024 * 1024, (const bf16_t*)(ws + WS_MEMN), 1024, 1024, 1024, 128, 128},
            Sched{4, 2, opaque_s(G), (opaque_s(bx) + 128) % opaque_s(G), 0, BIG, 0u, 256u * 1024 * 2, 0u, 0u, 256u * 1024 * 2, 0u}, EpiBf16{(bf16_t*)(ws + WS_VTMEM), 512, 0, 1.0f, nullptr, 0});
        }
#endif
        GSYNC();
#ifndef NO_POST
        postproj_phase(pp, l);
#endif
        GSYNC();
#ifndef NO_G1
        for (int r_ = 0; r_ < opaque_s(GREP); ++r_) {
        pg8::gemm_phase<EpiBf16>(lds, Gemm{XC, (const bf16_t*)(ws + WS_WLRU), 1024, 128, 128, 128, 128},
            Sched{64, 8, opaque_s(G), opaque_s(bx), 0, BIG, 0u, 256u * 1024 * 2, 128u * 2, 0u, 256u * 128 * 2, 0u}, EpiBf16{(bf16_t*)(ws + WS_RI), 2048, 0, 1.0f, nullptr, 0});
        pg8::gemm_phase<EpiBf16>(lds, Gemm{PROJ, (const bf16_t*)(ws + WS_WC1), 16 * LDP, 2048, 2048, LDP * 2, 128},
            Sched{32, 1, opaque_s(G), (opaque_s(bx) + 32) % opaque_s(G), 1, BIG, 0u, 0u, 0u, 0u, 0u, 0u}, EpiBf16{(bf16_t*)(ws + WS_HID), 256, 2, 1.0f, (const float*)(ws + WS_CBIAS), 0});
        pg8::gemm_phase<EpiBf16>(lds, Gemm{PROJ, (const bf16_t*)(ws + WS_KMEM), LDP, 1024, 256, 128, 128},
            Sched{64, 4, opaque_s(G), opaque_s(bx), 0, 32, (unsigned)C_QM * 2, 256u * LDP * 2, 256u * 2, 0u, 256u * 2, 256u * 1024 * 2}, EpiBf16{H, 1024, 0, 0.0625f * LOG2E, nullptr, 0});
        }
#endif
        GSYNC();
#ifndef NO_SCAN
        scan_phase(pp, l, 0);
#if defined(DUP_SCAN0)
        scan_phase(pp, l, 0);
#endif
#endif
#ifndef NO_MSM
        memsoftmax_phase(pp);
#endif
#ifndef NO_G2
        for (int r_ = 0; r_ < opaque_s(GREP); ++r_) {
        pg8::gemm_phase<EpiF32>(lds, Gemm{(const bf16_t*)(ws + WS_HID), (const bf16_t*)(ws + WS_WC2), 256, 256, 256, 128, 128},
            Sched{32, 1, opaque_s(G), (opaque_s(bx) + 96) % opaque_s(G), 0, 16, 0u, 256u * 256 * 2, 0u, 0u, 0u, 256u * 256 * 2}, EpiF32{(float*)(ws + WS_CRAW), 64, 64});
        }
#endif
        GSYNC();
#ifndef NO_SCAN
        scan_phase(pp, l, 1);
#endif
#ifndef NO_CMPF
        cmpfinal_phase(pp);
#endif
#ifndef NO_G1
        for (int r_ = 0; r_ < opaque_s(GREP); ++r_) {
        pg8::gemm_phase<EpiBf16>(lds, Gemm{H, (const bf16_t*)(ws + WS_VTMEM), 1024, 512, 256, 128, 128},
            Sched{64, 4, opaque_s(G), opaque_s(bx), 0, 32, 0u, 256u * 1024 * 2, 256u * 2, 0u, 256u * 512 * 2, 256u * 2}, EpiBf16{PROJ, LDP, 0, 1.0f, nullptr, C_QM});
        }
#endif
        GSYNC();
#ifndef NO_ATT
#if defined(DUP_ATT)
        attn_phase(pp, lds, opaque_s(0) != 0);
        __syncthreads();
#endif
        attn_phase(pp, lds, true);
#endif
        GSYNC();
#ifndef NO_G3
        for (int r_ = 0; r_ < opaque_s(GREP); ++r_) {
        pg8::gemm_phase<EpiMerge>(lds, Gemm{XC, (const bf16_t*)(ws + WS_WBRA), 1024, 1024, 1024, 128, 128},
            Sched{64, 4, opaque_s(G), opaque_s(bx), 0, BIG, 0u, 256u * 1024 * 2, 0u, 0u, 256u * 1024 * 2, 0u}, EpiMerge{PROJ + C_GM, LDP, Y, H, 0});
        pg8::gemm_phase<EpiMerge>(lds, Gemm{PROJ + C_Q, (const bf16_t*)(ws + WS_WBRB), LDP, 1024, 1024, 128, 128},
            Sched{64, 4, opaque_s(G), opaque_s(bx), 0, BIG, 0u, 256u * LDP * 2, 0u, 0u, 256u * 1024 * 2, 0u}, EpiMerge{PROJ + C_GM + 1024, LDP, Y, H, 1});
        pg8::gemm_phase<EpiMerge>(lds, Gemm{PROJ + C_QM, (const bf16_t*)(ws + WS_WBRC), LDP, 1024, 1024, 128, 128},
            Sched{64, 4, opaque_s(G), opaque_s(bx), 0, BIG, 0u, 256u * LDP * 2, 0u, 0u, 256u * 1024 * 2, 0u}, EpiMerge{PROJ + C_GM + 2048, LDP, Y, H, 2});
        }
#endif
        GSYNC();
#ifndef NO_G2
        for (int r_ = 0; r_ < opaque_s(GREP); ++r_) {
        pg8::gemm_phase<EpiF32>(lds, Gemm{H, (const bf16_t*)(ws + WS_WOUT), 1024, 1024, 1024, 128, 128},
            Sched{64, 4, opaque_s(G), opaque_s(bx), 0, BIG, 0u, 256u * 1024 * 2, 0u, 0u, 256u * 1024 * 2, 0u}, EpiF32{Y, 1024, 1024});
        }
#endif
        GSYNC();
#ifndef NO_ROW
        row_phase((l == 0) ? pp->x : pp->out, Y, pp->ln_mix_post + (size_t)l * 1024, pp->out, pp->ln_mlp_pre + (size_t)l * 1024, H);
#endif
        GSYNC();
#ifndef NO_G1
        for (int r_ = 0; r_ < opaque_s(GREP); ++r_) {
        pg8::gemm_phase<EpiBf16>(lds, Gemm{H, (const bf16_t*)(ws + WS_WM1), 1024, 1024, 1024, 128, 128},
            Sched{64, 16, opaque_s(G), opaque_s(bx), 0, BIG, 0u, 256u * 1024 * 2, 0u, 0u, 256u * 1024 * 2, 0u}, EpiBf16{PROJ, FF_, 1, 1.0f, nullptr, 0});
        }
#endif
        GSYNC();
#ifndef NO_G2
        for (int r_ = 0; r_ < opaque_s(GREP); ++r_) {
        pg8::gemm_phase<EpiF32>(lds, Gemm{PROJ, (const bf16_t*)(ws + WS_WM2), FF_, FF_, FF_, 128, 128},
            Sched{64, 4, opaque_s(G), opaque_s(bx), 0, BIG, 0u, 256u * FF_ * 2, 0u, 0u, 256u * FF_ * 2, 0u}, EpiF32{Y, 1024, 1024});
        }
#endif
        GSYNC();
#ifndef NO_ROW
        row_phase(pp->out, Y, pp->ln_mlp_post + (size_t)l * 1024, pp->out, (l + 1 < NLAYER) ? pp->ln_mix_pre + (size_t)(l + 1) * 1024 : nullptr, (l + 1 < NLAYER) ? H : nullptr);
#endif
#ifndef NO_PREP
        if (l + 1 < NLAYER) prep_phase(pp, l + 1, lds);
#if defined(DUP_PREP)
        if (l + 1 < NLAYER) prep_phase(pp, l + 1, lds);
#endif
#endif
        GSYNC();
    }
#undef ws
#undef PROJ
#undef H
#undef XC
#undef Y
}

extern "C" void kernel_launch(void* const* d_in, const int* in_sizes, int n_in, void* d_out, int out_size, void* d_ws, size_t ws_size, hipStream_t stream) {
    static int grid = 0;
    if (grid == 0) {
        int dev = 0, cus = 0, per_cu = 0;
        hipGetDevice(&dev); hipDeviceGetAttribute(&cus, hipDeviceAttributeMultiprocessorCount, dev);
        hipFuncSetAttribute((const void*)fwd_megakernel, hipFuncAttributeMaxDynamicSharedMemorySize, LDS_BYTES);
        hipOccupancyMaxActiveBlocksPerMultiprocessor(&per_cu, (const void*)fwd_megakernel, 512, LDS_BYTES);
        if (per_cu < 1) per_cu = 1;
        (void)hipGetLastError();
        grid = cus * 1;
        if (ws_size < WS_END) { fprintf(stderr, "kernel_launch: workspace too small (%zu < %zu)\n", ws_size, (size_t)WS_END); grid = -1; }
    }
    if (grid < 0) return;
    Params p{};
    p.x = (const float*)d_in[0]; p.mem = (const float*)d_in[1]; p.pos = (const int*)d_in[2];
    p.ln_mix_pre = (const float*)d_in[3]; p.w_in = (const float*)d_in[4]; p.conv_w = (const float*)d_in[5]; p.conv_b = (const float*)d_in[6];
    p.lru_wr = (const float*)d_in[7]; p.lru_br = (const float*)d_in[8]; p.lru_wi = (const float*)d_in[9]; p.lru_bi = (const float*)d_in[10]; p.lru_lambda = (const float*)d_in[11];
    p.cmp_pe = (const float*)d_in[12]; p.cmp_w1 = (const float*)d_in[13]; p.cmp_b1 = (const float*)d_in[14]; p.cmp_w2 = (const float*)d_in[15];
    p.ln_mem = (const float*)d_in[16]; p.w_mem_kv = (const float*)d_in[17]; p.w_br_rnn = (const float*)d_in[18]; p.w_br_nsa = (const float*)d_in[19]; p.w_br_mem = (const float*)d_in[20]; p.w_out = (const float*)d_in[21];
    p.ln_mix_post = (const float*)d_in[22]; p.ln_mlp_pre = (const float*)d_in[23]; p.mlp_w1 = (const float*)d_in[24]; p.mlp_w2 = (const float*)d_in[25]; p.ln_mlp_post = (const float*)d_in[26];
    p.out = (float*)d_out; p.ws = (unsigned char*)d_ws;
    (void)hipMemsetAsync((unsigned char*)d_ws + WS_BAR, 0, 16384, stream);
    void* args[] = {&p};
    hipError_t e = hipLaunchCooperativeKernel((const void*)fwd_megakernel, dim3(grid), dim3(512), args, LDS_BYTES, stream);
    if (e != hipSuccess) fprintf(stderr, "cooperative launch failed: %s (grid %d)\n", hipGetErrorString(e), grid);
}
```

```cpp
#include <hip/hip_runtime.h>
#include <hip/hip_cooperative_groups.h>
#include <cstdint>
#include <cstdio>
namespace cg = cooperative_groups;

#define LAS __attribute__((address_space(3)))
#define DI __device__ __forceinline__
typedef unsigned short bf16_t;
typedef short bf16x8 __attribute__((ext_vector_type(8)));
typedef short s16x4 __attribute__((ext_vector_type(4)));
typedef float f32x4 __attribute__((ext_vector_type(4)));
typedef float f32x16 __attribute__((ext_vector_type(16)));
typedef float f32x2 __attribute__((ext_vector_type(2)));
typedef unsigned u32x4 __attribute__((ext_vector_type(4)));
typedef unsigned u32x2 __attribute__((ext_vector_type(2)));
typedef __bf16 bf16x2v __attribute__((ext_vector_type(2)));
typedef unsigned long long u64;

constexpr int T_ = 16384, S_ = 8192, D_ = 1024, FF_ = 4096, LDP = 8960, NLAYER = 4;
constexpr int C_XR = 0, C_YR = 1024, C_Q = 2048, C_KC = 3072, C_VC = 3328, C_KS = 3584, C_VS = 3840, C_KW = 4096, C_VW = 4352,
              C_QM = 4608, C_GM = 5632, C_GN = 8704;
constexpr float EPS = 1e-6f;
constexpr float LOG2E = 1.4426950408889634f;

constexpr size_t al256(size_t x) { return (x + 255) & ~(size_t)255; }
constexpr size_t WS_PROJ = 0;
constexpr size_t WS_WIN = al256(WS_PROJ + (size_t)(T_ + 64) * LDP * 2);
constexpr size_t WS_WMKV = WS_WIN + (size_t)LDP * 1024 * 2;
constexpr size_t WS_WBRA = WS_WMKV + (size_t)2048 * 1024 * 2;
constexpr size_t WS_WBRB = WS_WBRA + (size_t)1024 * 1024 * 2;
constexpr size_t WS_WBRC = WS_WBRB + (size_t)1024 * 1024 * 2;
constexpr size_t WS_WOUT = WS_WBRC + (size_t)1024 * 1024 * 2;
constexpr size_t WS_WM1 = WS_WOUT + (size_t)1024 * 1024 * 2;
constexpr size_t WS_WM2 = WS_WM1 + (size_t)4096 * 1024 * 2;
constexpr size_t WS_WC1 = WS_WM2 + (size_t)4096 * 1024 * 2;
constexpr size_t WS_WC2 = WS_WC1 + (size_t)2 * 256 * 2048 * 2;
constexpr size_t WS_WLRU = WS_WC2 + (size_t)2 * 256 * 256 * 2;
constexpr size_t WS_H = WS_WLRU + (size_t)2048 * 128 * 2;
constexpr size_t WS_VTS = WS_H + (size_t)T_ * 1024 * 2;
constexpr size_t WS_VTW = WS_VTS + (size_t)8 * 64 * S_ * 2;
constexpr size_t WS_XC = WS_VTW + (size_t)8 * 64 * S_ * 2;
constexpr size_t WS_RI = WS_XC + (size_t)T_ * 1024 * 2;
constexpr size_t WS_HID = WS_RI + (size_t)T_ * 2048 * 2;
constexpr size_t WS_CRAW = WS_HID + (size_t)8192 * 256 * 2;
constexpr size_t WS_KCMP = WS_CRAW + (size_t)8192 * 64 * 4;
constexpr size_t WS_VTCMP = WS_KCMP + (size_t)8 * 512 * 64 * 2;
constexpr size_t WS_MEMN = WS_VTCMP + (size_t)8 * 512 * 64 * 2;
constexpr size_t WS_KMEM = WS_MEMN + (size_t)512 * 1024 * 2;
constexpr size_t WS_VTMEM = WS_KMEM + (size_t)512 * 1024 * 2;
constexpr size_t WS_SCA = WS_VTMEM + (size_t)512 * 1024 * 2;
constexpr size_t WS_SCH = WS_SCA + (size_t)2 * 128 * 1024 * 4;
constexpr size_t WS_CBP = WS_SCH + (size_t)2 * 128 * 1024 * 4;
constexpr size_t WS_CBIAS = WS_CBP + (size_t)16 * 512 * 4;
constexpr size_t WS_KF = al256(WS_CBIAS + 512 * 4);
constexpr size_t WS_BAR = WS_KF + (size_t)8 * 64 * S_ * 2;
constexpr size_t WS_END = WS_BAR + 16384;
constexpr int L_BARST = 147392;

#ifndef GREP
#define GREP 1
#endif
constexpr int LDS_BYTES = 147456;

DI unsigned f2bf(float f) { unsigned u = __builtin_bit_cast(unsigned, f); return (u + 0x7fffu + ((u >> 16) & 1u)) >> 16; }
DI unsigned pk2(float lo, float hi) { f32x2 f = {lo, hi}; bf16x2v r = __builtin_convertvector(f, bf16x2v); return __builtin_bit_cast(unsigned, r); }
DI float bf2f(unsigned short b) { return __builtin_bit_cast(float, (unsigned)b << 16); }
DI float bflo(unsigned w) { return __builtin_bit_cast(float, w << 16); }
DI float bfhi(unsigned w) { return __builtin_bit_cast(float, w & 0xffff0000u); }
DI float fexp2(float x) { return __builtin_amdgcn_exp2f(x); }
DI float sigmoidf_(float x) { return 1.0f / (1.0f + fexp2(-x * LOG2E)); }
DI float gelu_tanh(float x) { const float z = 0.7978845608028654f * (x + 0.044715f * x * x * x); return x / (1.0f + fexp2(-2.0f * LOG2E * z)); }
DI float shx(float v, int mask, int lane) { return __builtin_bit_cast(float, __builtin_amdgcn_ds_bpermute((lane ^ mask) << 2, __builtin_bit_cast(int, v))); }
DI u64 shx64(u64 v, int mask, int lane) { const int a = (lane ^ mask) << 2; const unsigned lo = (unsigned)__builtin_amdgcn_ds_bpermute(a, (int)(unsigned)v), hi = (unsigned)__builtin_amdgcn_ds_bpermute(a, (int)(unsigned)(v >> 32)); return ((u64)hi << 32) | lo; }
DI int opaque_s(int v) { asm volatile("" : "+s"(v)); return v; }
DI float wave_sum(float v, int lane) {
#pragma unroll
    for (int o = 1; o < 64; o <<= 1) v += shx(v, o, lane);
    return v;
}

namespace pg8 {
constexpr int BM = 256, BK = 64, HALF = 128, HTB = HALF * BK * 2, STAGE_BYTES = 8 * HTB, NXCD = 8, WGM = 8;
__host__ __device__ __forceinline__ int lds_byte(int r, int c) { const int st = (r >> 4) * 2 + (c >> 5), rr = r & 15, cc = c & 31, ob = rr * 64 + cc * 2; return st * 1024 + (ob ^ (((ob >> 9) & 1) << 5)); }
__host__ __device__ __forceinline__ void stage_rc(int b, int& R, int& C) { const int st = b / 1024, sb = b % 1024, swz = sb ^ (((sb >> 9) & 1) << 5); R = (st >> 1) * 16 + swz / 64; C = (st & 1) * 32 + (swz % 64) / 2; }
__host__ __device__ __forceinline__ int perm32(int rho) { const int n = rho >> 4, i = rho & 15; return 8 * (i >> 2) + 4 * n + (i & 3); }

struct Unit { int pm, pn; unsigned aoff, boff; };
struct Gemm { const bf16_t* A; const bf16_t* Bt; int lda, ldb, K, kstepA, kstepB; };

struct Sched {
    int nM, nN, G, c, kind, mdiv; unsigned a0, sAm, sAn, b0, sBn, sBb;
    DI bool next(int i, Unit& u) const {
        const long L = (long)i * G + c; const int nwg = nM * nN; if (L >= nwg) return false;
        int wgid = (int)L; { const int q = nwg / NXCD, r = nwg % NXCD, xcd = wgid % NXCD, off = wgid / NXCD; wgid = (xcd < r ? xcd * (q + 1) : r * (q + 1) + (xcd - r) * q) + off; }
        const int nig = WGM * nN, gid = wgid / nig, fm = gid * WGM, gsz = (nM - fm) < WGM ? (nM - fm) : WGM;
        const int pm = fm + ((wgid % nig) % gsz), pn = (wgid % nig) / gsz;
        u.pm = pm; u.pn = pn;
        if (kind == 1) {
            const int j = pm >> 4, b = (pm >> 3) & 1, g = (pm >> 1) & 3, ch = pm & 1;
            u.aoff = (unsigned)(((b * S_ + ch * 4096) * LDP + C_KC + j * 256 + g * 64) * 2); u.boff = (unsigned)(j * 256 * 2048 * 2);
        } else { const unsigned bb = (unsigned)(pm / mdiv); u.aoff = a0 + (unsigned)pm * sAm + (unsigned)pn * sAn; u.boff = b0 + (unsigned)pn * sBn + bb * sBb; }
        return true;
    }
};

DI unsigned cvt_pk_bf16(float lo, float hi) { return pk2(lo, hi); }

struct EpiBf16 {
    static constexpr bool PERM = true;
    bf16_t* O; int ldc; int act; float scale; const float* bias; int oc0;
    DI void operator()(const f32x4 (&acc)[2][2][4][2], const Unit& u, int wr, int wc, int fr, int fq) const {
        const int row0 = u.pm * 256 + wr * 64 + fr, col0 = oc0 + u.pn * 256 + wc * 32 + 8 * fq, bc0 = (u.pm >> 4) * 256 + wc * 32 + 8 * fq;
#pragma unroll
        for (int ai = 0; ai < 2; ++ai)
#pragma unroll
            for (int m = 0; m < 4; ++m) { bf16_t* rowp = O + (size_t)(row0 + ai * HALF + m * 16) * ldc + col0;
#pragma unroll
                for (int bj = 0; bj < 2; ++bj) { f32x4 v0 = acc[ai][bj][m][0], v1 = acc[ai][bj][m][1];
                    if (act == 0) { v0 = v0 * scale; v1 = v1 * scale; }
                    else if (act == 1) {
#pragma unroll
                        for (int e = 0; e < 4; ++e) { const float a = fmaxf(v0[e], 0.f), b = fmaxf(v1[e], 0.f); v0[e] = a * a; v1[e] = b * b; } }
                    else { const f32x4 b0 = *(const f32x4*)(bias + bc0 + bj * HALF), b1 = *(const f32x4*)(bias + bc0 + bj * HALF + 4);
#pragma unroll
                        for (int e = 0; e < 4; ++e) { v0[e] = gelu_tanh(v0[e] + b0[e]); v1[e] = gelu_tanh(v1[e] + b1[e]); } }
                    u32x4 w; w.x = cvt_pk_bf16(v0[0], v0[1]); w.y = cvt_pk_bf16(v0[2], v0[3]); w.z = cvt_pk_bf16(v1[0], v1[1]); w.w = cvt_pk_bf16(v1[2], v1[3]);
                    *(u32x4*)(rowp + bj * HALF) = w; } }
    }
};
struct EpiF32 {
    static constexpr bool PERM = false;
    float* O; int ldc; int ncol;
    DI void operator()(const f32x4 (&acc)[2][2][4][2], const Unit& u, int wr, int wc, int fr, int fq) const {
        const int row0 = u.pm * 256 + wr * 64 + fr, col0 = u.pn * 256 + wc * 32 + 4 * fq;
#pragma unroll
        for (int ai = 0; ai < 2; ++ai)
#pragma unroll
            for (int m = 0; m < 4; ++m) { float* rowp = O + (size_t)(row0 + ai * HALF + m * 16) * ldc;
#pragma unroll
                for (int bj = 0; bj < 2; ++bj)
#pragma unroll
                    for (int n = 0; n < 2; ++n) { const int c = col0 + bj * HALF + n * 16; if (c < ncol) *(f32x4*)(rowp + c) = acc[ai][bj][m][n]; } }
    }
};
struct EpiMerge {
    static constexpr bool PERM = false;
    const bf16_t* gate; int ldg; float* M; bf16_t* Hout; int mode;
    DI void operator()(const f32x4 (&acc)[2][2][4][2], const Unit& u, int wr, int wc, int fr, int fq) const {
        const int row0 = u.pm * 256 + wr * 64 + fr, col0 = u.pn * 256 + wc * 32 + 4 * fq;
#pragma unroll
        for (int ai = 0; ai < 2; ++ai)
#pragma unroll
            for (int m = 0; m < 4; ++m) { const size_t r = (size_t)(row0 + ai * HALF + m * 16);
#pragma unroll
                for (int bj = 0; bj < 2; ++bj)
#pragma unroll
                    for (int n = 0; n < 2; ++n) { const int c = col0 + bj * HALF + n * 16;
                        const u32x2 gw = *(const u32x2*)(gate + r * ldg + c);
                        f32x4 g; g[0] = sigmoidf_(bflo(gw.x)); g[1] = sigmoidf_(bfhi(gw.x)); g[2] = sigmoidf_(bflo(gw.y)); g[3] = sigmoidf_(bfhi(gw.y));
                        f32x4 v = acc[ai][bj][m][n] * g;
                        float* mp = M + r * 1024 + c;
                        if (mode != 0) v = v + *(const f32x4*)mp;
                        if (mode != 2) *(f32x4*)mp = v;
                        else { u32x2 w; w.x = cvt_pk_bf16(v[0], v[1]); w.y = cvt_pk_bf16(v[2], v[3]); *(u32x2*)(Hout + r * 1024 + c) = w; } } }
    }
};

template <class Epi>
DI void gemm_phase(LAS unsigned char* lds, const Gemm g, const Sched& S, const Epi& E) {
    int tid = threadIdx.x; asm volatile("" : "+v"(tid));
    const int wid = __builtin_amdgcn_readfirstlane(tid >> 6), lane = tid & 63, wr = wid >> 2, wc = wid & 3, fr = lane & 15, fq = lane >> 4;
    const int nt = opaque_s(g.K / BK);
    unsigned voffA[2], voffB[2];
#pragma unroll
    for (int i = 0; i < 2; ++i) { int R, C; stage_rc(tid * 16 + i * 8192, R, C); const int Rb = Epi::PERM ? ((R & ~31) + perm32(R & 31)) : R;
        voffA[i] = (unsigned)(R * g.lda + C) * 2u; voffB[i] = (unsigned)(Rb * g.ldb + C) * 2u; }
    const size_t kstepA = (size_t)g.kstepA, kstepB = (size_t)g.kstepB;
    const size_t hstepA = (size_t)HALF * g.lda * 2, hstepB = (size_t)HALF * g.ldb * 2;
    const unsigned ldsw = (unsigned)wid * 1024u;
    const int aoff = lds_byte(wr * 64 + fr, fq * 8), boff = lds_byte(wc * 32 + fr, fq * 8);
#define PG8_SA(b, h) (((b) * 2 + (h)) * HTB)
#define PG8_SB(b, h) ((4 + (b) * 2 + (h)) * HTB)
#define PG8_STAGE(bufoff, gbase, voff) do { _Pragma("unroll") for (int _i = 0; _i < 2; ++_i) \
        __builtin_amdgcn_global_load_lds((const unsigned*)((const char*)(gbase) + (voff)[_i]), (LAS unsigned*)(lds + (bufoff) + ldsw + _i * 8192), 16, 0, 0); } while (0)
#define PG8_LDA(dst, b, h) do { _Pragma("unroll") for (int m = 0; m < 4; ++m) _Pragma("unroll") for (int k = 0; k < 2; ++k) dst[m][k] = *(const LAS bf16x8*)(lds + PG8_SA(b, h) + aoff + m * 2048 + k * 1024); } while (0)
#define PG8_LDB(dst, b, h) do { _Pragma("unroll") for (int n = 0; n < 2; ++n) _Pragma("unroll") for (int k = 0; k < 2; ++k) dst[n][k] = *(const LAS bf16x8*)(lds + PG8_SB(b, h) + boff + n * 2048 + k * 1024); } while (0)
#define PG8_MMA(ai, bj, At, Bt) do { __builtin_amdgcn_s_setprio(1); _Pragma("unroll") for (int m = 0; m < 4; ++m) _Pragma("unroll") for (int n = 0; n < 2; ++n) _Pragma("unroll") for (int k = 0; k < 2; ++k) \
        acc[ai][bj][m][n] = __builtin_amdgcn_mfma_f32_16x16x32_bf16(Bt[n][k], At[m][k], acc[ai][bj][m][n], 0, 0, 0); __builtin_amdgcn_s_setprio(0); } while (0)
#define PG8_WAIT_V(n) asm volatile("s_waitcnt vmcnt(" #n ")" ::: "memory")
#define PG8_WAIT_L(n) asm volatile("s_waitcnt lgkmcnt(" #n ")" ::: "memory")
#define PG8_BAR __builtin_amdgcn_s_barrier()
#define PG8_SCHED __builtin_amdgcn_sched_barrier(0)
    Unit cur, nxt; int ui = 0;
    if (!S.next(0, cur)) return;
    f32x4 acc[2][2][4][2];
#pragma unroll
    for (int a = 0; a < 2; ++a)
#pragma unroll
        for (int b = 0; b < 2; ++b)
#pragma unroll
            for (int m = 0; m < 4; ++m)
#pragma unroll
                for (int n = 0; n < 2; ++n) acc[a][b][m][n] = (f32x4){0.f, 0.f, 0.f, 0.f};
    bf16x8 At[4][2], B0[2][2], B1[2][2];
    const char* cA = (const char*)g.A + cur.aoff; const char* cB = (const char*)g.Bt + cur.boff;
    PG8_STAGE(PG8_SB(0, 0), cB, voffB); PG8_STAGE(PG8_SB(0, 1), cB + hstepB, voffB); PG8_STAGE(PG8_SA(0, 0), cA, voffA); PG8_STAGE(PG8_SA(0, 1), cA + hstepA, voffA);
    if (wr == 1) PG8_BAR;
    PG8_WAIT_V(2); PG8_BAR;
    PG8_STAGE(PG8_SB(1, 0), cB + kstepB, voffB); PG8_STAGE(PG8_SA(1, 0), cA + kstepA, voffA); PG8_STAGE(PG8_SB(1, 1), cB + hstepB + kstepB, voffB);
    PG8_WAIT_V(6); PG8_BAR;
    for (;;) {
        const bool has_next = S.next(ui + 1, nxt);
        const char* nA = has_next ? (const char*)g.A + nxt.aoff : cA; const char* nB = has_next ? (const char*)g.Bt + nxt.boff : cB;
        for (int t = 0; t < nt; t += 2) {
            const bool last = (t == nt - 2);
            const char* a1 = cA + (size_t)(t + 1) * kstepA;
            const char* a2 = last ? nA : cA + (size_t)(t + 2) * kstepA; const char* b2 = last ? nB : cB + (size_t)(t + 2) * kstepB;
            const char* a3 = a2 + kstepA; const char* b3 = b2 + kstepB;
            PG8_LDB(B0, 0, 0); PG8_LDB(B1, 0, 1); PG8_SCHED; PG8_LDA(At, 0, 0); PG8_STAGE(PG8_SA(1, 1), a1 + hstepA, voffA);
            PG8_WAIT_V(8); PG8_WAIT_L(0); PG8_BAR; PG8_MMA(0, 0, At, B0); PG8_MMA(0, 1, At, B1); PG8_BAR; PG8_SCHED;
            PG8_LDA(At, 0, 1); PG8_STAGE(PG8_SB(0, 0), b2, voffB); PG8_STAGE(PG8_SB(0, 1), b2 + hstepB, voffB); PG8_STAGE(PG8_SA(0, 0), a2, voffA);
            PG8_WAIT_V(8); PG8_WAIT_L(0); PG8_BAR; PG8_MMA(1, 0, At, B0); PG8_MMA(1, 1, At, B1); PG8_BAR; PG8_SCHED;
            PG8_LDB(B0, 1, 0); PG8_LDB(B1, 1, 1); PG8_SCHED; PG8_LDA(At, 1, 0); PG8_STAGE(PG8_SA(0, 1), a2 + hstepA, voffA);
            PG8_WAIT_V(8); PG8_WAIT_L(0); PG8_BAR; PG8_MMA(0, 0, At, B0); PG8_MMA(0, 1, At, B1); PG8_BAR; PG8_SCHED;
            PG8_LDA(At, 1, 1); PG8_STAGE(PG8_SB(1, 0), b3, voffB); PG8_STAGE(PG8_SB(1, 1), b3 + hstepB, voffB); PG8_STAGE(PG8_SA(1, 0), a3, voffA);
            PG8_WAIT_V(8); PG8_WAIT_L(0); PG8_BAR; PG8_MMA(1, 0, At, B0); PG8_MMA(1, 1, At, B1); PG8_BAR; PG8_SCHED;
        }
        if (wr == 0) PG8_BAR;
        E(acc, cur, wr, wc, fr, fq);
        if (!has_next) break;
#pragma unroll
        for (int a = 0; a < 2; ++a)
#pragma unroll
            for (int b = 0; b < 2; ++b)
#pragma unroll
                for (int m = 0; m < 4; ++m)
#pragma unroll
                    for (int n = 0; n < 2; ++n) acc[a][b][m][n] = (f32x4){0.f, 0.f, 0.f, 0.f};
        cur = nxt; cA = nA; cB = nB; ++ui;
        if (wr == 1) PG8_BAR;
    }
    PG8_WAIT_V(0);
    PG8_BAR;
#undef PG8_SA
#undef PG8_SB
#undef PG8_STAGE
#undef PG8_LDA
#undef PG8_LDB
#undef PG8_MMA
#undef PG8_WAIT_V
#undef PG8_WAIT_L
#undef PG8_BAR
#undef PG8_SCHED
}
}


#define XB_TMO      128
#define XB_XCNT(j)  (256  + 64 * (j))
#define XB_XSUB(j)  (1280 + 64 * (j))
#define XB_XGEN(j)  (2304 + 64 * (j))
#define XB_TOP      3328
#define XB_TOPGEN   3392
#define XCD_BAR_WORDS 3456
#define XB_SPIN_CAP (1u << 22)
DI unsigned xb_ld(unsigned* p)              { return __hip_atomic_load(p, __ATOMIC_RELAXED, __HIP_MEMORY_SCOPE_AGENT); }
DI unsigned xb_add(unsigned* p, unsigned v) { return __hip_atomic_fetch_add(p, v, __ATOMIC_RELAXED, __HIP_MEMORY_SCOPE_AGENT); }
DI unsigned xb_xcc_id() { return (unsigned)__builtin_amdgcn_s_getreg((3 << 11) | 20) & 0xFu; }
#define XB_SPIN(cond, bar) do { unsigned _sp = 0; while (cond) { __builtin_amdgcn_s_sleep(1); \
    if ((++_sp & 255u) == 0u) { if (xb_ld(&(bar)[XB_TMO])) break; if (_sp > XB_SPIN_CAP) { atomicAdd(&(bar)[XB_TMO], 1u); break; } } } } while (0)
DI void xcd_barrier_complete(unsigned* bar, unsigned x, unsigned& nloc, unsigned& nx) {
    const unsigned G = gridDim.x * gridDim.y * gridDim.z;
    unsigned sum, cnt, mine, sp = 0u;
    for (;;) {
        sum = 0u; cnt = 0u; mine = 0u;
#pragma unroll
        for (unsigned j = 0; j < 16; ++j) { const unsigned c = xb_ld(&bar[XB_XCNT(j)]); sum += c; cnt += (c > 0u) ? 1u : 0u; mine = (j == x) ? c : mine; }
        if (sum == G) break;
        __builtin_amdgcn_s_sleep(1);
        if ((++sp & 255u) == 0u) { if (xb_ld(&bar[XB_TMO])) break; if (sp > XB_SPIN_CAP) { atomicAdd(&bar[XB_TMO], 1u); break; } }
    }
    nloc = mine > 0u ? mine : 1u; nx = cnt > 0u ? cnt : 1u;
}
DI void xcd_barrier(unsigned* bar, volatile LAS unsigned* st) {
    asm volatile("s_waitcnt vmcnt(0)" ::: "memory");
    __syncthreads();
    if (threadIdx.x == 0) {
        __builtin_amdgcn_s_waitcnt(0);
        const unsigned x = xb_xcc_id();
        unsigned nloc = st[0], nx = st[1];
        if (nloc == 0u) { xcd_barrier_complete(bar, x, nloc, nx); st[0] = nloc; st[1] = nx; }
        const unsigned old = xb_add(&bar[XB_XSUB(x)], 1u);
        const unsigned gen = old / nloc;
        if (old + 1u == (gen + 1u) * nloc) {
            __builtin_amdgcn_fence(__ATOMIC_RELEASE, "agent");
            asm volatile("s_waitcnt vmcnt(0)" ::: "memory");
            const unsigned og = xb_add(&bar[XB_TOP], 1u);
            const unsigned tg = og / nx;
            if (og + 1u == (tg + 1u) * nx) xb_add(&bar[XB_TOPGEN], 1u);
            else XB_SPIN(xb_ld(&bar[XB_TOPGEN]) == tg, bar);
            __builtin_amdgcn_fence(__ATOMIC_ACQUIRE, "agent");
            xb_add(&bar[XB_XGEN(x)], 1u);
            asm volatile("s_waitcnt vmcnt(0)" ::: "memory");
        } else {
            XB_SPIN(xb_ld(&bar[XB_XGEN(x)]) == gen, bar);
            __builtin_amdgcn_fence(__ATOMIC_ACQUIRE, "agent");
            asm volatile("s_waitcnt vmcnt(0)" ::: "memory");
        }
    }
    __syncthreads();
}

struct Params {
    const float* x; const float* mem; const int* pos;
    const float* ln_mix_pre; const float* w_in; const float* conv_w; const float* conv_b;
    const float* lru_wr; const float* lru_br; const float* lru_wi; const float* lru_bi; const float* lru_lambda;
    const float* cmp_pe; const float* cmp_w1; const float* cmp_b1; const float* cmp_w2;
    const float* ln_mem; const float* w_mem_kv; const float* w_br_rnn; const float* w_br_nsa; const float* w_br_mem; const float* w_out;
    const float* ln_mix_post; const float* ln_mlp_pre; const float* mlp_w1; const float* mlp_w2; const float* ln_mlp_post;
    float* out; unsigned char* ws;
};
typedef const __attribute__((address_space(4))) Params* PP;
#define PPOPAQ() asm volatile("" : "+s"(pp))

DI void tr_item(const float* W, int ldw, int srccol, int valid, int k0, bf16_t* WT, int ldt, int drow0, LAS float* scr, int lane) {
    const int c32 = lane & 31;
#pragma unroll 8
    for (int i = 0; i < 32; ++i) { const int kk = 2 * i + (lane >> 5); float v = 0.f; if (c32 < valid) v = W[(size_t)(k0 + kk) * ldw + srccol + c32]; scr[kk * 33 + c32] = v; }
    __builtin_amdgcn_s_waitcnt(0xc07f); asm volatile("s_waitcnt lgkmcnt(0)" ::: "memory");
    const int c = lane & 7;
#pragma unroll
    for (int j = 0; j < 4; ++j) { const int n = (lane >> 3) + 8 * j; const LAS float* s = scr + (8 * c) * 33 + n;
        u32x4 o; o.x = pk2(s[0 * 33], s[1 * 33]); o.y = pk2(s[2 * 33], s[3 * 33]); o.z = pk2(s[4 * 33], s[5 * 33]); o.w = pk2(s[6 * 33], s[7 * 33]);
        *(u32x4*)(WT + (size_t)(drow0 + n) * ldt + k0 + 8 * c) = o; }
    asm volatile("s_waitcnt lgkmcnt(0)" ::: "memory");
}

DI void prep_phase(PP pp, int l, LAS unsigned char* lds) {
    PPOPAQ();
    int tid = threadIdx.x; asm volatile("" : "+v"(tid));
    const int lane = tid & 63, wave = __builtin_amdgcn_readfirstlane(tid >> 6);
    const int G_ = opaque_s((int)gridDim.x), bx_ = opaque_s((int)blockIdx.x);
    const int gw = bx_ * 8 + wave, NGW = G_ * 8, gtid = bx_ * 512 + tid, NT = G_ * 512;
    (void)lane; (void)wave; (void)gw; (void)NGW; (void)gtid; (void)NT;
    LAS float* scr = (LAS float*)(lds + wave * 8704);
    unsigned char* ws = pp->ws;
    const float* w_in = pp->w_in + (size_t)l * 1024 * 8752;
    constexpr int I_IN = 16 * 280, I_MKV = 16 * 64, I_BR = 16 * 32, I_M1 = 16 * 128, I_M2 = 64 * 32, I_C1 = 2 * 32 * 8, I_C2 = 2 * 4 * 8, I_LRU = 2 * 8 * 2 * 4;
    constexpr int NITEMS = I_IN + I_MKV + 4 * I_BR + I_M1 + I_M2 + I_C1 + I_C2 + I_LRU;
    for (int it = gw; it < NITEMS; it += NGW) {
        int r = it;
        if (r < I_IN) { const int kb = r / 280, nb = r % 280, n0 = 32 * nb; int src, valid = 32;
            if (n0 < 4608) src = n0; else if (n0 < 5632) src = n0 - 4608 + 4656; else if (n0 < 8704) src = n0 - 5632 + 5680;
            else { src = n0 - 8704 + 4608; valid = 48 - (n0 - 8704); valid = valid < 0 ? 0 : (valid > 32 ? 32 : valid); if (valid == 0) src = 0; }
            tr_item(w_in, 8752, src, valid, 64 * kb, (bf16_t*)(ws + WS_WIN), 1024, n0, scr, lane); continue; } r -= I_IN;
        if (r < I_MKV) { tr_item(pp->w_mem_kv + (size_t)l * 1024 * 2048, 2048, 32 * (r % 64), 32, 64 * (r / 64), (bf16_t*)(ws + WS_WMKV), 1024, 32 * (r % 64), scr, lane); continue; } r -= I_MKV;
        if (r < I_BR) { tr_item(pp->w_br_rnn + (size_t)l * 1024 * 1024, 1024, 32 * (r % 32), 32, 64 * (r / 32), (bf16_t*)(ws + WS_WBRA), 1024, 32 * (r % 32), scr, lane); continue; } r -= I_BR;
        if (r < I_BR) { tr_item(pp->w_br_nsa + (size_t)l * 1024 * 1024, 1024, 32 * (r % 32), 32, 64 * (r / 32), (bf16_t*)(ws + WS_WBRB), 1024, 32 * (r % 32), scr, lane); continue; } r -= I_BR;
        if (r < I_BR) { tr_item(pp->w_br_mem + (size_t)l * 1024 * 1024, 1024, 32 * (r % 32), 32, 64 * (r / 32), (bf16_t*)(ws + WS_WBRC), 1024, 32 * (r % 32), scr, lane); continue; } r -= I_BR;
        if (r < I_BR) { tr_item(pp->w_out + (size_t)l * 1024 * 1024, 1024, 32 * (r % 32), 32, 64 * (r / 32), (bf16_t*)(ws + WS_WOUT), 1024, 32 * (r % 32), scr, lane); continue; } r -= I_BR;
        if (r < I_M1) { tr_item(pp->mlp_w1 + (size_t)l * 1024 * 4096, 4096, 32 * (r % 128), 32, 64 * (r / 128), (bf16_t*)(ws + WS_WM1), 1024, 32 * (r % 128), scr, lane); continue; } r -= I_M1;
        if (r < I_M2) { tr_item(pp->mlp_w2 + (size_t)l * 4096 * 1024, 1024, 32 * (r % 32), 32, 64 * (r / 32), (bf16_t*)(ws + WS_WM2), 4096, 32 * (r % 32), scr, lane); continue; } r -= I_M2;
        if (r < I_C1) { const int j = r / 256, q = r % 256;
            tr_item(pp->cmp_w1 + ((size_t)l * 2 + j) * 2048 * 256, 256, 32 * (q % 8), 32, 64 * (q / 8), (bf16_t*)(ws + WS_WC1) + (size_t)j * 256 * 2048, 2048, 32 * (q % 8), scr, lane); continue; } r -= I_C1;
        if (r < I_C2) { const int j = r / 32, q = r % 32; const int n0 = 32 * (q % 8);
            tr_item(pp->cmp_w2 + ((size_t)l * 2 + j) * 256 * 64, 64, n0 < 64 ? n0 : 0, n0 < 64 ? 32 : 0, 64 * (q / 8), (bf16_t*)(ws + WS_WC2) + (size_t)j * 256 * 256, 256, n0, scr, lane); continue; } r -= I_C2;
        { const int ri = r / 64, q = r % 64, blk = q / 8, q2 = q % 8;
            const float* W = (ri == 0 ? pp->lru_wr : pp->lru_wi) + ((size_t)l * 8 + blk) * 128 * 128;
            tr_item(W, 128, 32 * (q2 % 4), 32, 64 * (q2 / 4), (bf16_t*)(ws + WS_WLRU), 128, blk * 256 + ri * 128 + 32 * (q2 % 4), scr, lane); }
    }
    for (int m = gw; m < 512; m += NGW) {
        const f32x4* xr = (const f32x4*)(pp->mem + (size_t)m * 1024) + lane; const f32x4* gr = (const f32x4*)(pp->ln_mem + (size_t)l * 1024) + lane;
        f32x4 v[4]; float s = 0.f;
#pragma unroll
        for (int j = 0; j < 4; ++j) { v[j] = xr[64 * j]; s += (v[j].x * v[j].x + v[j].y * v[j].y) + (v[j].z * v[j].z + v[j].w * v[j].w); }
        const float rs = 1.0f / sqrtf(wave_sum(s, lane) * (1.f / 1024.f) + EPS);
        u32x2* o8 = (u32x2*)((bf16_t*)(ws + WS_MEMN) + (size_t)m * 1024) + lane;
#pragma unroll
        for (int j = 0; j < 4; ++j) { const f32x4 g = gr[64 * j]; u32x2 w; w.x = pk2(v[j].x * rs * g.x, v[j].y * rs * g.y); w.y = pk2(v[j].z * rs * g.z, v[j].w * rs * g.w); o8[64 * j] = w; }
    }
    {
        const int gt = gw * 64 + lane;
        if (gt < 16 * 512) { const int prt = gt / 512, jn = gt % 512, j = jn / 256, n = jn % 256;
            const float* w1 = pp->cmp_w1 + ((size_t)l * 2 + j) * 2048 * 256 + n; const float* pe = pp->cmp_pe + ((size_t)l * 2 + j) * 2048;
            float s = 0.f;
            for (int k = prt * 128; k < prt * 128 + 128; ++k) s += pe[k] * w1[(size_t)k * 256];
            ((float*)(ws + WS_CBP))[gt] = s; }
    }
}

DI void row_phase(const float* xin, const float* y, const float* gpost, float* xout, const float* gnext, bf16_t* hout) {
    int tid = threadIdx.x; asm volatile("" : "+v"(tid));
    const int lane = tid & 63, wave = __builtin_amdgcn_readfirstlane(tid >> 6);
    const int G_ = opaque_s((int)gridDim.x), bx_ = opaque_s((int)blockIdx.x);
    const int gw = bx_ * 8 + wave, NGW = G_ * 8, gtid = bx_ * 512 + tid, NT = G_ * 512;
    (void)lane; (void)wave; (void)gw; (void)NGW; (void)gtid; (void)NT;
    for (int m = gw; m < T_; m += NGW) {
        const f32x4* xr = (const f32x4*)(xin + (size_t)m * 1024) + lane;
        f32x4 v[4];
#pragma unroll
        for (int j = 0; j < 4; ++j) v[j] = xr[64 * j];
        if (y) {
            const f32x4* yr = (const f32x4*)(y + (size_t)m * 1024) + lane; const f32x4* gr = (const f32x4*)gpost + lane;
            f32x4 w[4]; float s = 0.f;
#pragma unroll
            for (int j = 0; j < 4; ++j) { w[j] = yr[64 * j]; s += (w[j].x * w[j].x + w[j].y * w[j].y) + (w[j].z * w[j].z + w[j].w * w[j].w); }
            const float rs = 1.0f / sqrtf(wave_sum(s, lane) * (1.f / 1024.f) + EPS);
            f32x4* xo = (f32x4*)(xout + (size_t)m * 1024) + lane;
#pragma unroll
            for (int j = 0; j < 4; ++j) { v[j] = v[j] + w[j] * rs * gr[64 * j]; xo[64 * j] = v[j]; }
        }
        if (hout) {
            float s = 0.f;
#pragma unroll
            for (int j = 0; j < 4; ++j) s += (v[j].x * v[j].x + v[j].y * v[j].y) + (v[j].z * v[j].z + v[j].w * v[j].w);
            const float rs = 1.0f / sqrtf(wave_sum(s, lane) * (1.f / 1024.f) + EPS);
            const f32x4* gr = (const f32x4*)gnext + lane; u32x2* o8 = (u32x2*)(hout + (size_t)m * 1024) + lane;
#pragma unroll
            for (int j = 0; j < 4; ++j) { const f32x4 g = gr[64 * j]; u32x2 w; w.x = pk2(v[j].x * rs * g.x, v[j].y * rs * g.y); w.y = pk2(v[j].z * rs * g.z, v[j].w * rs * g.w); o8[64 * j] = w; }
        }
    }
}

DI void rope8(u32x4& lo, u32x4& hi, float pos, int d0, float scale) {
    unsigned* pl = (unsigned*)&lo; unsigned* ph = (unsigned*)&hi;
    float x1[8], x2[8];
#pragma unroll
    for (int e = 0; e < 4; ++e) { x1[2 * e] = bflo(pl[e]); x1[2 * e + 1] = bfhi(pl[e]); x2[2 * e] = bflo(ph[e]); x2[2 * e + 1] = bfhi(ph[e]); }
#pragma unroll
    for (int e = 0; e < 8; ++e) {
        const float inv = fexp2(-(float)(d0 + e) * 0.41524101186092029f);
        const float ang = pos * inv;
        const double rev = (double)ang * 0.15915494309189535; const float fr = (float)(rev - __builtin_rint(rev));
        const float sn = __builtin_amdgcn_sinf(fr), cs = __builtin_amdgcn_cosf(fr);
        const float a = (x1[e] * cs - x2[e] * sn) * scale, b = (x2[e] * cs + x1[e] * sn) * scale; x1[e] = a; x2[e] = b;
    }
#pragma unroll
    for (int e = 0; e < 4; ++e) { pl[e] = pk2(x1[2 * e], x1[2 * e + 1]); ph[e] = pk2(x2[2 * e], x2[2 * e + 1]); }
}

DI void postproj_phase(PP pp, int l) {
    PPOPAQ();
    int tid = threadIdx.x; asm volatile("" : "+v"(tid));
    const int lane = tid & 63, wave = __builtin_amdgcn_readfirstlane(tid >> 6);
    const int G_ = opaque_s((int)gridDim.x), bx_ = opaque_s((int)blockIdx.x);
    const int gw = bx_ * 8 + wave, NGW = G_ * 8, gtid = bx_ * 512 + tid, NT = G_ * 512;
    (void)lane; (void)wave; (void)gw; (void)NGW; (void)gtid; (void)NT;
    unsigned char* ws = pp->ws; bf16_t* PROJ = (bf16_t*)(ws + WS_PROJ);
    {
        const float* cw = pp->conv_w + (size_t)l * 4 * 1024; const float* cb = pp->conv_b + (size_t)l * 1024; bf16_t* XC = (bf16_t*)(ws + WS_XC);
        for (int i = gtid; i < T_ * 128; i += NT) { const int t = i >> 7, c8 = (i & 127) * 8, ts = t & (S_ - 1);
            float acc[8];
#pragma unroll
            for (int e = 0; e < 8; ++e) acc[e] = cb[c8 + e];
#pragma unroll
            for (int w = 0; w < 4; ++w) { if (ts - 3 + w >= 0) { const u32x4 xv = *(const u32x4*)(PROJ + (size_t)(t - 3 + w) * LDP + C_XR + c8); const unsigned* xp = (const unsigned*)&xv;
                    const f32x4 k0 = *(const f32x4*)(cw + w * 1024 + c8), k1 = *(const f32x4*)(cw + w * 1024 + c8 + 4);
                    acc[0] += k0.x * bflo(xp[0]); acc[1] += k0.y * bfhi(xp[0]); acc[2] += k0.z * bflo(xp[1]); acc[3] += k0.w * bfhi(xp[1]);
                    acc[4] += k1.x * bflo(xp[2]); acc[5] += k1.y * bfhi(xp[2]); acc[6] += k1.z * bflo(xp[3]); acc[7] += k1.w * bfhi(xp[3]); } }
            u32x4 o; o.x = pk2(acc[0], acc[1]); o.y = pk2(acc[2], acc[3]); o.z = pk2(acc[4], acc[5]); o.w = pk2(acc[6], acc[7]);
            *(u32x4*)(XC + (size_t)t * 1024 + c8) = o; }
    }
    for (int i = gtid; i < T_ * 20 * 4; i += NT) { const int t = i / 80, r = i % 80, hd = r >> 2, d0 = (r & 3) * 8;
        int col; float sc = 1.0f;
        if (hd < 16) { col = C_Q + hd * 64; sc = 0.125f * LOG2E; } else col = C_KW + (hd - 16) * 64;
        bf16_t* base = PROJ + (size_t)t * LDP + col + d0;
        u32x4 lo = *(const u32x4*)base, hi = *(const u32x4*)(base + 32);
        rope8(lo, hi, (float)pp->pos[t], d0, sc);
        *(u32x4*)base = lo; *(u32x4*)(base + 32) = hi; }
    for (int i = gtid; i < 8 * 128 * 2 * 4 * 64; i += NT) { const int ln = i & 63, ks = (i >> 6) & 3, u = (i >> 8) & 1, j = (i >> 9) & 127, bg = i >> 16, b = bg >> 2, g = bg & 3;
        const int n = ln & 31, hh = ln >> 5, t = 64 * j + 32 * u + n, d0 = 16 * ks + 8 * hh, dl = d0 & 31;
        const bf16_t* base = PROJ + (size_t)(b * S_ + t) * LDP + C_KS + g * 64 + dl;
        u32x4 lo = *(const u32x4*)base, hi = *(const u32x4*)(base + 32);
        rope8(lo, hi, (float)pp->pos[b * S_ + t], dl, 1.0f);
        *(u32x4*)((bf16_t*)(ws + WS_KF) + (size_t)i * 8) = (d0 < 32) ? lo : hi; }
    for (int i = gtid; i < 8 * 128 * 2 * 2 * 2 * 64; i += NT) { const int ln = i & 63, st = (i >> 6) & 1, u = (i >> 7) & 1, ds = (i >> 8) & 1, j = (i >> 9) & 127, bg = i >> 16, b = bg >> 2, g = bg & 3;
        const int n = ln & 31, hh = ln >> 5, key0 = 64 * j + 32 * u + 16 * st + 4 * hh;
        const bf16_t* src = PROJ + (size_t)(b * S_ + key0) * LDP + C_VS + g * 64 + 32 * ds + n;
        unsigned short v[8];
#pragma unroll
        for (int e = 0; e < 8; ++e) v[e] = src[(size_t)(e < 4 ? e : e + 4) * LDP];
        u32x4 o; o.x = v[0] | ((unsigned)v[1] << 16); o.y = v[2] | ((unsigned)v[3] << 16); o.z = v[4] | ((unsigned)v[5] << 16); o.w = v[6] | ((unsigned)v[7] << 16);
        *(u32x4*)((bf16_t*)(ws + WS_VTS) + (size_t)i * 8) = o; }
    for (int i = gtid; i < 2 * 4 * 1024 * 64; i += NT) { const int d = i & 63, t8 = (i >> 6) & 1023, g = (i >> 16) & 3, b = (i >> 18) & 1, which = 1;
        const bf16_t* src = PROJ + (size_t)(b * S_ + t8 * 8) * LDP + (which ? C_VW : C_VS) + g * 64 + d;
        unsigned short v[8];
#pragma unroll
        for (int e = 0; e < 8; ++e) v[e] = src[(size_t)e * LDP];
        u32x4 o; o.x = v[0] | ((unsigned)v[1] << 16); o.y = v[2] | ((unsigned)v[3] << 16); o.z = v[4] | ((unsigned)v[5] << 16); o.w = v[6] | ((unsigned)v[7] << 16);
        *(u32x4*)((bf16_t*)(ws + (which ? WS_VTW : WS_VTS)) + ((size_t)(b * 4 + g) * 64 + d) * S_ + t8 * 8) = o; }
    if (gtid < 512) { const float* part = (const float*)(ws + WS_CBP); float s = pp->cmp_b1[(size_t)l * 512 + gtid];
        for (int q = 0; q < 16; ++q) s += part[q * 512 + gtid];
        ((float*)(ws + WS_CBIAS))[gtid] = s; }
}

DI void lru_ab(float rp, float ip, float xc, float cl, float& a, float& bb) {
    const float la = cl * sigmoidf_(rp);
    a = fexp2(la * LOG2E);
    const float x2 = 2.0f * la;
    float om;
    if (x2 > -0.1f) om = -x2 * (1.0f + x2 * (0.5f + x2 * (0.16666667f + x2 * (0.041666668f + x2 * 0.0083333338f)))); else om = 1.0f - a * a;
    bb = sqrtf(om) * sigmoidf_(ip) * xc;
}
DI void scan_phase(PP pp, int l, int pass) {
    PPOPAQ();
    int tid = threadIdx.x; asm volatile("" : "+v"(tid));
    const int G_ = opaque_s((int)gridDim.x), bx_ = opaque_s((int)blockIdx.x);
    unsigned char* ws = pp->ws; const bf16_t* __restrict__ RI = (const bf16_t*)(ws + WS_RI); bf16_t* XC = (bf16_t*)(ws + WS_XC); const bf16_t* __restrict__ PROJ = (const bf16_t*)(ws + WS_PROJ);
    f32x2* SA = (f32x2*)(ws + WS_SCA); f32x2* SH = (f32x2*)(ws + WS_SCH);
    const int ch = 2 * tid, blk = ch >> 7, cc = ch & 127, rcol = blk * 256 + cc;
    const f32x2 lam = *(const f32x2*)(pp->lru_lambda + (size_t)l * 1024 + ch), br = *(const f32x2*)(pp->lru_br + (size_t)l * 1024 + ch), bi = *(const f32x2*)(pp->lru_bi + (size_t)l * 1024 + ch);
    float cl[2];
#pragma unroll
    for (int e = 0; e < 2; ++e) { const float ex = fexp2(-lam[e] * LOG2E);
        const float sp = (ex < 0.05f) ? ex * (1.0f - ex * (0.5f - ex * (0.33333334f - ex * (0.25f - ex * (0.2f - ex * 0.16666667f))))) : ((-lam[e] > 20.f) ? -lam[e] : 0.6931471805599453f * __builtin_amdgcn_logf(1.0f + ex));
        cl[e] = -8.0f * sp; }
    for (int u = bx_; u < 256; u += G_) { const int b = u >> 7, k = u & 127;
        const size_t row0 = (size_t)b * S_ + k * 64;
        if (pass == 0) {
            float A0 = 1.f, H0 = 0.f, A1 = 1.f, H1 = 0.f;
            for (int s8 = 0; s8 < 64; s8 += 8) { unsigned rw[8], iw[8], xw[8];
#pragma unroll
                for (int e = 0; e < 8; ++e) { const size_t row = row0 + s8 + e; rw[e] = *(const unsigned*)(RI + row * 2048 + rcol); iw[e] = *(const unsigned*)(RI + row * 2048 + rcol + 128); xw[e] = *(const unsigned*)(XC + row * 1024 + ch); }
#pragma unroll
                for (int e = 0; e < 8; ++e) { float a, bb;
                    lru_ab(bflo(rw[e]) + br[0], bflo(iw[e]) + bi[0], bflo(xw[e]), cl[0], a, bb); A0 *= a; H0 = a * H0 + bb;
                    lru_ab(bfhi(rw[e]) + br[1], bfhi(iw[e]) + bi[1], bfhi(xw[e]), cl[1], a, bb); A1 *= a; H1 = a * H1 + bb; } }
            SA[((size_t)b * 128 + k) * 512 + tid] = (f32x2){A0, A1}; SH[((size_t)b * 128 + k) * 512 + tid] = (f32x2){H0, H1};
        } else {
            float h0 = 0.f, h1 = 0.f;
            const f32x2* __restrict__ sa = SA + (size_t)b * 128 * 512 + tid; const f32x2* __restrict__ sh = SH + (size_t)b * 128 * 512 + tid;
#pragma unroll 16
            for (int q = 0; q < k; ++q) { const f32x2 a = sa[(size_t)q * 512], hh = sh[(size_t)q * 512]; h0 = a[0] * h0 + hh[0]; h1 = a[1] * h1 + hh[1]; }
            for (int s8 = 0; s8 < 64; s8 += 8) { unsigned rw[8], iw[8], xw[8], yw[8];
#pragma unroll
                for (int e = 0; e < 8; ++e) { const size_t row = row0 + s8 + e; rw[e] = *(const unsigned*)(RI + row * 2048 + rcol); iw[e] = *(const unsigned*)(RI + row * 2048 + rcol + 128); xw[e] = *(const unsigned*)(XC + row * 1024 + ch);
                    yw[e] = *(const unsigned*)(PROJ + row * LDP + C_YR + ch); }
#pragma unroll
                for (int e = 0; e < 8; ++e) { float a, bb;
                    lru_ab(bflo(rw[e]) + br[0], bflo(iw[e]) + bi[0], bflo(xw[e]), cl[0], a, bb); h0 = a * h0 + bb;
                    lru_ab(bfhi(rw[e]) + br[1], bfhi(iw[e]) + bi[1], bfhi(xw[e]), cl[1], a, bb); h1 = a * h1 + bb;
                    *(unsigned*)(XC + (row0 + s8 + e) * 1024 + ch) = pk2(h0 * gelu_tanh(bflo(yw[e])), h1 * gelu_tanh(bfhi(yw[e]))); } }
        }
    }
}

DI void memsoftmax_phase(PP pp) {
    PPOPAQ();
    int tid = threadIdx.x; asm volatile("" : "+v"(tid));
    const int lane = tid & 63, wave = __builtin_amdgcn_readfirstlane(tid >> 6);
    const int G_ = opaque_s((int)gridDim.x), bx_ = opaque_s((int)blockIdx.x);
    const int gw = bx_ * 8 + wave, NGW = G_ * 8, gtid = bx_ * 512 + tid, NT = G_ * 512;
    (void)lane; (void)wave; (void)gw; (void)NGW; (void)gtid; (void)NT;
    bf16_t* SP = (bf16_t*)(pp->ws + WS_H);
    for (int m = gw; m < T_; m += NGW) {
        u32x4* ptr = (u32x4*)(SP + (size_t)m * 1024 + lane * 16);
        u32x4 a = ptr[0], b = ptr[1]; const unsigned* pa = (const unsigned*)&a; const unsigned* pb = (const unsigned*)&b;
        float v[16];
#pragma unroll
        for (int e = 0; e < 4; ++e) { v[2 * e] = bflo(pa[e]); v[2 * e + 1] = bfhi(pa[e]); v[8 + 2 * e] = bflo(pb[e]); v[8 + 2 * e + 1] = bfhi(pb[e]); }
        float mx = v[0];
#pragma unroll
        for (int e = 1; e < 16; ++e) mx = fmaxf(mx, v[e]);
#pragma unroll
        for (int o = 1; o < 16; o <<= 1) mx = fmaxf(mx, shx(mx, o, lane));
        float s = 0.f;
#pragma unroll
        for (int e = 0; e < 16; ++e) { v[e] = fexp2(v[e] - mx); s += v[e]; }
#pragma unroll
        for (int o = 1; o < 16; o <<= 1) s += shx(s, o, lane);
        const float inv = 1.0f / s;
        u32x4 oa, ob; unsigned* qa = (unsigned*)&oa; unsigned* qb = (unsigned*)&ob;
#pragma unroll
        for (int e = 0; e < 4; ++e) { qa[e] = pk2(v[2 * e] * inv, v[2 * e + 1] * inv); qb[e] = pk2(v[8 + 2 * e] * inv, v[8 + 2 * e + 1] * inv); }
        ptr[0] = oa; ptr[1] = ob;
    }
}

DI void cmpfinal_phase(PP pp) {
    PPOPAQ();
    int tid = threadIdx.x; asm volatile("" : "+v"(tid));
    const int lane = tid & 63, wave = __builtin_amdgcn_readfirstlane(tid >> 6);
    const int G_ = opaque_s((int)gridDim.x), bx_ = opaque_s((int)blockIdx.x);
    const int gw = bx_ * 8 + wave, NGW = G_ * 8, gtid = bx_ * 512 + tid, NT = G_ * 512;
    (void)lane; (void)wave; (void)gw; (void)NGW; (void)gtid; (void)NT;
    unsigned char* ws = pp->ws; const float* CR = (const float*)(ws + WS_CRAW);
    for (int i = gtid; i < 2 * 4 * 512 * 32; i += NT) { const int d = i & 31, c = (i >> 5) & 511, bg = i >> 14, b = bg >> 2;
        const float* src = CR + ((size_t)bg * 512 + c) * 64; float x1 = src[d], x2 = src[d + 32];
        float o1 = 0.f, o2 = 0.f;
        if (c < 511) { const float pos = (float)pp->pos[b * S_ + 16 * c + 31]; const float inv = fexp2(-(float)d * 0.41524101186092029f); const float ang = pos * inv;
            const double rev = (double)ang * 0.15915494309189535; const float fr = (float)(rev - __builtin_rint(rev));
            const float sn = __builtin_amdgcn_sinf(fr), cs = __builtin_amdgcn_cosf(fr); o1 = x1 * cs - x2 * sn; o2 = x2 * cs + x1 * sn; }
        bf16_t* dst = (bf16_t*)(ws + WS_KCMP) + ((size_t)bg * 512 + c) * 64; dst[d] = (bf16_t)f2bf(o1); dst[d + 32] = (bf16_t)f2bf(o2); }
    for (int i = gtid; i < 2 * 4 * 64 * 512; i += NT) { const int c = i & 511, d = (i >> 9) & 63, bg = i >> 15;
        const float v = (c < 511) ? CR[((size_t)(8 + bg) * 512 + c) * 64 + d] : 0.f;
        ((bf16_t*)(ws + WS_VTCMP))[((size_t)bg * 64 + d) * 512 + c] = (bf16_t)f2bf(v); }
}

constexpr int KSTR = 144, VSTR = 136;
constexpr int L_K = 0, L_V = 2 * 64 * KSTR, L_IMP = L_V + 2 * 64 * VSTR, IMPSTR = 132, L_SEL = L_IMP + 64 * IMPSTR * 4, L_ATT_END = L_SEL + 64 * 16, L_OT = L_ATT_END;
DI int crow(int r, int hi) { return (r & 3) + 8 * (r >> 2) + 4 * hi; }

struct TileSrc { const bf16_t* K; int kstr; const bf16_t* Vt; int vstr; };

template <int MODE>
DI void attn_loop(LAS unsigned char* lds, const TileSrc src, int j0, int j1, const bf16x8 (&qf)[4], f32x16 (&o)[2], float& m_run, float& l_run,
                  int tl, int t, int tb, u64 selLo, u64 selHi, int tid, int wave, int lane) {
    const int n = lane & 31, hh = lane >> 5;
    const int lrow = tid >> 3, lchunk = tid & 7;
    u32x4 kreg, vreg;
    kreg = *(const u32x4*)(src.K + (size_t)(64 * j0 + lrow) * src.kstr + lchunk * 8);
    vreg = *(const u32x4*)(src.Vt + (size_t)lrow * src.vstr + 64 * j0 + lchunk * 8);
    float carry = 0.f;
    int buf = 0;
    for (int j = j0; j <= j1; ++j) {
        LAS unsigned char* Kl = lds + L_K + buf * 64 * KSTR; LAS unsigned char* Vl = lds + L_V + buf * 64 * VSTR;
        *(LAS u32x4*)(Kl + lrow * KSTR + lchunk * 16) = kreg;
        *(LAS u32x2*)(Vl + lrow * VSTR + lchunk * 16) = (u32x2){vreg.x, vreg.y}; *(LAS u32x2*)(Vl + lrow * VSTR + lchunk * 16 + 8) = (u32x2){vreg.z, vreg.w};
        __syncthreads();
        if (j < j1) { kreg = *(const u32x4*)(src.K + (size_t)(64 * (j + 1) + lrow) * src.kstr + lchunk * 8);
                      vreg = *(const u32x4*)(src.Vt + (size_t)lrow * src.vstr + 64 * (j + 1) + lchunk * 8); }
        buf ^= 1;
        bool active = true;
        if (MODE == 2) { const bool bit = ((j < 64 ? selLo : selHi) >> (j & 63)) & 1ull; active = __ballot(bit) != 0ull; }
        if (!active) continue;
        f32x16 s[2];
#pragma unroll
        for (int u = 0; u < 2; ++u) {
#pragma unroll
            for (int e = 0; e < 16; ++e) s[u][e] = 0.f;
#pragma unroll
            for (int ks = 0; ks < 4; ++ks) { const bf16x8 kf = *(const LAS bf16x8*)(Kl + (32 * u + n) * KSTR + (ks * 16 + 8 * hh) * 2);
                s[u] = __builtin_amdgcn_mfma_f32_32x32x16_bf16(kf, qf[ks], s[u], 0, 0, 0); }
        }
        const float NEGINF = -__builtin_inff();
        if (MODE <= 1) { const int cmax = min(510, (t - 31) >> 4);
#pragma unroll
            for (int u = 0; u < 2; ++u)
#pragma unroll
                for (int e = 0; e < 16; ++e) { const int c = 64 * j + 32 * u + crow(e, hh); if (c > cmax) s[u][e] = NEGINF; }
        } else if (MODE == 2) { const bool bit = ((j < 64 ? selLo : selHi) >> (j & 63)) & 1ull; const int lim = (j == tb) ? tl : 64;
#pragma unroll
            for (int u = 0; u < 2; ++u)
#pragma unroll
                for (int e = 0; e < 16; ++e) { const int kk = 32 * u + crow(e, hh); if (!bit || kk > lim) s[u][e] = NEGINF; }
        } else {
#pragma unroll
            for (int u = 0; u < 2; ++u)
#pragma unroll
                for (int e = 0; e < 16; ++e) { const int df = t - (64 * j + 32 * u + crow(e, hh)); if ((unsigned)df >= 512u) s[u][e] = NEGINF; }
        }
        if (MODE == 1) {
            const float msafe = (m_run == NEGINF) ? 0.f : m_run;
#pragma unroll
            for (int u = 0; u < 2; ++u)
#pragma unroll
                for (int e = 0; e < 16; ++e) s[u][e] = fexp2(s[u][e] - msafe) * l_run;
            if (tb >= 16) {
                float w1[8], w2[8], pw2[8];
#pragma unroll
                for (int u = 0; u < 2; ++u)
#pragma unroll
                    for (int gi = 0; gi < 4; ++gi) { const float p0 = s[u][4 * gi], p1 = s[u][4 * gi + 1], p2 = s[u][4 * gi + 2], p3 = s[u][4 * gi + 3];
                        w1[u * 4 + gi] = p0 + p1 + p2 + 0.5f * p3; w2[u * 4 + gi] = 0.5f * p3; }
#pragma unroll
                for (int q = 0; q < 8; ++q) pw2[q] = shx(w2[q], 32, lane);
                float tot[8];
#pragma unroll
                for (int q = 0; q < 8; ++q) { const float prev = (q == 0) ? carry : pw2[q > 0 ? q - 1 : 0]; tot[q] = w1[q] + (hh ? pw2[q] : prev); }
                carry = pw2[7];
#pragma unroll
                for (int q = 0; q < 8; ++q) { float v = tot[q]; v += shx(v, 1, lane); v += shx(v, 2, lane); tot[q] = v; }
                if ((n & 3) == 0) { LAS float* imp = (LAS float*)(lds + L_IMP) + (8 * wave + (n >> 2)) * IMPSTR;
#pragma unroll
                    for (int q = 0; q < 8; ++q) { const int jj = 16 * j + 8 * (q >> 2) + 2 * (q & 3) + hh; if (jj < 128) imp[jj] = tot[q]; } }
            }
        } else {
            float mloc = s[0][0];
#pragma unroll
            for (int u = 0; u < 2; ++u)
#pragma unroll
                for (int e = 0; e < 16; ++e) mloc = fmaxf(mloc, s[u][e]);
            mloc = fmaxf(mloc, shx(mloc, 32, lane));
            const float mnew = fmaxf(m_run, mloc); const float msafe = (mnew == NEGINF) ? 0.f : mnew;
            const float alpha = fexp2(m_run - msafe);
            float ls = 0.f;
#pragma unroll
            for (int u = 0; u < 2; ++u)
#pragma unroll
                for (int e = 0; e < 16; ++e) { s[u][e] = fexp2(s[u][e] - msafe); ls += s[u][e]; }
            l_run = l_run * alpha + ls; m_run = mnew;
            if (MODE != 0) {
#pragma unroll
                for (int ds = 0; ds < 2; ++ds)
#pragma unroll
                    for (int e = 0; e < 16; ++e) o[ds][e] *= alpha;
            }
        }
        if (MODE != 0) {
#pragma unroll
            for (int u = 0; u < 2; ++u)
#pragma unroll
                for (int st = 0; st < 2; ++st) {
                    u32x4 pp; pp.x = pk2(s[u][8 * st], s[u][8 * st + 1]); pp.y = pk2(s[u][8 * st + 2], s[u][8 * st + 3]); pp.z = pk2(s[u][8 * st + 4], s[u][8 * st + 5]); pp.w = pk2(s[u][8 * st + 6], s[u][8 * st + 7]);
                    const bf16x8 pb = __builtin_bit_cast(bf16x8, pp);
#pragma unroll
                    for (int ds = 0; ds < 2; ++ds) { const LAS unsigned char* vp = Vl + (32 * ds + n) * VSTR + (32 * u + 16 * st + 4 * hh) * 2;
                        const u32x2 a0 = *(const LAS u32x2*)vp, a1 = *(const LAS u32x2*)(vp + 16);
                        const u32x4 av = {a0.x, a0.y, a1.x, a1.y};
                        o[ds] = __builtin_amdgcn_mfma_f32_32x32x16_bf16(__builtin_bit_cast(bf16x8, av), pb, o[ds], 0, 0, 0); }
                }
        }
    }
    __syncthreads();
}

DI void sel_direct(const bf16_t* __restrict__ KFb, const bf16_t* __restrict__ VFb, u64 uLo, u64 uHi, const bf16x8 (&qf)[4], f32x16 (&o)[2], float& m_run, float& l_run,
                   int tl, int tb, u64 selLo, u64 selHi, int lane) {
    const int n = lane & 31, hh = lane >> 5;
    const float NEGINF = -__builtin_inff();
    const bf16_t* kp = KFb + lane * 8;
    const bf16_t* vp = VFb + lane * 8;
    (void)n;
    bf16x8 kc[2][4], kn[2][4];
    int j = (uLo != 0ull) ? __builtin_ctzll(uLo) : 64 + __builtin_ctzll(uHi);
    if (uLo != 0ull) uLo &= uLo - 1ull; else uHi &= uHi - 1ull;
#pragma unroll
    for (int u = 0; u < 2; ++u)
#pragma unroll
        for (int ks = 0; ks < 4; ++ks) kc[u][ks] = *(const bf16x8*)(kp + (size_t)(((j * 2 + u) * 4 + ks) * 512));
    for (;;) {
        const bool more = (uLo | uHi) != 0ull;
        int jn = j;
        if (more) { jn = (uLo != 0ull) ? __builtin_ctzll(uLo) : 64 + __builtin_ctzll(uHi); if (uLo != 0ull) uLo &= uLo - 1ull; else uHi &= uHi - 1ull;
#pragma unroll
            for (int u = 0; u < 2; ++u)
#pragma unroll
                for (int ks = 0; ks < 4; ++ks) kn[u][ks] = *(const bf16x8*)(kp + (size_t)(((jn * 2 + u) * 4 + ks) * 512)); }
        bf16x8 vf[2][2][2];
#pragma unroll
        for (int ds = 0; ds < 2; ++ds)
#pragma unroll
            for (int u = 0; u < 2; ++u)
#pragma unroll
                for (int st = 0; st < 2; ++st) vf[ds][u][st] = *(const bf16x8*)(vp + (size_t)((((j * 2 + ds) * 2 + u) * 2 + st) * 512));
        f32x16 s[2];
#pragma unroll
        for (int u = 0; u < 2; ++u) {
#pragma unroll
            for (int e = 0; e < 16; ++e) s[u][e] = 0.f;
#pragma unroll
            for (int ks = 0; ks < 4; ++ks) s[u] = __builtin_amdgcn_mfma_f32_32x32x16_bf16(kc[u][ks], qf[ks], s[u], 0, 0, 0);
        }
        const bool bit = ((j < 64 ? selLo : selHi) >> (j & 63)) & 1ull;
        if (j == tb) {
#pragma unroll
            for (int u = 0; u < 2; ++u)
#pragma unroll
                for (int e = 0; e < 16; ++e) { const int kk = 32 * u + crow(e, hh); if (kk > tl) s[u][e] = NEGINF; }
        }
        float mloc = fmaxf(s[0][0], s[1][0]);
#pragma unroll
        for (int e = 1; e < 16; ++e) mloc = fmaxf(mloc, fmaxf(s[0][e], s[1][e]));
        mloc = fmaxf(mloc, shx(mloc, 32, lane));
        const float mnew = bit ? fmaxf(m_run, mloc) : m_run;
        const float msafe = (mnew == NEGINF) ? 0.f : mnew;
        const float alpha = fexp2(m_run - msafe);
        const float sub = bit ? msafe : __builtin_inff();
        float ls = 0.f;
#pragma unroll
        for (int u = 0; u < 2; ++u)
#pragma unroll
            for (int e = 0; e < 16; ++e) { s[u][e] = fexp2(s[u][e] - sub); ls += s[u][e]; }
        l_run = l_run * alpha + ls; m_run = mnew;
        if (__ballot(alpha != 1.0f) != 0ull) {
#pragma unroll
            for (int ds = 0; ds < 2; ++ds)
#pragma unroll
                for (int e = 0; e < 16; ++e) o[ds][e] *= alpha;
        }
#pragma unroll
        for (int u = 0; u < 2; ++u)
#pragma unroll
            for (int st = 0; st < 2; ++st) {
                u32x4 pp; pp.x = pk2(s[u][8 * st], s[u][8 * st + 1]); pp.y = pk2(s[u][8 * st + 2], s[u][8 * st + 3]); pp.z = pk2(s[u][8 * st + 4], s[u][8 * st + 5]); pp.w = pk2(s[u][8 * st + 6], s[u][8 * st + 7]);
                const bf16x8 pb = __builtin_bit_cast(bf16x8, pp);
#pragma unroll
                for (int ds = 0; ds < 2; ++ds) o[ds] = __builtin_amdgcn_mfma_f32_32x32x16_bf16(vf[ds][u][st], pb, o[ds], 0, 0, 0);
            }
        if (!more) break;
#pragma unroll
        for (int u = 0; u < 2; ++u)
#pragma unroll
            for (int ks = 0; ks < 4; ++ks) kc[u][ks] = kn[u][ks];
        j = jn;
    }
}

DI void attn_phase(PP pp, LAS unsigned char* lds, bool do_store) {
    PPOPAQ();
    int tid = threadIdx.x; asm volatile("" : "+v"(tid));
    const int lane = tid & 63, wave = __builtin_amdgcn_readfirstlane(tid >> 6);
    const int G_ = opaque_s((int)gridDim.x), bx_ = opaque_s((int)blockIdx.x);
    const int gw = bx_ * 8 + wave, NGW = G_ * 8, gtid = bx_ * 512 + tid, NT = G_ * 512;
    (void)lane; (void)wave; (void)gw; (void)NGW; (void)gtid; (void)NT;
    unsigned char* ws = pp->ws; bf16_t* PROJ = (bf16_t*)(ws + WS_PROJ);
    const int n = lane & 31, hh = lane >> 5, G = G_;
    for (int it = 0; it < 4; ++it) {
        const int cc = (it & 1) ? (G - 1 - bx_) : bx_;
        const int rho = it * G + cc; if (rho >= 1024) continue;
        const int tb = 127 - (rho >> 3), bg = rho & 7, b = bg >> 2, g = bg & 3;
        const int t0 = 64 * tb, tl = 8 * wave + (n >> 2), r = n & 3, t = t0 + tl;
        const size_t trow = (size_t)b * S_ + t;
        bf16_t* qptr = PROJ + trow * LDP + C_Q + (4 * g + r) * 64;
        bf16x8 qf[4];
#pragma unroll
        for (int ks = 0; ks < 4; ++ks) qf[ks] = *(const bf16x8*)(qptr + ks * 16 + 8 * hh);
        f32x16 o[2];
        LAS float* OT = (LAS float*)(lds + L_OT) + wave * 2048 + lane;
        for (int i = tid; i < 64 * IMPSTR; i += 512) ((LAS float*)(lds + L_IMP))[i] = 0.f;
        {
            TileSrc src{(const bf16_t*)(ws + WS_KCMP) + (size_t)bg * 512 * 64, 64, (const bf16_t*)(ws + WS_VTCMP) + (size_t)bg * 64 * 512, 512};
            int nvalid = (t0 + 32) / 16 + 1; if (nvalid > 511) nvalid = 511;
            const int j1 = (nvalid - 1) >> 6;
            float m = -__builtin_inff(), l = 0.f;
            attn_loop<0>(lds, src, 0, j1, qf, o, m, l, tl, t, tb, 0ull, 0ull, tid, wave, lane);
            l += shx(l, 32, lane);
            float inv = 1.0f / fmaxf(l, 1e-30f);
#pragma unroll
            for (int ds = 0; ds < 2; ++ds)
#pragma unroll
                for (int e = 0; e < 16; ++e) o[ds][e] = 0.f;
            attn_loop<1>(lds, src, 0, j1, qf, o, m, inv, tl, t, tb, 0ull, 0ull, tid, wave, lane);
#pragma unroll
            for (int ds = 0; ds < 2; ++ds)
#pragma unroll
                for (int e = 0; e < 16; ++e) OT[(ds * 16 + e) * 64] = o[ds][e];
        }
        {
            const int tok = tid >> 3, prt = tid & 7;
            unsigned mk[4] = {0u, 0u, 0u, 0u};
            if (tb < 16) { mk[0] = (tb == 31) ? 0xffffffffu : ((2u << tb) - 1u); }
            else {
                const LAS float* imp = (const LAS float*)(lds + L_IMP) + tok * IMPSTR + 16 * prt;
                u64 keys[16];
#pragma unroll
                for (int e = 0; e < 16; ++e) { const int j = 16 * prt + e; const unsigned bits = __builtin_bit_cast(unsigned, imp[e]);
                    keys[e] = (j >= 1 && j <= tb - 1) ? (((u64)(bits + 1u) << 32) | (u64)(127 - j)) : 0ull; }
                mk[0] = 1u; mk[tb >> 5] |= 1u << (tb & 31);
                for (int round = 0; round < 14; ++round) {
                    u64 best = keys[0];
#pragma unroll
                    for (int e = 1; e < 16; ++e) best = keys[e] > best ? keys[e] : best;
#pragma unroll
                    for (int o2 = 1; o2 < 8; o2 <<= 1) { const u64 other = shx64(best, o2, lane); best = other > best ? other : best; }
                    if (best != 0ull) { const int jw = 127 - (int)(best & 127ull);
                        mk[0] |= (jw < 32) ? (1u << (jw & 31)) : 0u; mk[1] |= (jw >= 32 && jw < 64) ? (1u << (jw & 31)) : 0u;
                        mk[2] |= (jw >= 64 && jw < 96) ? (1u << (jw & 31)) : 0u; mk[3] |= (jw >= 96) ? (1u << (jw & 31)) : 0u; }
#pragma unroll
                    for (int e = 0; e < 16; ++e) if (keys[e] == best) keys[e] = 0ull;
                }
            }
            if (prt == 0) { LAS unsigned* sm = (LAS unsigned*)(lds + L_SEL) + tok * 4; sm[0] = mk[0]; sm[1] = mk[1]; sm[2] = mk[2]; sm[3] = mk[3]; }
            __syncthreads();
        }
        u64 selLo, selHi;
        { const LAS unsigned* sm = (const LAS unsigned*)(lds + L_SEL) + tl * 4; selLo = (u64)sm[0] | ((u64)sm[1] << 32); selHi = (u64)sm[2] | ((u64)sm[3] << 32); }
        {
            TileSrc src{PROJ + (size_t)b * S_ * LDP + C_KS + g * 64, LDP, (const bf16_t*)(ws + WS_VTS) + (size_t)bg * 64 * S_, S_};
            float m = -__builtin_inff(), l = 0.f;
#pragma unroll
            for (int ds = 0; ds < 2; ++ds)
#pragma unroll
                for (int e = 0; e < 16; ++e) o[ds][e] = 0.f;
            u64 uLo = 0ull, uHi = 0ull;
            { const LAS unsigned* sm = (const LAS unsigned*)(lds + L_SEL) + 8 * wave * 4;
#pragma unroll
              for (int i = 0; i < 8; ++i) { uLo |= (u64)sm[4 * i] | ((u64)sm[4 * i + 1] << 32); uHi |= (u64)sm[4 * i + 2] | ((u64)sm[4 * i + 3] << 32); } }
            uLo = ((u64)(unsigned)__builtin_amdgcn_readfirstlane((int)(unsigned)(uLo >> 32)) << 32) | (unsigned)__builtin_amdgcn_readfirstlane((int)(unsigned)uLo);
            uHi = ((u64)(unsigned)__builtin_amdgcn_readfirstlane((int)(unsigned)(uHi >> 32)) << 32) | (unsigned)__builtin_amdgcn_readfirstlane((int)(unsigned)uHi);
            sel_direct((const bf16_t*)(ws + WS_KF) + (size_t)bg * 64 * S_, (const bf16_t*)(ws + WS_VTS) + (size_t)bg * 64 * S_, uLo, uHi, qf, o, m, l, tl, tb, selLo, selHi, lane);
            __syncthreads();
            l += shx(l, 32, lane);
            const float f = sigmoidf_(bf2f(PROJ[((size_t)b * S_ + t) * LDP + C_GN + g * 12 + r * 3 + 1])) / (sigmoidf_(bf2f(PROJ[((size_t)b * S_ + t) * LDP + C_GN + g * 12 + r * 3])) * fmaxf(l, 1e-30f));
#pragma unroll
            for (int ds = 0; ds < 2; ++ds)
#pragma unroll
                for (int e = 0; e < 16; ++e) OT[(ds * 16 + e) * 64] += f * o[ds][e];
        }
        {
            TileSrc src{PROJ + (size_t)b * S_ * LDP + C_KW + g * 64, LDP, (const bf16_t*)(ws + WS_VTW) + (size_t)bg * 64 * S_, S_};
            float m = -__builtin_inff(), l = 0.f;
#pragma unroll
            for (int ds = 0; ds < 2; ++ds)
#pragma unroll
                for (int e = 0; e < 16; ++e) o[ds][e] = 0.f;
            attn_loop<3>(lds, src, tb >= 8 ? tb - 8 : 0, tb, qf, o, m, l, tl, t, tb, 0ull, 0ull, tid, wave, lane);
            l += shx(l, 32, lane);
            const float f = sigmoidf_(bf2f(PROJ[((size_t)b * S_ + t) * LDP + C_GN + g * 12 + r * 3 + 2])) / (sigmoidf_(bf2f(PROJ[((size_t)b * S_ + t) * LDP + C_GN + g * 12 + r * 3])) * fmaxf(l, 1e-30f));
#pragma unroll
            for (int ds = 0; ds < 2; ++ds)
#pragma unroll
                for (int e = 0; e < 16; ++e) OT[(ds * 16 + e) * 64] += f * o[ds][e];
        }
        if (do_store) {
            int ln2 = lane; asm volatile("" : "+v"(ln2));
            const int n2 = ln2 & 31, h2 = ln2 >> 5, t2 = t0 + 8 * wave + (n2 >> 2), r2 = n2 & 3;
            bf16_t* rowp = PROJ + ((size_t)b * S_ + t2) * LDP;
            const float gcv = sigmoidf_(bf2f(rowp[C_GN + g * 12 + r2 * 3]));
            bf16_t* op = rowp + C_Q + (4 * g + r2) * 64 + 4 * h2;
#pragma unroll
            for (int ds = 0; ds < 2; ++ds)
#pragma unroll
                for (int gi = 0; gi < 4; ++gi) { const float* dummy = nullptr; (void)dummy; u32x2 w; w.x = pk2(gcv * OT[(ds * 16 + 4 * gi) * 64], gcv * OT[(ds * 16 + 4 * gi + 1) * 64]); w.y = pk2(gcv * OT[(ds * 16 + 4 * gi + 2) * 64], gcv * OT[(ds * 16 + 4 * gi + 3) * 64]);
                    *(u32x2*)(op + 32 * ds + 8 * gi) = w; }
        }
    }
}

__global__ void __launch_bounds__(512, 2) fwd_megakernel(Params p) {
    extern __shared__ __attribute__((aligned(16))) unsigned char lds_raw[];
    LAS unsigned char* lds = (LAS unsigned char*)lds_raw;
    cg::grid_group grid = cg::this_grid();
    const int G = gridDim.x, bx = blockIdx.x;
    PP pp = (PP)__builtin_amdgcn_kernarg_segment_ptr();
    volatile LAS unsigned* barst = (volatile LAS unsigned*)(lds + L_BARST);
    if (threadIdx.x == 0) { barst[0] = 0u; barst[1] = 0u; (void)xb_add((unsigned*)(pp->ws + WS_BAR) + XB_XCNT(xb_xcc_id()), 1u); }
    __syncthreads();
#define GSYNC() xcd_barrier((unsigned*)(ws + WS_BAR), barst)
#define ws (pp->ws)
#define PROJ ((bf16_t*)(ws + WS_PROJ))
#define H ((bf16_t*)(ws + WS_H))
#define XC ((bf16_t*)(ws + WS_XC))
#define Y ((float*)(ws + WS_RI))
    const int BIG = 1 << 30;

#ifndef NO_PREP
    prep_phase(pp, 0, lds);
#endif
#ifndef NO_ROW
    row_phase(pp->x, nullptr, nullptr, nullptr, pp->ln_mix_pre, H);
#endif
    grid.sync();

    for (int l = 0; l < NLAYER; ++l) {
        PPOPAQ();
        using pg8::Gemm; using pg8::Sched; using pg8::EpiBf16; using pg8::EpiF32; using pg8::EpiMerge;
#ifndef NO_G1
        for (int r_ = 0; r_ < opaque_s(GREP); ++r_) {
        pg8::gemm_phase<EpiBf16>(lds, Gemm{H, (const bf16_t*)(ws + WS_WIN), 1024, 1024, 1024, 128, 128},
            Sched{64, 35, opaque_s(G), opaque_s(bx), 0, BIG, 0u, 256u * 1024 * 2, 0u, 0u, 256u * 1024 * 2, 0u}, EpiBf16{PROJ, LDP, 0, 1.0f, nullptr, 0});
        pg8::gemm_phase<EpiBf16>(lds, Gemm{(const bf16_t*)(ws + WS_MEMN), (const bf16_t*)(ws + WS_WMKV), 1024, 1024, 1024, 128, 128},
            Sched{2, 4, opaque_s(G), (opaque_s(bx) + 64) % opaque_s(G), 0, BIG, 0u, 256u * 1024 * 2, 0u, 0u, 256u * 1024 * 2, 0u}, EpiBf16{(bf16_t*)(ws + WS_KMEM), 1024, 0, 1.0f, nullptr, 0});
        pg8::gemm_phase<EpiBf16>(lds, Gemm{(const bf16_t*)(ws + WS_WMKV) + (size_t)1024 * 1024, (const bf16_t*)(ws + WS_MEMN), 1024, 1024, 1024, 128, 128},
            Sched{4, 2, opaque_s(G), (opaque_s(bx) + 128) % opaque_s(G), 0, BIG, 0u, 256u * 1024 * 2, 0u, 0u, 256u * 1024 * 2, 0u}, EpiBf16{(bf16_t*)(ws + WS_VTMEM), 512, 0, 1.0f, nullptr, 0});
        }
#endif
        GSYNC();
#ifndef NO_POST
        postproj_phase(pp, l);
#endif
        GSYNC();
#ifndef NO_G1
        for (int r_ = 0; r_ < opaque_s(GREP); ++r_) {
        pg8::gemm_phase<EpiBf16>(lds, Gemm{XC, (const bf16_t*)(ws + WS_WLRU), 1024, 128, 128, 128, 128},
            Sched{64, 8, opaque_s(G), opaque_s(bx), 0, BIG, 0u, 256u * 1024 * 2, 128u * 2, 0u, 256u * 128 * 2, 0u}, EpiBf16{(bf16_t*)(ws + WS_RI), 2048, 0, 1.0f, nullptr, 0});
        pg8::gemm_phase<EpiBf16>(lds, Gemm{PROJ, (const bf16_t*)(ws + WS_WC1), 16 * LDP, 2048, 2048, LDP * 2, 128},
            Sched{32, 1, opaque_s(G), (opaque_s(bx) + 32) % opaque_s(G), 1, BIG, 0u, 0u, 0u, 0u, 0u, 0u}, EpiBf16{(bf16_t*)(ws + WS_HID), 256, 2, 1.0f, (const float*)(ws + WS_CBIAS), 0});
        pg8::gemm_phase<EpiBf16>(lds, Gemm{PROJ, (const bf16_t*)(ws + WS_KMEM), LDP, 1024, 256, 128, 128},
            Sched{64, 4, opaque_s(G), opaque_s(bx), 0, 32, (unsigned)C_QM * 2, 256u * LDP * 2, 256u * 2, 0u, 256u * 2, 256u * 1024 * 2}, EpiBf16{H, 1024, 0, 0.0625f * LOG2E, nullptr, 0});
        }
#endif
        GSYNC();
#ifndef NO_SCAN
        scan_phase(pp, l, 0);
#if defined(DUP_SCAN0)
        scan_phase(pp, l, 0);
#endif
#endif
#ifndef NO_MSM
        memsoftmax_phase(pp);
#endif
#ifndef NO_G2
        for (int r_ = 0; r_ < opaque_s(GREP); ++r_) {
        pg8::gemm_phase<EpiF32>(lds, Gemm{(const bf16_t*)(ws + WS_HID), (const bf16_t*)(ws + WS_WC2), 256, 256, 256, 128, 128},
            Sched{32, 1, opaque_s(G), (opaque_s(bx) + 96) % opaque_s(G), 0, 16, 0u, 256u * 256 * 2, 0u, 0u, 0u, 256u * 256 * 2}, EpiF32{(float*)(ws + WS_CRAW), 64, 64});
        }
#endif
        GSYNC();
#ifndef NO_SCAN
        scan_phase(pp, l, 1);
#endif
#ifndef NO_CMPF
        cmpfinal_phase(pp);
#endif
#ifndef NO_G1
        for (int r_ = 0; r_ < opaque_s(GREP); ++r_) {
        pg8::gemm_phase<EpiBf16>(lds, Gemm{H, (const bf16_t*)(ws + WS_VTMEM), 1024, 512, 256, 128, 128},
            Sched{64, 4, opaque_s(G), opaque_s(bx), 0, 32, 0u, 256u * 1024 * 2, 256u * 2, 0u, 256u * 512 * 2, 256u * 2}, EpiBf16{PROJ, LDP, 0, 1.0f, nullptr, C_QM});
        }
#endif
        GSYNC();
#ifndef NO_ATT
#if defined(DUP_ATT)
        attn_phase(pp, lds, opaque_s(0) != 0);
        __syncthreads();
#endif
        attn_phase(pp, lds, true);
#endif
        GSYNC();
#ifndef NO_G3
        for (int r_ = 0; r_ < opaque_s(GREP); ++r_) {
        pg8::gemm_phase<EpiMerge>(lds, Gemm{XC, (const bf16_t*)(ws + WS_WBRA), 1024, 1024, 1024, 128, 128},
            Sched{64, 4, opaque_s(G), opaque_s(bx), 0, BIG, 0u, 256u * 1024 * 2, 0u, 0u, 256u * 1024 * 2, 0u}, EpiMerge{PROJ + C_GM, LDP, Y, H, 0});
        pg8::gemm_phase<EpiMerge>(lds, Gemm{PROJ + C_Q, (const bf16_t*)(ws + WS_WBRB), LDP, 1024, 1024, 128, 128},
            Sched{64, 4, opaque_s(G), opaque_s(bx), 0, BIG, 0u, 256u * LDP * 2, 0u, 0u, 256u * 1024 * 2, 0u}, EpiMerge{PROJ + C_GM + 1024, LDP, Y, H, 1});
        pg8::gemm_phase<EpiMerge>(lds, Gemm{PROJ + C_QM, (const bf16_t*)(ws + WS_WBRC), LDP, 1024, 1024, 128, 128},
            Sched{64, 4, opaque_s(G), opaque_s(bx), 0, BIG, 0u, 256u * LDP * 2, 0u, 0u, 256u * 1024 * 2, 0u}, EpiMerge{PROJ + C_GM + 2048, LDP, Y, H, 2});
        }
#endif
        GSYNC();
#ifndef NO_G2
        for (int r_ = 0; r_ < opaque_s(GREP); ++r_) {
        pg8::gemm_phase<EpiF32>(lds, Gemm{H, (const bf16_t*)(ws + WS_WOUT), 1024, 1024, 1024, 128, 128},
            Sched{64, 4, opaque_s(G), opaque_s(bx), 0, BIG, 0u, 256u * 1024 * 2, 0u, 0u, 256u * 1024 * 2, 0u}, EpiF32{Y, 1024, 1024});
        }
#endif
        GSYNC();
#ifndef NO_ROW
        row_phase((l == 0) ? pp->x : pp->out, Y, pp->ln_mix_post + (size_t)l * 1024, pp->out, pp->ln_mlp_pre + (size_t)l * 1024, H);
#endif
        GSYNC();
#ifndef NO_G1
        for (int r_ = 0; r_ < opaque_s(GREP); ++r_) {
        pg8::gemm_phase<EpiBf16>(lds, Gemm{H, (const bf16_t*)(ws + WS_WM1), 1024, 1024, 1024, 128, 128},
            Sched{64, 16, opaque_s(G), opaque_s(bx), 0, BIG, 0u, 256u * 1024 * 2, 0u, 0u, 256u * 1024 * 2, 0u}, EpiBf16{PROJ, FF_, 1, 1.0f, nullptr, 0});
        }
#endif
        GSYNC();
#ifndef NO_G2
        for (int r_ = 0; r_ < opaque_s(GREP); ++r_) {
        pg8::gemm_phase<EpiF32>(lds, Gemm{PROJ, (const bf16_t*)(ws + WS_WM2), FF_, FF_, FF_, 128, 128},
            Sched{64, 4, opaque_s(G), opaque_s(bx), 0, BIG, 0u, 256u * FF_ * 2, 0u, 0u, 256u * FF_ * 2, 0u}, EpiF32{Y, 1024, 1024});
        }
#endif
        GSYNC();
#ifndef NO_ROW
        row_phase(pp->out, Y, pp->ln_mlp_post + (size_t)l * 1024, pp->out, (l + 1 < NLAYER) ? pp->ln_mix_pre + (size_t)(l + 1) * 1024 : nullptr, (l + 1 < NLAYER) ? H : nullptr);
#endif
#ifndef NO_PREP
        if (l + 1 < NLAYER) prep_phase(pp, l + 1, lds);
#if defined(DUP_PREP)
        if (l + 1 < NLAYER) prep_phase(pp, l + 1, lds);
#endif
#endif
        GSYNC();
    }
#undef ws
#undef PROJ
#undef H
#undef XC
#undef Y
}

extern "C" void kernel_launch(void* const* d_in, const int* in_sizes, int n_in, void* d_out, int out_size, void* d_ws, size_t ws_size, hipStream_t stream) {
    static int grid = 0;
    if (grid == 0) {
        int dev = 0, cus = 0, per_cu = 0;
        hipGetDevice(&dev); hipDeviceGetAttribute(&cus, hipDeviceAttributeMultiprocessorCount, dev);
        hipFuncSetAttribute((const void*)fwd_megakernel, hipFuncAttributeMaxDynamicSharedMemorySize, LDS_BYTES);
        hipOccupancyMaxActiveBlocksPerMultiprocessor(&per_cu, (const void*)fwd_megakernel, 512, LDS_BYTES);
        if (per_cu < 1) per_cu = 1;
        (void)hipGetLastError();
        grid = cus * 1;
        if (ws_size < WS_END) { fprintf(stderr, "kernel_launch: workspace too small (%zu < %zu)\n", ws_size, (size_t)WS_END); grid = -1; }
    }
    if (grid < 0) return;
    Params p{};
    p.x = (const float*)d_in[0]; p.mem = (const float*)d_in[1]; p.pos = (const int*)d_in[2];
    p.ln_mix_pre = (const float*)d_in[3]; p.w_in = (const float*)d_in[4]; p.conv_w = (const float*)d_in[5]; p.conv_b = (const float*)d_in[6];
    p.lru_wr = (const float*)d_in[7]; p.lru_br = (const float*)d_in[8]; p.lru_wi = (const float*)d_in[9]; p.lru_bi = (const float*)d_in[10]; p.lru_lambda = (const float*)d_in[11];
    p.cmp_pe = (const float*)d_in[12]; p.cmp_w1 = (const float*)d_in[13]; p.cmp_b1 = (const float*)d_in[14]; p.cmp_w2 = (const float*)d_in[15];
    p.ln_mem = (const float*)d_in[16]; p.w_mem_kv = (const float*)d_in[17]; p.w_br_rnn = (const float*)d_in[18]; p.w_br_nsa = (const float*)d_in[19]; p.w_br_mem = (const float*)d_in[20]; p.w_out = (const float*)d_in[21];
    p.ln_mix_post = (const float*)d_in[22]; p.ln_mlp_pre = (const float*)d_in[23]; p.mlp_w1 = (const float*)d_in[24]; p.mlp_w2 = (const float*)d_in[25]; p.ln_mlp_post = (const float*)d_in[26];
    p.out = (float*)d_out; p.ws = (unsigned char*)d_ws;
    (void)hipMemsetAsync((unsigned char*)d_ws + WS_BAR, 0, 16384, stream);
    void* args[] = {&p};
    hipError_t e = hipLaunchCooperativeKernel((const void*)fwd_megakernel, dim3(grid), dim3(512), args, LDS_BYTES, stream);
    if (e != hipSuccess) fprintf(stderr, "cooperative launch failed: %s (grid %d)\n", hipGetErrorString(e), grid);
}
```

```cpp
#include <hip/hip_runtime.h>
#include <hip/hip_cooperative_groups.h>
#include <cstdint>
#include <cstdio>
namespace cg = cooperative_groups;

#define LAS __attribute__((address_space(3)))
#define DI __device__ __forceinline__
typedef unsigned short bf16_t;
typedef short bf16x8 __attribute__((ext_vector_type(8)));
typedef short s16x4 __attribute__((ext_vector_type(4)));
typedef float f32x4 __attribute__((ext_vector_type(4)));
typedef float f32x16 __attribute__((ext_vector_type(16)));
typedef float f32x2 __attribute__((ext_vector_type(2)));
typedef unsigned u32x4 __attribute__((ext_vector_type(4)));
typedef unsigned u32x2 __attribute__((ext_vector_type(2)));
typedef __bf16 bf16x2v __attribute__((ext_vector_type(2)));
typedef unsigned long long u64;

constexpr int T_ = 16384, S_ = 8192, D_ = 1024, FF_ = 4096, LDP = 8960, NLAYER = 4;
constexpr int C_XR = 0, C_YR = 1024, C_Q = 2048, C_KC = 3072, C_VC = 3328, C_KS = 3584, C_VS = 3840, C_KW = 4096, C_VW = 4352,
              C_QM = 4608, C_GM = 5632, C_GN = 8704;
constexpr float EPS = 1e-6f;
constexpr float LOG2E = 1.4426950408889634f;

constexpr size_t al256(size_t x) { return (x + 255) & ~(size_t)255; }
constexpr size_t WS_PROJ = 0;
constexpr size_t WS_WIN = al256(WS_PROJ + (size_t)(T_ + 64) * LDP * 2);
constexpr size_t WS_WMKV = WS_WIN + (size_t)LDP * 1024 * 2;
constexpr size_t WS_WBRA = WS_WMKV + (size_t)2048 * 1024 * 2;
constexpr size_t WS_WBRB = WS_WBRA + (size_t)1024 * 1024 * 2;
constexpr size_t WS_WBRC = WS_WBRB + (size_t)1024 * 1024 * 2;
constexpr size_t WS_WOUT = WS_WBRC + (size_t)1024 * 1024 * 2;
constexpr size_t WS_WM1 = WS_WOUT + (size_t)1024 * 1024 * 2;
constexpr size_t WS_WM2 = WS_WM1 + (size_t)4096 * 1024 * 2;
constexpr size_t WS_WC1 = WS_WM2 + (size_t)4096 * 1024 * 2;
constexpr size_t WS_WC2 = WS_WC1 + (size_t)2 * 256 * 2048 * 2;
constexpr size_t WS_WLRU = WS_WC2 + (size_t)2 * 256 * 256 * 2;
constexpr size_t WS_H = WS_WLRU + (size_t)2048 * 128 * 2;
constexpr size_t WS_VTS = WS_H + (size_t)T_ * 1024 * 2;
constexpr size_t WS_VTW = WS_VTS + (size_t)8 * 64 * S_ * 2;
constexpr size_t WS_XC = WS_VTW + (size_t)8 * 64 * S_ * 2;
constexpr size_t WS_RI = WS_XC + (size_t)T_ * 1024 * 2;
constexpr size_t WS_HID = WS_RI + (size_t)T_ * 2048 * 2;
constexpr size_t WS_CRAW = WS_HID + (size_t)8192 * 256 * 2;
constexpr size_t WS_KCMP = WS_CRAW + (size_t)8192 * 64 * 4;
constexpr size_t WS_VTCMP = WS_KCMP + (size_t)8 * 512 * 64 * 2;
constexpr size_t WS_MEMN = WS_VTCMP + (size_t)8 * 512 * 64 * 2;
constexpr size_t WS_KMEM = WS_MEMN + (size_t)512 * 1024 * 2;
constexpr size_t WS_VTMEM = WS_KMEM + (size_t)512 * 1024 * 2;
constexpr size_t WS_SCA = WS_VTMEM + (size_t)512 * 1024 * 2;
constexpr size_t WS_SCH = WS_SCA + (size_t)2 * 128 * 1024 * 4;
constexpr size_t WS_CBP = WS_SCH + (size_t)2 * 128 * 1024 * 4;
constexpr size_t WS_CBIAS = WS_CBP + (size_t)16 * 512 * 4;
constexpr size_t WS_KF = al256(WS_CBIAS + 512 * 4);
constexpr size_t WS_BAR = WS_KF + (size_t)8 * 64 * S_ * 2;
constexpr size_t WS_END = WS_BAR + 16384;
constexpr int L_BARST = 147392;

#ifndef GREP
#define GREP 1
#endif
constexpr int LDS_BYTES = 147456;

DI unsigned f2bf(float f) { unsigned u = __builtin_bit_cast(unsigned, f); return (u + 0x7fffu + ((u >> 16) & 1u)) >> 16; }
DI unsigned pk2(float lo, float hi) { f32x2 f = {lo, hi}; bf16x2v r = __builtin_convertvector(f, bf16x2v); return __builtin_bit_cast(unsigned, r); }
DI float bf2f(unsigned short b) { return __builtin_bit_cast(float, (unsigned)b << 16); }
DI float bflo(unsigned w) { return __builtin_bit_cast(float, w << 16); }
DI float bfhi(unsigned w) { return __builtin_bit_cast(float, w & 0xffff0000u); }
DI float fexp2(float x) { return __builtin_amdgcn_exp2f(x); }
DI float sigmoidf_(float x) { return 1.0f / (1.0f + fexp2(-x * LOG2E)); }
DI float gelu_tanh(float x) { const float z = 0.7978845608028654f * (x + 0.044715f * x * x * x); return x / (1.0f + fexp2(-2.0f * LOG2E * z)); }
DI float shx(float v, int mask, int lane) { return __builtin_bit_cast(float, __builtin_amdgcn_ds_bpermute((lane ^ mask) << 2, __builtin_bit_cast(int, v))); }
DI u64 shx64(u64 v, int mask, int lane) { const int a = (lane ^ mask) << 2; const unsigned lo = (unsigned)__builtin_amdgcn_ds_bpermute(a, (int)(unsigned)v), hi = (unsigned)__builtin_amdgcn_ds_bpermute(a, (int)(unsigned)(v >> 32)); return ((u64)hi << 32) | lo; }
DI unsigned pk4_fp8(float a, float b, float c, float d) { int w = 0; w = __builtin_amdgcn_cvt_pk_fp8_f32(a, b, w, false); w = __builtin_amdgcn_cvt_pk_fp8_f32(c, d, w, true); return (unsigned)w; }
DI long mk64(unsigned lo, unsigned hi) { return (long)(((u64)hi << 32) | (u64)lo); }
DI int opaque_s(int v) { asm volatile("" : "+s"(v)); return v; }
DI float wave_sum(float v, int lane) {
#pragma unroll
    for (int o = 1; o < 64; o <<= 1) v += shx(v, o, lane);
    return v;
}

namespace pg8 {
constexpr int BM = 256, BK = 64, HALF = 128, HTB = HALF * BK * 2, STAGE_BYTES = 8 * HTB, NXCD = 8, WGM = 8;
__host__ __device__ __forceinline__ int lds_byte(int r, int c) { const int st = (r >> 4) * 2 + (c >> 5), rr = r & 15, cc = c & 31, ob = rr * 64 + cc * 2; return st * 1024 + (ob ^ (((ob >> 9) & 1) << 5)); }
__host__ __device__ __forceinline__ void stage_rc(int b, int& R, int& C) { const int st = b / 1024, sb = b % 1024, swz = sb ^ (((sb >> 9) & 1) << 5); R = (st >> 1) * 16 + swz / 64; C = (st & 1) * 32 + (swz % 64) / 2; }
__host__ __device__ __forceinline__ int perm32(int rho) { const int n = rho >> 4, i = rho & 15; return 8 * (i >> 2) + 4 * n + (i & 3); }

struct Unit { int pm, pn; unsigned aoff, boff; };
struct Gemm { const bf16_t* A; const bf16_t* Bt; int lda, ldb, K, kstepA, kstepB; };

struct Sched {
    int nM, nN, G, c, kind, mdiv; unsigned a0, sAm, sAn, b0, sBn, sBb;
    DI bool next(int i, Unit& u) const {
        const long L = (long)i * G + c; const int nwg = nM * nN; if (L >= nwg) return false;
        int wgid = (int)L; { const int q = nwg / NXCD, r = nwg % NXCD, xcd = wgid % NXCD, off = wgid / NXCD; wgid = (xcd < r ? xcd * (q + 1) : r * (q + 1) + (xcd - r) * q) + off; }
        const int nig = WGM * nN, gid = wgid / nig, fm = gid * WGM, gsz = (nM - fm) < WGM ? (nM - fm) : WGM;
        const int pm = fm + ((wgid % nig) % gsz), pn = (wgid % nig) / gsz;
        u.pm = pm; u.pn = pn;
        if (kind == 1) {
            const int j = pm >> 4, b = (pm >> 3) & 1, g = (pm >> 1) & 3, ch = pm & 1;
            u.aoff = (unsigned)(((b * S_ + ch * 4096) * LDP + C_KC + j * 256 + g * 64) * 2); u.boff = (unsigned)(j * 256 * 2048 * 2);
        } else { const unsigned bb = (unsigned)(pm / mdiv); u.aoff = a0 + (unsigned)pm * sAm + (unsigned)pn * sAn; u.boff = b0 + (unsigned)pn * sBn + bb * sBb; }
        return true;
    }
};

DI unsigned cvt_pk_bf16(float lo, float hi) { return pk2(lo, hi); }

struct EpiBf16 {
    static constexpr bool PERM = true;
    bf16_t* O; int ldc; int act; float scale; const float* bias; int oc0;
    DI void operator()(const f32x4 (&acc)[2][2][4][2], const Unit& u, int wr, int wc, int fr, int fq) const {
        const int row0 = u.pm * 256 + wr * 64 + fr, col0 = oc0 + u.pn * 256 + wc * 32 + 8 * fq, bc0 = (u.pm >> 4) * 256 + wc * 32 + 8 * fq;
#pragma unroll
        for (int ai = 0; ai < 2; ++ai)
#pragma unroll
            for (int m = 0; m < 4; ++m) { bf16_t* rowp = O + (size_t)(row0 + ai * HALF + m * 16) * ldc + col0;
#pragma unroll
                for (int bj = 0; bj < 2; ++bj) { f32x4 v0 = acc[ai][bj][m][0], v1 = acc[ai][bj][m][1];
                    if (act == 0) { v0 = v0 * scale; v1 = v1 * scale; }
                    else if (act == 1) {
#pragma unroll
                        for (int e = 0; e < 4; ++e) { const float a = fmaxf(v0[e], 0.f), b = fmaxf(v1[e], 0.f); v0[e] = a * a; v1[e] = b * b; } }
                    else { const f32x4 b0 = *(const f32x4*)(bias + bc0 + bj * HALF), b1 = *(const f32x4*)(bias + bc0 + bj * HALF + 4);
#pragma unroll
                        for (int e = 0; e < 4; ++e) { v0[e] = gelu_tanh(v0[e] + b0[e]); v1[e] = gelu_tanh(v1[e] + b1[e]); } }
                    u32x4 w; w.x = cvt_pk_bf16(v0[0], v0[1]); w.y = cvt_pk_bf16(v0[2], v0[3]); w.z = cvt_pk_bf16(v1[0], v1[1]); w.w = cvt_pk_bf16(v1[2], v1[3]);
                    *(u32x4*)(rowp + bj * HALF) = w; } }
    }
};
struct EpiF32 {
    static constexpr bool PERM = false;
    float* O; int ldc; int ncol;
    DI void operator()(const f32x4 (&acc)[2][2][4][2], const Unit& u, int wr, int wc, int fr, int fq) const {
        const int row0 = u.pm * 256 + wr * 64 + fr, col0 = u.pn * 256 + wc * 32 + 4 * fq;
#pragma unroll
        for (int ai = 0; ai < 2; ++ai)
#pragma unroll
            for (int m = 0; m < 4; ++m) { float* rowp = O + (size_t)(row0 + ai * HALF + m * 16) * ldc;
#pragma unroll
                for (int bj = 0; bj < 2; ++bj)
#pragma unroll
                    for (int n = 0; n < 2; ++n) { const int c = col0 + bj * HALF + n * 16; if (c < ncol) *(f32x4*)(rowp + c) = acc[ai][bj][m][n]; } }
    }
};
struct EpiMerge {
    static constexpr bool PERM = false;
    const bf16_t* gate; int ldg; float* M; bf16_t* Hout; int mode;
    DI void operator()(const f32x4 (&acc)[2][2][4][2], const Unit& u, int wr, int wc, int fr, int fq) const {
        const int row0 = u.pm * 256 + wr * 64 + fr, col0 = u.pn * 256 + wc * 32 + 4 * fq;
#pragma unroll
        for (int ai = 0; ai < 2; ++ai)
#pragma unroll
            for (int m = 0; m < 4; ++m) { const size_t r = (size_t)(row0 + ai * HALF + m * 16);
#pragma unroll
                for (int bj = 0; bj < 2; ++bj)
#pragma unroll
                    for (int n = 0; n < 2; ++n) { const int c = col0 + bj * HALF + n * 16;
                        const u32x2 gw = *(const u32x2*)(gate + r * ldg + c);
                        f32x4 g; g[0] = sigmoidf_(bflo(gw.x)); g[1] = sigmoidf_(bfhi(gw.x)); g[2] = sigmoidf_(bflo(gw.y)); g[3] = sigmoidf_(bfhi(gw.y));
                        f32x4 v = acc[ai][bj][m][n] * g;
                        float* mp = M + r * 1024 + c;
                        if (mode != 0) v = v + *(const f32x4*)mp;
                        if (mode != 2) *(f32x4*)mp = v;
                        else { u32x2 w; w.x = cvt_pk_bf16(v[0], v[1]); w.y = cvt_pk_bf16(v[2], v[3]); *(u32x2*)(Hout + r * 1024 + c) = w; } } }
    }
};

template <class Epi>
DI void gemm_phase(LAS unsigned char* lds, const Gemm g, const Sched& S, const Epi& E) {
    int tid = threadIdx.x; asm volatile("" : "+v"(tid));
    const int wid = __builtin_amdgcn_readfirstlane(tid >> 6), lane = tid & 63, wr = wid >> 2, wc = wid & 3, fr = lane & 15, fq = lane >> 4;
    const int nt = opaque_s(g.K / BK);
    unsigned voffA[2], voffB[2];
#pragma unroll
    for (int i = 0; i < 2; ++i) { int R, C; stage_rc(tid * 16 + i * 8192, R, C); const int Rb = Epi::PERM ? ((R & ~31) + perm32(R & 31)) : R;
        voffA[i] = (unsigned)(R * g.lda + C) * 2u; voffB[i] = (unsigned)(Rb * g.ldb + C) * 2u; }
    const size_t kstepA = (size_t)g.kstepA, kstepB = (size_t)g.kstepB;
    const size_t hstepA = (size_t)HALF * g.lda * 2, hstepB = (size_t)HALF * g.ldb * 2;
    const unsigned ldsw = (unsigned)wid * 1024u;
    const int aoff = lds_byte(wr * 64 + fr, fq * 8), boff = lds_byte(wc * 32 + fr, fq * 8);
#define PG8_SA(b, h) (((b) * 2 + (h)) * HTB)
#define PG8_SB(b, h) ((4 + (b) * 2 + (h)) * HTB)
#define PG8_STAGE(bufoff, gbase, voff) do { _Pragma("unroll") for (int _i = 0; _i < 2; ++_i) \
        __builtin_amdgcn_global_load_lds((const unsigned*)((const char*)(gbase) + (voff)[_i]), (LAS unsigned*)(lds + (bufoff) + ldsw + _i * 8192), 16, 0, 0); } while (0)
#define PG8_LDA(dst, b, h) do { _Pragma("unroll") for (int m = 0; m < 4; ++m) _Pragma("unroll") for (int k = 0; k < 2; ++k) dst[m][k] = *(const LAS bf16x8*)(lds + PG8_SA(b, h) + aoff + m * 2048 + k * 1024); } while (0)
#define PG8_LDB(dst, b, h) do { _Pragma("unroll") for (int n = 0; n < 2; ++n) _Pragma("unroll") for (int k = 0; k < 2; ++k) dst[n][k] = *(const LAS bf16x8*)(lds + PG8_SB(b, h) + boff + n * 2048 + k * 1024); } while (0)
#define PG8_MMA(ai, bj, At, Bt) do { __builtin_amdgcn_s_setprio(1); _Pragma("unroll") for (int m = 0; m < 4; ++m) _Pragma("unroll") for (int n = 0; n < 2; ++n) _Pragma("unroll") for (int k = 0; k < 2; ++k) \
        acc[ai][bj][m][n] = __builtin_amdgcn_mfma_f32_16x16x32_bf16(Bt[n][k], At[m][k], acc[ai][bj][m][n], 0, 0, 0); __builtin_amdgcn_s_setprio(0); } while (0)
#define PG8_WAIT_V(n) asm volatile("s_waitcnt vmcnt(" #n ")" ::: "memory")
#define PG8_WAIT_L(n) asm volatile("s_waitcnt lgkmcnt(" #n ")" ::: "memory")
#define PG8_BAR __builtin_amdgcn_s_barrier()
#define PG8_SCHED __builtin_amdgcn_sched_barrier(0)
    Unit cur, nxt; int ui = 0;
    if (!S.next(0, cur)) return;
    f32x4 acc[2][2][4][2];
#pragma unroll
    for (int a = 0; a < 2; ++a)
#pragma unroll
        for (int b = 0; b < 2; ++b)
#pragma unroll
            for (int m = 0; m < 4; ++m)
#pragma unroll
                for (int n = 0; n < 2; ++n) acc[a][b][m][n] = (f32x4){0.f, 0.f, 0.f, 0.f};
    bf16x8 At[4][2], B0[2][2], B1[2][2];
    const char* cA = (const char*)g.A + cur.aoff; const char* cB = (const char*)g.Bt + cur.boff;
    PG8_STAGE(PG8_SB(0, 0), cB, voffB); PG8_STAGE(PG8_SB(0, 1), cB + hstepB, voffB); PG8_STAGE(PG8_SA(0, 0), cA, voffA); PG8_STAGE(PG8_SA(0, 1), cA + hstepA, voffA);
    if (wr == 1) PG8_BAR;
    PG8_WAIT_V(2); PG8_BAR;
    PG8_STAGE(PG8_SB(1, 0), cB + kstepB, voffB); PG8_STAGE(PG8_SA(1, 0), cA + kstepA, voffA); PG8_STAGE(PG8_SB(1, 1), cB + hstepB + kstepB, voffB);
    PG8_WAIT_V(6); PG8_BAR;
    for (;;) {
        const bool has_next = S.next(ui + 1, nxt);
        const char* nA = has_next ? (const char*)g.A + nxt.aoff : cA; const char* nB = has_next ? (const char*)g.Bt + nxt.boff : cB;
        for (int t = 0; t < nt; t += 2) {
            const bool last = (t == nt - 2);
            const char* a1 = cA + (size_t)(t + 1) * kstepA;
            const char* a2 = last ? nA : cA + (size_t)(t + 2) * kstepA; const char* b2 = last ? nB : cB + (size_t)(t + 2) * kstepB;
            const char* a3 = a2 + kstepA; const char* b3 = b2 + kstepB;
            PG8_LDB(B0, 0, 0); PG8_LDB(B1, 0, 1); PG8_SCHED; PG8_LDA(At, 0, 0); PG8_STAGE(PG8_SA(1, 1), a1 + hstepA, voffA);
            PG8_WAIT_V(8); PG8_WAIT_L(0); PG8_BAR; PG8_MMA(0, 0, At, B0); PG8_MMA(0, 1, At, B1); PG8_BAR; PG8_SCHED;
            PG8_LDA(At, 0, 1); PG8_STAGE(PG8_SB(0, 0), b2, voffB); PG8_STAGE(PG8_SB(0, 1), b2 + hstepB, voffB); PG8_STAGE(PG8_SA(0, 0), a2, voffA);
            PG8_WAIT_V(8); PG8_WAIT_L(0); PG8_BAR; PG8_MMA(1, 0, At, B0); PG8_MMA(1, 1, At, B1); PG8_BAR; PG8_SCHED;
            PG8_LDB(B0, 1, 0); PG8_LDB(B1, 1, 1); PG8_SCHED; PG8_LDA(At, 1, 0); PG8_STAGE(PG8_SA(0, 1), a2 + hstepA, voffA);
            PG8_WAIT_V(8); PG8_WAIT_L(0); PG8_BAR; PG8_MMA(0, 0, At, B0); PG8_MMA(0, 1, At, B1); PG8_BAR; PG8_SCHED;
            PG8_LDA(At, 1, 1); PG8_STAGE(PG8_SB(1, 0), b3, voffB); PG8_STAGE(PG8_SB(1, 1), b3 + hstepB, voffB); PG8_STAGE(PG8_SA(1, 0), a3, voffA);
            PG8_WAIT_V(8); PG8_WAIT_L(0); PG8_BAR; PG8_MMA(1, 0, At, B0); PG8_MMA(1, 1, At, B1); PG8_BAR; PG8_SCHED;
        }
        if (wr == 0) PG8_BAR;
        E(acc, cur, wr, wc, fr, fq);
        if (!has_next) break;
#pragma unroll
        for (int a = 0; a < 2; ++a)
#pragma unroll
            for (int b = 0; b < 2; ++b)
#pragma unroll
                for (int m = 0; m < 4; ++m)
#pragma unroll
                    for (int n = 0; n < 2; ++n) acc[a][b][m][n] = (f32x4){0.f, 0.f, 0.f, 0.f};
        cur = nxt; cA = nA; cB = nB; ++ui;
        if (wr == 1) PG8_BAR;
    }
    PG8_WAIT_V(0);
    PG8_BAR;
#undef PG8_SA
#undef PG8_SB
#undef PG8_STAGE
#undef PG8_LDA
#undef PG8_LDB
#undef PG8_MMA
#undef PG8_WAIT_V
#undef PG8_WAIT_L
#undef PG8_BAR
#undef PG8_SCHED
}
}


#define XB_TMO      128
#define XB_XCNT(j)  (256  + 64 * (j))
#define XB_XSUB(j)  (1280 + 64 * (j))
#define XB_XGEN(j)  (2304 + 64 * (j))
#define XB_TOP      3328
#define XB_TOPGEN   3392
#define XCD_BAR_WORDS 3456
#define XB_SPIN_CAP (1u << 22)
DI unsigned xb_ld(unsigned* p)              { return __hip_atomic_load(p, __ATOMIC_RELAXED, __HIP_MEMORY_SCOPE_AGENT); }
DI unsigned xb_add(unsigned* p, unsigned v) { return __hip_atomic_fetch_add(p, v, __ATOMIC_RELAXED, __HIP_MEMORY_SCOPE_AGENT); }
DI unsigned xb_xcc_id() { return (unsigned)__builtin_amdgcn_s_getreg((3 << 11) | 20) & 0xFu; }
#define XB_SPIN(cond, bar) do { unsigned _sp = 0; while (cond) { __builtin_amdgcn_s_sleep(1); \
    if ((++_sp & 255u) == 0u) { if (xb_ld(&(bar)[XB_TMO])) break; if (_sp > XB_SPIN_CAP) { atomicAdd(&(bar)[XB_TMO], 1u); break; } } } } while (0)
DI void xcd_barrier_complete(unsigned* bar, unsigned x, unsigned& nloc, unsigned& nx) {
    const unsigned G = gridDim.x * gridDim.y * gridDim.z;
    unsigned sum, cnt, mine, sp = 0u;
    for (;;) {
        sum = 0u; cnt = 0u; mine = 0u;
#pragma unroll
        for (unsigned j = 0; j < 16; ++j) { const unsigned c = xb_ld(&bar[XB_XCNT(j)]); sum += c; cnt += (c > 0u) ? 1u : 0u; mine = (j == x) ? c : mine; }
        if (sum == G) break;
        __builtin_amdgcn_s_sleep(1);
        if ((++sp & 255u) == 0u) { if (xb_ld(&bar[XB_TMO])) break; if (sp > XB_SPIN_CAP) { atomicAdd(&bar[XB_TMO], 1u); break; } }
    }
    nloc = mine > 0u ? mine : 1u; nx = cnt > 0u ? cnt : 1u;
}
DI void xcd_barrier(unsigned* bar, volatile LAS unsigned* st) {
    asm volatile("s_waitcnt vmcnt(0)" ::: "memory");
    __syncthreads();
    if (threadIdx.x == 0) {
        __builtin_amdgcn_s_waitcnt(0);
        const unsigned x = xb_xcc_id();
        unsigned nloc = st[0], nx = st[1];
        if (nloc == 0u) { xcd_barrier_complete(bar, x, nloc, nx); st[0] = nloc; st[1] = nx; }
        const unsigned old = xb_add(&bar[XB_XSUB(x)], 1u);
        const unsigned gen = old / nloc;
        if (old + 1u == (gen + 1u) * nloc) {
            __builtin_amdgcn_fence(__ATOMIC_RELEASE, "agent");
            asm volatile("s_waitcnt vmcnt(0)" ::: "memory");
            const unsigned og = xb_add(&bar[XB_TOP], 1u);
            const unsigned tg = og / nx;
            if (og + 1u == (tg + 1u) * nx) xb_add(&bar[XB_TOPGEN], 1u);
            else XB_SPIN(xb_ld(&bar[XB_TOPGEN]) == tg, bar);
            __builtin_amdgcn_fence(__ATOMIC_ACQUIRE, "agent");
            xb_add(&bar[XB_XGEN(x)], 1u);
            asm volatile("s_waitcnt vmcnt(0)" ::: "memory");
        } else {
            XB_SPIN(xb_ld(&bar[XB_XGEN(x)]) == gen, bar);
            __builtin_amdgcn_fence(__ATOMIC_ACQUIRE, "agent");
            asm volatile("s_waitcnt vmcnt(0)" ::: "memory");
        }
    }
    __syncthreads();
}

struct Params {
    const float* x; const float* mem; const int* pos;
    const float* ln_mix_pre; const float* w_in; const float* conv_w; const float* conv_b;
    const float* lru_wr; const float* lru_br; const float* lru_wi; const float* lru_bi; const float* lru_lambda;
    const float* cmp_pe; const float* cmp_w1; const float* cmp_b1; const float* cmp_w2;
    const float* ln_mem; const float* w_mem_kv; const float* w_br_rnn; const float* w_br_nsa; const float* w_br_mem; const float* w_out;
    const float* ln_mix_post; const float* ln_mlp_pre; const float* mlp_w1; const float* mlp_w2; const float* ln_mlp_post;
    float* out; unsigned char* ws;
};
typedef const __attribute__((address_space(4))) Params* PP;
#define PPOPAQ() asm volatile("" : "+s"(pp))

DI void tr_item(const float* W, int ldw, int srccol, int valid, int k0, bf16_t* WT, int ldt, int drow0, LAS float* scr, int lane) {
    const int c32 = lane & 31;
#pragma unroll 8
    for (int i = 0; i < 32; ++i) { const int kk = 2 * i + (lane >> 5); float v = 0.f; if (c32 < valid) v = W[(size_t)(k0 + kk) * ldw + srccol + c32]; scr[kk * 33 + c32] = v; }
    __builtin_amdgcn_s_waitcnt(0xc07f); asm volatile("s_waitcnt lgkmcnt(0)" ::: "memory");
    const int c = lane & 7;
#pragma unroll
    for (int j = 0; j < 4; ++j) { const int n = (lane >> 3) + 8 * j; const LAS float* s = scr + (8 * c) * 33 + n;
        u32x4 o; o.x = pk2(s[0 * 33], s[1 * 33]); o.y = pk2(s[2 * 33], s[3 * 33]); o.z = pk2(s[4 * 33], s[5 * 33]); o.w = pk2(s[6 * 33], s[7 * 33]);
        *(u32x4*)(WT + (size_t)(drow0 + n) * ldt + k0 + 8 * c) = o; }
    asm volatile("s_waitcnt lgkmcnt(0)" ::: "memory");
}

DI void prep_phase(PP pp, int l, LAS unsigned char* lds) {
    PPOPAQ();
    int tid = threadIdx.x; asm volatile("" : "+v"(tid));
    const int lane = tid & 63, wave = __builtin_amdgcn_readfirstlane(tid >> 6);
    const int G_ = opaque_s((int)gridDim.x), bx_ = opaque_s((int)blockIdx.x);
    const int gw = bx_ * 8 + wave, NGW = G_ * 8, gtid = bx_ * 512 + tid, NT = G_ * 512;
    (void)lane; (void)wave; (void)gw; (void)NGW; (void)gtid; (void)NT;
    LAS float* scr = (LAS float*)(lds + wave * 8704);
    unsigned char* ws = pp->ws;
    const float* w_in = pp->w_in + (size_t)l * 1024 * 8752;
    constexpr int I_IN = 16 * 280, I_MKV = 16 * 64, I_BR = 16 * 32, I_M1 = 16 * 128, I_M2 = 64 * 32, I_C1 = 2 * 32 * 8, I_C2 = 2 * 4 * 8, I_LRU = 2 * 8 * 2 * 4;
    constexpr int NITEMS = I_IN + I_MKV + 4 * I_BR + I_M1 + I_M2 + I_C1 + I_C2 + I_LRU;
    for (int it = gw; it < NITEMS; it += NGW) {
        int r = it;
        if (r < I_IN) { const int kb = r / 280, nb = r % 280, n0 = 32 * nb; int src, valid = 32;
            if (n0 < 4608) src = n0; else if (n0 < 5632) src = n0 - 4608 + 4656; else if (n0 < 8704) src = n0 - 5632 + 5680;
            else { src = n0 - 8704 + 4608; valid = 48 - (n0 - 8704); valid = valid < 0 ? 0 : (valid > 32 ? 32 : valid); if (valid == 0) src = 0; }
            tr_item(w_in, 8752, src, valid, 64 * kb, (bf16_t*)(ws + WS_WIN), 1024, n0, scr, lane); continue; } r -= I_IN;
        if (r < I_MKV) { tr_item(pp->w_mem_kv + (size_t)l * 1024 * 2048, 2048, 32 * (r % 64), 32, 64 * (r / 64), (bf16_t*)(ws + WS_WMKV), 1024, 32 * (r % 64), scr, lane); continue; } r -= I_MKV;
        if (r < I_BR) { tr_item(pp->w_br_rnn + (size_t)l * 1024 * 1024, 1024, 32 * (r % 32), 32, 64 * (r / 32), (bf16_t*)(ws + WS_WBRA), 1024, 32 * (r % 32), scr, lane); continue; } r -= I_BR;
        if (r < I_BR) { tr_item(pp->w_br_nsa + (size_t)l * 1024 * 1024, 1024, 32 * (r % 32), 32, 64 * (r / 32), (bf16_t*)(ws + WS_WBRB), 1024, 32 * (r % 32), scr, lane); continue; } r -= I_BR;
        if (r < I_BR) { tr_item(pp->w_br_mem + (size_t)l * 1024 * 1024, 1024, 32 * (r % 32), 32, 64 * (r / 32), (bf16_t*)(ws + WS_WBRC), 1024, 32 * (r % 32), scr, lane); continue; } r -= I_BR;
        if (r < I_BR) { tr_item(pp->w_out + (size_t)l * 1024 * 1024, 1024, 32 * (r % 32), 32, 64 * (r / 32), (bf16_t*)(ws + WS_WOUT), 1024, 32 * (r % 32), scr, lane); continue; } r -= I_BR;
        if (r < I_M1) { tr_item(pp->mlp_w1 + (size_t)l * 1024 * 4096, 4096, 32 * (r % 128), 32, 64 * (r / 128), (bf16_t*)(ws + WS_WM1), 1024, 32 * (r % 128), scr, lane); continue; } r -= I_M1;
        if (r < I_M2) { tr_item(pp->mlp_w2 + (size_t)l * 4096 * 1024, 1024, 32 * (r % 32), 32, 64 * (r / 32), (bf16_t*)(ws + WS_WM2), 4096, 32 * (r % 32), scr, lane); continue; } r -= I_M2;
        if (r < I_C1) { const int j = r / 256, q = r % 256;
            tr_item(pp->cmp_w1 + ((size_t)l * 2 + j) * 2048 * 256, 256, 32 * (q % 8), 32, 64 * (q / 8), (bf16_t*)(ws + WS_WC1) + (size_t)j * 256 * 2048, 2048, 32 * (q % 8), scr, lane); continue; } r -= I_C1;
        if (r < I_C2) { const int j = r / 32, q = r % 32; const int n0 = 32 * (q % 8);
            tr_item(pp->cmp_w2 + ((size_t)l * 2 + j) * 256 * 64, 64, n0 < 64 ? n0 : 0, n0 < 64 ? 32 : 0, 64 * (q / 8), (bf16_t*)(ws + WS_WC2) + (size_t)j * 256 * 256, 256, n0, scr, lane); continue; } r -= I_C2;
        { const int ri = r / 64, q = r % 64, blk = q / 8, q2 = q % 8;
            const float* W = (ri == 0 ? pp->lru_wr : pp->lru_wi) + ((size_t)l * 8 + blk) * 128 * 128;
            tr_item(W, 128, 32 * (q2 % 4), 32, 64 * (q2 / 4), (bf16_t*)(ws + WS_WLRU), 128, blk * 256 + ri * 128 + 32 * (q2 % 4), scr, lane); }
    }
    for (int m = gw; m < 512; m += NGW) {
        const f32x4* xr = (const f32x4*)(pp->mem + (size_t)m * 1024) + lane; const f32x4* gr = (const f32x4*)(pp->ln_mem + (size_t)l * 1024) + lane;
        f32x4 v[4]; float s = 0.f;
#pragma unroll
        for (int j = 0; j < 4; ++j) { v[j] = xr[64 * j]; s += (v[j].x * v[j].x + v[j].y * v[j].y) + (v[j].z * v[j].z + v[j].w * v[j].w); }
        const float rs = 1.0f / sqrtf(wave_sum(s, lane) * (1.f / 1024.f) + EPS);
        u32x2* o8 = (u32x2*)((bf16_t*)(ws + WS_MEMN) + (size_t)m * 1024) + lane;
#pragma unroll
        for (int j = 0; j < 4; ++j) { const f32x4 g = gr[64 * j]; u32x2 w; w.x = pk2(v[j].x * rs * g.x, v[j].y * rs * g.y); w.y = pk2(v[j].z * rs * g.z, v[j].w * rs * g.w); o8[64 * j] = w; }
    }
    {
        const int gt = gw * 64 + lane;
        if (gt < 16 * 512) { const int prt = gt / 512, jn = gt % 512, j = jn / 256, n = jn % 256;
            const float* w1 = pp->cmp_w1 + ((size_t)l * 2 + j) * 2048 * 256 + n; const float* pe = pp->cmp_pe + ((size_t)l * 2 + j) * 2048;
            float s = 0.f;
            for (int k = prt * 128; k < prt * 128 + 128; ++k) s += pe[k] * w1[(size_t)k * 256];
            ((float*)(ws + WS_CBP))[gt] = s; }
    }
}

DI void row_phase(const float* xin, const float* y, const float* gpost, float* xout, const float* gnext, bf16_t* hout) {
    int tid = threadIdx.x; asm volatile("" : "+v"(tid));
    const int lane = tid & 63, wave = __builtin_amdgcn_readfirstlane(tid >> 6);
    const int G_ = opaque_s((int)gridDim.x), bx_ = opaque_s((int)blockIdx.x);
    const int gw = bx_ * 8 + wave, NGW = G_ * 8, gtid = bx_ * 512 + tid, NT = G_ * 512;
    (void)lane; (void)wave; (void)gw; (void)NGW; (void)gtid; (void)NT;
    for (int m = gw; m < T_; m += NGW) {
        const f32x4* xr = (const f32x4*)(xin + (size_t)m * 1024) + lane;
        f32x4 v[4];
#pragma unroll
        for (int j = 0; j < 4; ++j) v[j] = xr[64 * j];
        if (y) {
            const f32x4* yr = (const f32x4*)(y + (size_t)m * 1024) + lane; const f32x4* gr = (const f32x4*)gpost + lane;
            f32x4 w[4]; float s = 0.f;
#pragma unroll
            for (int j = 0; j < 4; ++j) { w[j] = yr[64 * j]; s += (w[j].x * w[j].x + w[j].y * w[j].y) + (w[j].z * w[j].z + w[j].w * w[j].w); }
            const float rs = 1.0f / sqrtf(wave_sum(s, lane) * (1.f / 1024.f) + EPS);
            f32x4* xo = (f32x4*)(xout + (size_t)m * 1024) + lane;
#pragma unroll
            for (int j = 0; j < 4; ++j) { v[j] = v[j] + w[j] * rs * gr[64 * j]; xo[64 * j] = v[j]; }
        }
        if (hout) {
            float s = 0.f;
#pragma unroll
            for (int j = 0; j < 4; ++j) s += (v[j].x * v[j].x + v[j].y * v[j].y) + (v[j].z * v[j].z + v[j].w * v[j].w);
            const float rs = 1.0f / sqrtf(wave_sum(s, lane) * (1.f / 1024.f) + EPS);
            const f32x4* gr = (const f32x4*)gnext + lane; u32x2* o8 = (u32x2*)(hout + (size_t)m * 1024) + lane;
#pragma unroll
            for (int j = 0; j < 4; ++j) { const f32x4 g = gr[64 * j]; u32x2 w; w.x = pk2(v[j].x * rs * g.x, v[j].y * rs * g.y); w.y = pk2(v[j].z * rs * g.z, v[j].w * rs * g.w); o8[64 * j] = w; }
        }
    }
}

DI void rope8(u32x4& lo, u32x4& hi, float pos, int d0, float scale) {
    unsigned* pl = (unsigned*)&lo; unsigned* ph = (unsigned*)&hi;
    float x1[8], x2[8];
#pragma unroll
    for (int e = 0; e < 4; ++e) { x1[2 * e] = bflo(pl[e]); x1[2 * e + 1] = bfhi(pl[e]); x2[2 * e] = bflo(ph[e]); x2[2 * e + 1] = bfhi(ph[e]); }
#pragma unroll
    for (int e = 0; e < 8; ++e) {
        const float inv = fexp2(-(float)(d0 + e) * 0.41524101186092029f);
        const float ang = pos * inv;
        const double rev = (double)ang * 0.15915494309189535; const float fr = (float)(rev - __builtin_rint(rev));
        const float sn = __builtin_amdgcn_sinf(fr), cs = __builtin_amdgcn_cosf(fr);
        const float a = (x1[e] * cs - x2[e] * sn) * scale, b = (x2[e] * cs + x1[e] * sn) * scale; x1[e] = a; x2[e] = b;
    }
#pragma unroll
    for (int e = 0; e < 4; ++e) { pl[e] = pk2(x1[2 * e], x1[2 * e + 1]); ph[e] = pk2(x2[2 * e], x2[2 * e + 1]); }
}

DI void postproj_phase(PP pp, int l) {
    PPOPAQ();
    int tid = threadIdx.x; asm volatile("" : "+v"(tid));
    const int lane = tid & 63, wave = __builtin_amdgcn_readfirstlane(tid >> 6);
    const int G_ = opaque_s((int)gridDim.x), bx_ = opaque_s((int)blockIdx.x);
    const int gw = bx_ * 8 + wave, NGW = G_ * 8, gtid = bx_ * 512 + tid, NT = G_ * 512;
    (void)lane; (void)wave; (void)gw; (void)NGW; (void)gtid; (void)NT;
    unsigned char* ws = pp->ws; bf16_t* PROJ = (bf16_t*)(ws + WS_PROJ);
    {
        const float* cw = pp->conv_w + (size_t)l * 4 * 1024; const float* cb = pp->conv_b + (size_t)l * 1024; bf16_t* XC = (bf16_t*)(ws + WS_XC);
        for (int i = gtid; i < T_ * 128; i += NT) { const int t = i >> 7, c8 = (i & 127) * 8, ts = t & (S_ - 1);
            float acc[8];
#pragma unroll
            for (int e = 0; e < 8; ++e) acc[e] = cb[c8 + e];
#pragma unroll
            for (int w = 0; w < 4; ++w) { if (ts - 3 + w >= 0) { const u32x4 xv = *(const u32x4*)(PROJ + (size_t)(t - 3 + w) * LDP + C_XR + c8); const unsigned* xp = (const unsigned*)&xv;
                    const f32x4 k0 = *(const f32x4*)(cw + w * 1024 + c8), k1 = *(const f32x4*)(cw + w * 1024 + c8 + 4);
                    acc[0] += k0.x * bflo(xp[0]); acc[1] += k0.y * bfhi(xp[0]); acc[2] += k0.z * bflo(xp[1]); acc[3] += k0.w * bfhi(xp[1]);
                    acc[4] += k1.x * bflo(xp[2]); acc[5] += k1.y * bfhi(xp[2]); acc[6] += k1.z * bflo(xp[3]); acc[7] += k1.w * bfhi(xp[3]); } }
            u32x4 o; o.x = pk2(acc[0], acc[1]); o.y = pk2(acc[2], acc[3]); o.z = pk2(acc[4], acc[5]); o.w = pk2(acc[6], acc[7]);
            *(u32x4*)(XC + (size_t)t * 1024 + c8) = o; }
    }
    for (int i = gtid; i < T_ * 20 * 4; i += NT) { const int t = i / 80, r = i % 80, hd = r >> 2, d0 = (r & 3) * 8;
        int col; float sc = 1.0f;
        if (hd < 16) { col = C_Q + hd * 64; sc = 0.125f * LOG2E; } else col = C_KW + (hd - 16) * 64;
        bf16_t* base = PROJ + (size_t)t * LDP + col + d0;
        u32x4 lo = *(const u32x4*)base, hi = *(const u32x4*)(base + 32);
        rope8(lo, hi, (float)pp->pos[t], d0, sc);
        *(u32x4*)base = lo; *(u32x4*)(base + 32) = hi; }
    for (int i = gtid; i < 8 * 128 * 2 * 2 * 64; i += NT) { const int ln = i & 63, kp = (i >> 6) & 1, u = (i >> 7) & 1, j = (i >> 8) & 127, bg = i >> 15, b = bg >> 2, g = bg & 3;
        const int n = ln & 31, hh = ln >> 5, t = 64 * j + 32 * u + n;
        const float posf = (float)pp->pos[b * S_ + t];
        u32x4 outw;
#pragma unroll
        for (int q = 0; q < 2; ++q) { const int ks = 2 * kp + q, d0 = 16 * ks + 8 * hh, dl = d0 & 31;
            const bf16_t* base = PROJ + (size_t)(b * S_ + t) * LDP + C_KS + g * 64 + dl;
            u32x4 lo = *(const u32x4*)base, hi = *(const u32x4*)(base + 32);
            rope8(lo, hi, posf, dl, 1.0f);
            const u32x4 r = (d0 < 32) ? lo : hi;
            const unsigned w0 = pk4_fp8(bflo(r.x), bfhi(r.x), bflo(r.y), bfhi(r.y)), w1 = pk4_fp8(bflo(r.z), bfhi(r.z), bflo(r.w), bfhi(r.w));
            if (q == 0) { outw.x = w0; outw.y = w1; } else { outw.z = w0; outw.w = w1; } }
        *(u32x4*)((unsigned char*)(ws + WS_KF) + (size_t)i * 16) = outw; }
    for (int i = gtid; i < 8 * 128 * 2 * 2 * 64; i += NT) { const int ln = i & 63, u = (i >> 6) & 1, ds = (i >> 7) & 1, j = (i >> 8) & 127, bg = i >> 15, b = bg >> 2, g = bg & 3;
        const int n = ln & 31, hh = ln >> 5;
        u32x4 outw;
#pragma unroll
        for (int st = 0; st < 2; ++st) { const int key0 = 64 * j + 32 * u + 16 * st + 4 * hh;
            const bf16_t* src = PROJ + (size_t)(b * S_ + key0) * LDP + C_VS + g * 64 + 32 * ds + n;
            float v[8];
#pragma unroll
            for (int e = 0; e < 8; ++e) v[e] = bf2f(src[(size_t)(e < 4 ? e : e + 4) * LDP]);
            const unsigned w0 = pk4_fp8(v[0], v[1], v[2], v[3]), w1 = pk4_fp8(v[4], v[5], v[6], v[7]);
            if (st == 0) { outw.x = w0; outw.y = w1; } else { outw.z = w0; outw.w = w1; } }
        *(u32x4*)((unsigned char*)(ws + WS_VTS) + (size_t)i * 16) = outw; }
    for (int i = gtid; i < 2 * 4 * 1024 * 64; i += NT) { const int d = i & 63, t8 = (i >> 6) & 1023, g = (i >> 16) & 3, b = (i >> 18) & 1, which = 1;
        const bf16_t* src = PROJ + (size_t)(b * S_ + t8 * 8) * LDP + (which ? C_VW : C_VS) + g * 64 + d;
        unsigned short v[8];
#pragma unroll
        for (int e = 0; e < 8; ++e) v[e] = src[(size_t)e * LDP];
        u32x4 o; o.x = v[0] | ((unsigned)v[1] << 16); o.y = v[2] | ((unsigned)v[3] << 16); o.z = v[4] | ((unsigned)v[5] << 16); o.w = v[6] | ((unsigned)v[7] << 16);
        *(u32x4*)((bf16_t*)(ws + (which ? WS_VTW : WS_VTS)) + ((size_t)(b * 4 + g) * 64 + d) * S_ + t8 * 8) = o; }
    if (gtid < 512) { const float* part = (const float*)(ws + WS_CBP); float s = pp->cmp_b1[(size_t)l * 512 + gtid];
        for (int q = 0; q < 16; ++q) s += part[q * 512 + gtid];
        ((float*)(ws + WS_CBIAS))[gtid] = s; }
}

DI void lru_ab(float rp, float ip, float xc, float cl, float& a, float& bb) {
    const float la = cl * sigmoidf_(rp);
    a = fexp2(la * LOG2E);
    const float x2 = 2.0f * la;
    float om;
    if (x2 > -0.1f) om = -x2 * (1.0f + x2 * (0.5f + x2 * (0.16666667f + x2 * (0.041666668f + x2 * 0.0083333338f)))); else om = 1.0f - a * a;
    bb = sqrtf(om) * sigmoidf_(ip) * xc;
}
DI void scan_phase(PP pp, int l, int pass) {
    PPOPAQ();
    int tid = threadIdx.x; asm volatile("" : "+v"(tid));
    const int G_ = opaque_s((int)gridDim.x), bx_ = opaque_s((int)blockIdx.x);
    unsigned char* ws = pp->ws; const bf16_t* __restrict__ RI = (const bf16_t*)(ws + WS_RI); bf16_t* XC = (bf16_t*)(ws + WS_XC); const bf16_t* __restrict__ PROJ = (const bf16_t*)(ws + WS_PROJ);
    f32x2* SA = (f32x2*)(ws + WS_SCA); f32x2* SH = (f32x2*)(ws + WS_SCH);
    const int ch = 2 * tid, blk = ch >> 7, cc = ch & 127, rcol = blk * 256 + cc;
    const f32x2 lam = *(const f32x2*)(pp->lru_lambda + (size_t)l * 1024 + ch), br = *(const f32x2*)(pp->lru_br + (size_t)l * 1024 + ch), bi = *(const f32x2*)(pp->lru_bi + (size_t)l * 1024 + ch);
    float cl[2];
#pragma unroll
    for (int e = 0; e < 2; ++e) { const float ex = fexp2(-lam[e] * LOG2E);
        const float sp = (ex < 0.05f) ? ex * (1.0f - ex * (0.5f - ex * (0.33333334f - ex * (0.25f - ex * (0.2f - ex * 0.16666667f))))) : ((-lam[e] > 20.f) ? -lam[e] : 0.6931471805599453f * __builtin_amdgcn_logf(1.0f + ex));
        cl[e] = -8.0f * sp; }
    for (int u = bx_; u < 256; u += G_) { const int b = u >> 7, k = u & 127;
        const size_t row0 = (size_t)b * S_ + k * 64;
        if (pass == 0) {
            float A0 = 1.f, H0 = 0.f, A1 = 1.f, H1 = 0.f;
            for (int s8 = 0; s8 < 64; s8 += 8) { unsigned rw[8], iw[8], xw[8];
#pragma unroll
                for (int e = 0; e < 8; ++e) { const size_t row = row0 + s8 + e; rw[e] = *(const unsigned*)(RI + row * 2048 + rcol); iw[e] = *(const unsigned*)(RI + row * 2048 + rcol + 128); xw[e] = *(const unsigned*)(XC + row * 1024 + ch); }
#pragma unroll
                for (int e = 0; e < 8; ++e) { float a, bb;
                    lru_ab(bflo(rw[e]) + br[0], bflo(iw[e]) + bi[0], bflo(xw[e]), cl[0], a, bb); A0 *= a; H0 = a * H0 + bb;
                    lru_ab(bfhi(rw[e]) + br[1], bfhi(iw[e]) + bi[1], bfhi(xw[e]), cl[1], a, bb); A1 *= a; H1 = a * H1 + bb; } }
            SA[((size_t)b * 128 + k) * 512 + tid] = (f32x2){A0, A1}; SH[((size_t)b * 128 + k) * 512 + tid] = (f32x2){H0, H1};
        } else {
            float h0 = 0.f, h1 = 0.f;
            const f32x2* __restrict__ sa = SA + (size_t)b * 128 * 512 + tid; const f32x2* __restrict__ sh = SH + (size_t)b * 128 * 512 + tid;
#pragma unroll 16
            for (int q = 0; q < k; ++q) { const f32x2 a = sa[(size_t)q * 512], hh = sh[(size_t)q * 512]; h0 = a[0] * h0 + hh[0]; h1 = a[1] * h1 + hh[1]; }
            for (int s8 = 0; s8 < 64; s8 += 8) { unsigned rw[8], iw[8], xw[8], yw[8];
#pragma unroll
                for (int e = 0; e < 8; ++e) { const size_t row = row0 + s8 + e; rw[e] = *(const unsigned*)(RI + row * 2048 + rcol); iw[e] = *(const unsigned*)(RI + row * 2048 + rcol + 128); xw[e] = *(const unsigned*)(XC + row * 1024 + ch);
                    yw[e] = *(const unsigned*)(PROJ + row * LDP + C_YR + ch); }
#pragma unroll
                for (int e = 0; e < 8; ++e) { float a, bb;
                    lru_ab(bflo(rw[e]) + br[0], bflo(iw[e]) + bi[0], bflo(xw[e]), cl[0], a, bb); h0 = a * h0 + bb;
                    lru_ab(bfhi(rw[e]) + br[1], bfhi(iw[e]) + bi[1], bfhi(xw[e]), cl[1], a, bb); h1 = a * h1 + bb;
                    *(unsigned*)(XC + (row0 + s8 + e) * 1024 + ch) = pk2(h0 * gelu_tanh(bflo(yw[e])), h1 * gelu_tanh(bfhi(yw[e]))); } }
        }
    }
}

DI void memsoftmax_phase(PP pp) {
    PPOPAQ();
    int tid = threadIdx.x; asm volatile("" : "+v"(tid));
    const int lane = tid & 63, wave = __builtin_amdgcn_readfirstlane(tid >> 6);
    const int G_ = opaque_s((int)gridDim.x), bx_ = opaque_s((int)blockIdx.x);
    const int gw = bx_ * 8 + wave, NGW = G_ * 8, gtid = bx_ * 512 + tid, NT = G_ * 512;
    (void)lane; (void)wave; (void)gw; (void)NGW; (void)gtid; (void)NT;
    bf16_t* SP = (bf16_t*)(pp->ws + WS_H);
    for (int m = gw; m < T_; m += NGW) {
        u32x4* ptr = (u32x4*)(SP + (size_t)m * 1024 + lane * 16);
        u32x4 a = ptr[0], b = ptr[1]; const unsigned* pa = (const unsigned*)&a; const unsigned* pb = (const unsigned*)&b;
        float v[16];
#pragma unroll
        for (int e = 0; e < 4; ++e) { v[2 * e] = bflo(pa[e]); v[2 * e + 1] = bfhi(pa[e]); v[8 + 2 * e] = bflo(pb[e]); v[8 + 2 * e + 1] = bfhi(pb[e]); }
        float mx = v[0];
#pragma unroll
        for (int e = 1; e < 16; ++e) mx = fmaxf(mx, v[e]);
#pragma unroll
        for (int o = 1; o < 16; o <<= 1) mx = fmaxf(mx, shx(mx, o, lane));
        float s = 0.f;
#pragma unroll
        for (int e = 0; e < 16; ++e) { v[e] = fexp2(v[e] - mx); s += v[e]; }
#pragma unroll
        for (int o = 1; o < 16; o <<= 1) s += shx(s, o, lane);
        const float inv = 1.0f / s;
        u32x4 oa, ob; unsigned* qa = (unsigned*)&oa; unsigned* qb = (unsigned*)&ob;
#pragma unroll
        for (int e = 0; e < 4; ++e) { qa[e] = pk2(v[2 * e] * inv, v[2 * e + 1] * inv); qb[e] = pk2(v[8 + 2 * e] * inv, v[8 + 2 * e + 1] * inv); }
        ptr[0] = oa; ptr[1] = ob;
    }
}

DI void cmpfinal_phase(PP pp) {
    PPOPAQ();
    int tid = threadIdx.x; asm volatile("" : "+v"(tid));
    const int lane = tid & 63, wave = __builtin_amdgcn_readfirstlane(tid >> 6);
    const int G_ = opaque_s((int)gridDim.x), bx_ = opaque_s((int)blockIdx.x);
    const int gw = bx_ * 8 + wave, NGW = G_ * 8, gtid = bx_ * 512 + tid, NT = G_ * 512;
    (void)lane; (void)wave; (void)gw; (void)NGW; (void)gtid; (void)NT;
    unsigned char* ws = pp->ws; const float* CR = (const float*)(ws + WS_CRAW);
    for (int i = gtid; i < 2 * 4 * 512 * 32; i += NT) { const int d = i & 31, c = (i >> 5) & 511, bg = i >> 14, b = bg >> 2;
        const float* src = CR + ((size_t)bg * 512 + c) * 64; float x1 = src[d], x2 = src[d + 32];
        float o1 = 0.f, o2 = 0.f;
        if (c < 511) { const float pos = (float)pp->pos[b * S_ + 16 * c + 31]; const float inv = fexp2(-(float)d * 0.41524101186092029f); const float ang = pos * inv;
            const double rev = (double)ang * 0.15915494309189535; const float fr = (float)(rev - __builtin_rint(rev));
            const float sn = __builtin_amdgcn_sinf(fr), cs = __builtin_amdgcn_cosf(fr); o1 = x1 * cs - x2 * sn; o2 = x2 * cs + x1 * sn; }
        bf16_t* dst = (bf16_t*)(ws + WS_KCMP) + ((size_t)bg * 512 + c) * 64; dst[d] = (bf16_t)f2bf(o1); dst[d + 32] = (bf16_t)f2bf(o2); }
    for (int i = gtid; i < 2 * 4 * 64 * 512; i += NT) { const int c = i & 511, d = (i >> 9) & 63, bg = i >> 15;
        const float v = (c < 511) ? CR[((size_t)(8 + bg) * 512 + c) * 64 + d] : 0.f;
        ((bf16_t*)(ws + WS_VTCMP))[((size_t)bg * 64 + d) * 512 + c] = (bf16_t)f2bf(v); }
}

constexpr int KSTR = 144, VSTR = 136;
constexpr int L_K = 0, L_V = 2 * 64 * KSTR, L_IMP = L_V + 2 * 64 * VSTR, IMPSTR = 132, L_SEL = L_IMP + 64 * IMPSTR * 4, L_ATT_END = L_SEL + 64 * 16, L_OT = L_ATT_END;
DI int crow(int r, int hi) { return (r & 3) + 8 * (r >> 2) + 4 * hi; }

struct TileSrc { const bf16_t* K; int kstr; const bf16_t* Vt; int vstr; };

template <int MODE>
DI void attn_loop(LAS unsigned char* lds, const TileSrc src, int j0, int j1, const bf16x8 (&qf)[4], f32x16 (&o)[2], float& m_run, float& l_run,
                  int tl, int t, int tb, u64 selLo, u64 selHi, int tid, int wave, int lane) {
    const int n = lane & 31, hh = lane >> 5;
    const int lrow = tid >> 3, lchunk = tid & 7;
    u32x4 kreg, vreg;
    kreg = *(const u32x4*)(src.K + (size_t)(64 * j0 + lrow) * src.kstr + lchunk * 8);
    vreg = *(const u32x4*)(src.Vt + (size_t)lrow * src.vstr + 64 * j0 + lchunk * 8);
    float carry = 0.f;
    int buf = 0;
    for (int j = j0; j <= j1; ++j) {
        LAS unsigned char* Kl = lds + L_K + buf * 64 * KSTR; LAS unsigned char* Vl = lds + L_V + buf * 64 * VSTR;
        *(LAS u32x4*)(Kl + lrow * KSTR + lchunk * 16) = kreg;
        *(LAS u32x2*)(Vl + lrow * VSTR + lchunk * 16) = (u32x2){vreg.x, vreg.y}; *(LAS u32x2*)(Vl + lrow * VSTR + lchunk * 16 + 8) = (u32x2){vreg.z, vreg.w};
        __syncthreads();
        if (j < j1) { kreg = *(const u32x4*)(src.K + (size_t)(64 * (j + 1) + lrow) * src.kstr + lchunk * 8);
                      vreg = *(const u32x4*)(src.Vt + (size_t)lrow * src.vstr + 64 * (j + 1) + lchunk * 8); }
        buf ^= 1;
        bool active = true;
        if (MODE == 2) { const bool bit = ((j < 64 ? selLo : selHi) >> (j & 63)) & 1ull; active = __ballot(bit) != 0ull; }
        if (!active) continue;
        f32x16 s[2];
#pragma unroll
        for (int u = 0; u < 2; ++u) {
#pragma unroll
            for (int e = 0; e < 16; ++e) s[u][e] = 0.f;
#pragma unroll
            for (int ks = 0; ks < 4; ++ks) { const bf16x8 kf = *(const LAS bf16x8*)(Kl + (32 * u + n) * KSTR + (ks * 16 + 8 * hh) * 2);
                s[u] = __builtin_amdgcn_mfma_f32_32x32x16_bf16(kf, qf[ks], s[u], 0, 0, 0); }
        }
        const float NEGINF = -__builtin_inff();
        if (MODE <= 1) { const int cmax = min(510, (t - 31) >> 4);
#pragma unroll
            for (int u = 0; u < 2; ++u)
#pragma unroll
                for (int e = 0; e < 16; ++e) { const int c = 64 * j + 32 * u + crow(e, hh); if (c > cmax) s[u][e] = NEGINF; }
        } else if (MODE == 2) { const bool bit = ((j < 64 ? selLo : selHi) >> (j & 63)) & 1ull; const int lim = (j == tb) ? tl : 64;
#pragma unroll
            for (int u = 0; u < 2; ++u)
#pragma unroll
                for (int e = 0; e < 16; ++e) { const int kk = 32 * u + crow(e, hh); if (!bit || kk > lim) s[u][e] = NEGINF; }
        } else {
#pragma unroll
            for (int u = 0; u < 2; ++u)
#pragma unroll
                for (int e = 0; e < 16; ++e) { const int df = t - (64 * j + 32 * u + crow(e, hh)); if ((unsigned)df >= 512u) s[u][e] = NEGINF; }
        }
        if (MODE == 1) {
            const float msafe = (m_run == NEGINF) ? 0.f : m_run;
#pragma unroll
            for (int u = 0; u < 2; ++u)
#pragma unroll
                for (int e = 0; e < 16; ++e) s[u][e] = fexp2(s[u][e] - msafe) * l_run;
            if (tb >= 16) {
                float w1[8], w2[8], pw2[8];
#pragma unroll
                for (int u = 0; u < 2; ++u)
#pragma unroll
                    for (int gi = 0; gi < 4; ++gi) { const float p0 = s[u][4 * gi], p1 = s[u][4 * gi + 1], p2 = s[u][4 * gi + 2], p3 = s[u][4 * gi + 3];
                        w1[u * 4 + gi] = p0 + p1 + p2 + 0.5f * p3; w2[u * 4 + gi] = 0.5f * p3; }
#pragma unroll
                for (int q = 0; q < 8; ++q) pw2[q] = shx(w2[q], 32, lane);
                float tot[8];
#pragma unroll
                for (int q = 0; q < 8; ++q) { const float prev = (q == 0) ? carry : pw2[q > 0 ? q - 1 : 0]; tot[q] = w1[q] + (hh ? pw2[q] : prev); }
                carry = pw2[7];
#pragma unroll
                for (int q = 0; q < 8; ++q) { float v = tot[q]; v += shx(v, 1, lane); v += shx(v, 2, lane); tot[q] = v; }
                if ((n & 3) == 0) { LAS float* imp = (LAS float*)(lds + L_IMP) + (8 * wave + (n >> 2)) * IMPSTR;
#pragma unroll
                    for (int q = 0; q < 8; ++q) { const int jj = 16 * j + 8 * (q >> 2) + 2 * (q & 3) + hh; if (jj < 128) imp[jj] = tot[q]; } }
            }
        } else {
            float mloc = s[0][0];
#pragma unroll
            for (int u = 0; u < 2; ++u)
#pragma unroll
                for (int e = 0; e < 16; ++e) mloc = fmaxf(mloc, s[u][e]);
            mloc = fmaxf(mloc, shx(mloc, 32, lane));
            const float mnew = fmaxf(m_run, mloc); const float msafe = (mnew == NEGINF) ? 0.f : mnew;
            const float alpha = fexp2(m_run - msafe);
            float ls = 0.f;
#pragma unroll
            for (int u = 0; u < 2; ++u)
#pragma unroll
                for (int e = 0; e < 16; ++e) { s[u][e] = fexp2(s[u][e] - msafe); ls += s[u][e]; }
            l_run = l_run * alpha + ls; m_run = mnew;
            if (MODE != 0) {
#pragma unroll
                for (int ds = 0; ds < 2; ++ds)
#pragma unroll
                    for (int e = 0; e < 16; ++e) o[ds][e] *= alpha;
            }
        }
        if (MODE != 0) {
#pragma unroll
            for (int u = 0; u < 2; ++u)
#pragma unroll
                for (int st = 0; st < 2; ++st) {
                    u32x4 pp; pp.x = pk2(s[u][8 * st], s[u][8 * st + 1]); pp.y = pk2(s[u][8 * st + 2], s[u][8 * st + 3]); pp.z = pk2(s[u][8 * st + 4], s[u][8 * st + 5]); pp.w = pk2(s[u][8 * st + 6], s[u][8 * st + 7]);
                    const bf16x8 pb = __builtin_bit_cast(bf16x8, pp);
#pragma unroll
                    for (int ds = 0; ds < 2; ++ds) { const LAS unsigned char* vp = Vl + (32 * ds + n) * VSTR + (32 * u + 16 * st + 4 * hh) * 2;
                        const u32x2 a0 = *(const LAS u32x2*)vp, a1 = *(const LAS u32x2*)(vp + 16);
                        const u32x4 av = {a0.x, a0.y, a1.x, a1.y};
                        o[ds] = __builtin_amdgcn_mfma_f32_32x32x16_bf16(__builtin_bit_cast(bf16x8, av), pb, o[ds], 0, 0, 0); }
                }
        }
    }
    __syncthreads();
}

DI void sel_direct(const unsigned char* __restrict__ KFb, const unsigned char* __restrict__ VFb, u64 uLo, u64 uHi, const bf16x8 (&qf)[4], f32x16 (&o)[2], float& m_run, float& l_run,
                   int tl, int tb, u64 selLo, u64 selHi, int lane) {
    const int hh = lane >> 5;
    const float NEGINF = -__builtin_inff();
    const unsigned char* kp = KFb + lane * 16;
    const unsigned char* vp = VFb + lane * 16;
    long q8[4];
#pragma unroll
    for (int ks = 0; ks < 4; ++ks) { const u32x4 w = __builtin_bit_cast(u32x4, qf[ks]);
        q8[ks] = mk64(pk4_fp8(bflo(w.x), bfhi(w.x), bflo(w.y), bfhi(w.y)), pk4_fp8(bflo(w.z), bfhi(w.z), bflo(w.w), bfhi(w.w))); }
    u32x4 kc[2][2], kn[2][2];
    int j = (uLo != 0ull) ? __builtin_ctzll(uLo) : 64 + __builtin_ctzll(uHi);
    if (uLo != 0ull) uLo &= uLo - 1ull; else uHi &= uHi - 1ull;
#pragma unroll
    for (int u = 0; u < 2; ++u)
#pragma unroll
        for (int p = 0; p < 2; ++p) kc[u][p] = *(const u32x4*)(kp + (size_t)(((j * 2 + u) * 2 + p) * 1024));
    for (;;) {
        const bool more = (uLo | uHi) != 0ull;
        int jn = j;
        if (more) { jn = (uLo != 0ull) ? __builtin_ctzll(uLo) : 64 + __builtin_ctzll(uHi); if (uLo != 0ull) uLo &= uLo - 1ull; else uHi &= uHi - 1ull;
#pragma unroll
            for (int u = 0; u < 2; ++u)
#pragma unroll
                for (int p = 0; p < 2; ++p) kn[u][p] = *(const u32x4*)(kp + (size_t)(((jn * 2 + u) * 2 + p) * 1024)); }
        u32x4 vf[2][2];
#pragma unroll
        for (int ds = 0; ds < 2; ++ds)
#pragma unroll
            for (int u = 0; u < 2; ++u) vf[ds][u] = *(const u32x4*)(vp + (size_t)(((j * 2 + ds) * 2 + u) * 1024));
        f32x16 s[2];
#pragma unroll
        for (int u = 0; u < 2; ++u) {
#pragma unroll
            for (int e = 0; e < 16; ++e) s[u][e] = 0.f;
#pragma unroll
            for (int p = 0; p < 2; ++p) {
                s[u] = __builtin_amdgcn_mfma_f32_32x32x16_fp8_fp8(mk64(kc[u][p].x, kc[u][p].y), q8[2 * p], s[u], 0, 0, 0);
                s[u] = __builtin_amdgcn_mfma_f32_32x32x16_fp8_fp8(mk64(kc[u][p].z, kc[u][p].w), q8[2 * p + 1], s[u], 0, 0, 0); }
        }
        const bool bit = ((j < 64 ? selLo : selHi) >> (j & 63)) & 1ull;
        if (j == tb) {
#pragma unroll
            for (int u = 0; u < 2; ++u)
#pragma unroll
                for (int e = 0; e < 16; ++e) { const int kk = 32 * u + crow(e, hh); if (kk > tl) s[u][e] = NEGINF; }
        }
        float mloc = fmaxf(s[0][0], s[1][0]);
#pragma unroll
        for (int e = 1; e < 16; ++e) mloc = fmaxf(mloc, fmaxf(s[0][e], s[1][e]));
        mloc = fmaxf(mloc, shx(mloc, 32, lane));
        const float mnew = bit ? fmaxf(m_run, mloc) : m_run;
        const float msafe = (mnew == NEGINF) ? 0.f : mnew;
        const float alpha = fexp2(m_run - msafe);
        const float sub = bit ? msafe - 8.0f : __builtin_inff();
        float ls = 0.f;
#pragma unroll
        for (int u = 0; u < 2; ++u)
#pragma unroll
            for (int e = 0; e < 16; ++e) { s[u][e] = fexp2(s[u][e] - sub); ls += s[u][e]; }
        l_run = l_run * alpha + ls; m_run = mnew;
        if (__ballot(alpha != 1.0f) != 0ull) {
#pragma unroll
            for (int ds = 0; ds < 2; ++ds)
#pragma unroll
                for (int e = 0; e < 16; ++e) o[ds][e] *= alpha;
        }
#pragma unroll
        for (int u = 0; u < 2; ++u)
#pragma unroll
            for (int st = 0; st < 2; ++st) {
                const long pb = mk64(pk4_fp8(s[u][8 * st], s[u][8 * st + 1], s[u][8 * st + 2], s[u][8 * st + 3]), pk4_fp8(s[u][8 * st + 4], s[u][8 * st + 5], s[u][8 * st + 6], s[u][8 * st + 7]));
#pragma unroll
                for (int ds = 0; ds < 2; ++ds) { const long av = st == 0 ? mk64(vf[ds][u].x, vf[ds][u].y) : mk64(vf[ds][u].z, vf[ds][u].w);
                    o[ds] = __builtin_amdgcn_mfma_f32_32x32x16_fp8_fp8(av, pb, o[ds], 0, 0, 0); }
            }
        if (!more) break;
#pragma unroll
        for (int u = 0; u < 2; ++u)
#pragma unroll
            for (int p = 0; p < 2; ++p) kc[u][p] = kn[u][p];
        j = jn;
    }
}

DI void attn_phase(PP pp, LAS unsigned char* lds, bool do_store) {
    PPOPAQ();
    int tid = threadIdx.x; asm volatile("" : "+v"(tid));
    const int lane = tid & 63, wave = __builtin_amdgcn_readfirstlane(tid >> 6);
    const int G_ = opaque_s((int)gridDim.x), bx_ = opaque_s((int)blockIdx.x);
    const int gw = bx_ * 8 + wave, NGW = G_ * 8, gtid = bx_ * 512 + tid, NT = G_ * 512;
    (void)lane; (void)wave; (void)gw; (void)NGW; (void)gtid; (void)NT;
    unsigned char* ws = pp->ws; bf16_t* PROJ = (bf16_t*)(ws + WS_PROJ);
    const int n = lane & 31, hh = lane >> 5, G = G_;
    for (int it = 0; it < 4; ++it) {
        const int cc = (it & 1) ? (G - 1 - bx_) : bx_;
        const int rho = it * G + cc; if (rho >= 1024) continue;
        const int tb = 127 - (rho >> 3), bg = rho & 7, b = bg >> 2, g = bg & 3;
        const int t0 = 64 * tb, tl = 8 * wave + (n >> 2), r = n & 3, t = t0 + tl;
        const size_t trow = (size_t)b * S_ + t;
        bf16_t* qptr = PROJ + trow * LDP + C_Q + (4 * g + r) * 64;
        bf16x8 qf[4];
#pragma unroll
        for (int ks = 0; ks < 4; ++ks) qf[ks] = *(const bf16x8*)(qptr + ks * 16 + 8 * hh);
        f32x16 o[2];
        LAS float* OT = (LAS float*)(lds + L_OT) + wave * 2048 + lane;
        for (int i = tid; i < 64 * IMPSTR; i += 512) ((LAS float*)(lds + L_IMP))[i] = 0.f;
        {
            TileSrc src{(const bf16_t*)(ws + WS_KCMP) + (size_t)bg * 512 * 64, 64, (const bf16_t*)(ws + WS_VTCMP) + (size_t)bg * 64 * 512, 512};
            int nvalid = (t0 + 32) / 16 + 1; if (nvalid > 511) nvalid = 511;
            const int j1 = (nvalid - 1) >> 6;
            float m = -__builtin_inff(), l = 0.f;
            attn_loop<0>(lds, src, 0, j1, qf, o, m, l, tl, t, tb, 0ull, 0ull, tid, wave, lane);
            l += shx(l, 32, lane);
            float inv = 1.0f / fmaxf(l, 1e-30f);
#pragma unroll
            for (int ds = 0; ds < 2; ++ds)
#pragma unroll
                for (int e = 0; e < 16; ++e) o[ds][e] = 0.f;
            attn_loop<1>(lds, src, 0, j1, qf, o, m, inv, tl, t, tb, 0ull, 0ull, tid, wave, lane);
#pragma unroll
            for (int ds = 0; ds < 2; ++ds)
#pragma unroll
                for (int e = 0; e < 16; ++e) OT[(ds * 16 + e) * 64] = o[ds][e];
        }
        {
            const int tok = tid >> 3, prt = tid & 7;
            unsigned mk[4] = {0u, 0u, 0u, 0u};
            if (tb < 16) { mk[0] = (tb == 31) ? 0xffffffffu : ((2u << tb) - 1u); }
            else {
                const LAS float* imp = (const LAS float*)(lds + L_IMP) + tok * IMPSTR + 16 * prt;
                u64 keys[16];
#pragma unroll
                for (int e = 0; e < 16; ++e) { const int j = 16 * prt + e; const unsigned bits = __builtin_bit_cast(unsigned, imp[e]);
                    keys[e] = (j >= 1 && j <= tb - 1) ? (((u64)(bits + 1u) << 32) | (u64)(127 - j)) : 0ull; }
                mk[0] = 1u; mk[tb >> 5] |= 1u << (tb & 31);
                for (int round = 0; round < 14; ++round) {
                    u64 best = keys[0];
#pragma unroll
                    for (int e = 1; e < 16; ++e) best = keys[e] > best ? keys[e] : best;
#pragma unroll
                    for (int o2 = 1; o2 < 8; o2 <<= 1) { const u64 other = shx64(best, o2, lane); best = other > best ? other : best; }
                    if (best != 0ull) { const int jw = 127 - (int)(best & 127ull);
                        mk[0] |= (jw < 32) ? (1u << (jw & 31)) : 0u; mk[1] |= (jw >= 32 && jw < 64) ? (1u << (jw & 31)) : 0u;
                        mk[2] |= (jw >= 64 && jw < 96) ? (1u << (jw & 31)) : 0u; mk[3] |= (jw >= 96) ? (1u << (jw & 31)) : 0u; }
#pragma unroll
                    for (int e = 0; e < 16; ++e) if (keys[e] == best) keys[e] = 0ull;
                }
            }
            if (prt == 0) { LAS unsigned* sm = (LAS unsigned*)(lds + L_SEL) + tok * 4; sm[0] = mk[0]; sm[1] = mk[1]; sm[2] = mk[2]; sm[3] = mk[3]; }
            __syncthreads();
        }
        u64 selLo, selHi;
        { const LAS unsigned* sm = (const LAS unsigned*)(lds + L_SEL) + tl * 4; selLo = (u64)sm[0] | ((u64)sm[1] << 32); selHi = (u64)sm[2] | ((u64)sm[3] << 32); }
        {
            TileSrc src{PROJ + (size_t)b * S_ * LDP + C_KS + g * 64, LDP, (const bf16_t*)(ws + WS_VTS) + (size_t)bg * 64 * S_, S_};
            float m = -__builtin_inff(), l = 0.f;
#pragma unroll
            for (int ds = 0; ds < 2; ++ds)
#pragma unroll
                for (int e = 0; e < 16; ++e) o[ds][e] = 0.f;
            u64 uLo = 0ull, uHi = 0ull;
            { const LAS unsigned* sm = (const LAS unsigned*)(lds + L_SEL) + 8 * wave * 4;
#pragma unroll
              for (int i = 0; i < 8; ++i) { uLo |= (u64)sm[4 * i] | ((u64)sm[4 * i + 1] << 32); uHi |= (u64)sm[4 * i + 2] | ((u64)sm[4 * i + 3] << 32); } }
            uLo = ((u64)(unsigned)__builtin_amdgcn_readfirstlane((int)(unsigned)(uLo >> 32)) << 32) | (unsigned)__builtin_amdgcn_readfirstlane((int)(unsigned)uLo);
            uHi = ((u64)(unsigned)__builtin_amdgcn_readfirstlane((int)(unsigned)(uHi >> 32)) << 32) | (unsigned)__builtin_amdgcn_readfirstlane((int)(unsigned)uHi);
            sel_direct((const unsigned char*)(ws + WS_KF) + (size_t)bg * 128 * 4096, (const unsigned char*)(ws + WS_VTS) + (size_t)bg * 128 * 4096, uLo, uHi, qf, o, m, l, tl, tb, selLo, selHi, lane);
            __syncthreads();
            l += shx(l, 32, lane);
            const float f = sigmoidf_(bf2f(PROJ[((size_t)b * S_ + t) * LDP + C_GN + g * 12 + r * 3 + 1])) / (sigmoidf_(bf2f(PROJ[((size_t)b * S_ + t) * LDP + C_GN + g * 12 + r * 3])) * fmaxf(l, 1e-30f));
#pragma unroll
            for (int ds = 0; ds < 2; ++ds)
#pragma unroll
                for (int e = 0; e < 16; ++e) OT[(ds * 16 + e) * 64] += f * o[ds][e];
        }
        {
            TileSrc src{PROJ + (size_t)b * S_ * LDP + C_KW + g * 64, LDP, (const bf16_t*)(ws + WS_VTW) + (size_t)bg * 64 * S_, S_};
            float m = -__builtin_inff(), l = 0.f;
#pragma unroll
            for (int ds = 0; ds < 2; ++ds)
#pragma unroll
                for (int e = 0; e < 16; ++e) o[ds][e] = 0.f;
            attn_loop<3>(lds, src, tb >= 8 ? tb - 8 : 0, tb, qf, o, m, l, tl, t, tb, 0ull, 0ull, tid, wave, lane);
            l += shx(l, 32, lane);
            const float f = sigmoidf_(bf2f(PROJ[((size_t)b * S_ + t) * LDP + C_GN + g * 12 + r * 3 + 2])) / (sigmoidf_(bf2f(PROJ[((size_t)b * S_ + t) * LDP + C_GN + g * 12 + r * 3])) * fmaxf(l, 1e-30f));
#pragma unroll
            for (int ds = 0; ds < 2; ++ds)
#pragma unroll
                for (int e = 0; e < 16; ++e) OT[(ds * 16 + e) * 64] += f * o[ds][e];
        }
        if (do_store) {
            int ln2 = lane; asm volatile("" : "+v"(ln2));
            const int n2 = ln2 & 31, h2 = ln2 >> 5, t2 = t0 + 8 * wave + (n2 >> 2), r2 = n2 & 3;
            bf16_t* rowp = PROJ + ((size_t)b * S_ + t2) * LDP;
            const float gcv = sigmoidf_(bf2f(rowp[C_GN + g * 12 + r2 * 3]));
            bf16_t* op = rowp + C_Q + (4 * g + r2) * 64 + 4 * h2;
#pragma unroll
            for (int ds = 0; ds < 2; ++ds)
#pragma unroll
                for (int gi = 0; gi < 4; ++gi) { const float* dummy = nullptr; (void)dummy; u32x2 w; w.x = pk2(gcv * OT[(ds * 16 + 4 * gi) * 64], gcv * OT[(ds * 16 + 4 * gi + 1) * 64]); w.y = pk2(gcv * OT[(ds * 16 + 4 * gi + 2) * 64], gcv * OT[(ds * 16 + 4 * gi + 3) * 64]);
                    *(u32x2*)(op + 32 * ds + 8 * gi) = w; }
        }
    }
}

__global__ void __launch_bounds__(512, 2) fwd_megakernel(Params p) {
    extern __shared__ __attribute__((aligned(16))) unsigned char lds_raw[];
    LAS unsigned char* lds = (LAS unsigned char*)lds_raw;
    cg::grid_group grid = cg::this_grid();
    const int G = gridDim.x, bx = blockIdx.x;
    PP pp = (PP)__builtin_amdgcn_kernarg_segment_ptr();
    volatile LAS unsigned* barst = (volatile LAS unsigned*)(lds + L_BARST);
    if (threadIdx.x == 0) { barst[0] = 0u; barst[1] = 0u; (void)xb_add((unsigned*)(pp->ws + WS_BAR) + XB_XCNT(xb_xcc_id()), 1u); }
    __syncthreads();
#define GSYNC() xcd_barrier((unsigned*)(ws + WS_BAR), barst)
#define ws (pp->ws)
#define PROJ ((bf16_t*)(ws + WS_PROJ))
#define H ((bf16_t*)(ws + WS_H))
#define XC ((bf16_t*)(ws + WS_XC))
#define Y ((float*)(ws + WS_RI))
    const int BIG = 1 << 30;

#ifndef NO_PREP
    prep_phase(pp, 0, lds);
#endif
#ifndef NO_ROW
    row_phase(pp->x, nullptr, nullptr, nullptr, pp->ln_mix_pre, H);
#endif
    grid.sync();

    for (int l = 0; l < NLAYER; ++l) {
        PPOPAQ();
        using pg8::Gemm; using pg8::Sched; using pg8::EpiBf16; using pg8::EpiF32; using pg8::EpiMerge;
#ifndef NO_G1
        for (int r_ = 0; r_ < opaque_s(GREP); ++r_) {
        pg8::gemm_phase<EpiBf16>(lds, Gemm{H, (const bf16_t*)(ws + WS_WIN), 1024, 1024, 1024, 128, 128},
            Sched{64, 35, opaque_s(G), opaque_s(bx), 0, BIG, 0u, 256u * 1024 * 2, 0u, 0u, 256u * 1024 * 2, 0u}, EpiBf16{PROJ, LDP, 0, 1.0f, nullptr, 0});
        pg8::gemm_phase<EpiBf16>(lds, Gemm{(const bf16_t*)(ws + WS_MEMN), (const bf16_t*)(ws + WS_WMKV), 1024, 1024, 1024, 128, 128},
            Sched{2, 4, opaque_s(G), (opaque_s(bx) + 64) % opaque_s(G), 0, BIG, 0u, 256u * 1024 * 2, 0u, 0u, 256u * 1024 * 2, 0u}, EpiBf16{(bf16_t*)(ws + WS_KMEM), 1024, 0, 1.0f, nullptr, 0});
        pg8::gemm_phase<EpiBf16>(lds, Gemm{(const bf16_t*)(ws + WS_WMKV) + (size_t)1024 * 1024, (const bf16_t*)(ws + WS_MEMN), 1024, 1024, 1024, 128, 128},
            Sched{4, 2, opaque_s(G), (opaque_s(bx) + 128) % opaque_s(G), 0, BIG, 0u, 256u * 1024 * 2, 0u, 0u, 256u * 1024 * 2, 0u}, EpiBf16{(bf16_t*)(ws + WS_VTMEM), 512, 0, 1.0f, nullptr, 0});
        }
#endif
        GSYNC();
#ifndef NO_POST
        postproj_phase(pp, l);
#endif
        GSYNC();
#ifndef NO_G1
        for (int r_ = 0; r_ < opaque_s(GREP); ++r_) {
        pg8::gemm_phase<EpiBf16>(lds, Gemm{XC, (const bf16_t*)(ws + WS_WLRU), 1024, 128, 128, 128, 128},
            Sched{64, 8, opaque_s(G), opaque_s(bx), 0, BIG, 0u, 256u * 1024 * 2, 128u * 2, 0u, 256u * 128 * 2, 0u}, EpiBf16{(bf16_t*)(ws + WS_RI), 2048, 0, 1.0f, nullptr, 0});
        pg8::gemm_phase<EpiBf16>(lds, Gemm{PROJ, (const bf16_t*)(ws + WS_WC1), 16 * LDP, 2048, 2048, LDP * 2, 128},
            Sched{32, 1, opaque_s(G), (opaque_s(bx) + 32) % opaque_s(G), 1, BIG, 0u, 0u, 0u, 0u, 0u, 0u}, EpiBf16{(bf16_t*)(ws + WS_HID), 256, 2, 1.0f, (const float*)(ws + WS_CBIAS), 0});
        pg8::gemm_phase<EpiBf16>(lds, Gemm{PROJ, (const bf16_t*)(ws + WS_KMEM), LDP, 1024, 256, 128, 128},
            Sched{64, 4, opaque_s(G), opaque_s(bx), 0, 32, (unsigned)C_QM * 2, 256u * LDP * 2, 256u * 2, 0u, 256u * 2, 256u * 1024 * 2}, EpiBf16{H, 1024, 0, 0.0625f * LOG2E, nullptr, 0});
        }
#endif
        GSYNC();
#ifndef NO_SCAN
        scan_phase(pp, l, 0);
#if defined(DUP_SCAN0)
        scan_phase(pp, l, 0);
#endif
#endif
#ifndef NO_MSM
        memsoftmax_phase(pp);
#endif
#ifndef NO_G2
        for (int r_ = 0; r_ < opaque_s(GREP); ++r_) {
        pg8::gemm_phase<EpiF32>(lds, Gemm{(const bf16_t*)(ws + WS_HID), (const bf16_t*)(ws + WS_WC2), 256, 256, 256, 128, 128},
            Sched{32, 1, opaque_s(G), (opaque_s(bx) + 96) % opaque_s(G), 0, 16, 0u, 256u * 256 * 2, 0u, 0u, 0u, 256u * 256 * 2}, EpiF32{(float*)(ws + WS_CRAW), 64, 64});
        }
#endif
        GSYNC();
#ifndef NO_SCAN
        scan_phase(pp, l, 1);
#endif
#ifndef NO_CMPF
        cmpfinal_phase(pp);
#endif
#ifndef NO_G1
        for (int r_ = 0; r_ < opaque_s(GREP); ++r_) {
        pg8::gemm_phase<EpiBf16>(lds, Gemm{H, (const bf16_t*)(ws + WS_VTMEM), 1024, 512, 256, 128, 128},
            Sched{64, 4, opaque_s(G), opaque_s(bx), 0, 32, 0u, 256u * 1024 * 2, 256u * 2, 0u, 256u * 512 * 2, 256u * 2}, EpiBf16{PROJ, LDP, 0, 1.0f, nullptr, C_QM});
        }
#endif
        GSYNC();
#ifndef NO_ATT
#if defined(DUP_ATT)
        attn_phase(pp, lds, opaque_s(0) != 0);
        __syncthreads();
#endif
        attn_phase(pp, lds, true);
#endif
        GSYNC();
#ifndef NO_G3
        for (int r_ = 0; r_ < opaque_s(GREP); ++r_) {
        pg8::gemm_phase<EpiMerge>(lds, Gemm{XC, (const bf16_t*)(ws + WS_WBRA), 1024, 1024, 1024, 128, 128},
            Sched{64, 4, opaque_s(G), opaque_s(bx), 0, BIG, 0u, 256u * 1024 * 2, 0u, 0u, 256u * 1024 * 2, 0u}, EpiMerge{PROJ + C_GM, LDP, Y, H, 0});
        pg8::gemm_phase<EpiMerge>(lds, Gemm{PROJ + C_Q, (const bf16_t*)(ws + WS_WBRB), LDP, 1024, 1024, 128, 128},
            Sched{64, 4, opaque_s(G), opaque_s(bx), 0, BIG, 0u, 256u * LDP * 2, 0u, 0u, 256u * 1024 * 2, 0u}, EpiMerge{PROJ + C_GM + 1024, LDP, Y, H, 1});
        pg8::gemm_phase<EpiMerge>(lds, Gemm{PROJ + C_QM, (const bf16_t*)(ws + WS_WBRC), LDP, 1024, 1024, 128, 128},
            Sched{64, 4, opaque_s(G), opaque_s(bx), 0, BIG, 0u, 256u * LDP * 2, 0u, 0u, 256u * 1024 * 2, 0u}, EpiMerge{PROJ + C_GM + 2048, LDP, Y, H, 2});
        }
#endif
        GSYNC();
#ifndef NO_G2
        for (int r_ = 0; r_ < opaque_s(GREP); ++r_) {
        pg8::gemm_phase<EpiF32>(lds, Gemm{H, (const bf16_t*)(ws + WS_WOUT), 1024, 1024, 1024, 128, 128},
            Sched{64, 4, opaque_s(G), opaque_s(bx), 0, BIG, 0u, 256u * 1024 * 2, 0u, 0u, 256u * 1024 * 2, 0u}, EpiF32{Y, 1024, 1024});
        }
#endif
        GSYNC();
#ifndef NO_ROW
        row_phase((l == 0) ? pp->x : pp->out, Y, pp->ln_mix_post + (size_t)l * 1024, pp->out, pp->ln_mlp_pre + (size_t)l * 1024, H);
#endif
        GSYNC();
#ifndef NO_G1
        for (int r_ = 0; r_ < opaque_s(GREP); ++r_) {
        pg8::gemm_phase<EpiBf16>(lds, Gemm{H, (const bf16_t*)(ws + WS_WM1), 1024, 1024, 1024, 128, 128},
            Sched{64, 16, opaque_s(G), opaque_s(bx), 0, BIG, 0u, 256u * 1024 * 2, 0u, 0u, 256u * 1024 * 2, 0u}, EpiBf16{PROJ, FF_, 1, 1.0f, nullptr, 0});
        }
#endif
        GSYNC();
#ifndef NO_G2
        for (int r_ = 0; r_ < opaque_s(GREP); ++r_) {
        pg8::gemm_phase<EpiF32>(lds, Gemm{PROJ, (const bf16_t*)(ws + WS_WM2), FF_, FF_, FF_, 128, 128},
            Sched{64, 4, opaque_s(G), opaque_s(bx), 0, BIG, 0u, 256u * FF_ * 2, 0u, 0u, 256u * FF_ * 2, 0u}, EpiF32{Y, 1024, 1024});
        }
#endif
        GSYNC();
#ifndef NO_ROW
        row_phase(pp->out, Y, pp->ln_mlp_post + (size_t)l * 1024, pp->out, (l + 1 < NLAYER) ? pp->ln_mix_pre + (size_t)(l + 1) * 1024 : nullptr, (l + 1 < NLAYER) ? H : nullptr);
#endif
#ifndef NO_PREP
        if (l + 1 < NLAYER) prep_phase(pp, l + 1, lds);
#if defined(DUP_PREP)
        if (l + 1 < NLAYER) prep_phase(pp, l + 1, lds);
#endif
#endif
        GSYNC();
    }
#undef ws
#undef PROJ
#undef H
#undef XC
#undef Y
}

extern "C" void kernel_launch(void* const* d_in, const int* in_sizes, int n_in, void* d_out, int out_size, void* d_ws, size_t ws_size, hipStream_t stream) {
    static int grid = 0;
    if (grid == 0) {
        int dev = 0, cus = 0, per_cu = 0;
        hipGetDevice(&dev); hipDeviceGetAttribute(&cus, hipDeviceAttributeMultiprocessorCount, dev);
        hipFuncSetAttribute((const void*)fwd_megakernel, hipFuncAttributeMaxDynamicSharedMemorySize, LDS_BYTES);
        hipOccupancyMaxActiveBlocksPerMultiprocessor(&per_cu, (const void*)fwd_megakernel, 512, LDS_BYTES);
        if (per_cu < 1) per_cu = 1;
        (void)hipGetLastError();
        grid = cus * 1;
        if (ws_size < WS_END) { fprintf(stderr, "kernel_launch: workspace too small (%zu < %zu)\n", ws_size, (size_t)WS_END); grid = -1; }
    }
    if (grid < 0) return;
    Params p{};
    p.x = (const float*)d_in[0]; p.mem = (const float*)d_in[1]; p.pos = (const int*)d_in[2];
    p.ln_mix_pre = (const float*)d_in[3]; p.w_in = (const float*)d_in[4]; p.conv_w = (const float*)d_in[5]; p.conv_b = (const float*)d_in[6];
    p.lru_wr = (const float*)d_in[7]; p.lru_br = (const float*)d_in[8]; p.lru_wi = (const float*)d_in[9]; p.lru_bi = (const float*)d_in[10]; p.lru_lambda = (const float*)d_in[11];
    p.cmp_pe = (const float*)d_in[12]; p.cmp_w1 = (const float*)d_in[13]; p.cmp_b1 = (const float*)d_in[14]; p.cmp_w2 = (const float*)d_in[15];
    p.ln_mem = (const float*)d_in[16]; p.w_mem_kv = (const float*)d_in[17]; p.w_br_rnn = (const float*)d_in[18]; p.w_br_nsa = (const float*)d_in[19]; p.w_br_mem = (const float*)d_in[20]; p.w_out = (const float*)d_in[21];
    p.ln_mix_post = (const float*)d_in[22]; p.ln_mlp_pre = (const float*)d_in[23]; p.mlp_w1 = (const float*)d_in[24]; p.mlp_w2 = (const float*)d_in[25]; p.ln_mlp_post = (const float*)d_in[26];
    p.out = (float*)d_out; p.ws = (unsigned char*)d_ws;
    (void)hipMemsetAsync((unsigned char*)d_ws + WS_BAR, 0, 16384, stream);
    void* args[] = {&p};
    hipError_t e = hipLaunchCooperativeKernel((const void*)fwd_megakernel, dim3(grid), dim3(512), args, LDS_BYTES, stream);
    if (e != hipSuccess) fprintf(stderr, "cooperative launch failed: %s (grid %d)\n", hipGetErrorString(e), grid);
}
```

```cpp
#include <hip/hip_runtime.h>
#include <hip/hip_cooperative_groups.h>
#include <cstdint>
#include <cstdio>
namespace cg = cooperative_groups;

#define LAS __attribute__((address_space(3)))
#define DI __device__ __forceinline__
typedef unsigned short bf16_t;
typedef short bf16x8 __attribute__((ext_vector_type(8)));
typedef short s16x4 __attribute__((ext_vector_type(4)));
typedef float f32x4 __attribute__((ext_vector_type(4)));
typedef float f32x16 __attribute__((ext_vector_type(16)));
typedef float f32x2 __attribute__((ext_vector_type(2)));
typedef unsigned u32x4 __attribute__((ext_vector_type(4)));
typedef unsigned u32x2 __attribute__((ext_vector_type(2)));
typedef __bf16 bf16x2v __attribute__((ext_vector_type(2)));
typedef unsigned long long u64;

constexpr int T_ = 16384, S_ = 8192, D_ = 1024, FF_ = 4096, LDP = 8960, NLAYER = 4;
constexpr int C_XR = 0, C_YR = 1024, C_Q = 2048, C_KC = 3072, C_VC = 3328, C_KS = 3584, C_VS = 3840, C_KW = 4096, C_VW = 4352,
              C_QM = 4608, C_GM = 5632, C_GN = 8704;
constexpr float EPS = 1e-6f;
constexpr float LOG2E = 1.4426950408889634f;

constexpr size_t al256(size_t x) { return (x + 255) & ~(size_t)255; }
constexpr size_t WS_PROJ = 0;
constexpr size_t WS_WIN = al256(WS_PROJ + (size_t)(T_ + 64) * LDP * 2);
constexpr size_t WS_WMKV = WS_WIN + (size_t)LDP * 1024 * 2;
constexpr size_t WS_WBRA = WS_WMKV + (size_t)2048 * 1024 * 2;
constexpr size_t WS_WBRB = WS_WBRA + (size_t)1024 * 1024 * 2;
constexpr size_t WS_WBRC = WS_WBRB + (size_t)1024 * 1024 * 2;
constexpr size_t WS_WOUT = WS_WBRC + (size_t)1024 * 1024 * 2;
constexpr size_t WS_WM1 = WS_WOUT + (size_t)1024 * 1024 * 2;
constexpr size_t WS_WM2 = WS_WM1 + (size_t)4096 * 1024 * 2;
constexpr size_t WS_WC1 = WS_WM2 + (size_t)4096 * 1024 * 2;
constexpr size_t WS_WC2 = WS_WC1 + (size_t)2 * 256 * 2048 * 2;
constexpr size_t WS_WLRU = WS_WC2 + (size_t)2 * 256 * 256 * 2;
constexpr size_t WS_H = WS_WLRU + (size_t)2048 * 128 * 2;
constexpr size_t WS_VTS = WS_H + (size_t)T_ * 1024 * 2;
constexpr size_t WS_VTW = WS_VTS + (size_t)8 * 64 * S_ * 2;
constexpr size_t WS_XC = WS_VTW + (size_t)8 * 64 * S_ * 2;
constexpr size_t WS_RI = WS_XC + (size_t)T_ * 1024 * 2;
constexpr size_t WS_HID = WS_RI + (size_t)T_ * 2048 * 2;
constexpr size_t WS_CRAW = WS_HID + (size_t)8192 * 256 * 2;
constexpr size_t WS_KCMP = WS_CRAW + (size_t)8192 * 64 * 4;
constexpr size_t WS_VTCMP = WS_KCMP + (size_t)8 * 512 * 64 * 2;
constexpr size_t WS_MEMN = WS_VTCMP + (size_t)8 * 512 * 64 * 2;
constexpr size_t WS_KMEM = WS_MEMN + (size_t)512 * 1024 * 2;
constexpr size_t WS_VTMEM = WS_KMEM + (size_t)512 * 1024 * 2;
constexpr size_t WS_SCA = WS_VTMEM + (size_t)512 * 1024 * 2;
constexpr size_t WS_SCH = WS_SCA + (size_t)2 * 128 * 1024 * 4;
constexpr size_t WS_CBP = WS_SCH + (size_t)2 * 128 * 1024 * 4;
constexpr size_t WS_CBIAS = WS_CBP + (size_t)16 * 512 * 4;
constexpr size_t WS_KF = al256(WS_CBIAS + 512 * 4);
constexpr size_t WS_BAR = WS_KF + (size_t)8 * 64 * S_ * 2;
constexpr size_t WS_END = WS_BAR + 16384;
constexpr int L_BARST = 155584;

#ifndef GREP
#define GREP 1
#endif
constexpr int LDS_BYTES = 155648;

DI unsigned f2bf(float f) { unsigned u = __builtin_bit_cast(unsigned, f); return (u + 0x7fffu + ((u >> 16) & 1u)) >> 16; }
DI unsigned pk2(float lo, float hi) { f32x2 f = {lo, hi}; bf16x2v r = __builtin_convertvector(f, bf16x2v); return __builtin_bit_cast(unsigned, r); }
DI float bf2f(unsigned short b) { return __builtin_bit_cast(float, (unsigned)b << 16); }
DI float bflo(unsigned w) { return __builtin_bit_cast(float, w << 16); }
DI float bfhi(unsigned w) { return __builtin_bit_cast(float, w & 0xffff0000u); }
DI float fexp2(float x) { return __builtin_amdgcn_exp2f(x); }
DI float sigmoidf_(float x) { return 1.0f / (1.0f + fexp2(-x * LOG2E)); }
DI float gelu_tanh(float x) { const float z = 0.7978845608028654f * (x + 0.044715f * x * x * x); return x / (1.0f + fexp2(-2.0f * LOG2E * z)); }
DI float shx(float v, int mask, int lane) { return __builtin_bit_cast(float, __builtin_amdgcn_ds_bpermute((lane ^ mask) << 2, __builtin_bit_cast(int, v))); }
DI u64 shx64(u64 v, int mask, int lane) { const int a = (lane ^ mask) << 2; const unsigned lo = (unsigned)__builtin_amdgcn_ds_bpermute(a, (int)(unsigned)v), hi = (unsigned)__builtin_amdgcn_ds_bpermute(a, (int)(unsigned)(v >> 32)); return ((u64)hi << 32) | lo; }
DI unsigned pk4_fp8(float a, float b, float c, float d) { int w = 0; w = __builtin_amdgcn_cvt_pk_fp8_f32(a, b, w, false); w = __builtin_amdgcn_cvt_pk_fp8_f32(c, d, w, true); return (unsigned)w; }
DI long mk64(unsigned lo, unsigned hi) { return (long)(((u64)hi << 32) | (u64)lo); }
DI int opaque_s(int v) { asm volatile("" : "+s"(v)); return v; }
DI float wave_sum(float v, int lane) {
#pragma unroll
    for (int o = 1; o < 64; o <<= 1) v += shx(v, o, lane);
    return v;
}

namespace pg8 {
constexpr int BM = 256, BK = 64, HALF = 128, HTB = HALF * BK * 2, STAGE_BYTES = 8 * HTB, NXCD = 8, WGM = 8;
__host__ __device__ __forceinline__ int lds_byte(int r, int c) { const int st = (r >> 4) * 2 + (c >> 5), rr = r & 15, cc = c & 31, ob = rr * 64 + cc * 2; return st * 1024 + (ob ^ (((ob >> 9) & 1) << 5)); }
__host__ __device__ __forceinline__ void stage_rc(int b, int& R, int& C) { const int st = b / 1024, sb = b % 1024, swz = sb ^ (((sb >> 9) & 1) << 5); R = (st >> 1) * 16 + swz / 64; C = (st & 1) * 32 + (swz % 64) / 2; }
__host__ __device__ __forceinline__ int perm32(int rho) { const int n = rho >> 4, i = rho & 15; return 8 * (i >> 2) + 4 * n + (i & 3); }

struct Unit { int pm, pn; unsigned aoff, boff; };
struct Gemm { const bf16_t* A; const bf16_t* Bt; int lda, ldb, K, kstepA, kstepB; };

struct Sched {
    int nM, nN, G, c, kind, mdiv; unsigned a0, sAm, sAn, b0, sBn, sBb;
    DI bool next(int i, Unit& u) const {
        const long L = (long)i * G + c; const int nwg = nM * nN; if (L >= nwg) return false;
        int wgid = (int)L; { const int q = nwg / NXCD, r = nwg % NXCD, xcd = wgid % NXCD, off = wgid / NXCD; wgid = (xcd < r ? xcd * (q + 1) : r * (q + 1) + (xcd - r) * q) + off; }
        const int nig = WGM * nN, gid = wgid / nig, fm = gid * WGM, gsz = (nM - fm) < WGM ? (nM - fm) : WGM;
        const int pm = fm + ((wgid % nig) % gsz), pn = (wgid % nig) / gsz;
        u.pm = pm; u.pn = pn;
        if (kind == 1) {
            const int j = pm >> 4, b = (pm >> 3) & 1, g = (pm >> 1) & 3, ch = pm & 1;
            u.aoff = (unsigned)(((b * S_ + ch * 4096) * LDP + C_KC + j * 256 + g * 64) * 2); u.boff = (unsigned)(j * 256 * 2048 * 2);
        } else { const unsigned bb = (unsigned)(pm / mdiv); u.aoff = a0 + (unsigned)pm * sAm + (unsigned)pn * sAn; u.boff = b0 + (unsigned)pn * sBn + bb * sBb; }
        return true;
    }
};

DI unsigned cvt_pk_bf16(float lo, float hi) { return pk2(lo, hi); }

struct EpiBf16 {
    static constexpr bool PERM = true;
    bf16_t* O; int ldc; int act; float scale; const float* bias; int oc0;
    DI void operator()(const f32x4 (&acc)[2][2][4][2], const Unit& u, int wr, int wc, int fr, int fq) const {
        const int row0 = u.pm * 256 + wr * 64 + fr, col0 = oc0 + u.pn * 256 + wc * 32 + 8 * fq, bc0 = (u.pm >> 4) * 256 + wc * 32 + 8 * fq;
#pragma unroll
        for (int ai = 0; ai < 2; ++ai)
#pragma unroll
            for (int m = 0; m < 4; ++m) { bf16_t* rowp = O + (size_t)(row0 + ai * HALF + m * 16) * ldc + col0;
#pragma unroll
                for (int bj = 0; bj < 2; ++bj) { f32x4 v0 = acc[ai][bj][m][0], v1 = acc[ai][bj][m][1];
                    if (act == 0) { v0 = v0 * scale; v1 = v1 * scale; }
                    else if (act == 1) {
#pragma unroll
                        for (int e = 0; e < 4; ++e) { const float a = fmaxf(v0[e], 0.f), b = fmaxf(v1[e], 0.f); v0[e] = a * a; v1[e] = b * b; } }
                    else { const f32x4 b0 = *(const f32x4*)(bias + bc0 + bj * HALF), b1 = *(const f32x4*)(bias + bc0 + bj * HALF + 4);
#pragma unroll
                        for (int e = 0; e < 4; ++e) { v0[e] = gelu_tanh(v0[e] + b0[e]); v1[e] = gelu_tanh(v1[e] + b1[e]); } }
                    u32x4 w; w.x = cvt_pk_bf16(v0[0], v0[1]); w.y = cvt_pk_bf16(v0[2], v0[3]); w.z = cvt_pk_bf16(v1[0], v1[1]); w.w = cvt_pk_bf16(v1[2], v1[3]);
                    *(u32x4*)(rowp + bj * HALF) = w; } }
    }
};
struct EpiF32 {
    static constexpr bool PERM = false;
    float* O; int ldc; int ncol;
    DI void operator()(const f32x4 (&acc)[2][2][4][2], const Unit& u, int wr, int wc, int fr, int fq) const {
        const int row0 = u.pm * 256 + wr * 64 + fr, col0 = u.pn * 256 + wc * 32 + 4 * fq;
#pragma unroll
        for (int ai = 0; ai < 2; ++ai)
#pragma unroll
            for (int m = 0; m < 4; ++m) { float* rowp = O + (size_t)(row0 + ai * HALF + m * 16) * ldc;
#pragma unroll
                for (int bj = 0; bj < 2; ++bj)
#pragma unroll
                    for (int n = 0; n < 2; ++n) { const int c = col0 + bj * HALF + n * 16; if (c < ncol) *(f32x4*)(rowp + c) = acc[ai][bj][m][n]; } }
    }
};
struct EpiMerge {
    static constexpr bool PERM = false;
    const bf16_t* gate; int ldg; float* M; bf16_t* Hout; int mode;
    DI void operator()(const f32x4 (&acc)[2][2][4][2], const Unit& u, int wr, int wc, int fr, int fq) const {
        const int row0 = u.pm * 256 + wr * 64 + fr, col0 = u.pn * 256 + wc * 32 + 4 * fq;
#pragma unroll
        for (int ai = 0; ai < 2; ++ai)
#pragma unroll
            for (int m = 0; m < 4; ++m) { const size_t r = (size_t)(row0 + ai * HALF + m * 16);
#pragma unroll
                for (int bj = 0; bj < 2; ++bj)
#pragma unroll
                    for (int n = 0; n < 2; ++n) { const int c = col0 + bj * HALF + n * 16;
                        const u32x2 gw = *(const u32x2*)(gate + r * ldg + c);
                        f32x4 g; g[0] = sigmoidf_(bflo(gw.x)); g[1] = sigmoidf_(bfhi(gw.x)); g[2] = sigmoidf_(bflo(gw.y)); g[3] = sigmoidf_(bfhi(gw.y));
                        f32x4 v = acc[ai][bj][m][n] * g;
                        float* mp = M + r * 1024 + c;
                        if (mode != 0) v = v + *(const f32x4*)mp;
                        if (mode != 2) *(f32x4*)mp = v;
                        else { u32x2 w; w.x = cvt_pk_bf16(v[0], v[1]); w.y = cvt_pk_bf16(v[2], v[3]); *(u32x2*)(Hout + r * 1024 + c) = w; } } }
    }
};

template <class Epi>
DI void gemm_phase(LAS unsigned char* lds, const Gemm g, const Sched& S, const Epi& E) {
    int tid = threadIdx.x; asm volatile("" : "+v"(tid));
    const int wid = __builtin_amdgcn_readfirstlane(tid >> 6), lane = tid & 63, wr = wid >> 2, wc = wid & 3, fr = lane & 15, fq = lane >> 4;
    const int nt = opaque_s(g.K / BK);
    unsigned voffA[2], voffB[2];
#pragma unroll
    for (int i = 0; i < 2; ++i) { int R, C; stage_rc(tid * 16 + i * 8192, R, C); const int Rb = Epi::PERM ? ((R & ~31) + perm32(R & 31)) : R;
        voffA[i] = (unsigned)(R * g.lda + C) * 2u; voffB[i] = (unsigned)(Rb * g.ldb + C) * 2u; }
    const size_t kstepA = (size_t)g.kstepA, kstepB = (size_t)g.kstepB;
    const size_t hstepA = (size_t)HALF * g.lda * 2, hstepB = (size_t)HALF * g.ldb * 2;
    const unsigned ldsw = (unsigned)wid * 1024u;
    const int aoff = lds_byte(wr * 64 + fr, fq * 8), boff = lds_byte(wc * 32 + fr, fq * 8);
#define PG8_SA(b, h) (((b) * 2 + (h)) * HTB)
#define PG8_SB(b, h) ((4 + (b) * 2 + (h)) * HTB)
#define PG8_STAGE(bufoff, gbase, voff) do { _Pragma("unroll") for (int _i = 0; _i < 2; ++_i) \
        __builtin_amdgcn_global_load_lds((const unsigned*)((const char*)(gbase) + (voff)[_i]), (LAS unsigned*)(lds + (bufoff) + ldsw + _i * 8192), 16, 0, 0); } while (0)
#define PG8_LDA(dst, b, h) do { _Pragma("unroll") for (int m = 0; m < 4; ++m) _Pragma("unroll") for (int k = 0; k < 2; ++k) dst[m][k] = *(const LAS bf16x8*)(lds + PG8_SA(b, h) + aoff + m * 2048 + k * 1024); } while (0)
#define PG8_LDB(dst, b, h) do { _Pragma("unroll") for (int n = 0; n < 2; ++n) _Pragma("unroll") for (int k = 0; k < 2; ++k) dst[n][k] = *(const LAS bf16x8*)(lds + PG8_SB(b, h) + boff + n * 2048 + k * 1024); } while (0)
#define PG8_MMA(ai, bj, At, Bt) do { __builtin_amdgcn_s_setprio(1); _Pragma("unroll") for (int m = 0; m < 4; ++m) _Pragma("unroll") for (int n = 0; n < 2; ++n) _Pragma("unroll") for (int k = 0; k < 2; ++k) \
        acc[ai][bj][m][n] = __builtin_amdgcn_mfma_f32_16x16x32_bf16(Bt[n][k], At[m][k], acc[ai][bj][m][n], 0, 0, 0); __builtin_amdgcn_s_setprio(0); } while (0)
#define PG8_WAIT_V(n) asm volatile("s_waitcnt vmcnt(" #n ")" ::: "memory")
#define PG8_WAIT_L(n) asm volatile("s_waitcnt lgkmcnt(" #n ")" ::: "memory")
#define PG8_BAR __builtin_amdgcn_s_barrier()
#define PG8_SCHED __builtin_amdgcn_sched_barrier(0)
    Unit cur, nxt; int ui = 0;
    if (!S.next(0, cur)) return;
    f32x4 acc[2][2][4][2];
#pragma unroll
    for (int a = 0; a < 2; ++a)
#pragma unroll
        for (int b = 0; b < 2; ++b)
#pragma unroll
            for (int m = 0; m < 4; ++m)
#pragma unroll
                for (int n = 0; n < 2; ++n) acc[a][b][m][n] = (f32x4){0.f, 0.f, 0.f, 0.f};
    bf16x8 At[4][2], B0[2][2], B1[2][2];
    const char* cA = (const char*)g.A + cur.aoff; const char* cB = (const char*)g.Bt + cur.boff;
    PG8_STAGE(PG8_SB(0, 0), cB, voffB); PG8_STAGE(PG8_SB(0, 1), cB + hstepB, voffB); PG8_STAGE(PG8_SA(0, 0), cA, voffA); PG8_STAGE(PG8_SA(0, 1), cA + hstepA, voffA);
    if (wr == 1) PG8_BAR;
    PG8_WAIT_V(2); PG8_BAR;
    PG8_STAGE(PG8_SB(1, 0), cB + kstepB, voffB); PG8_STAGE(PG8_SA(1, 0), cA + kstepA, voffA); PG8_STAGE(PG8_SB(1, 1), cB + hstepB + kstepB, voffB);
    PG8_WAIT_V(6); PG8_BAR;
    for (;;) {
        const bool has_next = S.next(ui + 1, nxt);
        const char* nA = has_next ? (const char*)g.A + nxt.aoff : cA; const char* nB = has_next ? (const char*)g.Bt + nxt.boff : cB;
        for (int t = 0; t < nt; t += 2) {
            const bool last = (t == nt - 2);
            const char* a1 = cA + (size_t)(t + 1) * kstepA;
            const char* a2 = last ? nA : cA + (size_t)(t + 2) * kstepA; const char* b2 = last ? nB : cB + (size_t)(t + 2) * kstepB;
            const char* a3 = a2 + kstepA; const char* b3 = b2 + kstepB;
            PG8_LDB(B0, 0, 0); PG8_LDB(B1, 0, 1); PG8_SCHED; PG8_LDA(At, 0, 0); PG8_STAGE(PG8_SA(1, 1), a1 + hstepA, voffA);
            PG8_WAIT_V(8); PG8_WAIT_L(0); PG8_BAR; PG8_MMA(0, 0, At, B0); PG8_MMA(0, 1, At, B1); PG8_BAR; PG8_SCHED;
            PG8_LDA(At, 0, 1); PG8_STAGE(PG8_SB(0, 0), b2, voffB); PG8_STAGE(PG8_SB(0, 1), b2 + hstepB, voffB); PG8_STAGE(PG8_SA(0, 0), a2, voffA);
            PG8_WAIT_V(8); PG8_WAIT_L(0); PG8_BAR; PG8_MMA(1, 0, At, B0); PG8_MMA(1, 1, At, B1); PG8_BAR; PG8_SCHED;
            PG8_LDB(B0, 1, 0); PG8_LDB(B1, 1, 1); PG8_SCHED; PG8_LDA(At, 1, 0); PG8_STAGE(PG8_SA(0, 1), a2 + hstepA, voffA);
            PG8_WAIT_V(8); PG8_WAIT_L(0); PG8_BAR; PG8_MMA(0, 0, At, B0); PG8_MMA(0, 1, At, B1); PG8_BAR; PG8_SCHED;
            PG8_LDA(At, 1, 1); PG8_STAGE(PG8_SB(1, 0), b3, voffB); PG8_STAGE(PG8_SB(1, 1), b3 + hstepB, voffB); PG8_STAGE(PG8_SA(1, 0), a3, voffA);
            PG8_WAIT_V(8); PG8_WAIT_L(0); PG8_BAR; PG8_MMA(1, 0, At, B0); PG8_MMA(1, 1, At, B1); PG8_BAR; PG8_SCHED;
        }
        if (wr == 0) PG8_BAR;
        E(acc, cur, wr, wc, fr, fq);
        if (!has_next) break;
#pragma unroll
        for (int a = 0; a < 2; ++a)
#pragma unroll
            for (int b = 0; b < 2; ++b)
#pragma unroll
                for (int m = 0; m < 4; ++m)
#pragma unroll
                    for (int n = 0; n < 2; ++n) acc[a][b][m][n] = (f32x4){0.f, 0.f, 0.f, 0.f};
        cur = nxt; cA = nA; cB = nB; ++ui;
        if (wr == 1) PG8_BAR;
    }
    PG8_WAIT_V(0);
    PG8_BAR;
#undef PG8_SA
#undef PG8_SB
#undef PG8_STAGE
#undef PG8_LDA
#undef PG8_LDB
#undef PG8_MMA
#undef PG8_WAIT_V
#undef PG8_WAIT_L
#undef PG8_BAR
#undef PG8_SCHED
}
}


#define XB_TMO      128
#define XB_XCNT(j)  (256  + 64 * (j))
#define XB_XSUB(j)  (1280 + 64 * (j))
#define XB_XGEN(j)  (2304 + 64 * (j))
#define XB_TOP      3328
#define XB_TOPGEN   3392
#define XCD_BAR_WORDS 3456
#define XB_SPIN_CAP (1u << 22)
DI unsigned xb_ld(unsigned* p)              { return __hip_atomic_load(p, __ATOMIC_RELAXED, __HIP_MEMORY_SCOPE_AGENT); }
DI unsigned xb_add(unsigned* p, unsigned v) { return __hip_atomic_fetch_add(p, v, __ATOMIC_RELAXED, __HIP_MEMORY_SCOPE_AGENT); }
DI unsigned xb_xcc_id() { return (unsigned)__builtin_amdgcn_s_getreg((3 << 11) | 20) & 0xFu; }
#define XB_SPIN(cond, bar) do { unsigned _sp = 0; while (cond) { __builtin_amdgcn_s_sleep(1); \
    if ((++_sp & 255u) == 0u) { if (xb_ld(&(bar)[XB_TMO])) break; if (_sp > XB_SPIN_CAP) { atomicAdd(&(bar)[XB_TMO], 1u); break; } } } } while (0)
DI void xcd_barrier_complete(unsigned* bar, unsigned x, unsigned& nloc, unsigned& nx) {
    const unsigned G = gridDim.x * gridDim.y * gridDim.z;
    unsigned sum, cnt, mine, sp = 0u;
    for (;;) {
        sum = 0u; cnt = 0u; mine = 0u;
#pragma unroll
        for (unsigned j = 0; j < 16; ++j) { const unsigned c = xb_ld(&bar[XB_XCNT(j)]); sum += c; cnt += (c > 0u) ? 1u : 0u; mine = (j == x) ? c : mine; }
        if (sum == G) break;
        __builtin_amdgcn_s_sleep(1);
        if ((++sp & 255u) == 0u) { if (xb_ld(&bar[XB_TMO])) break; if (sp > XB_SPIN_CAP) { atomicAdd(&bar[XB_TMO], 1u); break; } }
    }
    nloc = mine > 0u ? mine : 1u; nx = cnt > 0u ? cnt : 1u;
}
DI void xcd_barrier(unsigned* bar, volatile LAS unsigned* st) {
    asm volatile("s_waitcnt vmcnt(0)" ::: "memory");
    __syncthreads();
    if (threadIdx.x == 0) {
        __builtin_amdgcn_s_waitcnt(0);
        const unsigned x = xb_xcc_id();
        unsigned nloc = st[0], nx = st[1];
        if (nloc == 0u) { xcd_barrier_complete(bar, x, nloc, nx); st[0] = nloc; st[1] = nx; }
        const unsigned old = xb_add(&bar[XB_XSUB(x)], 1u);
        const unsigned gen = old / nloc;
        if (old + 1u == (gen + 1u) * nloc) {
            __builtin_amdgcn_fence(__ATOMIC_RELEASE, "agent");
            asm volatile("s_waitcnt vmcnt(0)" ::: "memory");
            const unsigned og = xb_add(&bar[XB_TOP], 1u);
            const unsigned tg = og / nx;
            if (og + 1u == (tg + 1u) * nx) xb_add(&bar[XB_TOPGEN], 1u);
            else XB_SPIN(xb_ld(&bar[XB_TOPGEN]) == tg, bar);
            __builtin_amdgcn_fence(__ATOMIC_ACQUIRE, "agent");
            xb_add(&bar[XB_XGEN(x)], 1u);
            asm volatile("s_waitcnt vmcnt(0)" ::: "memory");
        } else {
            XB_SPIN(xb_ld(&bar[XB_XGEN(x)]) == gen, bar);
            __builtin_amdgcn_fence(__ATOMIC_ACQUIRE, "agent");
            asm volatile("s_waitcnt vmcnt(0)" ::: "memory");
        }
    }
    __syncthreads();
}

struct Params {
    const float* x; const float* mem; const int* pos;
    const float* ln_mix_pre; const float* w_in; const float* conv_w; const float* conv_b;
    const float* lru_wr; const float* lru_br; const float* lru_wi; const float* lru_bi; const float* lru_lambda;
    const float* cmp_pe; const float* cmp_w1; const float* cmp_b1; const float* cmp_w2;
    const float* ln_mem; const float* w_mem_kv; const float* w_br_rnn; const float* w_br_nsa; const float* w_br_mem; const float* w_out;
    const float* ln_mix_post; const float* ln_mlp_pre; const float* mlp_w1; const float* mlp_w2; const float* ln_mlp_post;
    float* out; unsigned char* ws;
};
typedef const __attribute__((address_space(4))) Params* PP;
#define PPOPAQ() asm volatile("" : "+s"(pp))

DI void tr_item(const float* W, int ldw, int srccol, int valid, int k0, bf16_t* WT, int ldt, int drow0, LAS float* scr, int lane) {
    const int c32 = lane & 31;
    float vv[32];
    const float* wp = W + (size_t)(k0 + (lane >> 5)) * ldw + srccol + (c32 < valid ? c32 : 0);
#pragma unroll
    for (int i = 0; i < 32; ++i) vv[i] = wp[(size_t)(2 * i) * ldw];
#pragma unroll
    for (int i = 0; i < 32; ++i) scr[(2 * i + (lane >> 5)) * 33 + c32] = (c32 < valid) ? vv[i] : 0.f;
    __builtin_amdgcn_s_waitcnt(0xc07f); asm volatile("s_waitcnt lgkmcnt(0)" ::: "memory");
    const int c = lane & 7;
#pragma unroll
    for (int j = 0; j < 4; ++j) { const int n = (lane >> 3) + 8 * j; const LAS float* s = scr + (8 * c) * 33 + n;
        u32x4 o; o.x = pk2(s[0 * 33], s[1 * 33]); o.y = pk2(s[2 * 33], s[3 * 33]); o.z = pk2(s[4 * 33], s[5 * 33]); o.w = pk2(s[6 * 33], s[7 * 33]);
        *(u32x4*)(WT + (size_t)(drow0 + n) * ldt + k0 + 8 * c) = o; }
    asm volatile("s_waitcnt lgkmcnt(0)" ::: "memory");
}

DI void prep_phase(PP pp, int l, LAS unsigned char* lds) {
    PPOPAQ();
    int tid = threadIdx.x; asm volatile("" : "+v"(tid));
    const int lane = tid & 63, wave = __builtin_amdgcn_readfirstlane(tid >> 6);
    const int G_ = opaque_s((int)gridDim.x), bx_ = opaque_s((int)blockIdx.x);
    const int gw = bx_ * 8 + wave, NGW = G_ * 8, gtid = bx_ * 512 + tid, NT = G_ * 512;
    (void)lane; (void)wave; (void)gw; (void)NGW; (void)gtid; (void)NT;
    LAS float* scr = (LAS float*)(lds + wave * 8704);
    unsigned char* ws = pp->ws;
    const float* w_in = pp->w_in + (size_t)l * 1024 * 8752;
    constexpr int I_IN = 16 * 280, I_MKV = 16 * 64, I_BR = 16 * 32, I_M1 = 16 * 128, I_M2 = 64 * 32, I_C1 = 2 * 32 * 8, I_C2 = 2 * 4 * 8, I_LRU = 2 * 8 * 2 * 4;
    constexpr int NITEMS = I_IN + I_MKV + 4 * I_BR + I_M1 + I_M2 + I_C1 + I_C2 + I_LRU;
    for (int it = gw; it < NITEMS; it += NGW) {
        int r = it;
        if (r < I_IN) { const int kb = r / 280, nb = r % 280, n0 = 32 * nb; int src, valid = 32;
            if (n0 < 4608) src = n0; else if (n0 < 5632) src = n0 - 4608 + 4656; else if (n0 < 8704) src = n0 - 5632 + 5680;
            else { src = n0 - 8704 + 4608; valid = 48 - (n0 - 8704); valid = valid < 0 ? 0 : (valid > 32 ? 32 : valid); if (valid == 0) src = 0; }
            tr_item(w_in, 8752, src, valid, 64 * kb, (bf16_t*)(ws + WS_WIN), 1024, n0, scr, lane); continue; } r -= I_IN;
        if (r < I_MKV) { tr_item(pp->w_mem_kv + (size_t)l * 1024 * 2048, 2048, 32 * (r % 64), 32, 64 * (r / 64), (bf16_t*)(ws + WS_WMKV), 1024, 32 * (r % 64), scr, lane); continue; } r -= I_MKV;
        if (r < I_BR) { tr_item(pp->w_br_rnn + (size_t)l * 1024 * 1024, 1024, 32 * (r % 32), 32, 64 * (r / 32), (bf16_t*)(ws + WS_WBRA), 1024, 32 * (r % 32), scr, lane); continue; } r -= I_BR;
        if (r < I_BR) { tr_item(pp->w_br_nsa + (size_t)l * 1024 * 1024, 1024, 32 * (r % 32), 32, 64 * (r / 32), (bf16_t*)(ws + WS_WBRB), 1024, 32 * (r % 32), scr, lane); continue; } r -= I_BR;
        if (r < I_BR) { tr_item(pp->w_br_mem + (size_t)l * 1024 * 1024, 1024, 32 * (r % 32), 32, 64 * (r / 32), (bf16_t*)(ws + WS_WBRC), 1024, 32 * (r % 32), scr, lane); continue; } r -= I_BR;
        if (r < I_BR) { tr_item(pp->w_out + (size_t)l * 1024 * 1024, 1024, 32 * (r % 32), 32, 64 * (r / 32), (bf16_t*)(ws + WS_WOUT), 1024, 32 * (r % 32), scr, lane); continue; } r -= I_BR;
        if (r < I_M1) { tr_item(pp->mlp_w1 + (size_t)l * 1024 * 4096, 4096, 32 * (r % 128), 32, 64 * (r / 128), (bf16_t*)(ws + WS_WM1), 1024, 32 * (r % 128), scr, lane); continue; } r -= I_M1;
        if (r < I_M2) { tr_item(pp->mlp_w2 + (size_t)l * 4096 * 1024, 1024, 32 * (r % 32), 32, 64 * (r / 32), (bf16_t*)(ws + WS_WM2), 4096, 32 * (r % 32), scr, lane); continue; } r -= I_M2;
        if (r < I_C1) { const int j = r / 256, q = r % 256;
            tr_item(pp->cmp_w1 + ((size_t)l * 2 + j) * 2048 * 256, 256, 32 * (q % 8), 32, 64 * (q / 8), (bf16_t*)(ws + WS_WC1) + (size_t)j * 256 * 2048, 2048, 32 * (q % 8), scr, lane); continue; } r -= I_C1;
        if (r < I_C2) { const int j = r / 32, q = r % 32; const int n0 = 32 * (q % 8);
            tr_item(pp->cmp_w2 + ((size_t)l * 2 + j) * 256 * 64, 64, n0 < 64 ? n0 : 0, n0 < 64 ? 32 : 0, 64 * (q / 8), (bf16_t*)(ws + WS_WC2) + (size_t)j * 256 * 256, 256, n0, scr, lane); continue; } r -= I_C2;
        { const int ri = r / 64, q = r % 64, blk = q / 8, q2 = q % 8;
            const float* W = (ri == 0 ? pp->lru_wr : pp->lru_wi) + ((size_t)l * 8 + blk) * 128 * 128;
            tr_item(W, 128, 32 * (q2 % 4), 32, 64 * (q2 / 4), (bf16_t*)(ws + WS_WLRU), 128, blk * 256 + ri * 128 + 32 * (q2 % 4), scr, lane); }
    }
    for (int m = gw; m < 512; m += NGW) {
        const f32x4* xr = (const f32x4*)(pp->mem + (size_t)m * 1024) + lane; const f32x4* gr = (const f32x4*)(pp->ln_mem + (size_t)l * 1024) + lane;
        f32x4 v[4]; float s = 0.f;
#pragma unroll
        for (int j = 0; j < 4; ++j) { v[j] = xr[64 * j]; s += (v[j].x * v[j].x + v[j].y * v[j].y) + (v[j].z * v[j].z + v[j].w * v[j].w); }
        const float rs = 1.0f / sqrtf(wave_sum(s, lane) * (1.f / 1024.f) + EPS);
        u32x2* o8 = (u32x2*)((bf16_t*)(ws + WS_MEMN) + (size_t)m * 1024) + lane;
#pragma unroll
        for (int j = 0; j < 4; ++j) { const f32x4 g = gr[64 * j]; u32x2 w; w.x = pk2(v[j].x * rs * g.x, v[j].y * rs * g.y); w.y = pk2(v[j].z * rs * g.z, v[j].w * rs * g.w); o8[64 * j] = w; }
    }
    {
        const int gt = gw * 64 + lane;
        if (gt < 16 * 512) { const int prt = gt / 512, jn = gt % 512, j = jn / 256, n = jn % 256;
            const float* w1 = pp->cmp_w1 + ((size_t)l * 2 + j) * 2048 * 256 + n; const float* pe = pp->cmp_pe + ((size_t)l * 2 + j) * 2048;
            float s = 0.f;
            for (int k = prt * 128; k < prt * 128 + 128; ++k) s += pe[k] * w1[(size_t)k * 256];
            ((float*)(ws + WS_CBP))[gt] = s; }
    }
}

DI void row_phase(const float* xin, const float* y, const float* gpost, float* xout, const float* gnext, bf16_t* hout) {
    int tid = threadIdx.x; asm volatile("" : "+v"(tid));
    const int lane = tid & 63, wave = __builtin_amdgcn_readfirstlane(tid >> 6);
    const int G_ = opaque_s((int)gridDim.x), bx_ = opaque_s((int)blockIdx.x);
    const int gw = bx_ * 8 + wave, NGW = G_ * 8, gtid = bx_ * 512 + tid, NT = G_ * 512;
    (void)lane; (void)wave; (void)gw; (void)NGW; (void)gtid; (void)NT;
    for (int m = gw; m < T_; m += NGW) {
        const f32x4* xr = (const f32x4*)(xin + (size_t)m * 1024) + lane;
        f32x4 v[4];
#pragma unroll
        for (int j = 0; j < 4; ++j) v[j] = xr[64 * j];
        if (y) {
            const f32x4* yr = (const f32x4*)(y + (size_t)m * 1024) + lane; const f32x4* gr = (const f32x4*)gpost + lane;
            f32x4 w[4]; float s = 0.f;
#pragma unroll
            for (int j = 0; j < 4; ++j) { w[j] = yr[64 * j]; s += (w[j].x * w[j].x + w[j].y * w[j].y) + (w[j].z * w[j].z + w[j].w * w[j].w); }
            const float rs = 1.0f / sqrtf(wave_sum(s, lane) * (1.f / 1024.f) + EPS);
            f32x4* xo = (f32x4*)(xout + (size_t)m * 1024) + lane;
#pragma unroll
            for (int j = 0; j < 4; ++j) { v[j] = v[j] + w[j] * rs * gr[64 * j]; xo[64 * j] = v[j]; }
        }
        if (hout) {
            float s = 0.f;
#pragma unroll
            for (int j = 0; j < 4; ++j) s += (v[j].x * v[j].x + v[j].y * v[j].y) + (v[j].z * v[j].z + v[j].w * v[j].w);
            const float rs = 1.0f / sqrtf(wave_sum(s, lane) * (1.f / 1024.f) + EPS);
            const f32x4* gr = (const f32x4*)gnext + lane; u32x2* o8 = (u32x2*)(hout + (size_t)m * 1024) + lane;
#pragma unroll
            for (int j = 0; j < 4; ++j) { const f32x4 g = gr[64 * j]; u32x2 w; w.x = pk2(v[j].x * rs * g.x, v[j].y * rs * g.y); w.y = pk2(v[j].z * rs * g.z, v[j].w * rs * g.w); o8[64 * j] = w; }
        }
    }
}

DI void rope8(u32x4& lo, u32x4& hi, float pos, int d0, float scale) {
    unsigned* pl = (unsigned*)&lo; unsigned* ph = (unsigned*)&hi;
    float x1[8], x2[8];
#pragma unroll
    for (int e = 0; e < 4; ++e) { x1[2 * e] = bflo(pl[e]); x1[2 * e + 1] = bfhi(pl[e]); x2[2 * e] = bflo(ph[e]); x2[2 * e + 1] = bfhi(ph[e]); }
#pragma unroll
    for (int e = 0; e < 8; ++e) {
        const float inv = fexp2(-(float)(d0 + e) * 0.41524101186092029f);
        const float ang = pos * inv;
        const double rev = (double)ang * 0.15915494309189535; const float fr = (float)(rev - __builtin_rint(rev));
        const float sn = __builtin_amdgcn_sinf(fr), cs = __builtin_amdgcn_cosf(fr);
        const float a = (x1[e] * cs - x2[e] * sn) * scale, b = (x2[e] * cs + x1[e] * sn) * scale; x1[e] = a; x2[e] = b;
    }
#pragma unroll
    for (int e = 0; e < 4; ++e) { pl[e] = pk2(x1[2 * e], x1[2 * e + 1]); ph[e] = pk2(x2[2 * e], x2[2 * e + 1]); }
}

DI void postproj_phase(PP pp, int l) {
    PPOPAQ();
    int tid = threadIdx.x; asm volatile("" : "+v"(tid));
    const int lane = tid & 63, wave = __builtin_amdgcn_readfirstlane(tid >> 6);
    const int G_ = opaque_s((int)gridDim.x), bx_ = opaque_s((int)blockIdx.x);
    const int gw = bx_ * 8 + wave, NGW = G_ * 8, gtid = bx_ * 512 + tid, NT = G_ * 512;
    (void)lane; (void)wave; (void)gw; (void)NGW; (void)gtid; (void)NT;
    unsigned char* ws = pp->ws; bf16_t* PROJ = (bf16_t*)(ws + WS_PROJ);
    {
        const float* cw = pp->conv_w + (size_t)l * 4 * 1024; const float* cb = pp->conv_b + (size_t)l * 1024; bf16_t* XC = (bf16_t*)(ws + WS_XC);
        for (int i = gtid; i < T_ * 128; i += NT) { const int t = i >> 7, c8 = (i & 127) * 8, ts = t & (S_ - 1);
            float acc[8];
#pragma unroll
            for (int e = 0; e < 8; ++e) acc[e] = cb[c8 + e];
#pragma unroll
            for (int w = 0; w < 4; ++w) { if (ts - 3 + w >= 0) { const u32x4 xv = *(const u32x4*)(PROJ + (size_t)(t - 3 + w) * LDP + C_XR + c8); const unsigned* xp = (const unsigned*)&xv;
                    const f32x4 k0 = *(const f32x4*)(cw + w * 1024 + c8), k1 = *(const f32x4*)(cw + w * 1024 + c8 + 4);
                    acc[0] += k0.x * bflo(xp[0]); acc[1] += k0.y * bfhi(xp[0]); acc[2] += k0.z * bflo(xp[1]); acc[3] += k0.w * bfhi(xp[1]);
                    acc[4] += k1.x * bflo(xp[2]); acc[5] += k1.y * bfhi(xp[2]); acc[6] += k1.z * bflo(xp[3]); acc[7] += k1.w * bfhi(xp[3]); } }
            u32x4 o; o.x = pk2(acc[0], acc[1]); o.y = pk2(acc[2], acc[3]); o.z = pk2(acc[4], acc[5]); o.w = pk2(acc[6], acc[7]);
            *(u32x4*)(XC + (size_t)t * 1024 + c8) = o; }
    }
    for (int i = gtid; i < T_ * 20 * 4; i += NT) { const int t = i / 80, r = i % 80, hd = r >> 2, d0 = (r & 3) * 8;
        int col; float sc = 1.0f;
        if (hd < 16) { col = C_Q + hd * 64; sc = 0.125f * LOG2E; } else col = C_KW + (hd - 16) * 64;
        bf16_t* base = PROJ + (size_t)t * LDP + col + d0;
        u32x4 lo = *(const u32x4*)base, hi = *(const u32x4*)(base + 32);
        rope8(lo, hi, (float)pp->pos[t], d0, sc);
        *(u32x4*)base = lo; *(u32x4*)(base + 32) = hi; }
    for (int i = gtid; i < 8 * 128 * 4 * 64; i += NT) { const int ln = i & 63, sub = (i >> 6) & 3, j = (i >> 8) & 127, bg = i >> 15, b = bg >> 2, g = bg & 3;
        const int r16 = ln & 15, quad = ln >> 4, t = 64 * j + 16 * sub + r16, dl = 8 * quad;
        const bf16_t* base = PROJ + (size_t)(b * S_ + t) * LDP + C_KS + g * 64 + dl;
        u32x4 lo = *(const u32x4*)base, hi = *(const u32x4*)(base + 32);
        rope8(lo, hi, (float)pp->pos[b * S_ + t], dl, 1.0f);
        u32x4 outw;
        outw.x = pk4_fp8(bflo(lo.x), bfhi(lo.x), bflo(lo.y), bfhi(lo.y)); outw.y = pk4_fp8(bflo(lo.z), bfhi(lo.z), bflo(lo.w), bfhi(lo.w));
        outw.z = pk4_fp8(bflo(hi.x), bfhi(hi.x), bflo(hi.y), bfhi(hi.y)); outw.w = pk4_fp8(bflo(hi.z), bfhi(hi.z), bflo(hi.w), bfhi(hi.w));
        *(u32x4*)((unsigned char*)(ws + WS_KF) + (size_t)i * 16) = outw; }
    for (int i = gtid; i < 8 * 128 * 4 * 64; i += NT) { const int ln = i & 63, dsub = (i >> 6) & 3, j = (i >> 8) & 127, bg = i >> 15, b = bg >> 2, g = bg & 3;
        const int r16 = ln & 15, quad = ln >> 4;
        u32x4 outw;
#pragma unroll
        for (int kst = 0; kst < 2; ++kst) { const int key0 = 64 * j + 32 * kst + 4 * quad;
            const bf16_t* src = PROJ + (size_t)(b * S_ + key0) * LDP + C_VS + g * 64 + 16 * dsub + r16;
            float v[8];
#pragma unroll
            for (int e = 0; e < 8; ++e) v[e] = bf2f(src[(size_t)(e < 4 ? e : e + 12) * LDP]);
            const unsigned w0 = pk4_fp8(v[0], v[1], v[2], v[3]), w1 = pk4_fp8(v[4], v[5], v[6], v[7]);
            if (kst == 0) { outw.x = w0; outw.y = w1; } else { outw.z = w0; outw.w = w1; } }
        *(u32x4*)((unsigned char*)(ws + WS_VTS) + (size_t)i * 16) = outw; }
    for (int i = gtid; i < 2 * 4 * 1024 * 64; i += NT) { const int d = i & 63, t8 = (i >> 6) & 1023, g = (i >> 16) & 3, b = (i >> 18) & 1, which = 1;
        const bf16_t* src = PROJ + (size_t)(b * S_ + t8 * 8) * LDP + (which ? C_VW : C_VS) + g * 64 + d;
        unsigned short v[8];
#pragma unroll
        for (int e = 0; e < 8; ++e) v[e] = src[(size_t)e * LDP];
        u32x4 o; o.x = v[0] | ((unsigned)v[1] << 16); o.y = v[2] | ((unsigned)v[3] << 16); o.z = v[4] | ((unsigned)v[5] << 16); o.w = v[6] | ((unsigned)v[7] << 16);
        *(u32x4*)((bf16_t*)(ws + (which ? WS_VTW : WS_VTS)) + ((size_t)(b * 4 + g) * 64 + d) * S_ + t8 * 8) = o; }
    if (gtid < 512) { const float* part = (const float*)(ws + WS_CBP); float s = pp->cmp_b1[(size_t)l * 512 + gtid];
        for (int q = 0; q < 16; ++q) s += part[q * 512 + gtid];
        ((float*)(ws + WS_CBIAS))[gtid] = s; }
}

DI void lru_ab(float rp, float ip, float xc, float cl, float& a, float& bb) {
    const float la = cl * sigmoidf_(rp);
    a = fexp2(la * LOG2E);
    const float x2 = 2.0f * la;
    float om;
    if (x2 > -0.1f) om = -x2 * (1.0f + x2 * (0.5f + x2 * (0.16666667f + x2 * (0.041666668f + x2 * 0.0083333338f)))); else om = 1.0f - a * a;
    bb = sqrtf(om) * sigmoidf_(ip) * xc;
}
DI void scan_phase(PP pp, int l, int pass) {
    PPOPAQ();
    int tid = threadIdx.x; asm volatile("" : "+v"(tid));
    const int G_ = opaque_s((int)gridDim.x), bx_ = opaque_s((int)blockIdx.x);
    unsigned char* ws = pp->ws; const bf16_t* __restrict__ RI = (const bf16_t*)(ws + WS_RI); bf16_t* XC = (bf16_t*)(ws + WS_XC); const bf16_t* __restrict__ PROJ = (const bf16_t*)(ws + WS_PROJ);
    f32x2* SA = (f32x2*)(ws + WS_SCA); f32x2* SH = (f32x2*)(ws + WS_SCH);
    const int ch = 2 * tid, blk = ch >> 7, cc = ch & 127, rcol = blk * 256 + cc;
    const f32x2 lam = *(const f32x2*)(pp->lru_lambda + (size_t)l * 1024 + ch), br = *(const f32x2*)(pp->lru_br + (size_t)l * 1024 + ch), bi = *(const f32x2*)(pp->lru_bi + (size_t)l * 1024 + ch);
    float cl[2];
#pragma unroll
    for (int e = 0; e < 2; ++e) { const float ex = fexp2(-lam[e] * LOG2E);
        const float sp = (ex < 0.05f) ? ex * (1.0f - ex * (0.5f - ex * (0.33333334f - ex * (0.25f - ex * (0.2f - ex * 0.16666667f))))) : ((-lam[e] > 20.f) ? -lam[e] : 0.6931471805599453f * __builtin_amdgcn_logf(1.0f + ex));
        cl[e] = -8.0f * sp; }
    for (int u = bx_; u < 256; u += G_) { const int b = u >> 7, k = u & 127;
        const size_t row0 = (size_t)b * S_ + k * 64;
        if (pass == 0) {
            float A0 = 1.f, H0 = 0.f, A1 = 1.f, H1 = 0.f;
            for (int s8 = 0; s8 < 64; s8 += 8) { unsigned rw[8], iw[8], xw[8];
#pragma unroll
                for (int e = 0; e < 8; ++e) { const size_t row = row0 + s8 + e; rw[e] = *(const unsigned*)(RI + row * 2048 + rcol); iw[e] = *(const unsigned*)(RI + row * 2048 + rcol + 128); xw[e] = *(const unsigned*)(XC + row * 1024 + ch); }
#pragma unroll
                for (int e = 0; e < 8; ++e) { float a, bb;
                    lru_ab(bflo(rw[e]) + br[0], bflo(iw[e]) + bi[0], bflo(xw[e]), cl[0], a, bb); A0 *= a; H0 = a * H0 + bb;
                    lru_ab(bfhi(rw[e]) + br[1], bfhi(iw[e]) + bi[1], bfhi(xw[e]), cl[1], a, bb); A1 *= a; H1 = a * H1 + bb; } }
            SA[((size_t)b * 128 + k) * 512 + tid] = (f32x2){A0, A1}; SH[((size_t)b * 128 + k) * 512 + tid] = (f32x2){H0, H1};
        } else {
            float h0 = 0.f, h1 = 0.f;
            const f32x2* __restrict__ sa = SA + (size_t)b * 128 * 512 + tid; const f32x2* __restrict__ sh = SH + (size_t)b * 128 * 512 + tid;
#pragma unroll 16
            for (int q = 0; q < k; ++q) { const f32x2 a = sa[(size_t)q * 512], hh = sh[(size_t)q * 512]; h0 = a[0] * h0 + hh[0]; h1 = a[1] * h1 + hh[1]; }
            for (int s8 = 0; s8 < 64; s8 += 8) { unsigned rw[8], iw[8], xw[8], yw[8];
#pragma unroll
                for (int e = 0; e < 8; ++e) { const size_t row = row0 + s8 + e; rw[e] = *(const unsigned*)(RI + row * 2048 + rcol); iw[e] = *(const unsigned*)(RI + row * 2048 + rcol + 128); xw[e] = *(const unsigned*)(XC + row * 1024 + ch);
                    yw[e] = *(const unsigned*)(PROJ + row * LDP + C_YR + ch); }
#pragma unroll
                for (int e = 0; e < 8; ++e) { float a, bb;
                    lru_ab(bflo(rw[e]) + br[0], bflo(iw[e]) + bi[0], bflo(xw[e]), cl[0], a, bb); h0 = a * h0 + bb;
                    lru_ab(bfhi(rw[e]) + br[1], bfhi(iw[e]) + bi[1], bfhi(xw[e]), cl[1], a, bb); h1 = a * h1 + bb;
                    *(unsigned*)(XC + (row0 + s8 + e) * 1024 + ch) = pk2(h0 * gelu_tanh(bflo(yw[e])), h1 * gelu_tanh(bfhi(yw[e]))); } }
        }
    }
}

DI void memsoftmax_phase(PP pp) {
    PPOPAQ();
    int tid = threadIdx.x; asm volatile("" : "+v"(tid));
    const int lane = tid & 63, wave = __builtin_amdgcn_readfirstlane(tid >> 6);
    const int G_ = opaque_s((int)gridDim.x), bx_ = opaque_s((int)blockIdx.x);
    const int gw = bx_ * 8 + wave, NGW = G_ * 8, gtid = bx_ * 512 + tid, NT = G_ * 512;
    (void)lane; (void)wave; (void)gw; (void)NGW; (void)gtid; (void)NT;
    bf16_t* SP = (bf16_t*)(pp->ws + WS_H);
    for (int m = gw; m < T_; m += NGW) {
        u32x4* ptr = (u32x4*)(SP + (size_t)m * 1024 + lane * 16);
        u32x4 a = ptr[0], b = ptr[1]; const unsigned* pa = (const unsigned*)&a; const unsigned* pb = (const unsigned*)&b;
        float v[16];
#pragma unroll
        for (int e = 0; e < 4; ++e) { v[2 * e] = bflo(pa[e]); v[2 * e + 1] = bfhi(pa[e]); v[8 + 2 * e] = bflo(pb[e]); v[8 + 2 * e + 1] = bfhi(pb[e]); }
        float mx = v[0];
#pragma unroll
        for (int e = 1; e < 16; ++e) mx = fmaxf(mx, v[e]);
#pragma unroll
        for (int o = 1; o < 16; o <<= 1) mx = fmaxf(mx, shx(mx, o, lane));
        float s = 0.f;
#pragma unroll
        for (int e = 0; e < 16; ++e) { v[e] = fexp2(v[e] - mx); s += v[e]; }
#pragma unroll
        for (int o = 1; o < 16; o <<= 1) s += shx(s, o, lane);
        const float inv = 1.0f / s;
        u32x4 oa, ob; unsigned* qa = (unsigned*)&oa; unsigned* qb = (unsigned*)&ob;
#pragma unroll
        for (int e = 0; e < 4; ++e) { qa[e] = pk2(v[2 * e] * inv, v[2 * e + 1] * inv); qb[e] = pk2(v[8 + 2 * e] * inv, v[8 + 2 * e + 1] * inv); }
        ptr[0] = oa; ptr[1] = ob;
    }
}

DI void cmpfinal_phase(PP pp) {
    PPOPAQ();
    int tid = threadIdx.x; asm volatile("" : "+v"(tid));
    const int lane = tid & 63, wave = __builtin_amdgcn_readfirstlane(tid >> 6);
    const int G_ = opaque_s((int)gridDim.x), bx_ = opaque_s((int)blockIdx.x);
    const int gw = bx_ * 8 + wave, NGW = G_ * 8, gtid = bx_ * 512 + tid, NT = G_ * 512;
    (void)lane; (void)wave; (void)gw; (void)NGW; (void)gtid; (void)NT;
    unsigned char* ws = pp->ws; const float* CR = (const float*)(ws + WS_CRAW);
    for (int i = gtid; i < 2 * 4 * 512 * 32; i += NT) { const int d = i & 31, c = (i >> 5) & 511, bg = i >> 14, b = bg >> 2;
        const float* src = CR + ((size_t)bg * 512 + c) * 64; float x1 = src[d], x2 = src[d + 32];
        float o1 = 0.f, o2 = 0.f;
        if (c < 511) { const float pos = (float)pp->pos[b * S_ + 16 * c + 31]; const float inv = fexp2(-(float)d * 0.41524101186092029f); const float ang = pos * inv;
            const double rev = (double)ang * 0.15915494309189535; const float fr = (float)(rev - __builtin_rint(rev));
            const float sn = __builtin_amdgcn_sinf(fr), cs = __builtin_amdgcn_cosf(fr); o1 = x1 * cs - x2 * sn; o2 = x2 * cs + x1 * sn; }
        bf16_t* dst = (bf16_t*)(ws + WS_KCMP) + ((size_t)bg * 512 + c) * 64; dst[d] = (bf16_t)f2bf(o1); dst[d + 32] = (bf16_t)f2bf(o2); }
    for (int i = gtid; i < 2 * 4 * 64 * 512; i += NT) { const int c = i & 511, d = (i >> 9) & 63, bg = i >> 15;
        const float v = (c < 511) ? CR[((size_t)(8 + bg) * 512 + c) * 64 + d] : 0.f;
        ((bf16_t*)(ws + WS_VTCMP))[((size_t)bg * 64 + d) * 512 + c] = (bf16_t)f2bf(v); }
}

constexpr int KSTR = 144, VSTR = 136;
constexpr int L_K = 0, L_V = 2 * 64 * KSTR, L_IMP = L_V + 2 * 64 * VSTR, IMPSTR = 132, L_SEL = L_IMP + 64 * IMPSTR * 4, L_ATT_END = L_SEL + 64 * 16, L_OT = L_ATT_END, L_Q8 = L_OT + 65536, L_ML = L_Q8 + 16384, OSSTR = 272;
DI int crow(int r, int hi) { return (r & 3) + 8 * (r >> 2) + 4 * hi; }

struct TileSrc { const bf16_t* K; int kstr; const bf16_t* Vt; int vstr; };

template <int MODE>
DI void attn_loop(LAS unsigned char* lds, const TileSrc src, int j0, int j1, const bf16x8 (&qf)[4], f32x16 (&o)[2], float& m_run, float& l_run,
                  int tl, int t, int tb, u64 selLo, u64 selHi, int tid, int wave, int lane) {
    const int n = lane & 31, hh = lane >> 5;
    const int lrow = tid >> 3, lchunk = tid & 7;
    u32x4 kreg, vreg;
    kreg = *(const u32x4*)(src.K + (size_t)(64 * j0 + lrow) * src.kstr + lchunk * 8);
    vreg = *(const u32x4*)(src.Vt + (size_t)lrow * src.vstr + 64 * j0 + lchunk * 8);
    float carry = 0.f;
    int buf = 0;
    for (int j = j0; j <= j1; ++j) {
        LAS unsigned char* Kl = lds + L_K + buf * 64 * KSTR; LAS unsigned char* Vl = lds + L_V + buf * 64 * VSTR;
        *(LAS u32x4*)(Kl + lrow * KSTR + lchunk * 16) = kreg;
        *(LAS u32x2*)(Vl + lrow * VSTR + lchunk * 16) = (u32x2){vreg.x, vreg.y}; *(LAS u32x2*)(Vl + lrow * VSTR + lchunk * 16 + 8) = (u32x2){vreg.z, vreg.w};
        __syncthreads();
        if (j < j1) { kreg = *(const u32x4*)(src.K + (size_t)(64 * (j + 1) + lrow) * src.kstr + lchunk * 8);
                      vreg = *(const u32x4*)(src.Vt + (size_t)lrow * src.vstr + 64 * (j + 1) + lchunk * 8); }
        buf ^= 1;
        bool active = true;
        if (MODE == 2) { const bool bit = ((j < 64 ? selLo : selHi) >> (j & 63)) & 1ull; active = __ballot(bit) != 0ull; }
        if (!active) continue;
        f32x16 s[2];
#pragma unroll
        for (int u = 0; u < 2; ++u) {
#pragma unroll
            for (int e = 0; e < 16; ++e) s[u][e] = 0.f;
#pragma unroll
            for (int ks = 0; ks < 4; ++ks) { const bf16x8 kf = *(const LAS bf16x8*)(Kl + (32 * u + n) * KSTR + (ks * 16 + 8 * hh) * 2);
                s[u] = __builtin_amdgcn_mfma_f32_32x32x16_bf16(kf, qf[ks], s[u], 0, 0, 0); }
        }
        const float NEGINF = -__builtin_inff();
        if (MODE <= 1) { const int cmax = min(510, (t - 31) >> 4);
#pragma unroll
            for (int u = 0; u < 2; ++u)
#pragma unroll
                for (int e = 0; e < 16; ++e) { const int c = 64 * j + 32 * u + crow(e, hh); if (c > cmax) s[u][e] = NEGINF; }
        } else if (MODE == 2) { const bool bit = ((j < 64 ? selLo : selHi) >> (j & 63)) & 1ull; const int lim = (j == tb) ? tl : 64;
#pragma unroll
            for (int u = 0; u < 2; ++u)
#pragma unroll
                for (int e = 0; e < 16; ++e) { const int kk = 32 * u + crow(e, hh); if (!bit || kk > lim) s[u][e] = NEGINF; }
        } else {
#pragma unroll
            for (int u = 0; u < 2; ++u)
#pragma unroll
                for (int e = 0; e < 16; ++e) { const int df = t - (64 * j + 32 * u + crow(e, hh)); if ((unsigned)df >= 512u) s[u][e] = NEGINF; }
        }
        if (MODE == 1) {
            const float msafe = (m_run == NEGINF) ? 0.f : m_run;
#pragma unroll
            for (int u = 0; u < 2; ++u)
#pragma unroll
                for (int e = 0; e < 16; ++e) s[u][e] = fexp2(s[u][e] - msafe) * l_run;
            if (tb >= 16) {
                float w1[8], w2[8], pw2[8];
#pragma unroll
                for (int u = 0; u < 2; ++u)
#pragma unroll
                    for (int gi = 0; gi < 4; ++gi) { const float p0 = s[u][4 * gi], p1 = s[u][4 * gi + 1], p2 = s[u][4 * gi + 2], p3 = s[u][4 * gi + 3];
                        w1[u * 4 + gi] = p0 + p1 + p2 + 0.5f * p3; w2[u * 4 + gi] = 0.5f * p3; }
#pragma unroll
                for (int q = 0; q < 8; ++q) pw2[q] = shx(w2[q], 32, lane);
                float tot[8];
#pragma unroll
                for (int q = 0; q < 8; ++q) { const float prev = (q == 0) ? carry : pw2[q > 0 ? q - 1 : 0]; tot[q] = w1[q] + (hh ? pw2[q] : prev); }
                carry = pw2[7];
#pragma unroll
                for (int q = 0; q < 8; ++q) { float v = tot[q]; v += shx(v, 1, lane); v += shx(v, 2, lane); tot[q] = v; }
                if ((n & 3) == 0) { LAS float* imp = (LAS float*)(lds + L_IMP) + (8 * wave + (n >> 2)) * IMPSTR;
#pragma unroll
                    for (int q = 0; q < 8; ++q) { const int jj = 16 * j + 8 * (q >> 2) + 2 * (q & 3) + hh; if (jj < 128) imp[jj] = tot[q]; } }
            }
        } else {
            float mloc = s[0][0];
#pragma unroll
            for (int u = 0; u < 2; ++u)
#pragma unroll
                for (int e = 0; e < 16; ++e) mloc = fmaxf(mloc, s[u][e]);
            mloc = fmaxf(mloc, shx(mloc, 32, lane));
            const float mnew = fmaxf(m_run, mloc); const float msafe = (mnew == NEGINF) ? 0.f : mnew;
            const float alpha = fexp2(m_run - msafe);
            float ls = 0.f;
#pragma unroll
            for (int u = 0; u < 2; ++u)
#pragma unroll
                for (int e = 0; e < 16; ++e) { s[u][e] = fexp2(s[u][e] - msafe); ls += s[u][e]; }
            l_run = l_run * alpha + ls; m_run = mnew;
            if (MODE != 0) {
#pragma unroll
                for (int ds = 0; ds < 2; ++ds)
#pragma unroll
                    for (int e = 0; e < 16; ++e) o[ds][e] *= alpha;
            }
        }
        if (MODE != 0) {
#pragma unroll
            for (int u = 0; u < 2; ++u)
#pragma unroll
                for (int st = 0; st < 2; ++st) {
                    u32x4 pp; pp.x = pk2(s[u][8 * st], s[u][8 * st + 1]); pp.y = pk2(s[u][8 * st + 2], s[u][8 * st + 3]); pp.z = pk2(s[u][8 * st + 4], s[u][8 * st + 5]); pp.w = pk2(s[u][8 * st + 6], s[u][8 * st + 7]);
                    const bf16x8 pb = __builtin_bit_cast(bf16x8, pp);
#pragma unroll
                    for (int ds = 0; ds < 2; ++ds) { const LAS unsigned char* vp = Vl + (32 * ds + n) * VSTR + (32 * u + 16 * st + 4 * hh) * 2;
                        const u32x2 a0 = *(const LAS u32x2*)vp, a1 = *(const LAS u32x2*)(vp + 16);
                        const u32x4 av = {a0.x, a0.y, a1.x, a1.y};
                        o[ds] = __builtin_amdgcn_mfma_f32_32x32x16_bf16(__builtin_bit_cast(bf16x8, av), pb, o[ds], 0, 0, 0); }
                }
        }
    }
    __syncthreads();
}

typedef float f32x4v __attribute__((ext_vector_type(4)));
DI void sel_tile(const u32x4 (&kc)[4], const u32x4 (&vf)[4], int j, LAS unsigned char* OSw, const LAS unsigned char* Q8w, LAS float* MLw, u64 tmLo, u64 tmHi, int tb, int wave, int lane) {
    const int q = lane & 15, quad = lane >> 4, head = q & 3, slot = q >> 2;
    const float NEGINF = -__builtin_inff();
    const bool tbit = (((j < 64 ? tmLo : tmHi) >> (j & 63)) & 1ull) != 0ull && lane < 8;
    unsigned act = (unsigned)__ballot(tbit) & 0xffu;
    while (act != 0u) {
        const int t0 = __builtin_ctz(act); act &= act - 1u;
        int t1 = -1, t2 = -1, t3 = -1;
        if (act != 0u) { t1 = __builtin_ctz(act); act &= act - 1u; }
        if (act != 0u) { t2 = __builtin_ctz(act); act &= act - 1u; }
        if (act != 0u) { t3 = __builtin_ctz(act); act &= act - 1u; }
        const int tsel = slot == 0 ? t0 : (slot == 1 ? t1 : (slot == 2 ? t2 : t3));
        const bool valid = tsel >= 0; const int tk = valid ? tsel : t0; const int rho = 4 * tk + head;
        const long qa = *(const LAS long*)(Q8w + rho * 64 + 8 * quad), qb = *(const LAS long*)(Q8w + rho * 64 + 32 + 8 * quad);
        f32x4v s[4];
#pragma unroll
        for (int sub = 0; sub < 4; ++sub) { s[sub] = (f32x4v){0.f, 0.f, 0.f, 0.f};
            s[sub] = __builtin_amdgcn_mfma_f32_16x16x32_fp8_fp8(mk64(kc[sub].x, kc[sub].y), qa, s[sub], 0, 0, 0);
            s[sub] = __builtin_amdgcn_mfma_f32_16x16x32_fp8_fp8(mk64(kc[sub].z, kc[sub].w), qb, s[sub], 0, 0, 0); }
        if (j == tb) { const int tlk = 8 * wave + tk;
#pragma unroll
            for (int sub = 0; sub < 4; ++sub)
#pragma unroll
                for (int i = 0; i < 4; ++i) { const int kk = 16 * sub + 4 * quad + i; if (kk > tlk) s[sub][i] = NEGINF; } }
        float mloc = fmaxf(fmaxf(s[0][0], s[1][0]), fmaxf(s[2][0], s[3][0]));
#pragma unroll
        for (int i = 1; i < 4; ++i) mloc = fmaxf(mloc, fmaxf(fmaxf(s[0][i], s[1][i]), fmaxf(s[2][i], s[3][i])));
        mloc = fmaxf(mloc, shx(mloc, 16, lane)); mloc = fmaxf(mloc, shx(mloc, 32, lane));
        const float m_old = MLw[rho], l_old = MLw[32 + rho];
        const float mnew = fmaxf(m_old, mloc);
        const float msafe = (mnew == NEGINF) ? 0.f : mnew;
        const float alpha = fexp2(m_old - msafe);
        const float sb = valid ? msafe - 8.0f : __builtin_inff();
        float ls = 0.f;
#pragma unroll
        for (int sub = 0; sub < 4; ++sub)
#pragma unroll
            for (int i = 0; i < 4; ++i) { s[sub][i] = fexp2(s[sub][i] - sb); ls += s[sub][i]; }
        ls += shx(ls, 16, lane); ls += shx(ls, 32, lane);
        if (valid && quad == 0) { MLw[rho] = mnew; MLw[32 + rho] = l_old * alpha + ls; }
        const long pb0 = mk64(pk4_fp8(s[0][0], s[0][1], s[0][2], s[0][3]), pk4_fp8(s[1][0], s[1][1], s[1][2], s[1][3]));
        const long pb1 = mk64(pk4_fp8(s[2][0], s[2][1], s[2][2], s[2][3]), pk4_fp8(s[3][0], s[3][1], s[3][2], s[3][3]));
#pragma unroll
        for (int dsub = 0; dsub < 4; ++dsub) { LAS f32x4v* op = (LAS f32x4v*)(OSw + rho * OSSTR + (16 * dsub + 4 * quad) * 4);
            f32x4v oacc = *op * alpha;
            oacc = __builtin_amdgcn_mfma_f32_16x16x32_fp8_fp8(mk64(vf[dsub].x, vf[dsub].y), pb0, oacc, 0, 0, 0);
            oacc = __builtin_amdgcn_mfma_f32_16x16x32_fp8_fp8(mk64(vf[dsub].z, vf[dsub].w), pb1, oacc, 0, 0, 0);
            if (valid) *op = oacc; }
    }
}
DI int sg_pop(u64& uLo, u64& uHi) {
    int j = -1;
    if (uLo != 0ull) { j = __builtin_ctzll(uLo); uLo &= uLo - 1ull; } else if (uHi != 0ull) { j = 64 + __builtin_ctzll(uHi); uHi &= uHi - 1ull; }
    return j;
}
DI void sel_gather(const unsigned char* __restrict__ KFb, const unsigned char* __restrict__ VFb, u64 uLo, u64 uHi, LAS unsigned char* OSw, const LAS unsigned char* Q8w, LAS float* MLw,
                   u64 tmLo, u64 tmHi, int tb, int wave, int lane) {
    const unsigned char* kp = KFb + lane * 16;
    const unsigned char* vp = VFb + lane * 16;
    u32x4 kb0[4], kb1[4], kb2[4], kb3[4], vb0[4], vb1[4], vb2[4], vb3[4];
#define SG_LOAD(KB, VB, jj) do { _Pragma("unroll") for (int sub = 0; sub < 4; ++sub) { KB[sub] = *(const u32x4*)(kp + (size_t)(((jj) * 4 + sub) * 1024)); VB[sub] = *(const u32x4*)(vp + (size_t)(((jj) * 4 + sub) * 1024)); } } while (0)
#define SG_STEP(KC, VC, KL, VL) { const int j3 = sg_pop(uLo, uHi); { const int j3c = j3 < 0 ? 0 : j3; SG_LOAD(KL, VL, j3c); } sel_tile(KC, VC, j0, OSw, Q8w, MLw, tmLo, tmHi, tb, wave, lane); if (j1 < 0) break; j0 = j1; j1 = j2; j2 = j3; }
    int j0 = sg_pop(uLo, uHi), j1 = sg_pop(uLo, uHi), j2 = sg_pop(uLo, uHi);
    SG_LOAD(kb0, vb0, j0); { const int j1c = j1 < 0 ? 0 : j1, j2c = j2 < 0 ? 0 : j2; SG_LOAD(kb1, vb1, j1c); SG_LOAD(kb2, vb2, j2c); }
    for (;;) {
        SG_STEP(kb0, vb0, kb3, vb3)
        SG_STEP(kb1, vb1, kb0, vb0)
        SG_STEP(kb2, vb2, kb1, vb1)
        SG_STEP(kb3, vb3, kb2, vb2)
    }
#undef SG_LOAD
#undef SG_STEP
}

DI void attn_phase(PP pp, LAS unsigned char* lds, bool do_store) {
    PPOPAQ();
    int tid = threadIdx.x; asm volatile("" : "+v"(tid));
    const int lane = tid & 63, wave = __builtin_amdgcn_readfirstlane(tid >> 6);
    const int G_ = opaque_s((int)gridDim.x), bx_ = opaque_s((int)blockIdx.x);
    const int gw = bx_ * 8 + wave, NGW = G_ * 8, gtid = bx_ * 512 + tid, NT = G_ * 512;
    (void)lane; (void)wave; (void)gw; (void)NGW; (void)gtid; (void)NT;
    unsigned char* ws = pp->ws; bf16_t* PROJ = (bf16_t*)(ws + WS_PROJ);
    const int n = lane & 31, hh = lane >> 5, G = G_;
    for (int it = 0; it < 4; ++it) {
        int tb, bg;
        if (G == 256) { const int kx = bx_ >> 3; bg = bx_ & 7; tb = 127 - (it * 32 + ((it & 1) ? 31 - kx : kx)); }
        else { const int cc = (it & 1) ? (G - 1 - bx_) : bx_; const int rho = it * G + cc; if (rho >= 1024) continue; tb = 127 - (rho >> 3); bg = rho & 7; }
        const int b = bg >> 2, g = bg & 3;
        const int t0 = 64 * tb, tl = 8 * wave + (n >> 2), r = n & 3, t = t0 + tl;
        const size_t trow = (size_t)b * S_ + t;
        bf16_t* qptr = PROJ + trow * LDP + C_Q + (4 * g + r) * 64;
        bf16x8 qf[4];
#pragma unroll
        for (int ks = 0; ks < 4; ++ks) qf[ks] = *(const bf16x8*)(qptr + ks * 16 + 8 * hh);
        f32x16 o[2];
        LAS float* OT = (LAS float*)(lds + L_OT) + wave * 2048 + lane;
        for (int i = tid; i < 64 * IMPSTR; i += 512) ((LAS float*)(lds + L_IMP))[i] = 0.f;
        {
            TileSrc src{(const bf16_t*)(ws + WS_KCMP) + (size_t)bg * 512 * 64, 64, (const bf16_t*)(ws + WS_VTCMP) + (size_t)bg * 64 * 512, 512};
            int nvalid = (t0 + 32) / 16 + 1; if (nvalid > 511) nvalid = 511;
            const int j1 = (nvalid - 1) >> 6;
            float m = -__builtin_inff(), l = 0.f;
            attn_loop<0>(lds, src, 0, j1, qf, o, m, l, tl, t, tb, 0ull, 0ull, tid, wave, lane);
            l += shx(l, 32, lane);
            float inv = 1.0f / fmaxf(l, 1e-30f);
#pragma unroll
            for (int ds = 0; ds < 2; ++ds)
#pragma unroll
                for (int e = 0; e < 16; ++e) o[ds][e] = 0.f;
            attn_loop<1>(lds, src, 0, j1, qf, o, m, inv, tl, t, tb, 0ull, 0ull, tid, wave, lane);
#pragma unroll
            for (int ds = 0; ds < 2; ++ds)
#pragma unroll
                for (int e = 0; e < 16; ++e) OT[(ds * 16 + e) * 64] = o[ds][e];
        }
        {
            const int tok = tid >> 3, prt = tid & 7;
            unsigned mk[4] = {0u, 0u, 0u, 0u};
            if (tb < 16) { mk[0] = (tb == 31) ? 0xffffffffu : ((2u << tb) - 1u); }
            else {
                const LAS float* imp = (const LAS float*)(lds + L_IMP) + tok * IMPSTR + 16 * prt;
                u64 keys[16];
#pragma unroll
                for (int e = 0; e < 16; ++e) { const int j = 16 * prt + e; const unsigned bits = __builtin_bit_cast(unsigned, imp[e]);
                    keys[e] = (j >= 1 && j <= tb - 1) ? (((u64)(bits + 1u) << 32) | (u64)(127 - j)) : 0ull; }
                mk[0] = 1u; mk[tb >> 5] |= 1u << (tb & 31);
                for (int round = 0; round < 14; ++round) {
                    u64 best = keys[0];
#pragma unroll
                    for (int e = 1; e < 16; ++e) best = keys[e] > best ? keys[e] : best;
#pragma unroll
                    for (int o2 = 1; o2 < 8; o2 <<= 1) { const u64 other = shx64(best, o2, lane); best = other > best ? other : best; }
                    if (best != 0ull) { const int jw = 127 - (int)(best & 127ull);
                        mk[0] |= (jw < 32) ? (1u << (jw & 31)) : 0u; mk[1] |= (jw >= 32 && jw < 64) ? (1u << (jw & 31)) : 0u;
                        mk[2] |= (jw >= 64 && jw < 96) ? (1u << (jw & 31)) : 0u; mk[3] |= (jw >= 96) ? (1u << (jw & 31)) : 0u; }
#pragma unroll
                    for (int e = 0; e < 16; ++e) if (keys[e] == best) keys[e] = 0ull;
                }
            }
            if (prt == 0) { LAS unsigned* sm = (LAS unsigned*)(lds + L_SEL) + tok * 4; sm[0] = mk[0]; sm[1] = mk[1]; sm[2] = mk[2]; sm[3] = mk[3]; }
            __syncthreads();
        }
        {
            TileSrc src{PROJ + (size_t)b * S_ * LDP + C_KW + g * 64, LDP, (const bf16_t*)(ws + WS_VTW) + (size_t)bg * 64 * S_, S_};
            float m = -__builtin_inff(), l = 0.f;
#pragma unroll
            for (int ds = 0; ds < 2; ++ds)
#pragma unroll
                for (int e = 0; e < 16; ++e) o[ds][e] = 0.f;
            attn_loop<3>(lds, src, tb >= 8 ? tb - 8 : 0, tb, qf, o, m, l, tl, t, tb, 0ull, 0ull, tid, wave, lane);
            l += shx(l, 32, lane);
            const float f = sigmoidf_(bf2f(PROJ[((size_t)b * S_ + t) * LDP + C_GN + g * 12 + r * 3 + 2])) / (sigmoidf_(bf2f(PROJ[((size_t)b * S_ + t) * LDP + C_GN + g * 12 + r * 3])) * fmaxf(l, 1e-30f));
#pragma unroll
            for (int ds = 0; ds < 2; ++ds)
#pragma unroll
                for (int e = 0; e < 16; ++e) OT[(ds * 16 + e) * 64] += f * o[ds][e];
        }
        __syncthreads();
        {
            u64 uLo = 0ull, uHi = 0ull;
            { const LAS unsigned* sm = (const LAS unsigned*)(lds + L_SEL) + 8 * wave * 4;
#pragma unroll
              for (int i = 0; i < 8; ++i) { uLo |= (u64)sm[4 * i] | ((u64)sm[4 * i + 1] << 32); uHi |= (u64)sm[4 * i + 2] | ((u64)sm[4 * i + 3] << 32); } }
            uLo = ((u64)(unsigned)__builtin_amdgcn_readfirstlane((int)(unsigned)(uLo >> 32)) << 32) | (unsigned)__builtin_amdgcn_readfirstlane((int)(unsigned)uLo);
            uHi = ((u64)(unsigned)__builtin_amdgcn_readfirstlane((int)(unsigned)(uHi >> 32)) << 32) | (unsigned)__builtin_amdgcn_readfirstlane((int)(unsigned)uHi);
            u64 tmLo, tmHi;
            { const LAS unsigned* sm = (const LAS unsigned*)(lds + L_SEL) + (8 * wave + (lane & 7)) * 4; tmLo = (u64)sm[0] | ((u64)sm[1] << 32); tmHi = (u64)sm[2] | ((u64)sm[3] << 32); }
            LAS unsigned char* OSw = lds + wave * (32 * OSSTR); LAS unsigned char* Q8w = lds + L_Q8 + wave * 2048; LAS float* MLw = (LAS float*)(lds + L_ML) + wave * 64;
            for (int i = lane; i < 32 * OSSTR / 4; i += 64) ((LAS float*)OSw)[i] = 0.f;
            MLw[lane] = (lane < 32) ? -__builtin_inff() : 0.f;
#pragma unroll
            for (int ks = 0; ks < 4; ++ks) { const u32x4 w = __builtin_bit_cast(u32x4, qf[ks]);
                *(LAS long*)(Q8w + n * 64 + 16 * ks + 8 * hh) = mk64(pk4_fp8(bflo(w.x), bfhi(w.x), bflo(w.y), bfhi(w.y)), pk4_fp8(bflo(w.z), bfhi(w.z), bflo(w.w), bfhi(w.w))); }
            sel_gather((const unsigned char*)(ws + WS_KF) + (size_t)bg * 128 * 4096, (const unsigned char*)(ws + WS_VTS) + (size_t)bg * 128 * 4096, uLo, uHi, OSw, Q8w, MLw, tmLo, tmHi, tb, wave, lane);
        }
        if (do_store) {
            int ln2 = lane; asm volatile("" : "+v"(ln2));
            const int n2 = ln2 & 31, h2 = ln2 >> 5, t2 = t0 + 8 * wave + (n2 >> 2), r2 = n2 & 3;
            bf16_t* rowp = PROJ + ((size_t)b * S_ + t2) * LDP;
            const float gcv = sigmoidf_(bf2f(rowp[C_GN + g * 12 + r2 * 3]));
            const LAS float* MLw = (const LAS float*)(lds + L_ML) + wave * 64;
            const float fsel = sigmoidf_(bf2f(rowp[C_GN + g * 12 + r2 * 3 + 1])) / fmaxf(MLw[32 + n2], 1e-30f);
            const LAS unsigned char* OSr = lds + wave * (32 * OSSTR) + n2 * OSSTR;
            bf16_t* op = rowp + C_Q + (4 * g + r2) * 64 + 4 * h2;
#pragma unroll
            for (int ds = 0; ds < 2; ++ds)
#pragma unroll
                for (int gi = 0; gi < 4; ++gi) { const f32x4v os = *(const LAS f32x4v*)(OSr + (32 * ds + 8 * gi + 4 * h2) * 4);
                    u32x2 w; w.x = pk2(gcv * OT[(ds * 16 + 4 * gi) * 64] + fsel * os[0], gcv * OT[(ds * 16 + 4 * gi + 1) * 64] + fsel * os[1]);
                    w.y = pk2(gcv * OT[(ds * 16 + 4 * gi + 2) * 64] + fsel * os[2], gcv * OT[(ds * 16 + 4 * gi + 3) * 64] + fsel * os[3]);
                    *(u32x2*)(op + 32 * ds + 8 * gi) = w; }
        }
        __syncthreads();
    }
}

__global__ void __launch_bounds__(512, 2) fwd_megakernel(Params p) {
    extern __shared__ __attribute__((aligned(16))) unsigned char lds_raw[];
    LAS unsigned char* lds = (LAS unsigned char*)lds_raw;
    cg::grid_group grid = cg::this_grid();
    const int G = gridDim.x, bx = blockIdx.x;
    PP pp = (PP)__builtin_amdgcn_kernarg_segment_ptr();
    volatile LAS unsigned* barst = (volatile LAS unsigned*)(lds + L_BARST);
    if (threadIdx.x == 0) { barst[0] = 0u; barst[1] = 0u; (void)xb_add((unsigned*)(pp->ws + WS_BAR) + XB_XCNT(xb_xcc_id()), 1u); }
    __syncthreads();
#define GSYNC() xcd_barrier((unsigned*)(ws + WS_BAR), barst)
#define ws (pp->ws)
#define PROJ ((bf16_t*)(ws + WS_PROJ))
#define H ((bf16_t*)(ws + WS_H))
#define XC ((bf16_t*)(ws + WS_XC))
#define Y ((float*)(ws + WS_RI))
    const int BIG = 1 << 30;

#ifndef NO_PREP
    prep_phase(pp, 0, lds);
#endif
#ifndef NO_ROW
    row_phase(pp->x, nullptr, nullptr, nullptr, pp->ln_mix_pre, H);
#endif
    grid.sync();

    for (int l = 0; l < NLAYER; ++l) {
        PPOPAQ();
        using pg8::Gemm; using pg8::Sched; using pg8::EpiBf16; using pg8::EpiF32; using pg8::EpiMerge;
#ifndef NO_G1
        for (int r_ = 0; r_ < opaque_s(GREP); ++r_) {
        pg8::gemm_phase<EpiBf16>(lds, Gemm{H, (const bf16_t*)(ws + WS_WIN), 1024, 1024, 1024, 128, 128},
            Sched{64, 35, opaque_s(G), opaque_s(bx), 0, BIG, 0u, 256u * 1024 * 2, 0u, 0u, 256u * 1024 * 2, 0u}, EpiBf16{PROJ, LDP, 0, 1.0f, nullptr, 0});
        pg8::gemm_phase<EpiBf16>(lds, Gemm{(const bf16_t*)(ws + WS_MEMN), (const bf16_t*)(ws + WS_WMKV), 1024, 1024, 1024, 128, 128},
            Sched{2, 4, opaque_s(G), (opaque_s(bx) + 64) % opaque_s(G), 0, BIG, 0u, 256u * 1024 * 2, 0u, 0u, 256u * 1024 * 2, 0u}, EpiBf16{(bf16_t*)(ws + WS_KMEM), 1024, 0, 1.0f, nullptr, 0});
        pg8::gemm_phase<EpiBf16>(lds, Gemm{(const bf16_t*)(ws + WS_WMKV) + (size_t)1024 * 1024, (const bf16_t*)(ws + WS_MEMN), 1024, 1024, 1024, 128, 128},
            Sched{4, 2, opaque_s(G), (opaque_s(bx) + 48) % opaque_s(G), 0, BIG, 0u, 256u * 1024 * 2, 0u, 0u, 256u * 1024 * 2, 0u}, EpiBf16{(bf16_t*)(ws + WS_VTMEM), 512, 0, 1.0f, nullptr, 0});
        }
#endif
        GSYNC();
#ifndef NO_POST
        postproj_phase(pp, l);
#endif
        GSYNC();
#ifndef NO_G1
        for (int r_ = 0; r_ < opaque_s(GREP); ++r_) {
        pg8::gemm_phase<EpiBf16>(lds, Gemm{XC, (const bf16_t*)(ws + WS_WLRU), 1024, 128, 128, 128, 128},
            Sched{64, 8, opaque_s(G), opaque_s(bx), 0, BIG, 0u, 256u * 1024 * 2, 128u * 2, 0u, 256u * 128 * 2, 0u}, EpiBf16{(bf16_t*)(ws + WS_RI), 2048, 0, 1.0f, nullptr, 0});
        pg8::gemm_phase<EpiBf16>(lds, Gemm{PROJ, (const bf16_t*)(ws + WS_WC1), 16 * LDP, 2048, 2048, LDP * 2, 128},
            Sched{32, 1, opaque_s(G), (opaque_s(bx) + 32) % opaque_s(G), 1, BIG, 0u, 0u, 0u, 0u, 0u, 0u}, EpiBf16{(bf16_t*)(ws + WS_HID), 256, 2, 1.0f, (const float*)(ws + WS_CBIAS), 0});
        pg8::gemm_phase<EpiBf16>(lds, Gemm{PROJ, (const bf16_t*)(ws + WS_KMEM), LDP, 1024, 256, 128, 128},
            Sched{64, 4, opaque_s(G), opaque_s(bx), 0, 32, (unsigned)C_QM * 2, 256u * LDP * 2, 256u * 2, 0u, 256u * 2, 256u * 1024 * 2}, EpiBf16{H, 1024, 0, 0.0625f * LOG2E, nullptr, 0});
        }
#endif
        GSYNC();
#ifndef NO_SCAN
        scan_phase(pp, l, 0);
#if defined(DUP_SCAN0)
        scan_phase(pp, l, 0);
#endif
#endif
#ifndef NO_MSM
        memsoftmax_phase(pp);
#endif
#ifndef NO_G2
        for (int r_ = 0; r_ < opaque_s(GREP); ++r_) {
        pg8::gemm_phase<EpiF32>(lds, Gemm{(const bf16_t*)(ws + WS_HID), (const bf16_t*)(ws + WS_WC2), 256, 256, 256, 128, 128},
            Sched{32, 1, opaque_s(G), (opaque_s(bx) + 96) % opaque_s(G), 0, 16, 0u, 256u * 256 * 2, 0u, 0u, 0u, 256u * 256 * 2}, EpiF32{(float*)(ws + WS_CRAW), 64, 64});
        }
#endif
        GSYNC();
#ifndef NO_SCAN
        scan_phase(pp, l, 1);
#endif
#ifndef NO_CMPF
        cmpfinal_phase(pp);
#endif
#ifndef NO_G1
        for (int r_ = 0; r_ < opaque_s(GREP); ++r_) {
        pg8::gemm_phase<EpiBf16>(lds, Gemm{H, (const bf16_t*)(ws + WS_VTMEM), 1024, 512, 256, 128, 128},
            Sched{64, 4, opaque_s(G), opaque_s(bx), 0, 32, 0u, 256u * 1024 * 2, 256u * 2, 0u, 256u * 512 * 2, 256u * 2}, EpiBf16{PROJ, LDP, 0, 1.0f, nullptr, C_QM});
        }
#endif
        GSYNC();
#ifndef NO_ATT
#if defined(DUP_ATT)
        attn_phase(pp, lds, opaque_s(0) != 0);
        __syncthreads();
#endif
        attn_phase(pp, lds, true);
#endif
        GSYNC();
#ifndef NO_G3
        for (int r_ = 0; r_ < opaque_s(GREP); ++r_) {
        pg8::gemm_phase<EpiMerge>(lds, Gemm{XC, (const bf16_t*)(ws + WS_WBRA), 1024, 1024, 1024, 128, 128},
            Sched{64, 4, opaque_s(G), opaque_s(bx), 0, BIG, 0u, 256u * 1024 * 2, 0u, 0u, 256u * 1024 * 2, 0u}, EpiMerge{PROJ + C_GM, LDP, Y, H, 0});
        pg8::gemm_phase<EpiMerge>(lds, Gemm{PROJ + C_Q, (const bf16_t*)(ws + WS_WBRB), LDP, 1024, 1024, 128, 128},
            Sched{64, 4, opaque_s(G), opaque_s(bx), 0, BIG, 0u, 256u * LDP * 2, 0u, 0u, 256u * 1024 * 2, 0u}, EpiMerge{PROJ + C_GM + 1024, LDP, Y, H, 1});
        pg8::gemm_phase<EpiMerge>(lds, Gemm{PROJ + C_QM, (const bf16_t*)(ws + WS_WBRC), LDP, 1024, 1024, 128, 128},
            Sched{64, 4, opaque_s(G), opaque_s(bx), 0, BIG, 0u, 256u * LDP * 2, 0u, 0u, 256u * 1024 * 2, 0u}, EpiMerge{PROJ + C_GM + 2048, LDP, Y, H, 2});
        }
#endif
        GSYNC();
#ifndef NO_G2
        for (int r_ = 0; r_ < opaque_s(GREP); ++r_) {
        pg8::gemm_phase<EpiF32>(lds, Gemm{H, (const bf16_t*)(ws + WS_WOUT), 1024, 1024, 1024, 128, 128},
            Sched{64, 4, opaque_s(G), opaque_s(bx), 0, BIG, 0u, 256u * 1024 * 2, 0u, 0u, 256u * 1024 * 2, 0u}, EpiF32{Y, 1024, 1024});
        }
#endif
        GSYNC();
#ifndef NO_ROW
        row_phase((l == 0) ? pp->x : pp->out, Y, pp->ln_mix_post + (size_t)l * 1024, pp->out, pp->ln_mlp_pre + (size_t)l * 1024, H);
#endif
        GSYNC();
#ifndef NO_G1
        for (int r_ = 0; r_ < opaque_s(GREP); ++r_) {
        pg8::gemm_phase<EpiBf16>(lds, Gemm{H, (const bf16_t*)(ws + WS_WM1), 1024, 1024, 1024, 128, 128},
            Sched{64, 16, opaque_s(G), opaque_s(bx), 0, BIG, 0u, 256u * 1024 * 2, 0u, 0u, 256u * 1024 * 2, 0u}, EpiBf16{PROJ, FF_, 1, 1.0f, nullptr, 0});
        }
#endif
        GSYNC();
#ifndef NO_G2
        for (int r_ = 0; r_ < opaque_s(GREP); ++r_) {
        pg8::gemm_phase<EpiF32>(lds, Gemm{PROJ, (const bf16_t*)(ws + WS_WM2), FF_, FF_, FF_, 128, 128},
            Sched{64, 4, opaque_s(G), opaque_s(bx), 0, BIG, 0u, 256u * FF_ * 2, 0u, 0u, 256u * FF_ * 2, 0u}, EpiF32{Y, 1024, 1024});
        }
#endif
        GSYNC();
#ifndef NO_ROW
        row_phase(pp->out, Y, pp->ln_mlp_post + (size_t)l * 1024, pp->out, (l + 1 < NLAYER) ? pp->ln_mix_pre + (size_t)(l + 1) * 1024 : nullptr, (l + 1 < NLAYER) ? H : nullptr);
#endif
#ifndef NO_PREP
        if (l + 1 < NLAYER) prep_phase(pp, l + 1, lds);
#if defined(DUP_PREP)
        if (l + 1 < NLAYER) prep_phase(pp, l + 1, lds);
#endif
#endif
        GSYNC();
    }
#undef ws
#undef PROJ
#undef H
#undef XC
#undef Y
}

extern "C" void kernel_launch(void* const* d_in, const int* in_sizes, int n_in, void* d_out, int out_size, void* d_ws, size_t ws_size, hipStream_t stream) {
    static int grid = 0;
    if (grid == 0) {
        int dev = 0, cus = 0, per_cu = 0;
        hipGetDevice(&dev); hipDeviceGetAttribute(&cus, hipDeviceAttributeMultiprocessorCount, dev);
        hipFuncSetAttribute((const void*)fwd_megakernel, hipFuncAttributeMaxDynamicSharedMemorySize, LDS_BYTES);
        hipOccupancyMaxActiveBlocksPerMultiprocessor(&per_cu, (const void*)fwd_megakernel, 512, LDS_BYTES);
        if (per_cu < 1) per_cu = 1;
        (void)hipGetLastError();
        grid = cus * 1;
        if (ws_size < WS_END) { fprintf(stderr, "kernel_launch: workspace too small (%zu < %zu)\n", ws_size, (size_t)WS_END); grid = -1; }
    }
    if (grid < 0) return;
    Params p{};
    p.x = (const float*)d_in[0]; p.mem = (const float*)d_in[1]; p.pos = (const int*)d_in[2];
    p.ln_mix_pre = (const float*)d_in[3]; p.w_in = (const float*)d_in[4]; p.conv_w = (const float*)d_in[5]; p.conv_b = (const float*)d_in[6];
    p.lru_wr = (const float*)d_in[7]; p.lru_br = (const float*)d_in[8]; p.lru_wi = (const float*)d_in[9]; p.lru_bi = (const float*)d_in[10]; p.lru_lambda = (const float*)d_in[11];
    p.cmp_pe = (const float*)d_in[12]; p.cmp_w1 = (const float*)d_in[13]; p.cmp_b1 = (const float*)d_in[14]; p.cmp_w2 = (const float*)d_in[15];
    p.ln_mem = (const float*)d_in[16]; p.w_mem_kv = (const float*)d_in[17]; p.w_br_rnn = (const float*)d_in[18]; p.w_br_nsa = (const float*)d_in[19]; p.w_br_mem = (const float*)d_in[20]; p.w_out = (const float*)d_in[21];
    p.ln_mix_post = (const float*)d_in[22]; p.ln_mlp_pre = (const float*)d_in[23]; p.mlp_w1 = (const float*)d_in[24]; p.mlp_w2 = (const float*)d_in[25]; p.ln_mlp_post = (const float*)d_in[26];
    p.out = (float*)d_out; p.ws = (unsigned char*)d_ws;
    (void)hipMemsetAsync((unsigned char*)d_ws + WS_BAR, 0, 16384, stream);
    void* args[] = {&p};
    hipError_t e = hipLaunchCooperativeKernel((const void*)fwd_megakernel, dim3(grid), dim3(512), args, LDS_BYTES, stream);
    if (e != hipSuccess) fprintf(stderr, "cooperative launch failed: %s (grid %d)\n", hipGetErrorString(e), grid);
}
```

```cpp
#include <hip/hip_runtime.h>
#include <hip/hip_cooperative_groups.h>
#include <cstdint>
#include <cstdio>
namespace cg = cooperative_groups;

#define LAS __attribute__((address_space(3)))
#define DI __device__ __forceinline__
typedef unsigned short bf16_t;
typedef short bf16x8 __attribute__((ext_vector_type(8)));
typedef short s16x4 __attribute__((ext_vector_type(4)));
typedef float f32x4 __attribute__((ext_vector_type(4)));
typedef float f32x16 __attribute__((ext_vector_type(16)));
typedef float f32x2 __attribute__((ext_vector_type(2)));
typedef unsigned u32x4 __attribute__((ext_vector_type(4)));
typedef unsigned u32x2 __attribute__((ext_vector_type(2)));
typedef __bf16 bf16x2v __attribute__((ext_vector_type(2)));
typedef unsigned long long u64;

constexpr int T_ = 16384, S_ = 8192, D_ = 1024, FF_ = 4096, LDP = 8960, NLAYER = 4;
constexpr int C_XR = 0, C_YR = 1024, C_Q = 2048, C_KC = 3072, C_VC = 3328, C_KS = 3584, C_VS = 3840, C_KW = 4096, C_VW = 4352,
              C_QM = 4608, C_GM = 5632, C_GN = 8704;
constexpr float EPS = 1e-6f;
constexpr float LOG2E = 1.4426950408889634f;

constexpr size_t al256(size_t x) { return (x + 255) & ~(size_t)255; }
constexpr size_t WS_PROJ = 0;
constexpr size_t WS_WIN = al256(WS_PROJ + (size_t)(T_ + 64) * LDP * 2);
constexpr size_t WS_WMKV = WS_WIN + (size_t)LDP * 1024 * 2;
constexpr size_t WS_WBRA = WS_WMKV + (size_t)2048 * 1024 * 2;
constexpr size_t WS_WBRB = WS_WBRA + (size_t)1024 * 1024 * 2;
constexpr size_t WS_WBRC = WS_WBRB + (size_t)1024 * 1024 * 2;
constexpr size_t WS_WOUT = WS_WBRC + (size_t)1024 * 1024 * 2;
constexpr size_t WS_WM1 = WS_WOUT + (size_t)1024 * 1024 * 2;
constexpr size_t WS_WM2 = WS_WM1 + (size_t)4096 * 1024 * 2;
constexpr size_t WS_WC1 = WS_WM2 + (size_t)4096 * 1024 * 2;
constexpr size_t WS_WC2 = WS_WC1 + (size_t)2 * 256 * 2048 * 2;
constexpr size_t WS_WLRU = WS_WC2 + (size_t)2 * 256 * 256 * 2;
constexpr size_t WS_H = WS_WLRU + (size_t)2048 * 128 * 2;
constexpr size_t WS_VTS = WS_H + (size_t)T_ * 1024 * 2;
constexpr size_t WS_VTW = WS_VTS + (size_t)8 * 64 * S_ * 2;
constexpr size_t WS_XC = WS_VTW + (size_t)8 * 64 * S_ * 2;
constexpr size_t WS_RI = WS_XC + (size_t)T_ * 1024 * 2;
constexpr size_t WS_HID = WS_RI + (size_t)T_ * 2048 * 2;
constexpr size_t WS_CRAW = WS_HID + (size_t)8192 * 256 * 2;
constexpr size_t WS_KCMP = WS_CRAW + (size_t)8192 * 64 * 4;
constexpr size_t WS_VTCMP = WS_KCMP + (size_t)8 * 512 * 64 * 2;
constexpr size_t WS_MEMN = WS_VTCMP + (size_t)8 * 512 * 64 * 2;
constexpr size_t WS_KMEM = WS_MEMN + (size_t)512 * 1024 * 2;
constexpr size_t WS_VTMEM = WS_KMEM + (size_t)512 * 1024 * 2;
constexpr size_t WS_SCA = WS_VTMEM + (size_t)512 * 1024 * 2;
constexpr size_t WS_SCH = WS_SCA + (size_t)2 * 128 * 1024 * 4;
constexpr size_t WS_CBP = WS_SCH + (size_t)2 * 128 * 1024 * 4;
constexpr size_t WS_CBIAS = WS_CBP + (size_t)16 * 512 * 4;
constexpr size_t WS_KF = al256(WS_CBIAS + 512 * 4);
constexpr size_t WS_BAR = WS_KF + (size_t)8 * 64 * S_ * 2;
constexpr size_t WS_END = WS_BAR + 16384;
constexpr int L_BARST = 155584;

#ifndef GREP
#define GREP 1
#endif
constexpr int LDS_BYTES = 155648;

DI unsigned f2bf(float f) { unsigned u = __builtin_bit_cast(unsigned, f); return (u + 0x7fffu + ((u >> 16) & 1u)) >> 16; }
DI unsigned pk2(float lo, float hi) { f32x2 f = {lo, hi}; bf16x2v r = __builtin_convertvector(f, bf16x2v); return __builtin_bit_cast(unsigned, r); }
DI float bf2f(unsigned short b) { return __builtin_bit_cast(float, (unsigned)b << 16); }
DI float bflo(unsigned w) { return __builtin_bit_cast(float, w << 16); }
DI float bfhi(unsigned w) { return __builtin_bit_cast(float, w & 0xffff0000u); }
DI float fexp2(float x) { return __builtin_amdgcn_exp2f(x); }
DI float sigmoidf_(float x) { return 1.0f / (1.0f + fexp2(-x * LOG2E)); }
DI float gelu_tanh(float x) { const float z = 0.7978845608028654f * (x + 0.044715f * x * x * x); return x / (1.0f + fexp2(-2.0f * LOG2E * z)); }
DI float shx(float v, int mask, int lane) { return __builtin_bit_cast(float, __builtin_amdgcn_ds_bpermute((lane ^ mask) << 2, __builtin_bit_cast(int, v))); }
DI u64 shx64(u64 v, int mask, int lane) { const int a = (lane ^ mask) << 2; const unsigned lo = (unsigned)__builtin_amdgcn_ds_bpermute(a, (int)(unsigned)v), hi = (unsigned)__builtin_amdgcn_ds_bpermute(a, (int)(unsigned)(v >> 32)); return ((u64)hi << 32) | lo; }
DI unsigned pk4_fp8(float a, float b, float c, float d) { int w = 0; w = __builtin_amdgcn_cvt_pk_fp8_f32(a, b, w, false); w = __builtin_amdgcn_cvt_pk_fp8_f32(c, d, w, true); return (unsigned)w; }
DI long mk64(unsigned lo, unsigned hi) { return (long)(((u64)hi << 32) | (u64)lo); }
DI int opaque_s(int v) { asm volatile("" : "+s"(v)); return v; }
DI float wave_sum(float v, int lane) {
#pragma unroll
    for (int o = 1; o < 64; o <<= 1) v += shx(v, o, lane);
    return v;
}

namespace pg8 {
constexpr int BM = 256, BK = 64, HALF = 128, HTB = HALF * BK * 2, STAGE_BYTES = 8 * HTB, NXCD = 8, WGM = 8;
__host__ __device__ __forceinline__ int lds_byte(int r, int c) { const int st = (r >> 4) * 2 + (c >> 5), rr = r & 15, cc = c & 31, ob = rr * 64 + cc * 2; return st * 1024 + (ob ^ (((ob >> 9) & 1) << 5)); }
__host__ __device__ __forceinline__ void stage_rc(int b, int& R, int& C) { const int st = b / 1024, sb = b % 1024, swz = sb ^ (((sb >> 9) & 1) << 5); R = (st >> 1) * 16 + swz / 64; C = (st & 1) * 32 + (swz % 64) / 2; }
__host__ __device__ __forceinline__ int perm32(int rho) { const int n = rho >> 4, i = rho & 15; return 8 * (i >> 2) + 4 * n + (i & 3); }

struct Unit { int pm, pn; unsigned aoff, boff; };
struct Gemm { const bf16_t* A; const bf16_t* Bt; int lda, ldb, K, kstepA, kstepB; };

struct Sched {
    int nM, nN, G, c, kind, mdiv; unsigned a0, sAm, sAn, b0, sBn, sBb;
    DI bool next(int i, Unit& u) const {
        const long L = (long)i * G + c; const int nwg = nM * nN; if (L >= nwg) return false;
        int wgid = (int)L; { const int q = nwg / NXCD, r = nwg % NXCD, xcd = wgid % NXCD, off = wgid / NXCD; wgid = (xcd < r ? xcd * (q + 1) : r * (q + 1) + (xcd - r) * q) + off; }
        const int nig = WGM * nN, gid = wgid / nig, fm = gid * WGM, gsz = (nM - fm) < WGM ? (nM - fm) : WGM;
        const int pm = fm + ((wgid % nig) % gsz), pn = (wgid % nig) / gsz;
        u.pm = pm; u.pn = pn;
        if (kind == 1) {
            const int j = pm >> 4, b = (pm >> 3) & 1, g = (pm >> 1) & 3, ch = pm & 1;
            u.aoff = (unsigned)(((b * S_ + ch * 4096) * LDP + C_KC + j * 256 + g * 64) * 2); u.boff = (unsigned)(j * 256 * 2048 * 2);
        } else { const unsigned bb = (unsigned)(pm / mdiv); u.aoff = a0 + (unsigned)pm * sAm + (unsigned)pn * sAn; u.boff = b0 + (unsigned)pn * sBn + bb * sBb; }
        return true;
    }
};

DI unsigned cvt_pk_bf16(float lo, float hi) { return pk2(lo, hi); }

struct EpiBf16 {
    static constexpr bool PERM = true;
    bf16_t* O; int ldc; int act; float scale; const float* bias; int oc0;
    DI void operator()(const f32x4 (&acc)[2][2][4][2], const Unit& u, int wr, int wc, int fr, int fq) const {
        const int row0 = u.pm * 256 + wr * 64 + fr, col0 = oc0 + u.pn * 256 + wc * 32 + 8 * fq, bc0 = (u.pm >> 4) * 256 + wc * 32 + 8 * fq;
#pragma unroll
        for (int ai = 0; ai < 2; ++ai)
#pragma unroll
            for (int m = 0; m < 4; ++m) { bf16_t* rowp = O + (size_t)(row0 + ai * HALF + m * 16) * ldc + col0;
#pragma unroll
                for (int bj = 0; bj < 2; ++bj) { f32x4 v0 = acc[ai][bj][m][0], v1 = acc[ai][bj][m][1];
                    if (act == 0) { v0 = v0 * scale; v1 = v1 * scale; }
                    else if (act == 1) {
#pragma unroll
                        for (int e = 0; e < 4; ++e) { const float a = fmaxf(v0[e], 0.f), b = fmaxf(v1[e], 0.f); v0[e] = a * a; v1[e] = b * b; } }
                    else { const f32x4 b0 = *(const f32x4*)(bias + bc0 + bj * HALF), b1 = *(const f32x4*)(bias + bc0 + bj * HALF + 4);
#pragma unroll
                        for (int e = 0; e < 4; ++e) { v0[e] = gelu_tanh(v0[e] + b0[e]); v1[e] = gelu_tanh(v1[e] + b1[e]); } }
                    u32x4 w; w.x = cvt_pk_bf16(v0[0], v0[1]); w.y = cvt_pk_bf16(v0[2], v0[3]); w.z = cvt_pk_bf16(v1[0], v1[1]); w.w = cvt_pk_bf16(v1[2], v1[3]);
                    *(u32x4*)(rowp + bj * HALF) = w; } }
    }
};
struct EpiF32 {
    static constexpr bool PERM = false;
    float* O; int ldc; int ncol;
    DI void operator()(const f32x4 (&acc)[2][2][4][2], const Unit& u, int wr, int wc, int fr, int fq) const {
        const int row0 = u.pm * 256 + wr * 64 + fr, col0 = u.pn * 256 + wc * 32 + 4 * fq;
#pragma unroll
        for (int ai = 0; ai < 2; ++ai)
#pragma unroll
            for (int m = 0; m < 4; ++m) { float* rowp = O + (size_t)(row0 + ai * HALF + m * 16) * ldc;
#pragma unroll
                for (int bj = 0; bj < 2; ++bj)
#pragma unroll
                    for (int n = 0; n < 2; ++n) { const int c = col0 + bj * HALF + n * 16; if (c < ncol) *(f32x4*)(rowp + c) = acc[ai][bj][m][n]; } }
    }
};
struct EpiMerge {
    static constexpr bool PERM = false;
    const bf16_t* gate; int ldg; float* M; bf16_t* Hout; int mode;
    DI void operator()(const f32x4 (&acc)[2][2][4][2], const Unit& u, int wr, int wc, int fr, int fq) const {
        const int row0 = u.pm * 256 + wr * 64 + fr, col0 = u.pn * 256 + wc * 32 + 4 * fq;
#pragma unroll
        for (int ai = 0; ai < 2; ++ai)
#pragma unroll
            for (int m = 0; m < 4; ++m) { const size_t r = (size_t)(row0 + ai * HALF + m * 16);
#pragma unroll
                for (int bj = 0; bj < 2; ++bj)
#pragma unroll
                    for (int n = 0; n < 2; ++n) { const int c = col0 + bj * HALF + n * 16;
                        const u32x2 gw = *(const u32x2*)(gate + r * ldg + c);
                        f32x4 g; g[0] = sigmoidf_(bflo(gw.x)); g[1] = sigmoidf_(bfhi(gw.x)); g[2] = sigmoidf_(bflo(gw.y)); g[3] = sigmoidf_(bfhi(gw.y));
                        f32x4 v = acc[ai][bj][m][n] * g;
                        float* mp = M + r * 1024 + c;
                        if (mode != 0) v = v + *(const f32x4*)mp;
                        if (mode != 2) *(f32x4*)mp = v;
                        else { u32x2 w; w.x = cvt_pk_bf16(v[0], v[1]); w.y = cvt_pk_bf16(v[2], v[3]); *(u32x2*)(Hout + r * 1024 + c) = w; } } }
    }
};

template <class Epi>
DI void gemm_phase(LAS unsigned char* lds, const Gemm g, const Sched& S, const Epi& E) {
    int tid = threadIdx.x; asm volatile("" : "+v"(tid));
    const int wid = __builtin_amdgcn_readfirstlane(tid >> 6), lane = tid & 63, wr = wid >> 2, wc = wid & 3, fr = lane & 15, fq = lane >> 4;
    const int nt = opaque_s(g.K / BK);
    unsigned voffA[2], voffB[2];
#pragma unroll
    for (int i = 0; i < 2; ++i) { int R, C; stage_rc(tid * 16 + i * 8192, R, C); const int Rb = Epi::PERM ? ((R & ~31) + perm32(R & 31)) : R;
        voffA[i] = (unsigned)(R * g.lda + C) * 2u; voffB[i] = (unsigned)(Rb * g.ldb + C) * 2u; }
    const size_t kstepA = (size_t)g.kstepA, kstepB = (size_t)g.kstepB;
    const size_t hstepA = (size_t)HALF * g.lda * 2, hstepB = (size_t)HALF * g.ldb * 2;
    const unsigned ldsw = (unsigned)wid * 1024u;
    const int aoff = lds_byte(wr * 64 + fr, fq * 8), boff = lds_byte(wc * 32 + fr, fq * 8);
#define PG8_SA(b, h) (((b) * 2 + (h)) * HTB)
#define PG8_SB(b, h) ((4 + (b) * 2 + (h)) * HTB)
#define PG8_STAGE(bufoff, gbase, voff) do { _Pragma("unroll") for (int _i = 0; _i < 2; ++_i) \
        __builtin_amdgcn_global_load_lds((const unsigned*)((const char*)(gbase) + (voff)[_i]), (LAS unsigned*)(lds + (bufoff) + ldsw + _i * 8192), 16, 0, 0); } while (0)
#define PG8_LDA(dst, b, h) do { _Pragma("unroll") for (int m = 0; m < 4; ++m) _Pragma("unroll") for (int k = 0; k < 2; ++k) dst[m][k] = *(const LAS bf16x8*)(lds + PG8_SA(b, h) + aoff + m * 2048 + k * 1024); } while (0)
#define PG8_LDB(dst, b, h) do { _Pragma("unroll") for (int n = 0; n < 2; ++n) _Pragma("unroll") for (int k = 0; k < 2; ++k) dst[n][k] = *(const LAS bf16x8*)(lds + PG8_SB(b, h) + boff + n * 2048 + k * 1024); } while (0)
#define PG8_MMA(ai, bj, At, Bt) do { __builtin_amdgcn_s_setprio(1); _Pragma("unroll") for (int m = 0; m < 4; ++m) _Pragma("unroll") for (int n = 0; n < 2; ++n) _Pragma("unroll") for (int k = 0; k < 2; ++k) \
        acc[ai][bj][m][n] = __builtin_amdgcn_mfma_f32_16x16x32_bf16(Bt[n][k], At[m][k], acc[ai][bj][m][n], 0, 0, 0); __builtin_amdgcn_s_setprio(0); } while (0)
#define PG8_WAIT_V(n) asm volatile("s_waitcnt vmcnt(" #n ")" ::: "memory")
#define PG8_WAIT_L(n) asm volatile("s_waitcnt lgkmcnt(" #n ")" ::: "memory")
#define PG8_BAR __builtin_amdgcn_s_barrier()
#define PG8_SCHED __builtin_amdgcn_sched_barrier(0)
    Unit cur, nxt; int ui = 0;
    if (!S.next(0, cur)) return;
    f32x4 acc[2][2][4][2];
#pragma unroll
    for (int a = 0; a < 2; ++a)
#pragma unroll
        for (int b = 0; b < 2; ++b)
#pragma unroll
            for (int m = 0; m < 4; ++m)
#pragma unroll
                for (int n = 0; n < 2; ++n) acc[a][b][m][n] = (f32x4){0.f, 0.f, 0.f, 0.f};
    bf16x8 At[4][2], B0[2][2], B1[2][2];
    const char* cA = (const char*)g.A + cur.aoff; const char* cB = (const char*)g.Bt + cur.boff;
    PG8_STAGE(PG8_SB(0, 0), cB, voffB); PG8_STAGE(PG8_SB(0, 1), cB + hstepB, voffB); PG8_STAGE(PG8_SA(0, 0), cA, voffA); PG8_STAGE(PG8_SA(0, 1), cA + hstepA, voffA);
    if (wr == 1) PG8_BAR;
    PG8_WAIT_V(2); PG8_BAR;
    PG8_STAGE(PG8_SB(1, 0), cB + kstepB, voffB); PG8_STAGE(PG8_SA(1, 0), cA + kstepA, voffA); PG8_STAGE(PG8_SB(1, 1), cB + hstepB + kstepB, voffB);
    PG8_WAIT_V(6); PG8_BAR;
    for (;;) {
        const bool has_next = S.next(ui + 1, nxt);
        const char* nA = has_next ? (const char*)g.A + nxt.aoff : cA; const char* nB = has_next ? (const char*)g.Bt + nxt.boff : cB;
        for (int t = 0; t < nt; t += 2) {
            const bool last = (t == nt - 2);
            const char* a1 = cA + (size_t)(t + 1) * kstepA;
            const char* a2 = last ? nA : cA + (size_t)(t + 2) * kstepA; const char* b2 = last ? nB : cB + (size_t)(t + 2) * kstepB;
            const char* a3 = a2 + kstepA; const char* b3 = b2 + kstepB;
            PG8_LDB(B0, 0, 0); PG8_LDB(B1, 0, 1); PG8_SCHED; PG8_LDA(At, 0, 0); PG8_STAGE(PG8_SA(1, 1), a1 + hstepA, voffA);
            PG8_WAIT_V(8); PG8_WAIT_L(0); PG8_BAR; PG8_MMA(0, 0, At, B0); PG8_MMA(0, 1, At, B1); PG8_BAR; PG8_SCHED;
            PG8_LDA(At, 0, 1); PG8_STAGE(PG8_SB(0, 0), b2, voffB); PG8_STAGE(PG8_SB(0, 1), b2 + hstepB, voffB); PG8_STAGE(PG8_SA(0, 0), a2, voffA);
            PG8_WAIT_V(8); PG8_WAIT_L(0); PG8_BAR; PG8_MMA(1, 0, At, B0); PG8_MMA(1, 1, At, B1); PG8_BAR; PG8_SCHED;
            PG8_LDB(B0, 1, 0); PG8_LDB(B1, 1, 1); PG8_SCHED; PG8_LDA(At, 1, 0); PG8_STAGE(PG8_SA(0, 1), a2 + hstepA, voffA);
            PG8_WAIT_V(8); PG8_WAIT_L(0); PG8_BAR; PG8_MMA(0, 0, At, B0); PG8_MMA(0, 1, At, B1); PG8_BAR; PG8_SCHED;
            PG8_LDA(At, 1, 1); PG8_STAGE(PG8_SB(1, 0), b3, voffB); PG8_STAGE(PG8_SB(1, 1), b3 + hstepB, voffB); PG8_STAGE(PG8_SA(1, 0), a3, voffA);
            PG8_WAIT_V(8); PG8_WAIT_L(0); PG8_BAR; PG8_MMA(1, 0, At, B0); PG8_MMA(1, 1, At, B1); PG8_BAR; PG8_SCHED;
        }
        if (wr == 0) PG8_BAR;
        E(acc, cur, wr, wc, fr, fq);
        if (!has_next) break;
#pragma unroll
        for (int a = 0; a < 2; ++a)
#pragma unroll
            for (int b = 0; b < 2; ++b)
#pragma unroll
                for (int m = 0; m < 4; ++m)
#pragma unroll
                    for (int n = 0; n < 2; ++n) acc[a][b][m][n] = (f32x4){0.f, 0.f, 0.f, 0.f};
        cur = nxt; cA = nA; cB = nB; ++ui;
        if (wr == 1) PG8_BAR;
    }
    PG8_WAIT_V(0);
    PG8_BAR;
#undef PG8_SA
#undef PG8_SB
#undef PG8_STAGE
#undef PG8_LDA
#undef PG8_LDB
#undef PG8_MMA
#undef PG8_WAIT_V
#undef PG8_WAIT_L
#undef PG8_BAR
#undef PG8_SCHED
}
}


#define XB_TMO      128
#define XB_XCNT(j)  (256  + 64 * (j))
#define XB_XSUB(j)  (1280 + 64 * (j))
#define XB_XGEN(j)  (2304 + 64 * (j))
#define XB_TOP      3328
#define XB_TOPGEN   3392
#define XCD_BAR_WORDS 3456
#define XB_SPIN_CAP (1u << 22)
DI unsigned xb_ld(unsigned* p)              { return __hip_atomic_load(p, __ATOMIC_RELAXED, __HIP_MEMORY_SCOPE_AGENT); }
DI unsigned xb_add(unsigned* p, unsigned v) { return __hip_atomic_fetch_add(p, v, __ATOMIC_RELAXED, __HIP_MEMORY_SCOPE_AGENT); }
DI unsigned xb_xcc_id() { return (unsigned)__builtin_amdgcn_s_getreg((3 << 11) | 20) & 0xFu; }
#define XB_SPIN(cond, bar) do { unsigned _sp = 0; while (cond) { __builtin_amdgcn_s_sleep(1); \
    if ((++_sp & 255u) == 0u) { if (xb_ld(&(bar)[XB_TMO])) break; if (_sp > XB_SPIN_CAP) { atomicAdd(&(bar)[XB_TMO], 1u); break; } } } } while (0)
DI void xcd_barrier_complete(unsigned* bar, unsigned x, unsigned& nloc, unsigned& nx) {
    const unsigned G = gridDim.x * gridDim.y * gridDim.z;
    unsigned sum, cnt, mine, sp = 0u;
    for (;;) {
        sum = 0u; cnt = 0u; mine = 0u;
#pragma unroll
        for (unsigned j = 0; j < 16; ++j) { const unsigned c = xb_ld(&bar[XB_XCNT(j)]); sum += c; cnt += (c > 0u) ? 1u : 0u; mine = (j == x) ? c : mine; }
        if (sum == G) break;
        __builtin_amdgcn_s_sleep(1);
        if ((++sp & 255u) == 0u) { if (xb_ld(&bar[XB_TMO])) break; if (sp > XB_SPIN_CAP) { atomicAdd(&bar[XB_TMO], 1u); break; } }
    }
    nloc = mine > 0u ? mine : 1u; nx = cnt > 0u ? cnt : 1u;
}
DI void xcd_barrier(unsigned* bar, volatile LAS unsigned* st) {
    asm volatile("s_waitcnt vmcnt(0)" ::: "memory");
    __syncthreads();
    if (threadIdx.x == 0) {
        __builtin_amdgcn_s_waitcnt(0);
        const unsigned x = xb_xcc_id();
        unsigned nloc = st[0], nx = st[1];
        if (nloc == 0u) { xcd_barrier_complete(bar, x, nloc, nx); st[0] = nloc; st[1] = nx; }
        const unsigned old = xb_add(&bar[XB_XSUB(x)], 1u);
        const unsigned gen = old / nloc;
        if (old + 1u == (gen + 1u) * nloc) {
            __builtin_amdgcn_fence(__ATOMIC_RELEASE, "agent");
            asm volatile("s_waitcnt vmcnt(0)" ::: "memory");
            const unsigned og = xb_add(&bar[XB_TOP], 1u);
            const unsigned tg = og / nx;
            if (og + 1u == (tg + 1u) * nx) xb_add(&bar[XB_TOPGEN], 1u);
            else XB_SPIN(xb_ld(&bar[XB_TOPGEN]) == tg, bar);
            __builtin_amdgcn_fence(__ATOMIC_ACQUIRE, "agent");
            xb_add(&bar[XB_XGEN(x)], 1u);
            asm volatile("s_waitcnt vmcnt(0)" ::: "memory");
        } else {
            XB_SPIN(xb_ld(&bar[XB_XGEN(x)]) == gen, bar);
            __builtin_amdgcn_fence(__ATOMIC_ACQUIRE, "agent");
            asm volatile("s_waitcnt vmcnt(0)" ::: "memory");
        }
    }
    __syncthreads();
}

struct Params {
    const float* x; const float* mem; const int* pos;
    const float* ln_mix_pre; const float* w_in; const float* conv_w; const float* conv_b;
    const float* lru_wr; const float* lru_br; const float* lru_wi; const float* lru_bi; const float* lru_lambda;
    const float* cmp_pe; const float* cmp_w1; const float* cmp_b1; const float* cmp_w2;
    const float* ln_mem; const float* w_mem_kv; const float* w_br_rnn; const float* w_br_nsa; const float* w_br_mem; const float* w_out;
    const float* ln_mix_post; const float* ln_mlp_pre; const float* mlp_w1; const float* mlp_w2; const float* ln_mlp_post;
    float* out; unsigned char* ws;
};
typedef const __attribute__((address_space(4))) Params* PP;
#define PPOPAQ() asm volatile("" : "+s"(pp))

DI void tr_item(const float* W, int ldw, int srccol, int valid, int k0, bf16_t* WT, int ldt, int drow0, LAS float* scr, int lane) {
    const int c32 = lane & 31;
    float vv[32];
    const float* wp = W + (size_t)(k0 + (lane >> 5)) * ldw + srccol + (c32 < valid ? c32 : 0);
#pragma unroll
    for (int i = 0; i < 32; ++i) vv[i] = wp[(size_t)(2 * i) * ldw];
#pragma unroll
    for (int i = 0; i < 32; ++i) scr[(2 * i + (lane >> 5)) * 33 + c32] = (c32 < valid) ? vv[i] : 0.f;
    __builtin_amdgcn_s_waitcnt(0xc07f); asm volatile("s_waitcnt lgkmcnt(0)" ::: "memory");
    const int c = lane & 7;
#pragma unroll
    for (int j = 0; j < 4; ++j) { const int n = (lane >> 3) + 8 * j; const LAS float* s = scr + (8 * c) * 33 + n;
        u32x4 o; o.x = pk2(s[0 * 33], s[1 * 33]); o.y = pk2(s[2 * 33], s[3 * 33]); o.z = pk2(s[4 * 33], s[5 * 33]); o.w = pk2(s[6 * 33], s[7 * 33]);
        *(u32x4*)(WT + (size_t)(drow0 + n) * ldt + k0 + 8 * c) = o; }
    asm volatile("s_waitcnt lgkmcnt(0)" ::: "memory");
}

DI void prep_phase(PP pp, int l, LAS unsigned char* lds) {
    PPOPAQ();
    int tid = threadIdx.x; asm volatile("" : "+v"(tid));
    const int lane = tid & 63, wave = __builtin_amdgcn_readfirstlane(tid >> 6);
    const int G_ = opaque_s((int)gridDim.x), bx_ = opaque_s((int)blockIdx.x);
    const int gw = bx_ * 8 + wave, NGW = G_ * 8, gtid = bx_ * 512 + tid, NT = G_ * 512;
    (void)lane; (void)wave; (void)gw; (void)NGW; (void)gtid; (void)NT;
    LAS float* scr = (LAS float*)(lds + wave * 8704);
    unsigned char* ws = pp->ws;
    const float* w_in = pp->w_in + (size_t)l * 1024 * 8752;
    constexpr int I_IN = 16 * 280, I_MKV = 16 * 64, I_BR = 16 * 32, I_M1 = 16 * 128, I_M2 = 64 * 32, I_C1 = 2 * 32 * 8, I_C2 = 2 * 4 * 8, I_LRU = 2 * 8 * 2 * 4;
    constexpr int NITEMS = I_IN + I_MKV + 4 * I_BR + I_M1 + I_M2 + I_C1 + I_C2 + I_LRU;
    for (int it = gw; it < NITEMS; it += NGW) {
        int r = it;
        if (r < I_IN) { const int kb = r / 280, nb = r % 280, n0 = 32 * nb; int src, valid = 32;
            if (n0 < 4608) src = n0; else if (n0 < 5632) src = n0 - 4608 + 4656; else if (n0 < 8704) src = n0 - 5632 + 5680;
            else { src = n0 - 8704 + 4608; valid = 48 - (n0 - 8704); valid = valid < 0 ? 0 : (valid > 32 ? 32 : valid); if (valid == 0) src = 0; }
            tr_item(w_in, 8752, src, valid, 64 * kb, (bf16_t*)(ws + WS_WIN), 1024, n0, scr, lane); continue; } r -= I_IN;
        if (r < I_MKV) { tr_item(pp->w_mem_kv + (size_t)l * 1024 * 2048, 2048, 32 * (r % 64), 32, 64 * (r / 64), (bf16_t*)(ws + WS_WMKV), 1024, 32 * (r % 64), scr, lane); continue; } r -= I_MKV;
        if (r < I_BR) { tr_item(pp->w_br_rnn + (size_t)l * 1024 * 1024, 1024, 32 * (r % 32), 32, 64 * (r / 32), (bf16_t*)(ws + WS_WBRA), 1024, 32 * (r % 32), scr, lane); continue; } r -= I_BR;
        if (r < I_BR) { tr_item(pp->w_br_nsa + (size_t)l * 1024 * 1024, 1024, 32 * (r % 32), 32, 64 * (r / 32), (bf16_t*)(ws + WS_WBRB), 1024, 32 * (r % 32), scr, lane); continue; } r -= I_BR;
        if (r < I_BR) { tr_item(pp->w_br_mem + (size_t)l * 1024 * 1024, 1024, 32 * (r % 32), 32, 64 * (r / 32), (bf16_t*)(ws + WS_WBRC), 1024, 32 * (r % 32), scr, lane); continue; } r -= I_BR;
        if (r < I_BR) { tr_item(pp->w_out + (size_t)l * 1024 * 1024, 1024, 32 * (r % 32), 32, 64 * (r / 32), (bf16_t*)(ws + WS_WOUT), 1024, 32 * (r % 32), scr, lane); continue; } r -= I_BR;
        if (r < I_M1) { tr_item(pp->mlp_w1 + (size_t)l * 1024 * 4096, 4096, 32 * (r % 128), 32, 64 * (r / 128), (bf16_t*)(ws + WS_WM1), 1024, 32 * (r % 128), scr, lane); continue; } r -= I_M1;
        if (r < I_M2) { tr_item(pp->mlp_w2 + (size_t)l * 4096 * 1024, 1024, 32 * (r % 32), 32, 64 * (r / 32), (bf16_t*)(ws + WS_WM2), 4096, 32 * (r % 32), scr, lane); continue; } r -= I_M2;
        if (r < I_C1) { const int j = r / 256, q = r % 256;
            tr_item(pp->cmp_w1 + ((size_t)l * 2 + j) * 2048 * 256, 256, 32 * (q % 8), 32, 64 * (q / 8), (bf16_t*)(ws + WS_WC1) + (size_t)j * 256 * 2048, 2048, 32 * (q % 8), scr, lane); continue; } r -= I_C1;
        if (r < I_C2) { const int j = r / 32, q = r % 32; const int n0 = 32 * (q % 8);
            tr_item(pp->cmp_w2 + ((size_t)l * 2 + j) * 256 * 64, 64, n0 < 64 ? n0 : 0, n0 < 64 ? 32 : 0, 64 * (q / 8), (bf16_t*)(ws + WS_WC2) + (size_t)j * 256 * 256, 256, n0, scr, lane); continue; } r -= I_C2;
        { const int ri = r / 64, q = r % 64, blk = q / 8, q2 = q % 8;
            const float* W = (ri == 0 ? pp->lru_wr : pp->lru_wi) + ((size_t)l * 8 + blk) * 128 * 128;
            tr_item(W, 128, 32 * (q2 % 4), 32, 64 * (q2 / 4), (bf16_t*)(ws + WS_WLRU), 128, blk * 256 + ri * 128 + 32 * (q2 % 4), scr, lane); }
    }
    for (int m = gw; m < 512; m += NGW) {
        const f32x4* xr = (const f32x4*)(pp->mem + (size_t)m * 1024) + lane; const f32x4* gr = (const f32x4*)(pp->ln_mem + (size_t)l * 1024) + lane;
        f32x4 v[4]; float s = 0.f;
#pragma unroll
        for (int j = 0; j < 4; ++j) { v[j] = xr[64 * j]; s += (v[j].x * v[j].x + v[j].y * v[j].y) + (v[j].z * v[j].z + v[j].w * v[j].w); }
        const float rs = 1.0f / sqrtf(wave_sum(s, lane) * (1.f / 1024.f) + EPS);
        u32x2* o8 = (u32x2*)((bf16_t*)(ws + WS_MEMN) + (size_t)m * 1024) + lane;
#pragma unroll
        for (int j = 0; j < 4; ++j) { const f32x4 g = gr[64 * j]; u32x2 w; w.x = pk2(v[j].x * rs * g.x, v[j].y * rs * g.y); w.y = pk2(v[j].z * rs * g.z, v[j].w * rs * g.w); o8[64 * j] = w; }
    }
    {
        const int gt = gw * 64 + lane;
        if (gt < 16 * 512) { const int prt = gt / 512, jn = gt % 512, j = jn / 256, n = jn % 256;
            const float* w1 = pp->cmp_w1 + ((size_t)l * 2 + j) * 2048 * 256 + n; const float* pe = pp->cmp_pe + ((size_t)l * 2 + j) * 2048;
            float s = 0.f;
            for (int k = prt * 128; k < prt * 128 + 128; ++k) s += pe[k] * w1[(size_t)k * 256];
            ((float*)(ws + WS_CBP))[gt] = s; }
    }
}

DI void row_phase(const float* xin, const float* y, const float* gpost, float* xout, const float* gnext, bf16_t* hout) {
    int tid = threadIdx.x; asm volatile("" : "+v"(tid));
    const int lane = tid & 63, wave = __builtin_amdgcn_readfirstlane(tid >> 6);
    const int G_ = opaque_s((int)gridDim.x), bx_ = opaque_s((int)blockIdx.x);
    const int gw = bx_ * 8 + wave, NGW = G_ * 8, gtid = bx_ * 512 + tid, NT = G_ * 512;
    (void)lane; (void)wave; (void)gw; (void)NGW; (void)gtid; (void)NT;
    for (int m = gw; m < T_; m += NGW) {
        const f32x4* xr = (const f32x4*)(xin + (size_t)m * 1024) + lane;
        f32x4 v[4];
#pragma unroll
        for (int j = 0; j < 4; ++j) v[j] = xr[64 * j];
        if (y) {
            const f32x4* yr = (const f32x4*)(y + (size_t)m * 1024) + lane; const f32x4* gr = (const f32x4*)gpost + lane;
            f32x4 w[4]; float s = 0.f;
#pragma unroll
            for (int j = 0; j < 4; ++j) { w[j] = yr[64 * j]; s += (w[j].x * w[j].x + w[j].y * w[j].y) + (w[j].z * w[j].z + w[j].w * w[j].w); }
            const float rs = 1.0f / sqrtf(wave_sum(s, lane) * (1.f / 1024.f) + EPS);
            f32x4* xo = (f32x4*)(xout + (size_t)m * 1024) + lane;
#pragma unroll
            for (int j = 0; j < 4; ++j) { v[j] = v[j] + w[j] * rs * gr[64 * j]; xo[64 * j] = v[j]; }
        }
        if (hout) {
            float s = 0.f;
#pragma unroll
            for (int j = 0; j < 4; ++j) s += (v[j].x * v[j].x + v[j].y * v[j].y) + (v[j].z * v[j].z + v[j].w * v[j].w);
            const float rs = 1.0f / sqrtf(wave_sum(s, lane) * (1.f / 1024.f) + EPS);
            const f32x4* gr = (const f32x4*)gnext + lane; u32x2* o8 = (u32x2*)(hout + (size_t)m * 1024) + lane;
#pragma unroll
            for (int j = 0; j < 4; ++j) { const f32x4 g = gr[64 * j]; u32x2 w; w.x = pk2(v[j].x * rs * g.x, v[j].y * rs * g.y); w.y = pk2(v[j].z * rs * g.z, v[j].w * rs * g.w); o8[64 * j] = w; }
        }
    }
}

DI void rope8(u32x4& lo, u32x4& hi, float pos, int d0, float scale) {
    unsigned* pl = (unsigned*)&lo; unsigned* ph = (unsigned*)&hi;
    float x1[8], x2[8];
#pragma unroll
    for (int e = 0; e < 4; ++e) { x1[2 * e] = bflo(pl[e]); x1[2 * e + 1] = bfhi(pl[e]); x2[2 * e] = bflo(ph[e]); x2[2 * e + 1] = bfhi(ph[e]); }
#pragma unroll
    for (int e = 0; e < 8; ++e) {
        const float inv = fexp2(-(float)(d0 + e) * 0.41524101186092029f);
        const float ang = pos * inv;
        const double rev = (double)ang * 0.15915494309189535; const float fr = (float)(rev - __builtin_rint(rev));
        const float sn = __builtin_amdgcn_sinf(fr), cs = __builtin_amdgcn_cosf(fr);
        const float a = (x1[e] * cs - x2[e] * sn) * scale, b = (x2[e] * cs + x1[e] * sn) * scale; x1[e] = a; x2[e] = b;
    }
#pragma unroll
    for (int e = 0; e < 4; ++e) { pl[e] = pk2(x1[2 * e], x1[2 * e + 1]); ph[e] = pk2(x2[2 * e], x2[2 * e + 1]); }
}

DI void postproj_phase(PP pp, int l) {
    PPOPAQ();
    if (opaque_s((int)blockIdx.x) < 32 && gridDim.x == 256) return;
    int tid = threadIdx.x; asm volatile("" : "+v"(tid));
    const int lane = tid & 63, wave = __builtin_amdgcn_readfirstlane(tid >> 6);
    const int G_ = opaque_s((int)gridDim.x), bx_ = opaque_s((int)blockIdx.x);
    const bool shr = (G_ == 256); const int gw = bx_ * 8 + wave, NGW = G_ * 8, gtid = (shr ? bx_ - 32 : bx_) * 512 + tid, NT = (shr ? G_ - 32 : G_) * 512;
    (void)lane; (void)wave; (void)gw; (void)NGW; (void)gtid; (void)NT;
    unsigned char* ws = pp->ws; bf16_t* PROJ = (bf16_t*)(ws + WS_PROJ);
    {
        const float* cw = pp->conv_w + (size_t)l * 4 * 1024; const float* cb = pp->conv_b + (size_t)l * 1024; bf16_t* XC = (bf16_t*)(ws + WS_XC);
        for (int i = gtid; i < (T_ / 8) * 128; i += NT) { const int tb8 = (i >> 7) * 8, c8 = (i & 127) * 8, ts0 = tb8 & (S_ - 1);
            u32x4 xr[11];
#pragma unroll
            for (int w = 0; w < 11; ++w) { const int tt = tb8 - 3 + w; const bool okr = ts0 - 3 + w >= 0; const u32x4 ld = *(const u32x4*)(PROJ + (size_t)(okr ? tt : tb8) * LDP + C_XR + c8);
                xr[w] = okr ? ld : (u32x4){0u, 0u, 0u, 0u}; }
            f32x4 kw[4][2];
#pragma unroll
            for (int w = 0; w < 4; ++w) { kw[w][0] = *(const f32x4*)(cw + w * 1024 + c8); kw[w][1] = *(const f32x4*)(cw + w * 1024 + c8 + 4); }
            const f32x4 b0 = *(const f32x4*)(cb + c8), b1 = *(const f32x4*)(cb + c8 + 4);
#pragma unroll
            for (int r = 0; r < 8; ++r) {
                float acc[8] = {b0.x, b0.y, b0.z, b0.w, b1.x, b1.y, b1.z, b1.w};
#pragma unroll
                for (int w = 0; w < 4; ++w) { const unsigned* xp = (const unsigned*)&xr[r + w]; const f32x4 k0 = kw[w][0], k1 = kw[w][1];
                    acc[0] += k0.x * bflo(xp[0]); acc[1] += k0.y * bfhi(xp[0]); acc[2] += k0.z * bflo(xp[1]); acc[3] += k0.w * bfhi(xp[1]);
                    acc[4] += k1.x * bflo(xp[2]); acc[5] += k1.y * bfhi(xp[2]); acc[6] += k1.z * bflo(xp[3]); acc[7] += k1.w * bfhi(xp[3]); }
                u32x4 o; o.x = pk2(acc[0], acc[1]); o.y = pk2(acc[2], acc[3]); o.z = pk2(acc[4], acc[5]); o.w = pk2(acc[6], acc[7]);
                *(u32x4*)(XC + (size_t)(tb8 + r) * 1024 + c8) = o; }
        }
    }
    for (int i = gtid; i < T_ * 20 * 4; i += NT) { const int t = i / 80, r = i % 80, hd = r >> 2, d0 = (r & 3) * 8;
        int col; float sc = 1.0f;
        if (hd < 16) { col = C_Q + hd * 64; sc = 0.125f * LOG2E; } else col = C_KW + (hd - 16) * 64;
        bf16_t* base = PROJ + (size_t)t * LDP + col + d0;
        u32x4 lo = *(const u32x4*)base, hi = *(const u32x4*)(base + 32);
        rope8(lo, hi, (float)pp->pos[t], d0, sc);
        *(u32x4*)base = lo; *(u32x4*)(base + 32) = hi; }
    for (int i = gtid; i < 8 * 128 * 4 * 64; i += NT) { const int ln = i & 63, sub = (i >> 6) & 3, j = (i >> 8) & 127, bg = i >> 15, b = bg >> 2, g = bg & 3;
        const int r16 = ln & 15, quad = ln >> 4, t = 64 * j + 16 * sub + r16, dl = 8 * quad;
        const bf16_t* base = PROJ + (size_t)(b * S_ + t) * LDP + C_KS + g * 64 + dl;
        u32x4 lo = *(const u32x4*)base, hi = *(const u32x4*)(base + 32);
        rope8(lo, hi, (float)pp->pos[b * S_ + t], dl, 1.0f);
        u32x4 outw;
        outw.x = pk4_fp8(bflo(lo.x), bfhi(lo.x), bflo(lo.y), bfhi(lo.y)); outw.y = pk4_fp8(bflo(lo.z), bfhi(lo.z), bflo(lo.w), bfhi(lo.w));
        outw.z = pk4_fp8(bflo(hi.x), bfhi(hi.x), bflo(hi.y), bfhi(hi.y)); outw.w = pk4_fp8(bflo(hi.z), bfhi(hi.z), bflo(hi.w), bfhi(hi.w));
        *(u32x4*)((unsigned char*)(ws + WS_KF) + (size_t)i * 16) = outw; }
    for (int i = gtid; i < 8 * 128 * 4 * 64; i += NT) { const int ln = i & 63, dsub = (i >> 6) & 3, j = (i >> 8) & 127, bg = i >> 15, b = bg >> 2, g = bg & 3;
        const int r16 = ln & 15, quad = ln >> 4;
        u32x4 outw;
#pragma unroll
        for (int kst = 0; kst < 2; ++kst) { const int key0 = 64 * j + 32 * kst + 4 * quad;
            const bf16_t* src = PROJ + (size_t)(b * S_ + key0) * LDP + C_VS + g * 64 + 16 * dsub + r16;
            float v[8];
#pragma unroll
            for (int e = 0; e < 8; ++e) v[e] = bf2f(src[(size_t)(e < 4 ? e : e + 12) * LDP]);
            const unsigned w0 = pk4_fp8(v[0], v[1], v[2], v[3]), w1 = pk4_fp8(v[4], v[5], v[6], v[7]);
            if (kst == 0) { outw.x = w0; outw.y = w1; } else { outw.z = w0; outw.w = w1; } }
        *(u32x4*)((unsigned char*)(ws + WS_VTS) + (size_t)i * 16) = outw; }
    for (int i = gtid; i < 2 * 4 * 1024 * 64; i += NT) { const int d = i & 63, t8 = (i >> 6) & 1023, g = (i >> 16) & 3, b = (i >> 18) & 1, which = 1;
        const bf16_t* src = PROJ + (size_t)(b * S_ + t8 * 8) * LDP + (which ? C_VW : C_VS) + g * 64 + d;
        unsigned short v[8];
#pragma unroll
        for (int e = 0; e < 8; ++e) v[e] = src[(size_t)e * LDP];
        u32x4 o; o.x = v[0] | ((unsigned)v[1] << 16); o.y = v[2] | ((unsigned)v[3] << 16); o.z = v[4] | ((unsigned)v[5] << 16); o.w = v[6] | ((unsigned)v[7] << 16);
        *(u32x4*)((bf16_t*)(ws + (which ? WS_VTW : WS_VTS)) + ((size_t)(b * 4 + g) * 64 + d) * S_ + t8 * 8) = o; }
}
DI void cbias_phase(PP pp, int l) {
    PPOPAQ();
    int tid = threadIdx.x; asm volatile("" : "+v"(tid));
    if (opaque_s((int)blockIdx.x) == 0) { unsigned char* ws = pp->ws; const float* part = (const float*)(ws + WS_CBP); float s = pp->cmp_b1[(size_t)l * 512 + tid];
        for (int q = 0; q < 16; ++q) s += part[q * 512 + tid];
        ((float*)(ws + WS_CBIAS))[tid] = s; }
}

DI void lru_ab(float rp, float ip, float xc, float cl, float& a, float& bb) {
    const float la = cl * sigmoidf_(rp);
    a = fexp2(la * LOG2E);
    const float x2 = 2.0f * la;
    float om;
    if (x2 > -0.1f) om = -x2 * (1.0f + x2 * (0.5f + x2 * (0.16666667f + x2 * (0.041666668f + x2 * 0.0083333338f)))); else om = 1.0f - a * a;
    bb = sqrtf(om) * sigmoidf_(ip) * xc;
}
DI void scan_phase(PP pp, int l, int pass) {
    PPOPAQ();
    int tid = threadIdx.x; asm volatile("" : "+v"(tid));
    const int G_ = opaque_s((int)gridDim.x), bx_ = opaque_s((int)blockIdx.x);
    unsigned char* ws = pp->ws; const bf16_t* __restrict__ RI = (const bf16_t*)(ws + WS_RI); bf16_t* XC = (bf16_t*)(ws + WS_XC); const bf16_t* __restrict__ PROJ = (const bf16_t*)(ws + WS_PROJ);
    f32x2* SA = (f32x2*)(ws + WS_SCA); f32x2* SH = (f32x2*)(ws + WS_SCH);
    const int ch = 2 * tid, blk = ch >> 7, cc = ch & 127, rcol = blk * 256 + cc;
    const f32x2 lam = *(const f32x2*)(pp->lru_lambda + (size_t)l * 1024 + ch), br = *(const f32x2*)(pp->lru_br + (size_t)l * 1024 + ch), bi = *(const f32x2*)(pp->lru_bi + (size_t)l * 1024 + ch);
    float cl[2];
#pragma unroll
    for (int e = 0; e < 2; ++e) { const float ex = fexp2(-lam[e] * LOG2E);
        const float sp = (ex < 0.05f) ? ex * (1.0f - ex * (0.5f - ex * (0.33333334f - ex * (0.25f - ex * (0.2f - ex * 0.16666667f))))) : ((-lam[e] > 20.f) ? -lam[e] : 0.6931471805599453f * __builtin_amdgcn_logf(1.0f + ex));
        cl[e] = -8.0f * sp; }
    for (int u = bx_; u < 256; u += G_) { const int b = u >> 7, k = u & 127;
        const size_t row0 = (size_t)b * S_ + k * 64;
        if (pass == 0) {
            float A0 = 1.f, H0 = 0.f, A1 = 1.f, H1 = 0.f;
            for (int s8 = 0; s8 < 64; s8 += 8) { unsigned rw[8], iw[8], xw[8];
#pragma unroll
                for (int e = 0; e < 8; ++e) { const size_t row = row0 + s8 + e; rw[e] = *(const unsigned*)(RI + row * 2048 + rcol); iw[e] = *(const unsigned*)(RI + row * 2048 + rcol + 128); xw[e] = *(const unsigned*)(XC + row * 1024 + ch); }
#pragma unroll
                for (int e = 0; e < 8; ++e) { float a, bb;
                    lru_ab(bflo(rw[e]) + br[0], bflo(iw[e]) + bi[0], bflo(xw[e]), cl[0], a, bb); A0 *= a; H0 = a * H0 + bb;
                    lru_ab(bfhi(rw[e]) + br[1], bfhi(iw[e]) + bi[1], bfhi(xw[e]), cl[1], a, bb); A1 *= a; H1 = a * H1 + bb; } }
            SA[((size_t)b * 128 + k) * 512 + tid] = (f32x2){A0, A1}; SH[((size_t)b * 128 + k) * 512 + tid] = (f32x2){H0, H1};
        } else {
            float h0 = 0.f, h1 = 0.f;
            const f32x2* __restrict__ sa = SA + (size_t)b * 128 * 512 + tid; const f32x2* __restrict__ sh = SH + (size_t)b * 128 * 512 + tid;
            for (int q0 = 0; q0 < k; q0 += 16) { f32x2 av[16], hv[16];
#pragma unroll
                for (int e = 0; e < 16; ++e) { const int qq = (q0 + e < k) ? q0 + e : q0; av[e] = sa[(size_t)qq * 512]; hv[e] = sh[(size_t)qq * 512]; }
#pragma unroll
                for (int e = 0; e < 16; ++e) if (q0 + e < k) { h0 = av[e][0] * h0 + hv[e][0]; h1 = av[e][1] * h1 + hv[e][1]; } }
            for (int s8 = 0; s8 < 64; s8 += 8) { unsigned rw[8], iw[8], xw[8], yw[8];
#pragma unroll
                for (int e = 0; e < 8; ++e) { const size_t row = row0 + s8 + e; rw[e] = *(const unsigned*)(RI + row * 2048 + rcol); iw[e] = *(const unsigned*)(RI + row * 2048 + rcol + 128); xw[e] = *(const unsigned*)(XC + row * 1024 + ch);
                    yw[e] = *(const unsigned*)(PROJ + row * LDP + C_YR + ch); }
#pragma unroll
                for (int e = 0; e < 8; ++e) { float a, bb;
                    lru_ab(bflo(rw[e]) + br[0], bflo(iw[e]) + bi[0], bflo(xw[e]), cl[0], a, bb); h0 = a * h0 + bb;
                    lru_ab(bfhi(rw[e]) + br[1], bfhi(iw[e]) + bi[1], bfhi(xw[e]), cl[1], a, bb); h1 = a * h1 + bb;
                    *(unsigned*)(XC + (row0 + s8 + e) * 1024 + ch) = pk2(h0 * gelu_tanh(bflo(yw[e])), h1 * gelu_tanh(bfhi(yw[e]))); } }
        }
    }
}

DI void memsoftmax_phase(PP pp) {
    PPOPAQ();
    int tid = threadIdx.x; asm volatile("" : "+v"(tid));
    const int lane = tid & 63, wave = __builtin_amdgcn_readfirstlane(tid >> 6);
    const int G_ = opaque_s((int)gridDim.x), bx_ = opaque_s((int)blockIdx.x);
    const int gw = bx_ * 8 + wave, NGW = G_ * 8, gtid = bx_ * 512 + tid, NT = G_ * 512;
    (void)lane; (void)wave; (void)gw; (void)NGW; (void)gtid; (void)NT;
    bf16_t* SP = (bf16_t*)(pp->ws + WS_H);
    for (int m0 = gw; m0 < T_; m0 += 4 * NGW) {
        u32x4 av[4], bv[4];
#pragma unroll
        for (int r = 0; r < 4; ++r) { const int m = (m0 + r * NGW < T_) ? m0 + r * NGW : m0; const u32x4* ptr = (const u32x4*)(SP + (size_t)m * 1024 + lane * 16); av[r] = ptr[0]; bv[r] = ptr[1]; }
#pragma unroll
        for (int r = 0; r < 4; ++r) {
            const unsigned* pa = (const unsigned*)&av[r]; const unsigned* pb = (const unsigned*)&bv[r];
            float v[16];
#pragma unroll
            for (int e = 0; e < 4; ++e) { v[2 * e] = bflo(pa[e]); v[2 * e + 1] = bfhi(pa[e]); v[8 + 2 * e] = bflo(pb[e]); v[8 + 2 * e + 1] = bfhi(pb[e]); }
            float mx = v[0];
#pragma unroll
            for (int e = 1; e < 16; ++e) mx = fmaxf(mx, v[e]);
#pragma unroll
            for (int o = 1; o < 16; o <<= 1) mx = fmaxf(mx, shx(mx, o, lane));
            float sm = 0.f;
#pragma unroll
            for (int e = 0; e < 16; ++e) { v[e] = fexp2(v[e] - mx); sm += v[e]; }
#pragma unroll
            for (int o = 1; o < 16; o <<= 1) sm += shx(sm, o, lane);
            const float inv = 1.0f / sm;
            u32x4 oa, ob; unsigned* qa = (unsigned*)&oa; unsigned* qb = (unsigned*)&ob;
#pragma unroll
            for (int e = 0; e < 4; ++e) { qa[e] = pk2(v[2 * e] * inv, v[2 * e + 1] * inv); qb[e] = pk2(v[8 + 2 * e] * inv, v[8 + 2 * e + 1] * inv); }
            if (m0 + r * NGW < T_) { u32x4* ptr = (u32x4*)(SP + (size_t)(m0 + r * NGW) * 1024 + lane * 16); ptr[0] = oa; ptr[1] = ob; }
        }
    }
}

DI void cmpfinal_phase(PP pp) {
    PPOPAQ();
    int tid = threadIdx.x; asm volatile("" : "+v"(tid));
    const int lane = tid & 63, wave = __builtin_amdgcn_readfirstlane(tid >> 6);
    const int G_ = opaque_s((int)gridDim.x), bx_ = opaque_s((int)blockIdx.x);
    const int gw = bx_ * 8 + wave, NGW = G_ * 8, gtid = bx_ * 512 + tid, NT = G_ * 512;
    (void)lane; (void)wave; (void)gw; (void)NGW; (void)gtid; (void)NT;
    unsigned char* ws = pp->ws; const float* CR = (const float*)(ws + WS_CRAW);
    for (int i = gtid; i < 2 * 4 * 512 * 32; i += NT) { const int d = i & 31, c = (i >> 5) & 511, bg = i >> 14, b = bg >> 2;
        const float* src = CR + ((size_t)bg * 512 + c) * 64; float x1 = src[d], x2 = src[d + 32];
        float o1 = 0.f, o2 = 0.f;
        if (c < 511) { const float pos = (float)pp->pos[b * S_ + 16 * c + 31]; const float inv = fexp2(-(float)d * 0.41524101186092029f); const float ang = pos * inv;
            const double rev = (double)ang * 0.15915494309189535; const float fr = (float)(rev - __builtin_rint(rev));
            const float sn = __builtin_amdgcn_sinf(fr), cs = __builtin_amdgcn_cosf(fr); o1 = x1 * cs - x2 * sn; o2 = x2 * cs + x1 * sn; }
        bf16_t* dst = (bf16_t*)(ws + WS_KCMP) + ((size_t)bg * 512 + c) * 64; dst[d] = (bf16_t)f2bf(o1); dst[d + 32] = (bf16_t)f2bf(o2); }
    for (int i = gtid; i < 2 * 4 * 64 * 512; i += NT) { const int c = i & 511, d = (i >> 9) & 63, bg = i >> 15;
        const float v = (c < 511) ? CR[((size_t)(8 + bg) * 512 + c) * 64 + d] : 0.f;
        ((bf16_t*)(ws + WS_VTCMP))[((size_t)bg * 64 + d) * 512 + c] = (bf16_t)f2bf(v); }
}

constexpr int KSTR = 144, VSTR = 136;
constexpr int L_K = 0, L_V = 2 * 64 * KSTR, L_IMP = L_V + 2 * 64 * VSTR, IMPSTR = 132, L_SEL = L_IMP + 64 * IMPSTR * 4, L_ATT_END = L_SEL + 64 * 16, L_OT = L_ATT_END, L_Q8 = L_OT + 65536, L_ML = L_Q8 + 16384, OSSTR = 272;
DI int crow(int r, int hi) { return (r & 3) + 8 * (r >> 2) + 4 * hi; }

struct TileSrc { const bf16_t* K; int kstr; const bf16_t* Vt; int vstr; };

template <int MODE>
DI void attn_loop(LAS unsigned char* lds, const TileSrc src, int j0, int j1, const bf16x8 (&qf)[4], f32x16 (&o)[2], float& m_run, float& l_run,
                  int tl, int t, int tb, u64 selLo, u64 selHi, int tid, int wave, int lane) {
    const int n = lane & 31, hh = lane >> 5;
    const int lrow = tid >> 3, lchunk = tid & 7;
    u32x4 kreg, vreg;
    kreg = *(const u32x4*)(src.K + (size_t)(64 * j0 + lrow) * src.kstr + lchunk * 8);
    vreg = *(const u32x4*)(src.Vt + (size_t)lrow * src.vstr + 64 * j0 + lchunk * 8);
    float carry = 0.f;
    int buf = 0;
    for (int j = j0; j <= j1; ++j) {
        LAS unsigned char* Kl = lds + L_K + buf * 64 * KSTR; LAS unsigned char* Vl = lds + L_V + buf * 64 * VSTR;
        *(LAS u32x4*)(Kl + lrow * KSTR + lchunk * 16) = kreg;
        *(LAS u32x2*)(Vl + lrow * VSTR + lchunk * 16) = (u32x2){vreg.x, vreg.y}; *(LAS u32x2*)(Vl + lrow * VSTR + lchunk * 16 + 8) = (u32x2){vreg.z, vreg.w};
        __syncthreads();
        if (j < j1) { kreg = *(const u32x4*)(src.K + (size_t)(64 * (j + 1) + lrow) * src.kstr + lchunk * 8);
                      vreg = *(const u32x4*)(src.Vt + (size_t)lrow * src.vstr + 64 * (j + 1) + lchunk * 8); }
        buf ^= 1;
        bool active = true;
        if (MODE == 2) { const bool bit = ((j < 64 ? selLo : selHi) >> (j & 63)) & 1ull; active = __ballot(bit) != 0ull; }
        if (!active) continue;
        f32x16 s[2];
#pragma unroll
        for (int u = 0; u < 2; ++u) {
#pragma unroll
            for (int e = 0; e < 16; ++e) s[u][e] = 0.f;
#pragma unroll
            for (int ks = 0; ks < 4; ++ks) { const bf16x8 kf = *(const LAS bf16x8*)(Kl + (32 * u + n) * KSTR + (ks * 16 + 8 * hh) * 2);
                s[u] = __builtin_amdgcn_mfma_f32_32x32x16_bf16(kf, qf[ks], s[u], 0, 0, 0); }
        }
        const float NEGINF = -__builtin_inff();
        if (MODE <= 1) { const int cmax = min(510, (t - 31) >> 4);
#pragma unroll
            for (int u = 0; u < 2; ++u)
#pragma unroll
                for (int e = 0; e < 16; ++e) { const int c = 64 * j + 32 * u + crow(e, hh); if (c > cmax) s[u][e] = NEGINF; }
        } else if (MODE == 2) { const bool bit = ((j < 64 ? selLo : selHi) >> (j & 63)) & 1ull; const int lim = (j == tb) ? tl : 64;
#pragma unroll
            for (int u = 0; u < 2; ++u)
#pragma unroll
                for (int e = 0; e < 16; ++e) { const int kk = 32 * u + crow(e, hh); if (!bit || kk > lim) s[u][e] = NEGINF; }
        } else {
#pragma unroll
            for (int u = 0; u < 2; ++u)
#pragma unroll
                for (int e = 0; e < 16; ++e) { const int df = t - (64 * j + 32 * u + crow(e, hh)); if ((unsigned)df >= 512u) s[u][e] = NEGINF; }
        }
        if (MODE == 1) {
            const float msafe = (m_run == NEGINF) ? 0.f : m_run;
#pragma unroll
            for (int u = 0; u < 2; ++u)
#pragma unroll
                for (int e = 0; e < 16; ++e) s[u][e] = fexp2(s[u][e] - msafe) * l_run;
            if (tb >= 16) {
                float w1[8], w2[8], pw2[8];
#pragma unroll
                for (int u = 0; u < 2; ++u)
#pragma unroll
                    for (int gi = 0; gi < 4; ++gi) { const float p0 = s[u][4 * gi], p1 = s[u][4 * gi + 1], p2 = s[u][4 * gi + 2], p3 = s[u][4 * gi + 3];
                        w1[u * 4 + gi] = p0 + p1 + p2 + 0.5f * p3; w2[u * 4 + gi] = 0.5f * p3; }
#pragma unroll
                for (int q = 0; q < 8; ++q) pw2[q] = shx(w2[q], 32, lane);
                float tot[8];
#pragma unroll
                for (int q = 0; q < 8; ++q) { const float prev = (q == 0) ? carry : pw2[q > 0 ? q - 1 : 0]; tot[q] = w1[q] + (hh ? pw2[q] : prev); }
                carry = pw2[7];
#pragma unroll
                for (int q = 0; q < 8; ++q) { float v = tot[q]; v += shx(v, 1, lane); v += shx(v, 2, lane); tot[q] = v; }
                if ((n & 3) == 0) { LAS float* imp = (LAS float*)(lds + L_IMP) + (8 * wave + (n >> 2)) * IMPSTR;
#pragma unroll
                    for (int q = 0; q < 8; ++q) { const int jj = 16 * j + 8 * (q >> 2) + 2 * (q & 3) + hh; if (jj < 128) imp[jj] = tot[q]; } }
            }
        } else {
            float mloc = s[0][0];
#pragma unroll
            for (int u = 0; u < 2; ++u)
#pragma unroll
                for (int e = 0; e < 16; ++e) mloc = fmaxf(mloc, s[u][e]);
            mloc = fmaxf(mloc, shx(mloc, 32, lane));
            const float mnew = fmaxf(m_run, mloc); const float msafe = (mnew == NEGINF) ? 0.f : mnew;
            const float alpha = fexp2(m_run - msafe);
            float ls = 0.f;
#pragma unroll
            for (int u = 0; u < 2; ++u)
#pragma unroll
                for (int e = 0; e < 16; ++e) { s[u][e] = fexp2(s[u][e] - msafe); ls += s[u][e]; }
            l_run = l_run * alpha + ls; m_run = mnew;
            if (MODE != 0) {
#pragma unroll
                for (int ds = 0; ds < 2; ++ds)
#pragma unroll
                    for (int e = 0; e < 16; ++e) o[ds][e] *= alpha;
            }
        }
        if (MODE != 0) {
#pragma unroll
            for (int u = 0; u < 2; ++u)
#pragma unroll
                for (int st = 0; st < 2; ++st) {
                    u32x4 pp; pp.x = pk2(s[u][8 * st], s[u][8 * st + 1]); pp.y = pk2(s[u][8 * st + 2], s[u][8 * st + 3]); pp.z = pk2(s[u][8 * st + 4], s[u][8 * st + 5]); pp.w = pk2(s[u][8 * st + 6], s[u][8 * st + 7]);
                    const bf16x8 pb = __builtin_bit_cast(bf16x8, pp);
#pragma unroll
                    for (int ds = 0; ds < 2; ++ds) { const LAS unsigned char* vp = Vl + (32 * ds + n) * VSTR + (32 * u + 16 * st + 4 * hh) * 2;
                        const u32x2 a0 = *(const LAS u32x2*)vp, a1 = *(const LAS u32x2*)(vp + 16);
                        const u32x4 av = {a0.x, a0.y, a1.x, a1.y};
                        o[ds] = __builtin_amdgcn_mfma_f32_32x32x16_bf16(__builtin_bit_cast(bf16x8, av), pb, o[ds], 0, 0, 0); }
                }
        }
    }
    __syncthreads();
}

typedef float f32x4v __attribute__((ext_vector_type(4)));
DI void sel_tile(const u32x4 (&kc)[4], const u32x4 (&vf)[4], int j, LAS unsigned char* OSw, const LAS unsigned char* Q8w, LAS float* MLw, u64 tmLo, u64 tmHi, int tb, int wave, int lane) {
    const int q = lane & 15, quad = lane >> 4, head = q & 3, slot = q >> 2;
    const float NEGINF = -__builtin_inff();
    const bool tbit = (((j < 64 ? tmLo : tmHi) >> (j & 63)) & 1ull) != 0ull && lane < 8;
    unsigned act = (unsigned)__ballot(tbit) & 0xffu;
    while (act != 0u) {
        const int t0 = __builtin_ctz(act); act &= act - 1u;
        int t1 = -1, t2 = -1, t3 = -1;
        if (act != 0u) { t1 = __builtin_ctz(act); act &= act - 1u; }
        if (act != 0u) { t2 = __builtin_ctz(act); act &= act - 1u; }
        if (act != 0u) { t3 = __builtin_ctz(act); act &= act - 1u; }
        const int tsel = slot == 0 ? t0 : (slot == 1 ? t1 : (slot == 2 ? t2 : t3));
        const bool valid = tsel >= 0; const int tk = valid ? tsel : t0; const int rho = 4 * tk + head;
        const long qa = *(const LAS long*)(Q8w + rho * 64 + 8 * quad), qb = *(const LAS long*)(Q8w + rho * 64 + 32 + 8 * quad);
        f32x4v s[4];
#pragma unroll
        for (int sub = 0; sub < 4; ++sub) { s[sub] = (f32x4v){0.f, 0.f, 0.f, 0.f};
            s[sub] = __builtin_amdgcn_mfma_f32_16x16x32_fp8_fp8(mk64(kc[sub].x, kc[sub].y), qa, s[sub], 0, 0, 0);
            s[sub] = __builtin_amdgcn_mfma_f32_16x16x32_fp8_fp8(mk64(kc[sub].z, kc[sub].w), qb, s[sub], 0, 0, 0); }
        if (j == tb) { const int tlk = 8 * wave + tk;
#pragma unroll
            for (int sub = 0; sub < 4; ++sub)
#pragma unroll
                for (int i = 0; i < 4; ++i) { const int kk = 16 * sub + 4 * quad + i; if (kk > tlk) s[sub][i] = NEGINF; } }
        float mloc = fmaxf(fmaxf(s[0][0], s[1][0]), fmaxf(s[2][0], s[3][0]));
#pragma unroll
        for (int i = 1; i < 4; ++i) mloc = fmaxf(mloc, fmaxf(fmaxf(s[0][i], s[1][i]), fmaxf(s[2][i], s[3][i])));
        mloc = fmaxf(mloc, shx(mloc, 16, lane)); mloc = fmaxf(mloc, shx(mloc, 32, lane));
        const float m_old = MLw[rho], l_old = MLw[32 + rho];
        const float mnew = fmaxf(m_old, mloc);
        const float msafe = (mnew == NEGINF) ? 0.f : mnew;
        const float alpha = fexp2(m_old - msafe);
        const float sb = valid ? msafe - 8.0f : __builtin_inff();
        float ls = 0.f;
#pragma unroll
        for (int sub = 0; sub < 4; ++sub)
#pragma unroll
            for (int i = 0; i < 4; ++i) { s[sub][i] = fexp2(s[sub][i] - sb); ls += s[sub][i]; }
        ls += shx(ls, 16, lane); ls += shx(ls, 32, lane);
        if (valid && quad == 0) { MLw[rho] = mnew; MLw[32 + rho] = l_old * alpha + ls; }
        const long pb0 = mk64(pk4_fp8(s[0][0], s[0][1], s[0][2], s[0][3]), pk4_fp8(s[1][0], s[1][1], s[1][2], s[1][3]));
        const long pb1 = mk64(pk4_fp8(s[2][0], s[2][1], s[2][2], s[2][3]), pk4_fp8(s[3][0], s[3][1], s[3][2], s[3][3]));
#pragma unroll
        for (int dsub = 0; dsub < 4; ++dsub) { LAS f32x4v* op = (LAS f32x4v*)(OSw + rho * OSSTR + (16 * dsub + 4 * quad) * 4);
            f32x4v oacc = *op * alpha;
            oacc = __builtin_amdgcn_mfma_f32_16x16x32_fp8_fp8(mk64(vf[dsub].x, vf[dsub].y), pb0, oacc, 0, 0, 0);
            oacc = __builtin_amdgcn_mfma_f32_16x16x32_fp8_fp8(mk64(vf[dsub].z, vf[dsub].w), pb1, oacc, 0, 0, 0);
            if (valid) *op = oacc; }
    }
}
DI int sg_pop(u64& uLo, u64& uHi) {
    int j = -1;
    if (uLo != 0ull) { j = __builtin_ctzll(uLo); uLo &= uLo - 1ull; } else if (uHi != 0ull) { j = 64 + __builtin_ctzll(uHi); uHi &= uHi - 1ull; }
    return j;
}
DI void sel_gather(const unsigned char* __restrict__ KFb, const unsigned char* __restrict__ VFb, u64 uLo, u64 uHi, LAS unsigned char* OSw, const LAS unsigned char* Q8w, LAS float* MLw,
                   u64 tmLo, u64 tmHi, int tb, int wave, int lane) {
    const unsigned char* kp = KFb + lane * 16;
    const unsigned char* vp = VFb + lane * 16;
    u32x4 kb0[4], kb1[4], kb2[4], kb3[4], vb0[4], vb1[4], vb2[4], vb3[4];
#define SG_LOAD(KB, VB, jj) do { _Pragma("unroll") for (int sub = 0; sub < 4; ++sub) { KB[sub] = *(const u32x4*)(kp + (size_t)(((jj) * 4 + sub) * 1024)); VB[sub] = *(const u32x4*)(vp + (size_t)(((jj) * 4 + sub) * 1024)); } } while (0)
#define SG_STEP(KC, VC, KL, VL) { const int j3 = sg_pop(uLo, uHi); { const int j3c = j3 < 0 ? 0 : j3; SG_LOAD(KL, VL, j3c); } sel_tile(KC, VC, j0, OSw, Q8w, MLw, tmLo, tmHi, tb, wave, lane); if (j1 < 0) break; j0 = j1; j1 = j2; j2 = j3; }
    int j0 = sg_pop(uLo, uHi), j1 = sg_pop(uLo, uHi), j2 = sg_pop(uLo, uHi);
    SG_LOAD(kb0, vb0, j0); { const int j1c = j1 < 0 ? 0 : j1, j2c = j2 < 0 ? 0 : j2; SG_LOAD(kb1, vb1, j1c); SG_LOAD(kb2, vb2, j2c); }
    for (;;) {
        SG_STEP(kb0, vb0, kb3, vb3)
        SG_STEP(kb1, vb1, kb0, vb0)
        SG_STEP(kb2, vb2, kb1, vb1)
        SG_STEP(kb3, vb3, kb2, vb2)
    }
#undef SG_LOAD
#undef SG_STEP
}

DI void attn_phase(PP pp, LAS unsigned char* lds, bool do_store) {
    PPOPAQ();
    int tid = threadIdx.x; asm volatile("" : "+v"(tid));
    const int lane = tid & 63, wave = __builtin_amdgcn_readfirstlane(tid >> 6);
    const int G_ = opaque_s((int)gridDim.x), bx_ = opaque_s((int)blockIdx.x);
    const int gw = bx_ * 8 + wave, NGW = G_ * 8, gtid = bx_ * 512 + tid, NT = G_ * 512;
    (void)lane; (void)wave; (void)gw; (void)NGW; (void)gtid; (void)NT;
    unsigned char* ws = pp->ws; bf16_t* PROJ = (bf16_t*)(ws + WS_PROJ);
    const int n = lane & 31, hh = lane >> 5, G = G_;
    for (int it = 0; it < 4; ++it) {
        int tb, bg;
        if (G == 256) { const int kx = bx_ >> 3; bg = bx_ & 7; tb = 127 - (it * 32 + ((it & 1) ? 31 - kx : kx)); }
        else { const int cc = (it & 1) ? (G - 1 - bx_) : bx_; const int rho = it * G + cc; if (rho >= 1024) continue; tb = 127 - (rho >> 3); bg = rho & 7; }
        const int b = bg >> 2, g = bg & 3;
        const int t0 = 64 * tb, tl = 8 * wave + (n >> 2), r = n & 3, t = t0 + tl;
        const size_t trow = (size_t)b * S_ + t;
        bf16_t* qptr = PROJ + trow * LDP + C_Q + (4 * g + r) * 64;
        bf16x8 qf[4];
#pragma unroll
        for (int ks = 0; ks < 4; ++ks) qf[ks] = *(const bf16x8*)(qptr + ks * 16 + 8 * hh);
        f32x16 o[2];
        LAS float* OT = (LAS float*)(lds + L_OT) + wave * 2048 + lane;
        for (int i = tid; i < 64 * IMPSTR; i += 512) ((LAS float*)(lds + L_IMP))[i] = 0.f;
        {
            TileSrc src{(const bf16_t*)(ws + WS_KCMP) + (size_t)bg * 512 * 64, 64, (const bf16_t*)(ws + WS_VTCMP) + (size_t)bg * 64 * 512, 512};
            int nvalid = (t0 + 32) / 16 + 1; if (nvalid > 511) nvalid = 511;
            const int j1 = (nvalid - 1) >> 6;
            float m = -__builtin_inff(), l = 0.f;
            attn_loop<0>(lds, src, 0, j1, qf, o, m, l, tl, t, tb, 0ull, 0ull, tid, wave, lane);
            l += shx(l, 32, lane);
            float inv = 1.0f / fmaxf(l, 1e-30f);
#pragma unroll
            for (int ds = 0; ds < 2; ++ds)
#pragma unroll
                for (int e = 0; e < 16; ++e) o[ds][e] = 0.f;
            attn_loop<1>(lds, src, 0, j1, qf, o, m, inv, tl, t, tb, 0ull, 0ull, tid, wave, lane);
#pragma unroll
            for (int ds = 0; ds < 2; ++ds)
#pragma unroll
                for (int e = 0; e < 16; ++e) OT[(ds * 16 + e) * 64] = o[ds][e];
        }
        {
            const int tok = tid >> 3, prt = tid & 7;
            unsigned mk[4] = {0u, 0u, 0u, 0u};
            if (tb < 16) { mk[0] = (tb == 31) ? 0xffffffffu : ((2u << tb) - 1u); }
            else {
                const LAS float* imp = (const LAS float*)(lds + L_IMP) + tok * IMPSTR + 16 * prt;
                u64 keys[16];
#pragma unroll
                for (int e = 0; e < 16; ++e) { const int j = 16 * prt + e; const unsigned bits = __builtin_bit_cast(unsigned, imp[e]);
                    keys[e] = (j >= 1 && j <= tb - 1) ? (((u64)(bits + 1u) << 32) | (u64)(127 - j)) : 0ull; }
                mk[0] = 1u; mk[tb >> 5] |= 1u << (tb & 31);
                for (int round = 0; round < 14; ++round) {
                    u64 best = keys[0];
#pragma unroll
                    for (int e = 1; e < 16; ++e) best = keys[e] > best ? keys[e] : best;
#pragma unroll
                    for (int o2 = 1; o2 < 8; o2 <<= 1) { const u64 other = shx64(best, o2, lane); best = other > best ? other : best; }
                    if (best != 0ull) { const int jw = 127 - (int)(best & 127ull);
                        mk[0] |= (jw < 32) ? (1u << (jw & 31)) : 0u; mk[1] |= (jw >= 32 && jw < 64) ? (1u << (jw & 31)) : 0u;
                        mk[2] |= (jw >= 64 && jw < 96) ? (1u << (jw & 31)) : 0u; mk[3] |= (jw >= 96) ? (1u << (jw & 31)) : 0u; }
#pragma unroll
                    for (int e = 0; e < 16; ++e) if (keys[e] == best) keys[e] = 0ull;
                }
            }
            if (prt == 0) { LAS unsigned* sm = (LAS unsigned*)(lds + L_SEL) + tok * 4; sm[0] = mk[0]; sm[1] = mk[1]; sm[2] = mk[2]; sm[3] = mk[3]; }
            __syncthreads();
        }
        {
            TileSrc src{PROJ + (size_t)b * S_ * LDP + C_KW + g * 64, LDP, (const bf16_t*)(ws + WS_VTW) + (size_t)bg * 64 * S_, S_};
            float m = -__builtin_inff(), l = 0.f;
#pragma unroll
            for (int ds = 0; ds < 2; ++ds)
#pragma unroll
                for (int e = 0; e < 16; ++e) o[ds][e] = 0.f;
            attn_loop<3>(lds, src, tb >= 8 ? tb - 8 : 0, tb, qf, o, m, l, tl, t, tb, 0ull, 0ull, tid, wave, lane);
            l += shx(l, 32, lane);
            const float f = sigmoidf_(bf2f(PROJ[((size_t)b * S_ + t) * LDP + C_GN + g * 12 + r * 3 + 2])) / (sigmoidf_(bf2f(PROJ[((size_t)b * S_ + t) * LDP + C_GN + g * 12 + r * 3])) * fmaxf(l, 1e-30f));
#pragma unroll
            for (int ds = 0; ds < 2; ++ds)
#pragma unroll
                for (int e = 0; e < 16; ++e) OT[(ds * 16 + e) * 64] += f * o[ds][e];
        }
        __syncthreads();
        {
            u64 uLo = 0ull, uHi = 0ull;
            { const LAS unsigned* sm = (const LAS unsigned*)(lds + L_SEL) + 8 * wave * 4;
#pragma unroll
              for (int i = 0; i < 8; ++i) { uLo |= (u64)sm[4 * i] | ((u64)sm[4 * i + 1] << 32); uHi |= (u64)sm[4 * i + 2] | ((u64)sm[4 * i + 3] << 32); } }
            uLo = ((u64)(unsigned)__builtin_amdgcn_readfirstlane((int)(unsigned)(uLo >> 32)) << 32) | (unsigned)__builtin_amdgcn_readfirstlane((int)(unsigned)uLo);
            uHi = ((u64)(unsigned)__builtin_amdgcn_readfirstlane((int)(unsigned)(uHi >> 32)) << 32) | (unsigned)__builtin_amdgcn_readfirstlane((int)(unsigned)uHi);
            u64 tmLo, tmHi;
            { const LAS unsigned* sm = (const LAS unsigned*)(lds + L_SEL) + (8 * wave + (lane & 7)) * 4; tmLo = (u64)sm[0] | ((u64)sm[1] << 32); tmHi = (u64)sm[2] | ((u64)sm[3] << 32); }
            LAS unsigned char* OSw = lds + wave * (32 * OSSTR); LAS unsigned char* Q8w = lds + L_Q8 + wave * 2048; LAS float* MLw = (LAS float*)(lds + L_ML) + wave * 64;
            for (int i = lane; i < 32 * OSSTR / 4; i += 64) ((LAS float*)OSw)[i] = 0.f;
            MLw[lane] = (lane < 32) ? -__builtin_inff() : 0.f;
#pragma unroll
            for (int ks = 0; ks < 4; ++ks) { const u32x4 w = __builtin_bit_cast(u32x4, qf[ks]);
                *(LAS long*)(Q8w + n * 64 + 16 * ks + 8 * hh) = mk64(pk4_fp8(bflo(w.x), bfhi(w.x), bflo(w.y), bfhi(w.y)), pk4_fp8(bflo(w.z), bfhi(w.z), bflo(w.w), bfhi(w.w))); }
            sel_gather((const unsigned char*)(ws + WS_KF) + (size_t)bg * 128 * 4096, (const unsigned char*)(ws + WS_VTS) + (size_t)bg * 128 * 4096, uLo, uHi, OSw, Q8w, MLw, tmLo, tmHi, tb, wave, lane);
        }
        if (do_store) {
            int ln2 = lane; asm volatile("" : "+v"(ln2));
            const int n2 = ln2 & 31, h2 = ln2 >> 5, t2 = t0 + 8 * wave + (n2 >> 2), r2 = n2 & 3;
            bf16_t* rowp = PROJ + ((size_t)b * S_ + t2) * LDP;
            const float gcv = sigmoidf_(bf2f(rowp[C_GN + g * 12 + r2 * 3]));
            const LAS float* MLw = (const LAS float*)(lds + L_ML) + wave * 64;
            const float fsel = sigmoidf_(bf2f(rowp[C_GN + g * 12 + r2 * 3 + 1])) / fmaxf(MLw[32 + n2], 1e-30f);
            const LAS unsigned char* OSr = lds + wave * (32 * OSSTR) + n2 * OSSTR;
            bf16_t* op = rowp + C_Q + (4 * g + r2) * 64 + 4 * h2;
#pragma unroll
            for (int ds = 0; ds < 2; ++ds)
#pragma unroll
                for (int gi = 0; gi < 4; ++gi) { const f32x4v os = *(const LAS f32x4v*)(OSr + (32 * ds + 8 * gi + 4 * h2) * 4);
                    u32x2 w; w.x = pk2(gcv * OT[(ds * 16 + 4 * gi) * 64] + fsel * os[0], gcv * OT[(ds * 16 + 4 * gi + 1) * 64] + fsel * os[1]);
                    w.y = pk2(gcv * OT[(ds * 16 + 4 * gi + 2) * 64] + fsel * os[2], gcv * OT[(ds * 16 + 4 * gi + 3) * 64] + fsel * os[3]);
                    *(u32x2*)(op + 32 * ds + 8 * gi) = w; }
        }
        __syncthreads();
    }
}

__global__ void __launch_bounds__(512, 2) fwd_megakernel(Params p) {
    extern __shared__ __attribute__((aligned(16))) unsigned char lds_raw[];
    LAS unsigned char* lds = (LAS unsigned char*)lds_raw;
    cg::grid_group grid = cg::this_grid();
    const int G = gridDim.x, bx = blockIdx.x;
    PP pp = (PP)__builtin_amdgcn_kernarg_segment_ptr();
    volatile LAS unsigned* barst = (volatile LAS unsigned*)(lds + L_BARST);
    if (threadIdx.x == 0) { barst[0] = 0u; barst[1] = 0u; (void)xb_add((unsigned*)(pp->ws + WS_BAR) + XB_XCNT(xb_xcc_id()), 1u); }
    __syncthreads();
#define GSYNC() xcd_barrier((unsigned*)(ws + WS_BAR), barst)
#define ws (pp->ws)
#define PROJ ((bf16_t*)(ws + WS_PROJ))
#define H ((bf16_t*)(ws + WS_H))
#define XC ((bf16_t*)(ws + WS_XC))
#define Y ((float*)(ws + WS_RI))
    const int BIG = 1 << 30;

#ifndef NO_PREP
    prep_phase(pp, 0, lds);
#endif
#ifndef NO_ROW
    row_phase(pp->x, nullptr, nullptr, nullptr, pp->ln_mix_pre, H);
#endif
    grid.sync();

    for (int l = 0; l < NLAYER; ++l) {
        PPOPAQ();
        using pg8::Gemm; using pg8::Sched; using pg8::EpiBf16; using pg8::EpiF32; using pg8::EpiMerge;
        cbias_phase(pp, l);
#ifndef NO_G1
        for (int r_ = 0; r_ < opaque_s(GREP); ++r_) {
        pg8::gemm_phase<EpiBf16>(lds, Gemm{H, (const bf16_t*)(ws + WS_WIN), 1024, 1024, 1024, 128, 128},
            Sched{64, 35, opaque_s(G), opaque_s(bx), 0, BIG, 0u, 256u * 1024 * 2, 0u, 0u, 256u * 1024 * 2, 0u}, EpiBf16{PROJ, LDP, 0, 1.0f, nullptr, 0});
        pg8::gemm_phase<EpiBf16>(lds, Gemm{(const bf16_t*)(ws + WS_MEMN), (const bf16_t*)(ws + WS_WMKV), 1024, 1024, 1024, 128, 128},
            Sched{2, 4, opaque_s(G), (opaque_s(bx) + 64) % opaque_s(G), 0, BIG, 0u, 256u * 1024 * 2, 0u, 0u, 256u * 1024 * 2, 0u}, EpiBf16{(bf16_t*)(ws + WS_KMEM), 1024, 0, 1.0f, nullptr, 0});
        pg8::gemm_phase<EpiBf16>(lds, Gemm{(const bf16_t*)(ws + WS_WMKV) + (size_t)1024 * 1024, (const bf16_t*)(ws + WS_MEMN), 1024, 1024, 1024, 128, 128},
            Sched{4, 2, opaque_s(G), (opaque_s(bx) + 48) % opaque_s(G), 0, BIG, 0u, 256u * 1024 * 2, 0u, 0u, 256u * 1024 * 2, 0u}, EpiBf16{(bf16_t*)(ws + WS_VTMEM), 512, 0, 1.0f, nullptr, 0});
        }
#endif
        GSYNC();
#ifndef NO_POST
        postproj_phase(pp, l);
#endif
#ifndef NO_G1
        if (opaque_s(G) == 256) {
        pg8::gemm_phase<EpiBf16>(lds, Gemm{PROJ, (const bf16_t*)(ws + WS_WC1), 16 * LDP, 2048, 2048, LDP * 2, 128},
            Sched{32, 1, opaque_s(G), opaque_s(bx), 1, BIG, 0u, 0u, 0u, 0u, 0u, 0u}, EpiBf16{(bf16_t*)(ws + WS_HID), 256, 2, 1.0f, (const float*)(ws + WS_CBIAS), 0});
        }
#endif
        GSYNC();
#ifndef NO_G1
        for (int r_ = 0; r_ < opaque_s(GREP); ++r_) {
        if (opaque_s(G) != 256) {
        pg8::gemm_phase<EpiBf16>(lds, Gemm{PROJ, (const bf16_t*)(ws + WS_WC1), 16 * LDP, 2048, 2048, LDP * 2, 128},
            Sched{32, 1, opaque_s(G), opaque_s(bx), 1, BIG, 0u, 0u, 0u, 0u, 0u, 0u}, EpiBf16{(bf16_t*)(ws + WS_HID), 256, 2, 1.0f, (const float*)(ws + WS_CBIAS), 0});
        }
        const int G224 = opaque_s(G), c224 = opaque_s(bx);
        pg8::gemm_phase<EpiBf16>(lds, Gemm{XC, (const bf16_t*)(ws + WS_WLRU), 1024, 128, 128, 128, 128},
            Sched{64, 8, G224, c224, 0, BIG, 0u, 256u * 1024 * 2, 128u * 2, 0u, 256u * 128 * 2, 0u}, EpiBf16{(bf16_t*)(ws + WS_RI), 2048, 0, 1.0f, nullptr, 0});
        pg8::gemm_phase<EpiBf16>(lds, Gemm{PROJ, (const bf16_t*)(ws + WS_KMEM), LDP, 1024, 256, 128, 128},
            Sched{64, 4, G224, c224, 0, 32, (unsigned)C_QM * 2, 256u * LDP * 2, 256u * 2, 0u, 256u * 2, 256u * 1024 * 2}, EpiBf16{H, 1024, 0, 0.0625f * LOG2E, nullptr, 0});
        }
#endif
        GSYNC();
#ifndef NO_SCAN
        scan_phase(pp, l, 0);
#if defined(DUP_SCAN0)
        scan_phase(pp, l, 0);
#endif
#endif
#ifndef NO_MSM
        memsoftmax_phase(pp);
#endif
#ifndef NO_G2
        for (int r_ = 0; r_ < opaque_s(GREP); ++r_) {
        pg8::gemm_phase<EpiF32>(lds, Gemm{(const bf16_t*)(ws + WS_HID), (const bf16_t*)(ws + WS_WC2), 256, 256, 256, 128, 128},
            Sched{32, 1, opaque_s(G), (opaque_s(bx) + 96) % opaque_s(G), 0, 16, 0u, 256u * 256 * 2, 0u, 0u, 0u, 256u * 256 * 2}, EpiF32{(float*)(ws + WS_CRAW), 64, 64});
        }
#endif
        GSYNC();
#ifndef NO_SCAN
        scan_phase(pp, l, 1);
#endif
#ifndef NO_CMPF
        cmpfinal_phase(pp);
#endif
#ifndef NO_G1
        for (int r_ = 0; r_ < opaque_s(GREP); ++r_) {
        pg8::gemm_phase<EpiBf16>(lds, Gemm{H, (const bf16_t*)(ws + WS_VTMEM), 1024, 512, 256, 128, 128},
            Sched{64, 4, opaque_s(G), opaque_s(bx), 0, 32, 0u, 256u * 1024 * 2, 256u * 2, 0u, 256u * 512 * 2, 256u * 2}, EpiBf16{PROJ, LDP, 0, 1.0f, nullptr, C_QM});
        }
#endif
        GSYNC();
#ifndef NO_ATT
#if defined(DUP_ATT)
        attn_phase(pp, lds, opaque_s(0) != 0);
        __syncthreads();
#endif
        attn_phase(pp, lds, true);
#endif
        GSYNC();
#ifndef NO_G3
        for (int r_ = 0; r_ < opaque_s(GREP); ++r_) {
        pg8::gemm_phase<EpiMerge>(lds, Gemm{XC, (const bf16_t*)(ws + WS_WBRA), 1024, 1024, 1024, 128, 128},
            Sched{64, 4, opaque_s(G), opaque_s(bx), 0, BIG, 0u, 256u * 1024 * 2, 0u, 0u, 256u * 1024 * 2, 0u}, EpiMerge{PROJ + C_GM, LDP, Y, H, 0});
        pg8::gemm_phase<EpiMerge>(lds, Gemm{PROJ + C_Q, (const bf16_t*)(ws + WS_WBRB), LDP, 1024, 1024, 128, 128},
            Sched{64, 4, opaque_s(G), opaque_s(bx), 0, BIG, 0u, 256u * LDP * 2, 0u, 0u, 256u * 1024 * 2, 0u}, EpiMerge{PROJ + C_GM + 1024, LDP, Y, H, 1});
        pg8::gemm_phase<EpiMerge>(lds, Gemm{PROJ + C_QM, (const bf16_t*)(ws + WS_WBRC), LDP, 1024, 1024, 128, 128},
            Sched{64, 4, opaque_s(G), opaque_s(bx), 0, BIG, 0u, 256u * LDP * 2, 0u, 0u, 256u * 1024 * 2, 0u}, EpiMerge{PROJ + C_GM + 2048, LDP, Y, H, 2});
        }
#endif
        GSYNC();
#ifndef NO_G2
        for (int r_ = 0; r_ < opaque_s(GREP); ++r_) {
        pg8::gemm_phase<EpiF32>(lds, Gemm{H, (const bf16_t*)(ws + WS_WOUT), 1024, 1024, 1024, 128, 128},
            Sched{64, 4, opaque_s(G), opaque_s(bx), 0, BIG, 0u, 256u * 1024 * 2, 0u, 0u, 256u * 1024 * 2, 0u}, EpiF32{Y, 1024, 1024});
        }
#endif
        GSYNC();
#ifndef NO_ROW
        row_phase((l == 0) ? pp->x : pp->out, Y, pp->ln_mix_post + (size_t)l * 1024, pp->out, pp->ln_mlp_pre + (size_t)l * 1024, H);
#endif
        GSYNC();
#ifndef NO_G1
        for (int r_ = 0; r_ < opaque_s(GREP); ++r_) {
        pg8::gemm_phase<EpiBf16>(lds, Gemm{H, (const bf16_t*)(ws + WS_WM1), 1024, 1024, 1024, 128, 128},
            Sched{64, 16, opaque_s(G), opaque_s(bx), 0, BIG, 0u, 256u * 1024 * 2, 0u, 0u, 256u * 1024 * 2, 0u}, EpiBf16{PROJ, FF_, 1, 1.0f, nullptr, 0});
        }
#endif
        GSYNC();
#ifndef NO_G2
        for (int r_ = 0; r_ < opaque_s(GREP); ++r_) {
        pg8::gemm_phase<EpiF32>(lds, Gemm{PROJ, (const bf16_t*)(ws + WS_WM2), FF_, FF_, FF_, 128, 128},
            Sched{64, 4, opaque_s(G), opaque_s(bx), 0, BIG, 0u, 256u * FF_ * 2, 0u, 0u, 256u * FF_ * 2, 0u}, EpiF32{Y, 1024, 1024});
        }
#endif
        GSYNC();
#ifndef NO_ROW
        row_phase(pp->out, Y, pp->ln_mlp_post + (size_t)l * 1024, pp->out, (l + 1 < NLAYER) ? pp->ln_mix_pre + (size_t)(l + 1) * 1024 : nullptr, (l + 1 < NLAYER) ? H : nullptr);
#endif
#ifndef NO_PREP
        if (l + 1 < NLAYER) prep_phase(pp, l + 1, lds);
#if defined(DUP_PREP)
        if (l + 1 < NLAYER) prep_phase(pp, l + 1, lds);
#endif
#endif
        GSYNC();
    }
#undef ws
#undef PROJ
#undef H
#undef XC
#undef Y
}

extern "C" void kernel_launch(void* const* d_in, const int* in_sizes, int n_in, void* d_out, int out_size, void* d_ws, size_t ws_size, hipStream_t stream) {
    static int grid = 0;
    if (grid == 0) {
        int dev = 0, cus = 0, per_cu = 0;
        hipGetDevice(&dev); hipDeviceGetAttribute(&cus, hipDeviceAttributeMultiprocessorCount, dev);
        hipFuncSetAttribute((const void*)fwd_megakernel, hipFuncAttributeMaxDynamicSharedMemorySize, LDS_BYTES);
        hipOccupancyMaxActiveBlocksPerMultiprocessor(&per_cu, (const void*)fwd_megakernel, 512, LDS_BYTES);
        if (per_cu < 1) per_cu = 1;
        (void)hipGetLastError();
        grid = cus * 1;
        if (ws_size < WS_END) { fprintf(stderr, "kernel_launch: workspace too small (%zu < %zu)\n", ws_size, (size_t)WS_END); grid = -1; }
    }
    if (grid < 0) return;
    Params p{};
    p.x = (const float*)d_in[0]; p.mem = (const float*)d_in[1]; p.pos = (const int*)d_in[2];
    p.ln_mix_pre = (const float*)d_in[3]; p.w_in = (const float*)d_in[4]; p.conv_w = (const float*)d_in[5]; p.conv_b = (const float*)d_in[6];
    p.lru_wr = (const float*)d_in[7]; p.lru_br = (const float*)d_in[8]; p.lru_wi = (const float*)d_in[9]; p.lru_bi = (const float*)d_in[10]; p.lru_lambda = (const float*)d_in[11];
    p.cmp_pe = (const float*)d_in[12]; p.cmp_w1 = (const float*)d_in[13]; p.cmp_b1 = (const float*)d_in[14]; p.cmp_w2 = (const float*)d_in[15];
    p.ln_mem = (const float*)d_in[16]; p.w_mem_kv = (const float*)d_in[17]; p.w_br_rnn = (const float*)d_in[18]; p.w_br_nsa = (const float*)d_in[19]; p.w_br_mem = (const float*)d_in[20]; p.w_out = (const float*)d_in[21];
    p.ln_mix_post = (const float*)d_in[22]; p.ln_mlp_pre = (const float*)d_in[23]; p.mlp_w1 = (const float*)d_in[24]; p.mlp_w2 = (const float*)d_in[25]; p.ln_mlp_post = (const float*)d_in[26];
    p.out = (float*)d_out; p.ws = (unsigned char*)d_ws;
    (void)hipMemsetAsync((unsigned char*)d_ws + WS_BAR, 0, 16384, stream);
    void* args[] = {&p};
    hipError_t e = hipLaunchCooperativeKernel((const void*)fwd_megakernel, dim3(grid), dim3(512), args, LDS_BYTES, stream);
    if (e != hipSuccess) fprintf(stderr, "cooperative launch failed: %s (grid %d)\n", hipGetErrorString(e), grid);
}
```

```cpp
#include <hip/hip_runtime.h>
#include <hip/hip_cooperative_groups.h>
#include <cstdint>
#include <cstdio>
namespace cg = cooperative_groups;

#define LAS __attribute__((address_space(3)))
#define DI __device__ __forceinline__
typedef unsigned short bf16_t;
typedef short bf16x8 __attribute__((ext_vector_type(8)));
typedef short s16x4 __attribute__((ext_vector_type(4)));
typedef float f32x4 __attribute__((ext_vector_type(4)));
typedef float f32x16 __attribute__((ext_vector_type(16)));
typedef float f32x2 __attribute__((ext_vector_type(2)));
typedef unsigned u32x4 __attribute__((ext_vector_type(4)));
typedef unsigned u32x2 __attribute__((ext_vector_type(2)));
typedef __bf16 bf16x2v __attribute__((ext_vector_type(2)));
typedef unsigned long long u64;

constexpr int T_ = 16384, S_ = 8192, D_ = 1024, FF_ = 4096, LDP = 8960, NLAYER = 4;
constexpr int C_XR = 0, C_YR = 1024, C_Q = 2048, C_KC = 3072, C_VC = 3328, C_KS = 3584, C_VS = 3840, C_KW = 4096, C_VW = 4352,
              C_QM = 4608, C_GM = 5632, C_GN = 8704;
constexpr float EPS = 1e-6f;
constexpr float LOG2E = 1.4426950408889634f;

constexpr size_t al256(size_t x) { return (x + 255) & ~(size_t)255; }
constexpr size_t WS_PROJ = 0;
constexpr size_t WS_WIN = al256(WS_PROJ + (size_t)(T_ + 64) * LDP * 2);
constexpr size_t WS_WMKV = WS_WIN + (size_t)LDP * 1024 * 2;
constexpr size_t WS_WBRA = WS_WMKV + (size_t)2048 * 1024 * 2;
constexpr size_t WS_WBRB = WS_WBRA + (size_t)1024 * 1024 * 2;
constexpr size_t WS_WBRC = WS_WBRB + (size_t)1024 * 1024 * 2;
constexpr size_t WS_WOUT = WS_WBRC + (size_t)1024 * 1024 * 2;
constexpr size_t WS_WM1 = WS_WOUT + (size_t)1024 * 1024 * 2;
constexpr size_t WS_WM2 = WS_WM1 + (size_t)4096 * 1024 * 2;
constexpr size_t WS_WC1 = WS_WM2 + (size_t)4096 * 1024 * 2;
constexpr size_t WS_WC2 = WS_WC1 + (size_t)2 * 256 * 2048 * 2;
constexpr size_t WS_WLRU = WS_WC2 + (size_t)2 * 256 * 256 * 2;
constexpr size_t WS_H = WS_WLRU + (size_t)2048 * 128 * 2;
constexpr size_t WS_VTS = WS_H + (size_t)T_ * 1024 * 2;
constexpr size_t WS_VTW = WS_VTS + (size_t)8 * 64 * S_ * 2;
constexpr size_t WS_XC = WS_VTW + (size_t)8 * 64 * S_ * 2;
constexpr size_t WS_RI = WS_XC + (size_t)T_ * 1024 * 2;
constexpr size_t WS_HID = WS_RI + (size_t)T_ * 2048 * 2;
constexpr size_t WS_CRAW = WS_HID + (size_t)8192 * 256 * 2;
constexpr size_t WS_KCMP = WS_CRAW + (size_t)8192 * 64 * 4;
constexpr size_t WS_VTCMP = WS_KCMP + (size_t)8 * 512 * 64 * 2;
constexpr size_t WS_MEMN = WS_VTCMP + (size_t)8 * 512 * 64 * 2;
constexpr size_t WS_KMEM = WS_MEMN + (size_t)512 * 1024 * 2;
constexpr size_t WS_VTMEM = WS_KMEM + (size_t)512 * 1024 * 2;
constexpr size_t WS_SCA = WS_VTMEM + (size_t)512 * 1024 * 2;
constexpr size_t WS_SCH = WS_SCA + (size_t)2 * 128 * 1024 * 4;
constexpr size_t WS_CBP = WS_SCH + (size_t)2 * 128 * 1024 * 4;
constexpr size_t WS_CBIAS = WS_CBP + (size_t)16 * 512 * 4;
constexpr size_t WS_KF = al256(WS_CBIAS + 512 * 4);
constexpr size_t WS_BAR = WS_KF + (size_t)8 * 64 * S_ * 2;
constexpr size_t WS_END = WS_BAR + 16384;
constexpr int L_BARST = 155584;

#ifndef GREP
#define GREP 1
#endif
constexpr int LDS_BYTES = 155648;

DI unsigned f2bf(float f) { unsigned u = __builtin_bit_cast(unsigned, f); return (u + 0x7fffu + ((u >> 16) & 1u)) >> 16; }
DI unsigned pk2(float lo, float hi) { f32x2 f = {lo, hi}; bf16x2v r = __builtin_convertvector(f, bf16x2v); return __builtin_bit_cast(unsigned, r); }
DI float bf2f(unsigned short b) { return __builtin_bit_cast(float, (unsigned)b << 16); }
DI float bflo(unsigned w) { return __builtin_bit_cast(float, w << 16); }
DI float bfhi(unsigned w) { return __builtin_bit_cast(float, w & 0xffff0000u); }
DI float fexp2(float x) { return __builtin_amdgcn_exp2f(x); }
DI float sigmoidf_(float x) { return 1.0f / (1.0f + fexp2(-x * LOG2E)); }
DI float gelu_tanh(float x) { const float z = 0.7978845608028654f * (x + 0.044715f * x * x * x); return x / (1.0f + fexp2(-2.0f * LOG2E * z)); }
DI float shx(float v, int mask, int lane) { return __builtin_bit_cast(float, __builtin_amdgcn_ds_bpermute((lane ^ mask) << 2, __builtin_bit_cast(int, v))); }
DI u64 shx64(u64 v, int mask, int lane) { const int a = (lane ^ mask) << 2; const unsigned lo = (unsigned)__builtin_amdgcn_ds_bpermute(a, (int)(unsigned)v), hi = (unsigned)__builtin_amdgcn_ds_bpermute(a, (int)(unsigned)(v >> 32)); return ((u64)hi << 32) | lo; }
DI unsigned pk4_fp8(float a, float b, float c, float d) { int w = 0; w = __builtin_amdgcn_cvt_pk_fp8_f32(a, b, w, false); w = __builtin_amdgcn_cvt_pk_fp8_f32(c, d, w, true); return (unsigned)w; }
DI long mk64(unsigned lo, unsigned hi) { return (long)(((u64)hi << 32) | (u64)lo); }
DI int opaque_s(int v) { asm volatile("" : "+s"(v)); return v; }
DI float wave_sum(float v, int lane) {
#pragma unroll
    for (int o = 1; o < 64; o <<= 1) v += shx(v, o, lane);
    return v;
}

namespace pg8 {
constexpr int BM = 256, BK = 64, HALF = 128, HTB = HALF * BK * 2, STAGE_BYTES = 8 * HTB, NXCD = 8, WGM = 8;
__host__ __device__ __forceinline__ int lds_byte(int r, int c) { const int st = (r >> 4) * 2 + (c >> 5), rr = r & 15, cc = c & 31, ob = rr * 64 + cc * 2; return st * 1024 + (ob ^ (((ob >> 9) & 1) << 5)); }
__host__ __device__ __forceinline__ void stage_rc(int b, int& R, int& C) { const int st = b / 1024, sb = b % 1024, swz = sb ^ (((sb >> 9) & 1) << 5); R = (st >> 1) * 16 + swz / 64; C = (st & 1) * 32 + (swz % 64) / 2; }
__host__ __device__ __forceinline__ int perm32(int rho) { const int n = rho >> 4, i = rho & 15; return 8 * (i >> 2) + 4 * n + (i & 3); }

struct Unit { int pm, pn; unsigned aoff, boff; };
struct Gemm { const bf16_t* A; const bf16_t* Bt; int lda, ldb, K, kstepA, kstepB; };

struct Sched {
    int nM, nN, G, c, kind, mdiv; unsigned a0, sAm, sAn, b0, sBn, sBb;
    DI bool next(int i, Unit& u) const {
        const long L = (long)i * G + c; const int nwg = nM * nN; if (L >= nwg) return false;
        int wgid = (int)L; { const int q = nwg / NXCD, r = nwg % NXCD, xcd = wgid % NXCD, off = wgid / NXCD; wgid = (xcd < r ? xcd * (q + 1) : r * (q + 1) + (xcd - r) * q) + off; }
        const int nig = WGM * nN, gid = wgid / nig, fm = gid * WGM, gsz = (nM - fm) < WGM ? (nM - fm) : WGM;
        const int pm = fm + ((wgid % nig) % gsz), pn = (wgid % nig) / gsz;
        u.pm = pm; u.pn = pn;
        if (kind == 1) {
            const int j = pm >> 4, b = (pm >> 3) & 1, g = (pm >> 1) & 3, ch = pm & 1;
            u.aoff = (unsigned)(((b * S_ + ch * 4096) * LDP + C_KC + j * 256 + g * 64) * 2); u.boff = (unsigned)(j * 256 * 2048 * 2);
        } else { const unsigned bb = (unsigned)(pm / mdiv); u.aoff = a0 + (unsigned)pm * sAm + (unsigned)pn * sAn; u.boff = b0 + (unsigned)pn * sBn + bb * sBb; }
        return true;
    }
};

DI unsigned cvt_pk_bf16(float lo, float hi) { return pk2(lo, hi); }

struct EpiBf16 {
    static constexpr bool PERM = true;
    bf16_t* O; int ldc; int act; float scale; const float* bias; int oc0;
    DI void operator()(const f32x4 (&acc)[2][2][4][2], const Unit& u, int wr, int wc, int fr, int fq) const {
        const int row0 = u.pm * 256 + wr * 64 + fr, col0 = oc0 + u.pn * 256 + wc * 32 + 8 * fq, bc0 = (u.pm >> 4) * 256 + wc * 32 + 8 * fq;
#pragma unroll
        for (int ai = 0; ai < 2; ++ai)
#pragma unroll
            for (int m = 0; m < 4; ++m) { bf16_t* rowp = O + (size_t)(row0 + ai * HALF + m * 16) * ldc + col0;
#pragma unroll
                for (int bj = 0; bj < 2; ++bj) { f32x4 v0 = acc[ai][bj][m][0], v1 = acc[ai][bj][m][1];
                    if (act == 0) { v0 = v0 * scale; v1 = v1 * scale; }
                    else if (act == 1) {
#pragma unroll
                        for (int e = 0; e < 4; ++e) { const float a = fmaxf(v0[e], 0.f), b = fmaxf(v1[e], 0.f); v0[e] = a * a; v1[e] = b * b; } }
                    else { const f32x4 b0 = *(const f32x4*)(bias + bc0 + bj * HALF), b1 = *(const f32x4*)(bias + bc0 + bj * HALF + 4);
#pragma unroll
                        for (int e = 0; e < 4; ++e) { v0[e] = gelu_tanh(v0[e] + b0[e]); v1[e] = gelu_tanh(v1[e] + b1[e]); } }
                    u32x4 w; w.x = cvt_pk_bf16(v0[0], v0[1]); w.y = cvt_pk_bf16(v0[2], v0[3]); w.z = cvt_pk_bf16(v1[0], v1[1]); w.w = cvt_pk_bf16(v1[2], v1[3]);
                    *(u32x4*)(rowp + bj * HALF) = w; } }
    }
};
struct EpiF32 {
    static constexpr bool PERM = false;
    float* O; int ldc; int ncol;
    DI void operator()(const f32x4 (&acc)[2][2][4][2], const Unit& u, int wr, int wc, int fr, int fq) const {
        const int row0 = u.pm * 256 + wr * 64 + fr, col0 = u.pn * 256 + wc * 32 + 4 * fq;
#pragma unroll
        for (int ai = 0; ai < 2; ++ai)
#pragma unroll
            for (int m = 0; m < 4; ++m) { float* rowp = O + (size_t)(row0 + ai * HALF + m * 16) * ldc;
#pragma unroll
                for (int bj = 0; bj < 2; ++bj)
#pragma unroll
                    for (int n = 0; n < 2; ++n) { const int c = col0 + bj * HALF + n * 16; if (c < ncol) *(f32x4*)(rowp + c) = acc[ai][bj][m][n]; } }
    }
};
struct EpiMerge {
    static constexpr bool PERM = false;
    const bf16_t* gate; int ldg; float* M; bf16_t* Hout; int mode;
    DI void operator()(const f32x4 (&acc)[2][2][4][2], const Unit& u, int wr, int wc, int fr, int fq) const {
        const int row0 = u.pm * 256 + wr * 64 + fr, col0 = u.pn * 256 + wc * 32 + 4 * fq;
#pragma unroll
        for (int ai = 0; ai < 2; ++ai)
#pragma unroll
            for (int m = 0; m < 4; ++m) { const size_t r = (size_t)(row0 + ai * HALF + m * 16);
#pragma unroll
                for (int bj = 0; bj < 2; ++bj)
#pragma unroll
                    for (int n = 0; n < 2; ++n) { const int c = col0 + bj * HALF + n * 16;
                        const u32x2 gw = *(const u32x2*)(gate + r * ldg + c);
                        f32x4 g; g[0] = sigmoidf_(bflo(gw.x)); g[1] = sigmoidf_(bfhi(gw.x)); g[2] = sigmoidf_(bflo(gw.y)); g[3] = sigmoidf_(bfhi(gw.y));
                        f32x4 v = acc[ai][bj][m][n] * g;
                        float* mp = M + r * 1024 + c;
                        if (mode != 0) v = v + *(const f32x4*)mp;
                        if (mode != 2) *(f32x4*)mp = v;
                        else { u32x2 w; w.x = cvt_pk_bf16(v[0], v[1]); w.y = cvt_pk_bf16(v[2], v[3]); *(u32x2*)(Hout + r * 1024 + c) = w; } } }
    }
};

template <class Epi>
DI void gemm_phase(LAS unsigned char* lds, const Gemm g, const Sched& S, const Epi& E) {
    int tid = threadIdx.x; asm volatile("" : "+v"(tid));
    const int wid = __builtin_amdgcn_readfirstlane(tid >> 6), lane = tid & 63, wr = wid >> 2, wc = wid & 3, fr = lane & 15, fq = lane >> 4;
    const int nt = opaque_s(g.K / BK);
    unsigned voffA[2], voffB[2];
#pragma unroll
    for (int i = 0; i < 2; ++i) { int R, C; stage_rc(tid * 16 + i * 8192, R, C); const int Rb = Epi::PERM ? ((R & ~31) + perm32(R & 31)) : R;
        voffA[i] = (unsigned)(R * g.lda + C) * 2u; voffB[i] = (unsigned)(Rb * g.ldb + C) * 2u; }
    const size_t kstepA = (size_t)g.kstepA, kstepB = (size_t)g.kstepB;
    const size_t hstepA = (size_t)HALF * g.lda * 2, hstepB = (size_t)HALF * g.ldb * 2;
    const unsigned ldsw = (unsigned)wid * 1024u;
    const int aoff = lds_byte(wr * 64 + fr, fq * 8), boff = lds_byte(wc * 32 + fr, fq * 8);
#define PG8_SA(b, h) (((b) * 2 + (h)) * HTB)
#define PG8_SB(b, h) ((4 + (b) * 2 + (h)) * HTB)
#define PG8_STAGE(bufoff, gbase, voff) do { _Pragma("unroll") for (int _i = 0; _i < 2; ++_i) \
        __builtin_amdgcn_global_load_lds((const unsigned*)((const char*)(gbase) + (voff)[_i]), (LAS unsigned*)(lds + (bufoff) + ldsw + _i * 8192), 16, 0, 0); } while (0)
#define PG8_LDA(dst, b, h) do { _Pragma("unroll") for (int m = 0; m < 4; ++m) _Pragma("unroll") for (int k = 0; k < 2; ++k) dst[m][k] = *(const LAS bf16x8*)(lds + PG8_SA(b, h) + aoff + m * 2048 + k * 1024); } while (0)
#define PG8_LDB(dst, b, h) do { _Pragma("unroll") for (int n = 0; n < 2; ++n) _Pragma("unroll") for (int k = 0; k < 2; ++k) dst[n][k] = *(const LAS bf16x8*)(lds + PG8_SB(b, h) + boff + n * 2048 + k * 1024); } while (0)
#define PG8_MMA(ai, bj, At, Bt) do { __builtin_amdgcn_s_setprio(1); _Pragma("unroll") for (int m = 0; m < 4; ++m) _Pragma("unroll") for (int n = 0; n < 2; ++n) _Pragma("unroll") for (int k = 0; k < 2; ++k) \
        acc[ai][bj][m][n] = __builtin_amdgcn_mfma_f32_16x16x32_bf16(Bt[n][k], At[m][k], acc[ai][bj][m][n], 0, 0, 0); __builtin_amdgcn_s_setprio(0); } while (0)
#define PG8_WAIT_V(n) asm volatile("s_waitcnt vmcnt(" #n ")" ::: "memory")
#define PG8_WAIT_L(n) asm volatile("s_waitcnt lgkmcnt(" #n ")" ::: "memory")
#define PG8_BAR __builtin_amdgcn_s_barrier()
#define PG8_SCHED __builtin_amdgcn_sched_barrier(0)
    Unit cur, nxt; int ui = 0;
    if (!S.next(0, cur)) return;
    f32x4 acc[2][2][4][2];
#pragma unroll
    for (int a = 0; a < 2; ++a)
#pragma unroll
        for (int b = 0; b < 2; ++b)
#pragma unroll
            for (int m = 0; m < 4; ++m)
#pragma unroll
                for (int n = 0; n < 2; ++n) acc[a][b][m][n] = (f32x4){0.f, 0.f, 0.f, 0.f};
    bf16x8 At[4][2], B0[2][2], B1[2][2];
    const char* cA = (const char*)g.A + cur.aoff; const char* cB = (const char*)g.Bt + cur.boff;
    PG8_STAGE(PG8_SB(0, 0), cB, voffB); PG8_STAGE(PG8_SB(0, 1), cB + hstepB, voffB); PG8_STAGE(PG8_SA(0, 0), cA, voffA); PG8_STAGE(PG8_SA(0, 1), cA + hstepA, voffA);
    if (wr == 1) PG8_BAR;
    PG8_WAIT_V(2); PG8_BAR;
    PG8_STAGE(PG8_SB(1, 0), cB + kstepB, voffB); PG8_STAGE(PG8_SA(1, 0), cA + kstepA, voffA); PG8_STAGE(PG8_SB(1, 1), cB + hstepB + kstepB, voffB);
    PG8_WAIT_V(6); PG8_BAR;
    for (;;) {
        const bool has_next = S.next(ui + 1, nxt);
        const char* nA = has_next ? (const char*)g.A + nxt.aoff : cA; const char* nB = has_next ? (const char*)g.Bt + nxt.boff : cB;
        for (int t = 0; t < nt; t += 2) {
            const bool last = (t == nt - 2);
            const char* a1 = cA + (size_t)(t + 1) * kstepA;
            const char* a2 = last ? nA : cA + (size_t)(t + 2) * kstepA; const char* b2 = last ? nB : cB + (size_t)(t + 2) * kstepB;
            const char* a3 = a2 + kstepA; const char* b3 = b2 + kstepB;
            PG8_LDB(B0, 0, 0); PG8_LDB(B1, 0, 1); PG8_SCHED; PG8_LDA(At, 0, 0); PG8_STAGE(PG8_SA(1, 1), a1 + hstepA, voffA);
            PG8_WAIT_V(8); PG8_WAIT_L(0); PG8_BAR; PG8_MMA(0, 0, At, B0); PG8_MMA(0, 1, At, B1); PG8_BAR; PG8_SCHED;
            PG8_LDA(At, 0, 1); PG8_STAGE(PG8_SB(0, 0), b2, voffB); PG8_STAGE(PG8_SB(0, 1), b2 + hstepB, voffB); PG8_STAGE(PG8_SA(0, 0), a2, voffA);
            PG8_WAIT_V(8); PG8_WAIT_L(0); PG8_BAR; PG8_MMA(1, 0, At, B0); PG8_MMA(1, 1, At, B1); PG8_BAR; PG8_SCHED;
            PG8_LDB(B0, 1, 0); PG8_LDB(B1, 1, 1); PG8_SCHED; PG8_LDA(At, 1, 0); PG8_STAGE(PG8_SA(0, 1), a2 + hstepA, voffA);
            PG8_WAIT_V(8); PG8_WAIT_L(0); PG8_BAR; PG8_MMA(0, 0, At, B0); PG8_MMA(0, 1, At, B1); PG8_BAR; PG8_SCHED;
            PG8_LDA(At, 1, 1); PG8_STAGE(PG8_SB(1, 0), b3, voffB); PG8_STAGE(PG8_SB(1, 1), b3 + hstepB, voffB); PG8_STAGE(PG8_SA(1, 0), a3, voffA);
            PG8_WAIT_V(8); PG8_WAIT_L(0); PG8_BAR; PG8_MMA(1, 0, At, B0); PG8_MMA(1, 1, At, B1); PG8_BAR; PG8_SCHED;
        }
        if (wr == 0) PG8_BAR;
        E(acc, cur, wr, wc, fr, fq);
        if (!has_next) break;
#pragma unroll
        for (int a = 0; a < 2; ++a)
#pragma unroll
            for (int b = 0; b < 2; ++b)
#pragma unroll
                for (int m = 0; m < 4; ++m)
#pragma unroll
                    for (int n = 0; n < 2; ++n) acc[a][b][m][n] = (f32x4){0.f, 0.f, 0.f, 0.f};
        cur = nxt; cA = nA; cB = nB; ++ui;
        if (wr == 1) PG8_BAR;
    }
    PG8_WAIT_V(0);
    PG8_BAR;
#undef PG8_SA
#undef PG8_SB
#undef PG8_STAGE
#undef PG8_LDA
#undef PG8_LDB
#undef PG8_MMA
#undef PG8_WAIT_V
#undef PG8_WAIT_L
#undef PG8_BAR
#undef PG8_SCHED
}
}


#define XB_TMO      128
#define XB_XCNT(j)  (256  + 64 * (j))
#define XB_XSUB(j)  (1280 + 64 * (j))
#define XB_XGEN(j)  (2304 + 64 * (j))
#define XB_TOP      3328
#define XB_TOPGEN   3392
#define XCD_BAR_WORDS 3456
#define XB_SPIN_CAP (1u << 22)
DI unsigned xb_ld(unsigned* p)              { return __hip_atomic_load(p, __ATOMIC_RELAXED, __HIP_MEMORY_SCOPE_AGENT); }
DI unsigned xb_add(unsigned* p, unsigned v) { return __hip_atomic_fetch_add(p, v, __ATOMIC_RELAXED, __HIP_MEMORY_SCOPE_AGENT); }
DI unsigned xb_xcc_id() { return (unsigned)__builtin_amdgcn_s_getreg((3 << 11) | 20) & 0xFu; }
#define XB_SPIN(cond, bar) do { unsigned _sp = 0; while (cond) { __builtin_amdgcn_s_sleep(1); \
    if ((++_sp & 255u) == 0u) { if (xb_ld(&(bar)[XB_TMO])) break; if (_sp > XB_SPIN_CAP) { atomicAdd(&(bar)[XB_TMO], 1u); break; } } } } while (0)
DI void xcd_barrier_complete(unsigned* bar, unsigned x, unsigned& nloc, unsigned& nx) {
    const unsigned G = gridDim.x * gridDim.y * gridDim.z;
    unsigned sum, cnt, mine, sp = 0u;
    for (;;) {
        sum = 0u; cnt = 0u; mine = 0u;
#pragma unroll
        for (unsigned j = 0; j < 16; ++j) { const unsigned c = xb_ld(&bar[XB_XCNT(j)]); sum += c; cnt += (c > 0u) ? 1u : 0u; mine = (j == x) ? c : mine; }
        if (sum == G) break;
        __builtin_amdgcn_s_sleep(1);
        if ((++sp & 255u) == 0u) { if (xb_ld(&bar[XB_TMO])) break; if (sp > XB_SPIN_CAP) { atomicAdd(&bar[XB_TMO], 1u); break; } }
    }
    nloc = mine > 0u ? mine : 1u; nx = cnt > 0u ? cnt : 1u;
}
DI void xcd_barrier(unsigned* bar, volatile LAS unsigned* st) {
    asm volatile("s_waitcnt vmcnt(0)" ::: "memory");
    __syncthreads();
    if (threadIdx.x == 0) {
        __builtin_amdgcn_s_waitcnt(0);
        const unsigned x = xb_xcc_id();
        unsigned nloc = st[0], nx = st[1];
        if (nloc == 0u) { xcd_barrier_complete(bar, x, nloc, nx); st[0] = nloc; st[1] = nx; }
        const unsigned old = xb_add(&bar[XB_XSUB(x)], 1u);
        const unsigned gen = old / nloc;
        if (old + 1u == (gen + 1u) * nloc) {
            __builtin_amdgcn_fence(__ATOMIC_RELEASE, "agent");
            asm volatile("s_waitcnt vmcnt(0)" ::: "memory");
            const unsigned og = xb_add(&bar[XB_TOP], 1u);
            const unsigned tg = og / nx;
            if (og + 1u == (tg + 1u) * nx) xb_add(&bar[XB_TOPGEN], 1u);
            else XB_SPIN(xb_ld(&bar[XB_TOPGEN]) == tg, bar);
            __builtin_amdgcn_fence(__ATOMIC_ACQUIRE, "agent");
            xb_add(&bar[XB_XGEN(x)], 1u);
            asm volatile("s_waitcnt vmcnt(0)" ::: "memory");
        } else {
            XB_SPIN(xb_ld(&bar[XB_XGEN(x)]) == gen, bar);
            __builtin_amdgcn_fence(__ATOMIC_ACQUIRE, "agent");
            asm volatile("s_waitcnt vmcnt(0)" ::: "memory");
        }
    }
    __syncthreads();
}

struct Params {
    const float* x; const float* mem; const int* pos;
    const float* ln_mix_pre; const float* w_in; const float* conv_w; const float* conv_b;
    const float* lru_wr; const float* lru_br; const float* lru_wi; const float* lru_bi; const float* lru_lambda;
    const float* cmp_pe; const float* cmp_w1; const float* cmp_b1; const float* cmp_w2;
    const float* ln_mem; const float* w_mem_kv; const float* w_br_rnn; const float* w_br_nsa; const float* w_br_mem; const float* w_out;
    const float* ln_mix_post; const float* ln_mlp_pre; const float* mlp_w1; const float* mlp_w2; const float* ln_mlp_post;
    float* out; unsigned char* ws;
};
typedef const __attribute__((address_space(4))) Params* PP;
#define PPOPAQ() asm volatile("" : "+s"(pp))

DI void tr_item(const float* W, int ldw, int srccol, int valid, int k0, bf16_t* WT, int ldt, int drow0, LAS float* scr, int lane) {
    const int c32 = lane & 31;
    float vv[32];
    const float* wp = W + (size_t)(k0 + (lane >> 5)) * ldw + srccol + (c32 < valid ? c32 : 0);
#pragma unroll
    for (int i = 0; i < 32; ++i) vv[i] = wp[(size_t)(2 * i) * ldw];
#pragma unroll
    for (int i = 0; i < 32; ++i) scr[(2 * i + (lane >> 5)) * 33 + c32] = (c32 < valid) ? vv[i] : 0.f;
    __builtin_amdgcn_s_waitcnt(0xc07f); asm volatile("s_waitcnt lgkmcnt(0)" ::: "memory");
    const int c = lane & 7;
#pragma unroll
    for (int j = 0; j < 4; ++j) { const int n = (lane >> 3) + 8 * j; const LAS float* s = scr + (8 * c) * 33 + n;
        u32x4 o; o.x = pk2(s[0 * 33], s[1 * 33]); o.y = pk2(s[2 * 33], s[3 * 33]); o.z = pk2(s[4 * 33], s[5 * 33]); o.w = pk2(s[6 * 33], s[7 * 33]);
        *(u32x4*)(WT + (size_t)(drow0 + n) * ldt + k0 + 8 * c) = o; }
    asm volatile("s_waitcnt lgkmcnt(0)" ::: "memory");
}

DI void prep_phase(PP pp, int l, LAS unsigned char* lds) {
    PPOPAQ();
    int tid = threadIdx.x; asm volatile("" : "+v"(tid));
    const int lane = tid & 63, wave = __builtin_amdgcn_readfirstlane(tid >> 6);
    const int G_ = opaque_s((int)gridDim.x), bx_ = opaque_s((int)blockIdx.x);
    const int gw = bx_ * 8 + wave, NGW = G_ * 8, gtid = bx_ * 512 + tid, NT = G_ * 512;
    (void)lane; (void)wave; (void)gw; (void)NGW; (void)gtid; (void)NT;
    LAS float* scr = (LAS float*)(lds + wave * 8704);
    unsigned char* ws = pp->ws;
    const float* w_in = pp->w_in + (size_t)l * 1024 * 8752;
    constexpr int I_IN = 16 * 280, I_MKV = 16 * 64, I_BR = 16 * 32, I_M1 = 16 * 128, I_M2 = 64 * 32, I_C1 = 2 * 32 * 8, I_C2 = 2 * 4 * 8, I_LRU = 2 * 8 * 2 * 4;
    constexpr int NITEMS = I_IN + I_MKV + 4 * I_BR + I_M1 + I_M2 + I_C1 + I_C2 + I_LRU;
    for (int it = gw; it < NITEMS; it += NGW) {
        int r = it;
        if (r < I_IN) { const int kb = r / 280, nb = r % 280, n0 = 32 * nb; int src, valid = 32;
            if (n0 < 4608) src = n0; else if (n0 < 5632) src = n0 - 4608 + 4656; else if (n0 < 8704) src = n0 - 5632 + 5680;
            else { src = n0 - 8704 + 4608; valid = 48 - (n0 - 8704); valid = valid < 0 ? 0 : (valid > 32 ? 32 : valid); if (valid == 0) src = 0; }
            tr_item(w_in, 8752, src, valid, 64 * kb, (bf16_t*)(ws + WS_WIN), 1024, n0, scr, lane); continue; } r -= I_IN;
        if (r < I_MKV) { tr_item(pp->w_mem_kv + (size_t)l * 1024 * 2048, 2048, 32 * (r % 64), 32, 64 * (r / 64), (bf16_t*)(ws + WS_WMKV), 1024, 32 * (r % 64), scr, lane); continue; } r -= I_MKV;
        if (r < I_BR) { tr_item(pp->w_br_rnn + (size_t)l * 1024 * 1024, 1024, 32 * (r % 32), 32, 64 * (r / 32), (bf16_t*)(ws + WS_WBRA), 1024, 32 * (r % 32), scr, lane); continue; } r -= I_BR;
        if (r < I_BR) { tr_item(pp->w_br_nsa + (size_t)l * 1024 * 1024, 1024, 32 * (r % 32), 32, 64 * (r / 32), (bf16_t*)(ws + WS_WBRB), 1024, 32 * (r % 32), scr, lane); continue; } r -= I_BR;
        if (r < I_BR) { tr_item(pp->w_br_mem + (size_t)l * 1024 * 1024, 1024, 32 * (r % 32), 32, 64 * (r / 32), (bf16_t*)(ws + WS_WBRC), 1024, 32 * (r % 32), scr, lane); continue; } r -= I_BR;
        if (r < I_BR) { tr_item(pp->w_out + (size_t)l * 1024 * 1024, 1024, 32 * (r % 32), 32, 64 * (r / 32), (bf16_t*)(ws + WS_WOUT), 1024, 32 * (r % 32), scr, lane); continue; } r -= I_BR;
        if (r < I_M1) { tr_item(pp->mlp_w1 + (size_t)l * 1024 * 4096, 4096, 32 * (r % 128), 32, 64 * (r / 128), (bf16_t*)(ws + WS_WM1), 1024, 32 * (r % 128), scr, lane); continue; } r -= I_M1;
        if (r < I_M2) { tr_item(pp->mlp_w2 + (size_t)l * 4096 * 1024, 1024, 32 * (r % 32), 32, 64 * (r / 32), (bf16_t*)(ws + WS_WM2), 4096, 32 * (r % 32), scr, lane); continue; } r -= I_M2;
        if (r < I_C1) { const int j = r / 256, q = r % 256;
            tr_item(pp->cmp_w1 + ((size_t)l * 2 + j) * 2048 * 256, 256, 32 * (q % 8), 32, 64 * (q / 8), (bf16_t*)(ws + WS_WC1) + (size_t)j * 256 * 2048, 2048, 32 * (q % 8), scr, lane); continue; } r -= I_C1;
        if (r < I_C2) { const int j = r / 32, q = r % 32; const int n0 = 32 * (q % 8);
            tr_item(pp->cmp_w2 + ((size_t)l * 2 + j) * 256 * 64, 64, n0 < 64 ? n0 : 0, n0 < 64 ? 32 : 0, 64 * (q / 8), (bf16_t*)(ws + WS_WC2) + (size_t)j * 256 * 256, 256, n0, scr, lane); continue; } r -= I_C2;
        { const int ri = r / 64, q = r % 64, blk = q / 8, q2 = q % 8;
            const float* W = (ri == 0 ? pp->lru_wr : pp->lru_wi) + ((size_t)l * 8 + blk) * 128 * 128;
            tr_item(W, 128, 32 * (q2 % 4), 32, 64 * (q2 / 4), (bf16_t*)(ws + WS_WLRU), 128, blk * 256 + ri * 128 + 32 * (q2 % 4), scr, lane); }
    }
    for (int m = gw; m < 512; m += NGW) {
        const f32x4* xr = (const f32x4*)(pp->mem + (size_t)m * 1024) + lane; const f32x4* gr = (const f32x4*)(pp->ln_mem + (size_t)l * 1024) + lane;
        f32x4 v[4]; float s = 0.f;
#pragma unroll
        for (int j = 0; j < 4; ++j) { v[j] = xr[64 * j]; s += (v[j].x * v[j].x + v[j].y * v[j].y) + (v[j].z * v[j].z + v[j].w * v[j].w); }
        const float rs = 1.0f / sqrtf(wave_sum(s, lane) * (1.f / 1024.f) + EPS);
        u32x2* o8 = (u32x2*)((bf16_t*)(ws + WS_MEMN) + (size_t)m * 1024) + lane;
#pragma unroll
        for (int j = 0; j < 4; ++j) { const f32x4 g = gr[64 * j]; u32x2 w; w.x = pk2(v[j].x * rs * g.x, v[j].y * rs * g.y); w.y = pk2(v[j].z * rs * g.z, v[j].w * rs * g.w); o8[64 * j] = w; }
    }
    {
        const int gt = gw * 64 + lane;
        if (gt < 16 * 512) { const int prt = gt / 512, jn = gt % 512, j = jn / 256, n = jn % 256;
            const float* w1 = pp->cmp_w1 + ((size_t)l * 2 + j) * 2048 * 256 + n; const float* pe = pp->cmp_pe + ((size_t)l * 2 + j) * 2048;
            float s = 0.f;
            for (int k = prt * 128; k < prt * 128 + 128; ++k) s += pe[k] * w1[(size_t)k * 256];
            ((float*)(ws + WS_CBP))[gt] = s; }
    }
}

DI void row_phase(const float* xin, const float* y, const float* gpost, float* xout, const float* gnext, bf16_t* hout) {
    int tid = threadIdx.x; asm volatile("" : "+v"(tid));
    const int lane = tid & 63, wave = __builtin_amdgcn_readfirstlane(tid >> 6);
    const int G_ = opaque_s((int)gridDim.x), bx_ = opaque_s((int)blockIdx.x);
    const int gw = bx_ * 8 + wave, NGW = G_ * 8, gtid = bx_ * 512 + tid, NT = G_ * 512;
    (void)lane; (void)wave; (void)gw; (void)NGW; (void)gtid; (void)NT;
    for (int m = gw; m < T_; m += NGW) {
        const f32x4* xr = (const f32x4*)(xin + (size_t)m * 1024) + lane;
        f32x4 v[4];
#pragma unroll
        for (int j = 0; j < 4; ++j) v[j] = xr[64 * j];
        if (y) {
            const f32x4* yr = (const f32x4*)(y + (size_t)m * 1024) + lane; const f32x4* gr = (const f32x4*)gpost + lane;
            f32x4 w[4]; float s = 0.f;
#pragma unroll
            for (int j = 0; j < 4; ++j) { w[j] = yr[64 * j]; s += (w[j].x * w[j].x + w[j].y * w[j].y) + (w[j].z * w[j].z + w[j].w * w[j].w); }
            const float rs = 1.0f / sqrtf(wave_sum(s, lane) * (1.f / 1024.f) + EPS);
            f32x4* xo = (f32x4*)(xout + (size_t)m * 1024) + lane;
#pragma unroll
            for (int j = 0; j < 4; ++j) { v[j] = v[j] + w[j] * rs * gr[64 * j]; xo[64 * j] = v[j]; }
        }
        if (hout) {
            float s = 0.f;
#pragma unroll
            for (int j = 0; j < 4; ++j) s += (v[j].x * v[j].x + v[j].y * v[j].y) + (v[j].z * v[j].z + v[j].w * v[j].w);
            const float rs = 1.0f / sqrtf(wave_sum(s, lane) * (1.f / 1024.f) + EPS);
            const f32x4* gr = (const f32x4*)gnext + lane; u32x2* o8 = (u32x2*)(hout + (size_t)m * 1024) + lane;
#pragma unroll
            for (int j = 0; j < 4; ++j) { const f32x4 g = gr[64 * j]; u32x2 w; w.x = pk2(v[j].x * rs * g.x, v[j].y * rs * g.y); w.y = pk2(v[j].z * rs * g.z, v[j].w * rs * g.w); o8[64 * j] = w; }
        }
    }
}

DI void rope8(u32x4& lo, u32x4& hi, float pos, int d0, float scale) {
    unsigned* pl = (unsigned*)&lo; unsigned* ph = (unsigned*)&hi;
    float x1[8], x2[8];
#pragma unroll
    for (int e = 0; e < 4; ++e) { x1[2 * e] = bflo(pl[e]); x1[2 * e + 1] = bfhi(pl[e]); x2[2 * e] = bflo(ph[e]); x2[2 * e + 1] = bfhi(ph[e]); }
#pragma unroll
    for (int e = 0; e < 8; ++e) {
        const float inv = fexp2(-(float)(d0 + e) * 0.41524101186092029f);
        const float ang = pos * inv;
        const double rev = (double)ang * 0.15915494309189535; const float fr = (float)(rev - __builtin_rint(rev));
        const float sn = __builtin_amdgcn_sinf(fr), cs = __builtin_amdgcn_cosf(fr);
        const float a = (x1[e] * cs - x2[e] * sn) * scale, b = (x2[e] * cs + x1[e] * sn) * scale; x1[e] = a; x2[e] = b;
    }
#pragma unroll
    for (int e = 0; e < 4; ++e) { pl[e] = pk2(x1[2 * e], x1[2 * e + 1]); ph[e] = pk2(x2[2 * e], x2[2 * e + 1]); }
}

DI void postproj_phase(PP pp, int l) {
    PPOPAQ();
    if (opaque_s((int)blockIdx.x) < 32 && gridDim.x == 256) return;
    int tid = threadIdx.x; asm volatile("" : "+v"(tid));
    const int lane = tid & 63, wave = __builtin_amdgcn_readfirstlane(tid >> 6);
    const int G_ = opaque_s((int)gridDim.x), bx_ = opaque_s((int)blockIdx.x);
    const bool shr = (G_ == 256); const int gw = bx_ * 8 + wave, NGW = G_ * 8, gtid = (shr ? bx_ - 32 : bx_) * 512 + tid, NT = (shr ? G_ - 32 : G_) * 512;
    (void)lane; (void)wave; (void)gw; (void)NGW; (void)gtid; (void)NT;
    unsigned char* ws = pp->ws; bf16_t* PROJ = (bf16_t*)(ws + WS_PROJ);
    {
        const float* cw = pp->conv_w + (size_t)l * 4 * 1024; const float* cb = pp->conv_b + (size_t)l * 1024; bf16_t* XC = (bf16_t*)(ws + WS_XC);
        for (int i = gtid; i < (T_ / 8) * 128; i += NT) { const int tb8 = (i >> 7) * 8, c8 = (i & 127) * 8, ts0 = tb8 & (S_ - 1);
            u32x4 xr[11];
#pragma unroll
            for (int w = 0; w < 11; ++w) { const int tt = tb8 - 3 + w; const bool okr = ts0 - 3 + w >= 0; const u32x4 ld = *(const u32x4*)(PROJ + (size_t)(okr ? tt : tb8) * LDP + C_XR + c8);
                xr[w] = okr ? ld : (u32x4){0u, 0u, 0u, 0u}; }
            f32x4 kw[4][2];
#pragma unroll
            for (int w = 0; w < 4; ++w) { kw[w][0] = *(const f32x4*)(cw + w * 1024 + c8); kw[w][1] = *(const f32x4*)(cw + w * 1024 + c8 + 4); }
            const f32x4 b0 = *(const f32x4*)(cb + c8), b1 = *(const f32x4*)(cb + c8 + 4);
#pragma unroll
            for (int r = 0; r < 8; ++r) {
                float acc[8] = {b0.x, b0.y, b0.z, b0.w, b1.x, b1.y, b1.z, b1.w};
#pragma unroll
                for (int w = 0; w < 4; ++w) { const unsigned* xp = (const unsigned*)&xr[r + w]; const f32x4 k0 = kw[w][0], k1 = kw[w][1];
                    acc[0] += k0.x * bflo(xp[0]); acc[1] += k0.y * bfhi(xp[0]); acc[2] += k0.z * bflo(xp[1]); acc[3] += k0.w * bfhi(xp[1]);
                    acc[4] += k1.x * bflo(xp[2]); acc[5] += k1.y * bfhi(xp[2]); acc[6] += k1.z * bflo(xp[3]); acc[7] += k1.w * bfhi(xp[3]); }
                u32x4 o; o.x = pk2(acc[0], acc[1]); o.y = pk2(acc[2], acc[3]); o.z = pk2(acc[4], acc[5]); o.w = pk2(acc[6], acc[7]);
                *(u32x4*)(XC + (size_t)(tb8 + r) * 1024 + c8) = o; }
        }
    }
    for (int i = gtid; i < T_ * 20 * 4; i += NT) { const int t = i / 80, r = i % 80, hd = r >> 2, d0 = (r & 3) * 8;
        int col; float sc = 1.0f;
        if (hd < 16) { col = C_Q + hd * 64; sc = 0.125f * LOG2E; } else col = C_KW + (hd - 16) * 64;
        bf16_t* base = PROJ + (size_t)t * LDP + col + d0;
        u32x4 lo = *(const u32x4*)base, hi = *(const u32x4*)(base + 32);
        rope8(lo, hi, (float)pp->pos[t], d0, sc);
        *(u32x4*)base = lo; *(u32x4*)(base + 32) = hi; }
    for (int i = gtid; i < 8 * 128 * 4 * 64; i += NT) { const int ln = i & 63, sub = (i >> 6) & 3, j = (i >> 8) & 127, bg = i >> 15, b = bg >> 2, g = bg & 3;
        const int r16 = ln & 15, quad = ln >> 4, t = 64 * j + 16 * sub + r16, dl = 8 * quad;
        const bf16_t* base = PROJ + (size_t)(b * S_ + t) * LDP + C_KS + g * 64 + dl;
        u32x4 lo = *(const u32x4*)base, hi = *(const u32x4*)(base + 32);
        rope8(lo, hi, (float)pp->pos[b * S_ + t], dl, 1.0f);
        u32x4 outw;
        outw.x = pk4_fp8(bflo(lo.x), bfhi(lo.x), bflo(lo.y), bfhi(lo.y)); outw.y = pk4_fp8(bflo(lo.z), bfhi(lo.z), bflo(lo.w), bfhi(lo.w));
        outw.z = pk4_fp8(bflo(hi.x), bfhi(hi.x), bflo(hi.y), bfhi(hi.y)); outw.w = pk4_fp8(bflo(hi.z), bfhi(hi.z), bflo(hi.w), bfhi(hi.w));
        *(u32x4*)((unsigned char*)(ws + WS_KF) + (size_t)i * 16) = outw; }
    for (int i = gtid; i < 8 * 128 * 4 * 64; i += NT) { const int ln = i & 63, dsub = (i >> 6) & 3, j = (i >> 8) & 127, bg = i >> 15, b = bg >> 2, g = bg & 3;
        const int r16 = ln & 15, quad = ln >> 4;
        u32x4 outw;
#pragma unroll
        for (int kst = 0; kst < 2; ++kst) { const int key0 = 64 * j + 32 * kst + 4 * quad;
            const bf16_t* src = PROJ + (size_t)(b * S_ + key0) * LDP + C_VS + g * 64 + 16 * dsub + r16;
            float v[8];
#pragma unroll
            for (int e = 0; e < 8; ++e) v[e] = bf2f(src[(size_t)(e < 4 ? e : e + 12) * LDP]);
            const unsigned w0 = pk4_fp8(v[0], v[1], v[2], v[3]), w1 = pk4_fp8(v[4], v[5], v[6], v[7]);
            if (kst == 0) { outw.x = w0; outw.y = w1; } else { outw.z = w0; outw.w = w1; } }
        *(u32x4*)((unsigned char*)(ws + WS_VTS) + (size_t)i * 16) = outw; }
    for (int i = gtid; i < 2 * 4 * 1024 * 64; i += NT) { const int d = i & 63, t8 = (i >> 6) & 1023, g = (i >> 16) & 3, b = (i >> 18) & 1, which = 1;
        const bf16_t* src = PROJ + (size_t)(b * S_ + t8 * 8) * LDP + (which ? C_VW : C_VS) + g * 64 + d;
        unsigned short v[8];
#pragma unroll
        for (int e = 0; e < 8; ++e) v[e] = src[(size_t)e * LDP];
        u32x4 o; o.x = v[0] | ((unsigned)v[1] << 16); o.y = v[2] | ((unsigned)v[3] << 16); o.z = v[4] | ((unsigned)v[5] << 16); o.w = v[6] | ((unsigned)v[7] << 16);
        *(u32x4*)((bf16_t*)(ws + (which ? WS_VTW : WS_VTS)) + ((size_t)(b * 4 + g) * 64 + d) * S_ + t8 * 8) = o; }
}
DI void cbias_phase(PP pp, int l) {
    PPOPAQ();
    int tid = threadIdx.x; asm volatile("" : "+v"(tid));
    if (opaque_s((int)blockIdx.x) == 0) { unsigned char* ws = pp->ws; const float* part = (const float*)(ws + WS_CBP); float s = pp->cmp_b1[(size_t)l * 512 + tid];
        for (int q = 0; q < 16; ++q) s += part[q * 512 + tid];
        ((float*)(ws + WS_CBIAS))[tid] = s; }
}

DI void lru_ab(float rp, float ip, float xc, float cl, float& a, float& bb) {
    const float la = cl * sigmoidf_(rp);
    a = fexp2(la * LOG2E);
    const float x2 = 2.0f * la;
    float om;
    if (x2 > -0.1f) om = -x2 * (1.0f + x2 * (0.5f + x2 * (0.16666667f + x2 * (0.041666668f + x2 * 0.0083333338f)))); else om = 1.0f - a * a;
    bb = sqrtf(om) * sigmoidf_(ip) * xc;
}
DI void scan_phase(PP pp, int l, int pass) {
    PPOPAQ();
    int tid = threadIdx.x; asm volatile("" : "+v"(tid));
    const int G_ = opaque_s((int)gridDim.x), bx_ = opaque_s((int)blockIdx.x);
    unsigned char* ws = pp->ws; const bf16_t* __restrict__ RI = (const bf16_t*)(ws + WS_RI); bf16_t* XC = (bf16_t*)(ws + WS_XC); const bf16_t* __restrict__ PROJ = (const bf16_t*)(ws + WS_PROJ);
    f32x2* SA = (f32x2*)(ws + WS_SCA); f32x2* SH = (f32x2*)(ws + WS_SCH);
    const int ch = 2 * tid, blk = ch >> 7, cc = ch & 127, rcol = blk * 256 + cc;
    const f32x2 lam = *(const f32x2*)(pp->lru_lambda + (size_t)l * 1024 + ch), br = *(const f32x2*)(pp->lru_br + (size_t)l * 1024 + ch), bi = *(const f32x2*)(pp->lru_bi + (size_t)l * 1024 + ch);
    float cl[2];
#pragma unroll
    for (int e = 0; e < 2; ++e) { const float ex = fexp2(-lam[e] * LOG2E);
        const float sp = (ex < 0.05f) ? ex * (1.0f - ex * (0.5f - ex * (0.33333334f - ex * (0.25f - ex * (0.2f - ex * 0.16666667f))))) : ((-lam[e] > 20.f) ? -lam[e] : 0.6931471805599453f * __builtin_amdgcn_logf(1.0f + ex));
        cl[e] = -8.0f * sp; }
    for (int u = bx_; u < 256; u += G_) { const int b = u >> 7, k = u & 127;
        const size_t row0 = (size_t)b * S_ + k * 64;
        if (pass == 0) {
            float A0 = 1.f, H0 = 0.f, A1 = 1.f, H1 = 0.f;
            for (int s8 = 0; s8 < 64; s8 += 8) { unsigned rw[8], iw[8], xw[8];
#pragma unroll
                for (int e = 0; e < 8; ++e) { const size_t row = row0 + s8 + e; rw[e] = *(const unsigned*)(RI + row * 2048 + rcol); iw[e] = *(const unsigned*)(RI + row * 2048 + rcol + 128); xw[e] = *(const unsigned*)(XC + row * 1024 + ch); }
#pragma unroll
                for (int e = 0; e < 8; ++e) { float a, bb;
                    lru_ab(bflo(rw[e]) + br[0], bflo(iw[e]) + bi[0], bflo(xw[e]), cl[0], a, bb); A0 *= a; H0 = a * H0 + bb;
                    lru_ab(bfhi(rw[e]) + br[1], bfhi(iw[e]) + bi[1], bfhi(xw[e]), cl[1], a, bb); A1 *= a; H1 = a * H1 + bb; } }
            SA[((size_t)b * 128 + k) * 512 + tid] = (f32x2){A0, A1}; SH[((size_t)b * 128 + k) * 512 + tid] = (f32x2){H0, H1};
        } else {
            float h0 = 0.f, h1 = 0.f;
            const f32x2* __restrict__ sa = SA + (size_t)b * 128 * 512 + tid; const f32x2* __restrict__ sh = SH + (size_t)b * 128 * 512 + tid;
            for (int q0 = 0; q0 < k; q0 += 16) { f32x2 av[16], hv[16];
#pragma unroll
                for (int e = 0; e < 16; ++e) { const int qq = (q0 + e < k) ? q0 + e : q0; av[e] = sa[(size_t)qq * 512]; hv[e] = sh[(size_t)qq * 512]; }
#pragma unroll
                for (int e = 0; e < 16; ++e) if (q0 + e < k) { h0 = av[e][0] * h0 + hv[e][0]; h1 = av[e][1] * h1 + hv[e][1]; } }
            for (int s8 = 0; s8 < 64; s8 += 8) { unsigned rw[8], iw[8], xw[8], yw[8];
#pragma unroll
                for (int e = 0; e < 8; ++e) { const size_t row = row0 + s8 + e; rw[e] = *(const unsigned*)(RI + row * 2048 + rcol); iw[e] = *(const unsigned*)(RI + row * 2048 + rcol + 128); xw[e] = *(const unsigned*)(XC + row * 1024 + ch);
                    yw[e] = *(const unsigned*)(PROJ + row * LDP + C_YR + ch); }
#pragma unroll
                for (int e = 0; e < 8; ++e) { float a, bb;
                    lru_ab(bflo(rw[e]) + br[0], bflo(iw[e]) + bi[0], bflo(xw[e]), cl[0], a, bb); h0 = a * h0 + bb;
                    lru_ab(bfhi(rw[e]) + br[1], bfhi(iw[e]) + bi[1], bfhi(xw[e]), cl[1], a, bb); h1 = a * h1 + bb;
                    *(unsigned*)(XC + (row0 + s8 + e) * 1024 + ch) = pk2(h0 * gelu_tanh(bflo(yw[e])), h1 * gelu_tanh(bfhi(yw[e]))); } }
        }
    }
}

DI void memsoftmax_phase(PP pp) {
    PPOPAQ();
    int tid = threadIdx.x; asm volatile("" : "+v"(tid));
    const int lane = tid & 63, wave = __builtin_amdgcn_readfirstlane(tid >> 6);
    const int G_ = opaque_s((int)gridDim.x), bx_ = opaque_s((int)blockIdx.x);
    const int gw = bx_ * 8 + wave, NGW = G_ * 8, gtid = bx_ * 512 + tid, NT = G_ * 512;
    (void)lane; (void)wave; (void)gw; (void)NGW; (void)gtid; (void)NT;
    bf16_t* SP = (bf16_t*)(pp->ws + WS_H);
    for (int m0 = gw; m0 < T_; m0 += 4 * NGW) {
        u32x4 av[4], bv[4];
#pragma unroll
        for (int r = 0; r < 4; ++r) { const int m = (m0 + r * NGW < T_) ? m0 + r * NGW : m0; const u32x4* ptr = (const u32x4*)(SP + (size_t)m * 1024 + lane * 16); av[r] = ptr[0]; bv[r] = ptr[1]; }
#pragma unroll
        for (int r = 0; r < 4; ++r) {
            const unsigned* pa = (const unsigned*)&av[r]; const unsigned* pb = (const unsigned*)&bv[r];
            float v[16];
#pragma unroll
            for (int e = 0; e < 4; ++e) { v[2 * e] = bflo(pa[e]); v[2 * e + 1] = bfhi(pa[e]); v[8 + 2 * e] = bflo(pb[e]); v[8 + 2 * e + 1] = bfhi(pb[e]); }
            float mx = v[0];
#pragma unroll
            for (int e = 1; e < 16; ++e) mx = fmaxf(mx, v[e]);
#pragma unroll
            for (int o = 1; o < 16; o <<= 1) mx = fmaxf(mx, shx(mx, o, lane));
            float sm = 0.f;
#pragma unroll
            for (int e = 0; e < 16; ++e) { v[e] = fexp2(v[e] - mx); sm += v[e]; }
#pragma unroll
            for (int o = 1; o < 16; o <<= 1) sm += shx(sm, o, lane);
            const float inv = 1.0f / sm;
            u32x4 oa, ob; unsigned* qa = (unsigned*)&oa; unsigned* qb = (unsigned*)&ob;
#pragma unroll
            for (int e = 0; e < 4; ++e) { qa[e] = pk2(v[2 * e] * inv, v[2 * e + 1] * inv); qb[e] = pk2(v[8 + 2 * e] * inv, v[8 + 2 * e + 1] * inv); }
            if (m0 + r * NGW < T_) { u32x4* ptr = (u32x4*)(SP + (size_t)(m0 + r * NGW) * 1024 + lane * 16); ptr[0] = oa; ptr[1] = ob; }
        }
    }
}

DI void cmpfinal_phase(PP pp) {
    PPOPAQ();
    int tid = threadIdx.x; asm volatile("" : "+v"(tid));
    const int lane = tid & 63, wave = __builtin_amdgcn_readfirstlane(tid >> 6);
    const int G_ = opaque_s((int)gridDim.x), bx_ = opaque_s((int)blockIdx.x);
    const int gw = bx_ * 8 + wave, NGW = G_ * 8, gtid = bx_ * 512 + tid, NT = G_ * 512;
    (void)lane; (void)wave; (void)gw; (void)NGW; (void)gtid; (void)NT;
    unsigned char* ws = pp->ws; const float* CR = (const float*)(ws + WS_CRAW);
    for (int i = gtid; i < 2 * 4 * 512 * 32; i += NT) { const int d = i & 31, c = (i >> 5) & 511, bg = i >> 14, b = bg >> 2;
        const float* src = CR + ((size_t)bg * 512 + c) * 64; float x1 = src[d], x2 = src[d + 32];
        float o1 = 0.f, o2 = 0.f;
        if (c < 511) { const float pos = (float)pp->pos[b * S_ + 16 * c + 31]; const float inv = fexp2(-(float)d * 0.41524101186092029f); const float ang = pos * inv;
            const double rev = (double)ang * 0.15915494309189535; const float fr = (float)(rev - __builtin_rint(rev));
            const float sn = __builtin_amdgcn_sinf(fr), cs = __builtin_amdgcn_cosf(fr); o1 = x1 * cs - x2 * sn; o2 = x2 * cs + x1 * sn; }
        bf16_t* dst = (bf16_t*)(ws + WS_KCMP) + ((size_t)bg * 512 + c) * 64; dst[d] = (bf16_t)f2bf(o1); dst[d + 32] = (bf16_t)f2bf(o2); }
    for (int i = gtid; i < 2 * 4 * 64 * 512; i += NT) { const int c = i & 511, d = (i >> 9) & 63, bg = i >> 15;
        const float v = (c < 511) ? CR[((size_t)(8 + bg) * 512 + c) * 64 + d] : 0.f;
        ((bf16_t*)(ws + WS_VTCMP))[((size_t)bg * 64 + d) * 512 + c] = (bf16_t)f2bf(v); }
}

constexpr int KSTR = 144, VSTR = 136;
constexpr int L_K = 0, L_V = 2 * 64 * KSTR, L_IMP = L_V + 2 * 64 * VSTR, IMPSTR = 132, L_SEL = L_IMP + 64 * IMPSTR * 4, L_ATT_END = L_SEL + 64 * 16, L_OT = L_ATT_END, L_Q8 = L_OT + 65536, L_ML = L_Q8 + 16384, OSSTR = 272;
DI int crow(int r, int hi) { return (r & 3) + 8 * (r >> 2) + 4 * hi; }

struct TileSrc { const bf16_t* K; int kstr; const bf16_t* Vt; int vstr; };

template <int MODE>
DI void attn_loop(LAS unsigned char* lds, const TileSrc src, int j0, int j1, const bf16x8 (&qf)[4], f32x16 (&o)[2], float& m_run, float& l_run,
                  int tl, int t, int tb, u64 selLo, u64 selHi, int tid, int wave, int lane) {
    const int n = lane & 31, hh = lane >> 5;
    const int lrow = tid >> 3, lchunk = tid & 7;
    u32x4 kreg, vreg;
    kreg = *(const u32x4*)(src.K + (size_t)(64 * j0 + lrow) * src.kstr + lchunk * 8);
    vreg = *(const u32x4*)(src.Vt + (size_t)lrow * src.vstr + 64 * j0 + lchunk * 8);
    float carry = 0.f;
    int buf = 0;
    for (int j = j0; j <= j1; ++j) {
        LAS unsigned char* Kl = lds + L_K + buf * 64 * KSTR; LAS unsigned char* Vl = lds + L_V + buf * 64 * VSTR;
        *(LAS u32x4*)(Kl + lrow * KSTR + lchunk * 16) = kreg;
        *(LAS u32x2*)(Vl + lrow * VSTR + lchunk * 16) = (u32x2){vreg.x, vreg.y}; *(LAS u32x2*)(Vl + lrow * VSTR + lchunk * 16 + 8) = (u32x2){vreg.z, vreg.w};
        __syncthreads();
        if (j < j1) { kreg = *(const u32x4*)(src.K + (size_t)(64 * (j + 1) + lrow) * src.kstr + lchunk * 8);
                      vreg = *(const u32x4*)(src.Vt + (size_t)lrow * src.vstr + 64 * (j + 1) + lchunk * 8); }
        buf ^= 1;
        bool active = true;
        if (MODE == 2) { const bool bit = ((j < 64 ? selLo : selHi) >> (j & 63)) & 1ull; active = __ballot(bit) != 0ull; }
        if (!active) continue;
        f32x16 s[2];
#pragma unroll
        for (int u = 0; u < 2; ++u) {
#pragma unroll
            for (int e = 0; e < 16; ++e) s[u][e] = 0.f;
#pragma unroll
            for (int ks = 0; ks < 4; ++ks) { const bf16x8 kf = *(const LAS bf16x8*)(Kl + (32 * u + n) * KSTR + (ks * 16 + 8 * hh) * 2);
                s[u] = __builtin_amdgcn_mfma_f32_32x32x16_bf16(kf, qf[ks], s[u], 0, 0, 0); }
        }
        const float NEGINF = -__builtin_inff();
        if (MODE <= 1) { const int cmax = min(510, (t - 31) >> 4);
#pragma unroll
            for (int u = 0; u < 2; ++u)
#pragma unroll
                for (int e = 0; e < 16; ++e) { const int c = 64 * j + 32 * u + crow(e, hh); if (c > cmax) s[u][e] = NEGINF; }
        } else if (MODE == 2) { const bool bit = ((j < 64 ? selLo : selHi) >> (j & 63)) & 1ull; const int lim = (j == tb) ? tl : 64;
#pragma unroll
            for (int u = 0; u < 2; ++u)
#pragma unroll
                for (int e = 0; e < 16; ++e) { const int kk = 32 * u + crow(e, hh); if (!bit || kk > lim) s[u][e] = NEGINF; }
        } else {
#pragma unroll
            for (int u = 0; u < 2; ++u)
#pragma unroll
                for (int e = 0; e < 16; ++e) { const int df = t - (64 * j + 32 * u + crow(e, hh)); if ((unsigned)df >= 512u) s[u][e] = NEGINF; }
        }
        if (MODE == 1) {
            const float msafe = (m_run == NEGINF) ? 0.f : m_run;
#pragma unroll
            for (int u = 0; u < 2; ++u)
#pragma unroll
                for (int e = 0; e < 16; ++e) s[u][e] = fexp2(s[u][e] - msafe) * l_run;
            if (tb >= 16) {
                float w1[8], w2[8], pw2[8];
#pragma unroll
                for (int u = 0; u < 2; ++u)
#pragma unroll
                    for (int gi = 0; gi < 4; ++gi) { const float p0 = s[u][4 * gi], p1 = s[u][4 * gi + 1], p2 = s[u][4 * gi + 2], p3 = s[u][4 * gi + 3];
                        w1[u * 4 + gi] = p0 + p1 + p2 + 0.5f * p3; w2[u * 4 + gi] = 0.5f * p3; }
#pragma unroll
                for (int q = 0; q < 8; ++q) pw2[q] = shx(w2[q], 32, lane);
                float tot[8];
#pragma unroll
                for (int q = 0; q < 8; ++q) { const float prev = (q == 0) ? carry : pw2[q > 0 ? q - 1 : 0]; tot[q] = w1[q] + (hh ? pw2[q] : prev); }
                carry = pw2[7];
#pragma unroll
                for (int q = 0; q < 8; ++q) { float v = tot[q]; v += shx(v, 1, lane); v += shx(v, 2, lane); tot[q] = v; }
                if ((n & 3) == 0) { LAS float* imp = (LAS float*)(lds + L_IMP) + (8 * wave + (n >> 2)) * IMPSTR;
#pragma unroll
                    for (int q = 0; q < 8; ++q) { const int jj = 16 * j + 8 * (q >> 2) + 2 * (q & 3) + hh; if (jj < 128) imp[jj] = tot[q]; } }
            }
        } else {
            float mloc = s[0][0];
#pragma unroll
            for (int u = 0; u < 2; ++u)
#pragma unroll
                for (int e = 0; e < 16; ++e) mloc = fmaxf(mloc, s[u][e]);
            mloc = fmaxf(mloc, shx(mloc, 32, lane));
            const float mnew = fmaxf(m_run, mloc); const float msafe = (mnew == NEGINF) ? 0.f : mnew;
            const float alpha = fexp2(m_run - msafe);
            float ls = 0.f;
#pragma unroll
            for (int u = 0; u < 2; ++u)
#pragma unroll
                for (int e = 0; e < 16; ++e) { s[u][e] = fexp2(s[u][e] - msafe); ls += s[u][e]; }
            l_run = l_run * alpha + ls; m_run = mnew;
            if (MODE != 0) {
#pragma unroll
                for (int ds = 0; ds < 2; ++ds)
#pragma unroll
                    for (int e = 0; e < 16; ++e) o[ds][e] *= alpha;
            }
        }
        if (MODE != 0) {
#pragma unroll
            for (int u = 0; u < 2; ++u)
#pragma unroll
                for (int st = 0; st < 2; ++st) {
                    u32x4 pp; pp.x = pk2(s[u][8 * st], s[u][8 * st + 1]); pp.y = pk2(s[u][8 * st + 2], s[u][8 * st + 3]); pp.z = pk2(s[u][8 * st + 4], s[u][8 * st + 5]); pp.w = pk2(s[u][8 * st + 6], s[u][8 * st + 7]);
                    const bf16x8 pb = __builtin_bit_cast(bf16x8, pp);
#pragma unroll
                    for (int ds = 0; ds < 2; ++ds) { const LAS unsigned char* vp = Vl + (32 * ds + n) * VSTR + (32 * u + 16 * st + 4 * hh) * 2;
                        const u32x2 a0 = *(const LAS u32x2*)vp, a1 = *(const LAS u32x2*)(vp + 16);
                        const u32x4 av = {a0.x, a0.y, a1.x, a1.y};
                        o[ds] = __builtin_amdgcn_mfma_f32_32x32x16_bf16(__builtin_bit_cast(bf16x8, av), pb, o[ds], 0, 0, 0); }
                }
        }
    }
    __syncthreads();
}

typedef float f32x4v __attribute__((ext_vector_type(4)));
DI void sel_tile(const u32x4 (&kc)[4], const u32x4 (&vf)[4], int j, LAS unsigned char* OSw, const LAS unsigned char* Q8w, LAS float* MLw, u64 tmLo, u64 tmHi, int tb, int wave, int lane) {
    const int q = lane & 15, quad = lane >> 4, head = q & 3, slot = q >> 2;
    const float NEGINF = -__builtin_inff();
    const bool tbit = (((j < 64 ? tmLo : tmHi) >> (j & 63)) & 1ull) != 0ull && lane < 8;
    unsigned act = (unsigned)__ballot(tbit) & 0xffu;
    while (act != 0u) {
        const int t0 = __builtin_ctz(act); act &= act - 1u;
        int t1 = -1, t2 = -1, t3 = -1;
        if (act != 0u) { t1 = __builtin_ctz(act); act &= act - 1u; }
        if (act != 0u) { t2 = __builtin_ctz(act); act &= act - 1u; }
        if (act != 0u) { t3 = __builtin_ctz(act); act &= act - 1u; }
        const int tsel = slot == 0 ? t0 : (slot == 1 ? t1 : (slot == 2 ? t2 : t3));
        const bool valid = tsel >= 0; const int tk = valid ? tsel : t0; const int rho = 4 * tk + head;
        const long qa = *(const LAS long*)(Q8w + rho * 64 + 8 * quad), qb = *(const LAS long*)(Q8w + rho * 64 + 32 + 8 * quad);
        f32x4v s[4];
#pragma unroll
        for (int sub = 0; sub < 4; ++sub) { s[sub] = (f32x4v){0.f, 0.f, 0.f, 0.f};
            s[sub] = __builtin_amdgcn_mfma_f32_16x16x32_fp8_fp8(mk64(kc[sub].x, kc[sub].y), qa, s[sub], 0, 0, 0);
            s[sub] = __builtin_amdgcn_mfma_f32_16x16x32_fp8_fp8(mk64(kc[sub].z, kc[sub].w), qb, s[sub], 0, 0, 0); }
        if (j == tb) { const int tlk = 8 * wave + tk;
#pragma unroll
            for (int sub = 0; sub < 4; ++sub)
#pragma unroll
                for (int i = 0; i < 4; ++i) { const int kk = 16 * sub + 4 * quad + i; if (kk > tlk) s[sub][i] = NEGINF; } }
        float mloc = fmaxf(fmaxf(s[0][0], s[1][0]), fmaxf(s[2][0], s[3][0]));
#pragma unroll
        for (int i = 1; i < 4; ++i) mloc = fmaxf(mloc, fmaxf(fmaxf(s[0][i], s[1][i]), fmaxf(s[2][i], s[3][i])));
        mloc = fmaxf(mloc, shx(mloc, 16, lane)); mloc = fmaxf(mloc, shx(mloc, 32, lane));
        const float m_old = MLw[rho], l_old = MLw[32 + rho];
        const float mnew = fmaxf(m_old, mloc);
        const float msafe = (mnew == NEGINF) ? 0.f : mnew;
        const float alpha = fexp2(m_old - msafe);
        const float sb = valid ? msafe - 8.0f : __builtin_inff();
        float ls = 0.f;
#pragma unroll
        for (int sub = 0; sub < 4; ++sub)
#pragma unroll
            for (int i = 0; i < 4; ++i) { s[sub][i] = fexp2(s[sub][i] - sb); ls += s[sub][i]; }
        ls += shx(ls, 16, lane); ls += shx(ls, 32, lane);
        if (valid && quad == 0) { MLw[rho] = mnew; MLw[32 + rho] = l_old * alpha + ls; }
        const long pb0 = mk64(pk4_fp8(s[0][0], s[0][1], s[0][2], s[0][3]), pk4_fp8(s[1][0], s[1][1], s[1][2], s[1][3]));
        const long pb1 = mk64(pk4_fp8(s[2][0], s[2][1], s[2][2], s[2][3]), pk4_fp8(s[3][0], s[3][1], s[3][2], s[3][3]));
#pragma unroll
        for (int dsub = 0; dsub < 4; ++dsub) { LAS f32x4v* op = (LAS f32x4v*)(OSw + rho * OSSTR + (16 * dsub + 4 * quad) * 4);
            f32x4v oacc = *op * alpha;
            oacc = __builtin_amdgcn_mfma_f32_16x16x32_fp8_fp8(mk64(vf[dsub].x, vf[dsub].y), pb0, oacc, 0, 0, 0);
            oacc = __builtin_amdgcn_mfma_f32_16x16x32_fp8_fp8(mk64(vf[dsub].z, vf[dsub].w), pb1, oacc, 0, 0, 0);
            if (valid) *op = oacc; }
    }
}
DI int sg_pop(u64& uLo, u64& uHi) {
    int j = -1;
    if (uLo != 0ull) { j = __builtin_ctzll(uLo); uLo &= uLo - 1ull; } else if (uHi != 0ull) { j = 64 + __builtin_ctzll(uHi); uHi &= uHi - 1ull; }
    return j;
}
DI void sel_gather(const unsigned char* __restrict__ KFb, const unsigned char* __restrict__ VFb, u64 uLo, u64 uHi, LAS unsigned char* OSw, const LAS unsigned char* Q8w, LAS float* MLw,
                   u64 tmLo, u64 tmHi, int tb, int wave, int lane) {
    const unsigned char* kp = KFb + lane * 16;
    const unsigned char* vp = VFb + lane * 16;
    u32x4 kb0[4], kb1[4], kb2[4], kb3[4], vb0[4], vb1[4], vb2[4], vb3[4];
#define SG_LOAD(KB, VB, jj) do { _Pragma("unroll") for (int sub = 0; sub < 4; ++sub) { KB[sub] = *(const u32x4*)(kp + (size_t)(((jj) * 4 + sub) * 1024)); VB[sub] = *(const u32x4*)(vp + (size_t)(((jj) * 4 + sub) * 1024)); } } while (0)
#define SG_STEP(KC, VC, KL, VL) { const int j3 = sg_pop(uLo, uHi); { const int j3c = j3 < 0 ? 0 : j3; SG_LOAD(KL, VL, j3c); } sel_tile(KC, VC, j0, OSw, Q8w, MLw, tmLo, tmHi, tb, wave, lane); if (j1 < 0) break; j0 = j1; j1 = j2; j2 = j3; }
    int j0 = sg_pop(uLo, uHi), j1 = sg_pop(uLo, uHi), j2 = sg_pop(uLo, uHi);
    SG_LOAD(kb0, vb0, j0); { const int j1c = j1 < 0 ? 0 : j1, j2c = j2 < 0 ? 0 : j2; SG_LOAD(kb1, vb1, j1c); SG_LOAD(kb2, vb2, j2c); }
    for (;;) {
        SG_STEP(kb0, vb0, kb3, vb3)
        SG_STEP(kb1, vb1, kb0, vb0)
        SG_STEP(kb2, vb2, kb1, vb1)
        SG_STEP(kb3, vb3, kb2, vb2)
    }
#undef SG_LOAD
#undef SG_STEP
}

DI void attn_phase(PP pp, LAS unsigned char* lds, bool do_store) {
    PPOPAQ();
    int tid = threadIdx.x; asm volatile("" : "+v"(tid));
    const int lane = tid & 63, wave = __builtin_amdgcn_readfirstlane(tid >> 6);
    const int G_ = opaque_s((int)gridDim.x), bx_ = opaque_s((int)blockIdx.x);
    const int gw = bx_ * 8 + wave, NGW = G_ * 8, gtid = bx_ * 512 + tid, NT = G_ * 512;
    (void)lane; (void)wave; (void)gw; (void)NGW; (void)gtid; (void)NT;
    unsigned char* ws = pp->ws; bf16_t* PROJ = (bf16_t*)(ws + WS_PROJ);
    const int n = lane & 31, hh = lane >> 5, G = G_;
    for (int it = 0; it < 4; ++it) {
        int tb, bg;
        if (G == 256) { const int kx = bx_ >> 3; bg = bx_ & 7; tb = 127 - (it * 32 + ((it & 1) ? 31 - kx : kx)); }
        else { const int cc = (it & 1) ? (G - 1 - bx_) : bx_; const int rho = it * G + cc; if (rho >= 1024) continue; tb = 127 - (rho >> 3); bg = rho & 7; }
        const int b = bg >> 2, g = bg & 3;
        const int t0 = 64 * tb, tl = 8 * wave + (n >> 2), r = n & 3, t = t0 + tl;
        const size_t trow = (size_t)b * S_ + t;
        bf16_t* qptr = PROJ + trow * LDP + C_Q + (4 * g + r) * 64;
        bf16x8 qf[4];
#pragma unroll
        for (int ks = 0; ks < 4; ++ks) qf[ks] = *(const bf16x8*)(qptr + ks * 16 + 8 * hh);
        f32x16 o[2];
        LAS float* OT = (LAS float*)(lds + L_OT) + wave * 2048 + lane;
        for (int i = tid; i < 64 * IMPSTR; i += 512) ((LAS float*)(lds + L_IMP))[i] = 0.f;
        {
            TileSrc src{(const bf16_t*)(ws + WS_KCMP) + (size_t)bg * 512 * 64, 64, (const bf16_t*)(ws + WS_VTCMP) + (size_t)bg * 64 * 512, 512};
            int nvalid = (t0 + 32) / 16 + 1; if (nvalid > 511) nvalid = 511;
            const int j1 = (nvalid - 1) >> 6;
            float m = -__builtin_inff(), l = 0.f;
            attn_loop<0>(lds, src, 0, j1, qf, o, m, l, tl, t, tb, 0ull, 0ull, tid, wave, lane);
            l += shx(l, 32, lane);
            float inv = 1.0f / fmaxf(l, 1e-30f);
#pragma unroll
            for (int ds = 0; ds < 2; ++ds)
#pragma unroll
                for (int e = 0; e < 16; ++e) o[ds][e] = 0.f;
            attn_loop<1>(lds, src, 0, j1, qf, o, m, inv, tl, t, tb, 0ull, 0ull, tid, wave, lane);
#pragma unroll
            for (int ds = 0; ds < 2; ++ds)
#pragma unroll
                for (int e = 0; e < 16; ++e) OT[(ds * 16 + e) * 64] = o[ds][e];
        }
        {
            const int tok = tid >> 3, prt = tid & 7;
            unsigned mk[4] = {0u, 0u, 0u, 0u};
            if (tb < 16) { mk[0] = (tb == 31) ? 0xffffffffu : ((2u << tb) - 1u); }
            else {
                const LAS float* imp = (const LAS float*)(lds + L_IMP) + tok * IMPSTR + 16 * prt;
                unsigned keys[16];
#pragma unroll
                for (int e = 0; e < 16; ++e) { const int j = 16 * prt + e; const unsigned bits = __builtin_bit_cast(unsigned, imp[e]);
                    keys[e] = (j >= 1 && j <= tb - 1) ? ((bits & 0xffffff80u) | (unsigned)(127 - j)) : 0u; }
                mk[0] = 1u; mk[tb >> 5] |= 1u << (tb & 31);
                for (int round = 0; round < 14; ++round) {
                    unsigned best = keys[0];
#pragma unroll
                    for (int e = 1; e < 16; ++e) best = keys[e] > best ? keys[e] : best;
#pragma unroll
                    for (int o2 = 1; o2 < 8; o2 <<= 1) { const unsigned other = (unsigned)__builtin_amdgcn_ds_bpermute((lane ^ o2) << 2, (int)best); best = other > best ? other : best; }
                    if (best != 0u) { const int jw = 127 - (int)(best & 127u);
                        mk[0] |= (jw < 32) ? (1u << (jw & 31)) : 0u; mk[1] |= (jw >= 32 && jw < 64) ? (1u << (jw & 31)) : 0u;
                        mk[2] |= (jw >= 64 && jw < 96) ? (1u << (jw & 31)) : 0u; mk[3] |= (jw >= 96) ? (1u << (jw & 31)) : 0u; }
#pragma unroll
                    for (int e = 0; e < 16; ++e) if (keys[e] == best) keys[e] = 0u;
                }
            }
            if (prt == 0) { LAS unsigned* sm = (LAS unsigned*)(lds + L_SEL) + tok * 4; sm[0] = mk[0]; sm[1] = mk[1]; sm[2] = mk[2]; sm[3] = mk[3]; }
            __syncthreads();
        }
        {
            TileSrc src{PROJ + (size_t)b * S_ * LDP + C_KW + g * 64, LDP, (const bf16_t*)(ws + WS_VTW) + (size_t)bg * 64 * S_, S_};
            float m = -__builtin_inff(), l = 0.f;
#pragma unroll
            for (int ds = 0; ds < 2; ++ds)
#pragma unroll
                for (int e = 0; e < 16; ++e) o[ds][e] = 0.f;
            attn_loop<3>(lds, src, tb >= 8 ? tb - 8 : 0, tb, qf, o, m, l, tl, t, tb, 0ull, 0ull, tid, wave, lane);
            l += shx(l, 32, lane);
            const float f = sigmoidf_(bf2f(PROJ[((size_t)b * S_ + t) * LDP + C_GN + g * 12 + r * 3 + 2])) / (sigmoidf_(bf2f(PROJ[((size_t)b * S_ + t) * LDP + C_GN + g * 12 + r * 3])) * fmaxf(l, 1e-30f));
#pragma unroll
            for (int ds = 0; ds < 2; ++ds)
#pragma unroll
                for (int e = 0; e < 16; ++e) OT[(ds * 16 + e) * 64] += f * o[ds][e];
        }
        __syncthreads();
        {
            u64 uLo = 0ull, uHi = 0ull;
            { const LAS unsigned* sm = (const LAS unsigned*)(lds + L_SEL) + 8 * wave * 4;
#pragma unroll
              for (int i = 0; i < 8; ++i) { uLo |= (u64)sm[4 * i] | ((u64)sm[4 * i + 1] << 32); uHi |= (u64)sm[4 * i + 2] | ((u64)sm[4 * i + 3] << 32); } }
            uLo = ((u64)(unsigned)__builtin_amdgcn_readfirstlane((int)(unsigned)(uLo >> 32)) << 32) | (unsigned)__builtin_amdgcn_readfirstlane((int)(unsigned)uLo);
            uHi = ((u64)(unsigned)__builtin_amdgcn_readfirstlane((int)(unsigned)(uHi >> 32)) << 32) | (unsigned)__builtin_amdgcn_readfirstlane((int)(unsigned)uHi);
            u64 tmLo, tmHi;
            { const LAS unsigned* sm = (const LAS unsigned*)(lds + L_SEL) + (8 * wave + (lane & 7)) * 4; tmLo = (u64)sm[0] | ((u64)sm[1] << 32); tmHi = (u64)sm[2] | ((u64)sm[3] << 32); }
            LAS unsigned char* OSw = lds + wave * (32 * OSSTR); LAS unsigned char* Q8w = lds + L_Q8 + wave * 2048; LAS float* MLw = (LAS float*)(lds + L_ML) + wave * 64;
            for (int i = lane; i < 32 * OSSTR / 4; i += 64) ((LAS float*)OSw)[i] = 0.f;
            MLw[lane] = (lane < 32) ? -__builtin_inff() : 0.f;
#pragma unroll
            for (int ks = 0; ks < 4; ++ks) { const u32x4 w = __builtin_bit_cast(u32x4, qf[ks]);
                *(LAS long*)(Q8w + n * 64 + 16 * ks + 8 * hh) = mk64(pk4_fp8(bflo(w.x), bfhi(w.x), bflo(w.y), bfhi(w.y)), pk4_fp8(bflo(w.z), bfhi(w.z), bflo(w.w), bfhi(w.w))); }
            sel_gather((const unsigned char*)(ws + WS_KF) + (size_t)bg * 128 * 4096, (const unsigned char*)(ws + WS_VTS) + (size_t)bg * 128 * 4096, uLo, uHi, OSw, Q8w, MLw, tmLo, tmHi, tb, wave, lane);
        }
        if (do_store) {
            int ln2 = lane; asm volatile("" : "+v"(ln2));
            const int n2 = ln2 & 31, h2 = ln2 >> 5, t2 = t0 + 8 * wave + (n2 >> 2), r2 = n2 & 3;
            bf16_t* rowp = PROJ + ((size_t)b * S_ + t2) * LDP;
            const float gcv = sigmoidf_(bf2f(rowp[C_GN + g * 12 + r2 * 3]));
            const LAS float* MLw = (const LAS float*)(lds + L_ML) + wave * 64;
            const float fsel = sigmoidf_(bf2f(rowp[C_GN + g * 12 + r2 * 3 + 1])) / fmaxf(MLw[32 + n2], 1e-30f);
            const LAS unsigned char* OSr = lds + wave * (32 * OSSTR) + n2 * OSSTR;
            bf16_t* op = rowp + C_Q + (4 * g + r2) * 64 + 4 * h2;
#pragma unroll
            for (int ds = 0; ds < 2; ++ds)
#pragma unroll
                for (int gi = 0; gi < 4; ++gi) { const f32x4v os = *(const LAS f32x4v*)(OSr + (32 * ds + 8 * gi + 4 * h2) * 4);
                    u32x2 w; w.x = pk2(gcv * OT[(ds * 16 + 4 * gi) * 64] + fsel * os[0], gcv * OT[(ds * 16 + 4 * gi + 1) * 64] + fsel * os[1]);
                    w.y = pk2(gcv * OT[(ds * 16 + 4 * gi + 2) * 64] + fsel * os[2], gcv * OT[(ds * 16 + 4 * gi + 3) * 64] + fsel * os[3]);
                    *(u32x2*)(op + 32 * ds + 8 * gi) = w; }
        }
        __syncthreads();
    }
}

__global__ void __launch_bounds__(512, 2) fwd_megakernel(Params p) {
    extern __shared__ __attribute__((aligned(16))) unsigned char lds_raw[];
    LAS unsigned char* lds = (LAS unsigned char*)lds_raw;
    cg::grid_group grid = cg::this_grid();
    const int G = gridDim.x, bx = blockIdx.x;
    PP pp = (PP)__builtin_amdgcn_kernarg_segment_ptr();
    volatile LAS unsigned* barst = (volatile LAS unsigned*)(lds + L_BARST);
    if (threadIdx.x == 0) { barst[0] = 0u; barst[1] = 0u; (void)xb_add((unsigned*)(pp->ws + WS_BAR) + XB_XCNT(xb_xcc_id()), 1u); }
    __syncthreads();
#define GSYNC() xcd_barrier((unsigned*)(ws + WS_BAR), barst)
#define ws (pp->ws)
#define PROJ ((bf16_t*)(ws + WS_PROJ))
#define H ((bf16_t*)(ws + WS_H))
#define XC ((bf16_t*)(ws + WS_XC))
#define Y ((float*)(ws + WS_RI))
    const int BIG = 1 << 30;

#ifndef NO_PREP
    prep_phase(pp, 0, lds);
#endif
#ifndef NO_ROW
    row_phase(pp->x, nullptr, nullptr, nullptr, pp->ln_mix_pre, H);
#endif
    grid.sync();

    for (int l = 0; l < NLAYER; ++l) {
        PPOPAQ();
        using pg8::Gemm; using pg8::Sched; using pg8::EpiBf16; using pg8::EpiF32; using pg8::EpiMerge;
        cbias_phase(pp, l);
#ifndef NO_G1
        for (int r_ = 0; r_ < opaque_s(GREP); ++r_) {
        pg8::gemm_phase<EpiBf16>(lds, Gemm{H, (const bf16_t*)(ws + WS_WIN), 1024, 1024, 1024, 128, 128},
            Sched{64, 35, opaque_s(G), opaque_s(bx), 0, BIG, 0u, 256u * 1024 * 2, 0u, 0u, 256u * 1024 * 2, 0u}, EpiBf16{PROJ, LDP, 0, 1.0f, nullptr, 0});
        pg8::gemm_phase<EpiBf16>(lds, Gemm{(const bf16_t*)(ws + WS_MEMN), (const bf16_t*)(ws + WS_WMKV), 1024, 1024, 1024, 128, 128},
            Sched{2, 4, opaque_s(G), (opaque_s(bx) + 64) % opaque_s(G), 0, BIG, 0u, 256u * 1024 * 2, 0u, 0u, 256u * 1024 * 2, 0u}, EpiBf16{(bf16_t*)(ws + WS_KMEM), 1024, 0, 1.0f, nullptr, 0});
        pg8::gemm_phase<EpiBf16>(lds, Gemm{(const bf16_t*)(ws + WS_WMKV) + (size_t)1024 * 1024, (const bf16_t*)(ws + WS_MEMN), 1024, 1024, 1024, 128, 128},
            Sched{4, 2, opaque_s(G), (opaque_s(bx) + 48) % opaque_s(G), 0, BIG, 0u, 256u * 1024 * 2, 0u, 0u, 256u * 1024 * 2, 0u}, EpiBf16{(bf16_t*)(ws + WS_VTMEM), 512, 0, 1.0f, nullptr, 0});
        }
#endif
        GSYNC();
#ifndef NO_POST
        postproj_phase(pp, l);
#endif
#ifndef NO_G1
        if (opaque_s(G) == 256) {
        pg8::gemm_phase<EpiBf16>(lds, Gemm{PROJ, (const bf16_t*)(ws + WS_WC1), 16 * LDP, 2048, 2048, LDP * 2, 128},
            Sched{32, 1, opaque_s(G), opaque_s(bx), 1, BIG, 0u, 0u, 0u, 0u, 0u, 0u}, EpiBf16{(bf16_t*)(ws + WS_HID), 256, 2, 1.0f, (const float*)(ws + WS_CBIAS), 0});
        }
#endif
        GSYNC();
#ifndef NO_G1
        for (int r_ = 0; r_ < opaque_s(GREP); ++r_) {
        if (opaque_s(G) != 256) {
        pg8::gemm_phase<EpiBf16>(lds, Gemm{PROJ, (const bf16_t*)(ws + WS_WC1), 16 * LDP, 2048, 2048, LDP * 2, 128},
            Sched{32, 1, opaque_s(G), opaque_s(bx), 1, BIG, 0u, 0u, 0u, 0u, 0u, 0u}, EpiBf16{(bf16_t*)(ws + WS_HID), 256, 2, 1.0f, (const float*)(ws + WS_CBIAS), 0});
        }
        const int G224 = opaque_s(G), c224 = opaque_s(bx);
        pg8::gemm_phase<EpiBf16>(lds, Gemm{XC, (const bf16_t*)(ws + WS_WLRU), 1024, 128, 128, 128, 128},
            Sched{64, 8, G224, c224, 0, BIG, 0u, 256u * 1024 * 2, 128u * 2, 0u, 256u * 128 * 2, 0u}, EpiBf16{(bf16_t*)(ws + WS_RI), 2048, 0, 1.0f, nullptr, 0});
        pg8::gemm_phase<EpiBf16>(lds, Gemm{PROJ, (const bf16_t*)(ws + WS_KMEM), LDP, 1024, 256, 128, 128},
            Sched{64, 4, G224, c224, 0, 32, (unsigned)C_QM * 2, 256u * LDP * 2, 256u * 2, 0u, 256u * 2, 256u * 1024 * 2}, EpiBf16{H, 1024, 0, 0.0625f * LOG2E, nullptr, 0});
        }
#endif
        GSYNC();
#ifndef NO_SCAN
        scan_phase(pp, l, 0);
#if defined(DUP_SCAN0)
        scan_phase(pp, l, 0);
#endif
#endif
#ifndef NO_MSM
        memsoftmax_phase(pp);
#endif
#ifndef NO_G2
        for (int r_ = 0; r_ < opaque_s(GREP); ++r_) {
        pg8::gemm_phase<EpiF32>(lds, Gemm{(const bf16_t*)(ws + WS_HID), (const bf16_t*)(ws + WS_WC2), 256, 256, 256, 128, 128},
            Sched{32, 1, opaque_s(G), (opaque_s(bx) + 96) % opaque_s(G), 0, 16, 0u, 256u * 256 * 2, 0u, 0u, 0u, 256u * 256 * 2}, EpiF32{(float*)(ws + WS_CRAW), 64, 64});
        }
#endif
        GSYNC();
#ifndef NO_SCAN
        scan_phase(pp, l, 1);
#endif
#ifndef NO_CMPF
        cmpfinal_phase(pp);
#endif
#ifndef NO_G1
        for (int r_ = 0; r_ < opaque_s(GREP); ++r_) {
        pg8::gemm_phase<EpiBf16>(lds, Gemm{H, (const bf16_t*)(ws + WS_VTMEM), 1024, 512, 256, 128, 128},
            Sched{64, 4, opaque_s(G), opaque_s(bx), 0, 32, 0u, 256u * 1024 * 2, 256u * 2, 0u, 256u * 512 * 2, 256u * 2}, EpiBf16{PROJ, LDP, 0, 1.0f, nullptr, C_QM});
        }
#endif
        GSYNC();
#ifndef NO_ATT
#if defined(DUP_ATT)
        attn_phase(pp, lds, opaque_s(0) != 0);
        __syncthreads();
#endif
        attn_phase(pp, lds, true);
#endif
        GSYNC();
#ifndef NO_G3
        for (int r_ = 0; r_ < opaque_s(GREP); ++r_) {
        pg8::gemm_phase<EpiMerge>(lds, Gemm{XC, (const bf16_t*)(ws + WS_WBRA), 1024, 1024, 1024, 128, 128},
            Sched{64, 4, opaque_s(G), opaque_s(bx), 0, BIG, 0u, 256u * 1024 * 2, 0u, 0u, 256u * 1024 * 2, 0u}, EpiMerge{PROJ + C_GM, LDP, Y, H, 0});
        pg8::gemm_phase<EpiMerge>(lds, Gemm{PROJ + C_Q, (const bf16_t*)(ws + WS_WBRB), LDP, 1024, 1024, 128, 128},
            Sched{64, 4, opaque_s(G), opaque_s(bx), 0, BIG, 0u, 256u * LDP * 2, 0u, 0u, 256u * 1024 * 2, 0u}, EpiMerge{PROJ + C_GM + 1024, LDP, Y, H, 1});
        pg8::gemm_phase<EpiMerge>(lds, Gemm{PROJ + C_QM, (const bf16_t*)(ws + WS_WBRC), LDP, 1024, 1024, 128, 128},
            Sched{64, 4, opaque_s(G), opaque_s(bx), 0, BIG, 0u, 256u * LDP * 2, 0u, 0u, 256u * 1024 * 2, 0u}, EpiMerge{PROJ + C_GM + 2048, LDP, Y, H, 2});
        }
#endif
        GSYNC();
#ifndef NO_G2
        for (int r_ = 0; r_ < opaque_s(GREP); ++r_) {
        pg8::gemm_phase<EpiF32>(lds, Gemm{H, (const bf16_t*)(ws + WS_WOUT), 1024, 1024, 1024, 128, 128},
            Sched{64, 4, opaque_s(G), opaque_s(bx), 0, BIG, 0u, 256u * 1024 * 2, 0u, 0u, 256u * 1024 * 2, 0u}, EpiF32{Y, 1024, 1024});
        }
#endif
        GSYNC();
#ifndef NO_ROW
        row_phase((l == 0) ? pp->x : pp->out, Y, pp->ln_mix_post + (size_t)l * 1024, pp->out, pp->ln_mlp_pre + (size_t)l * 1024, H);
#endif
        GSYNC();
#ifndef NO_G1
        for (int r_ = 0; r_ < opaque_s(GREP); ++r_) {
        pg8::gemm_phase<EpiBf16>(lds, Gemm{H, (const bf16_t*)(ws + WS_WM1), 1024, 1024, 1024, 128, 128},
            Sched{64, 16, opaque_s(G), opaque_s(bx), 0, BIG, 0u, 256u * 1024 * 2, 0u, 0u, 256u * 1024 * 2, 0u}, EpiBf16{PROJ, FF_, 1, 1.0f, nullptr, 0});
        }
#endif
        GSYNC();
#ifndef NO_G2
        for (int r_ = 0; r_ < opaque_s(GREP); ++r_) {
        pg8::gemm_phase<EpiF32>(lds, Gemm{PROJ, (const bf16_t*)(ws + WS_WM2), FF_, FF_, FF_, 128, 128},
            Sched{64, 4, opaque_s(G), opaque_s(bx), 0, BIG, 0u, 256u * FF_ * 2, 0u, 0u, 256u * FF_ * 2, 0u}, EpiF32{Y, 1024, 1024});
        }
#endif
        GSYNC();
#ifndef NO_ROW
        row_phase(pp->out, Y, pp->ln_mlp_post + (size_t)l * 1024, pp->out, (l + 1 < NLAYER) ? pp->ln_mix_pre + (size_t)(l + 1) * 1024 : nullptr, (l + 1 < NLAYER) ? H : nullptr);
#endif
#ifndef NO_PREP
        if (l + 1 < NLAYER) prep_phase(pp, l + 1, lds);
#if defined(DUP_PREP)
        if (l + 1 < NLAYER) prep_phase(pp, l + 1, lds);
#endif
#endif
        GSYNC();
    }
#undef ws
#undef PROJ
#undef H
#undef XC
#undef Y
}

extern "C" void kernel_launch(void* const* d_in, const int* in_sizes, int n_in, void* d_out, int out_size, void* d_ws, size_t ws_size, hipStream_t stream) {
    static int grid = 0;
    if (grid == 0) {
        int dev = 0, cus = 0, per_cu = 0;
        hipGetDevice(&dev); hipDeviceGetAttribute(&cus, hipDeviceAttributeMultiprocessorCount, dev);
        hipFuncSetAttribute((const void*)fwd_megakernel, hipFuncAttributeMaxDynamicSharedMemorySize, LDS_BYTES);
        hipOccupancyMaxActiveBlocksPerMultiprocessor(&per_cu, (const void*)fwd_megakernel, 512, LDS_BYTES);
        if (per_cu < 1) per_cu = 1;
        (void)hipGetLastError();
        grid = cus * 1;
        if (ws_size < WS_END) { fprintf(stderr, "kernel_launch: workspace too small (%zu < %zu)\n", ws_size, (size_t)WS_END); grid = -1; }
    }
    if (grid < 0) return;
    Params p{};
    p.x = (const float*)d_in[0]; p.mem = (const float*)d_in[1]; p.pos = (const int*)d_in[2];
    p.ln_mix_pre = (const float*)d_in[3]; p.w_in = (const float*)d_in[4]; p.conv_w = (const float*)d_in[5]; p.conv_b = (const float*)d_in[6];
    p.lru_wr = (const float*)d_in[7]; p.lru_br = (const float*)d_in[8]; p.lru_wi = (const float*)d_in[9]; p.lru_bi = (const float*)d_in[10]; p.lru_lambda = (const float*)d_in[11];
    p.cmp_pe = (const float*)d_in[12]; p.cmp_w1 = (const float*)d_in[13]; p.cmp_b1 = (const float*)d_in[14]; p.cmp_w2 = (const float*)d_in[15];
    p.ln_mem = (const float*)d_in[16]; p.w_mem_kv = (const float*)d_in[17]; p.w_br_rnn = (const float*)d_in[18]; p.w_br_nsa = (const float*)d_in[19]; p.w_br_mem = (const float*)d_in[20]; p.w_out = (const float*)d_in[21];
    p.ln_mix_post = (const float*)d_in[22]; p.ln_mlp_pre = (const float*)d_in[23]; p.mlp_w1 = (const float*)d_in[24]; p.mlp_w2 = (const float*)d_in[25]; p.ln_mlp_post = (const float*)d_in[26];
    p.out = (float*)d_out; p.ws = (unsigned char*)d_ws;
    (void)hipMemsetAsync((unsigned char*)d_ws + WS_BAR, 0, 16384, stream);
    void* args[] = {&p};
    hipError_t e = hipLaunchCooperativeKernel((const void*)fwd_megakernel, dim3(grid), dim3(512), args, LDS_BYTES, stream);
    if (e != hipSuccess) fprintf(stderr, "cooperative launch failed: %s (grid %d)\n", hipGetErrorString(e), grid);
}
```

```cpp
#include <hip/hip_runtime.h>
#include <hip/hip_cooperative_groups.h>
#include <cstdint>
#include <cstdio>
namespace cg = cooperative_groups;

#define LAS __attribute__((address_space(3)))
#define DI __device__ __forceinline__
typedef unsigned short bf16_t;
typedef short bf16x8 __attribute__((ext_vector_type(8)));
typedef short s16x4 __attribute__((ext_vector_type(4)));
typedef float f32x4 __attribute__((ext_vector_type(4)));
typedef float f32x16 __attribute__((ext_vector_type(16)));
typedef float f32x2 __attribute__((ext_vector_type(2)));
typedef unsigned u32x4 __attribute__((ext_vector_type(4)));
typedef unsigned u32x2 __attribute__((ext_vector_type(2)));
typedef __bf16 bf16x2v __attribute__((ext_vector_type(2)));
typedef unsigned long long u64;

constexpr int T_ = 16384, S_ = 8192, D_ = 1024, FF_ = 4096, LDP = 8960, NLAYER = 4;
constexpr int C_XR = 0, C_YR = 1024, C_Q = 2048, C_KC = 3072, C_VC = 3328, C_KS = 3584, C_VS = 3840, C_KW = 4096, C_VW = 4352,
              C_QM = 4608, C_GM = 5632, C_GN = 8704;
constexpr float EPS = 1e-6f;
constexpr float LOG2E = 1.4426950408889634f;

constexpr size_t al256(size_t x) { return (x + 255) & ~(size_t)255; }
constexpr size_t WS_PROJ = 0;
constexpr size_t WS_WIN = al256(WS_PROJ + (size_t)(T_ + 64) * LDP * 2);
constexpr size_t WS_WMKV = WS_WIN + (size_t)LDP * 1024 * 2;
constexpr size_t WS_WBRA = WS_WMKV + (size_t)2048 * 1024 * 2;
constexpr size_t WS_WBRB = WS_WBRA + (size_t)1024 * 1024 * 2;
constexpr size_t WS_WBRC = WS_WBRB + (size_t)1024 * 1024 * 2;
constexpr size_t WS_WOUT = WS_WBRC + (size_t)1024 * 1024 * 2;
constexpr size_t WS_WM1 = WS_WOUT + (size_t)1024 * 1024 * 2;
constexpr size_t WS_WM2 = WS_WM1 + (size_t)4096 * 1024 * 2;
constexpr size_t WS_WC1 = WS_WM2 + (size_t)4096 * 1024 * 2;
constexpr size_t WS_WC2 = WS_WC1 + (size_t)2 * 256 * 2048 * 2;
constexpr size_t WS_WLRU = WS_WC2 + (size_t)2 * 256 * 256 * 2;
constexpr size_t WS_H = WS_WLRU + (size_t)2048 * 128 * 2;
constexpr size_t WS_VTS = WS_H + (size_t)T_ * 1024 * 2;
constexpr size_t WS_VTW = WS_VTS + (size_t)8 * 64 * S_ * 2;
constexpr size_t WS_XC = WS_VTW + (size_t)8 * 64 * S_ * 2;
constexpr size_t WS_RI = WS_XC + (size_t)T_ * 1024 * 2;
constexpr size_t WS_HID = WS_RI + (size_t)T_ * 2048 * 2;
constexpr size_t WS_CRAW = WS_HID + (size_t)8192 * 256 * 2;
constexpr size_t WS_KCMP = WS_CRAW + (size_t)8192 * 64 * 4;
constexpr size_t WS_VTCMP = WS_KCMP + (size_t)8 * 512 * 64 * 2;
constexpr size_t WS_MEMN = WS_VTCMP + (size_t)8 * 512 * 64 * 2;
constexpr size_t WS_KMEM = WS_MEMN + (size_t)512 * 1024 * 2;
constexpr size_t WS_VTMEM = WS_KMEM + (size_t)512 * 1024 * 2;
constexpr size_t WS_SCA = WS_VTMEM + (size_t)512 * 1024 * 2;
constexpr size_t WS_SCH = WS_SCA + (size_t)2 * 128 * 1024 * 4;
constexpr size_t WS_CBP = WS_SCH + (size_t)2 * 128 * 1024 * 4;
constexpr size_t WS_CBIAS = WS_CBP + (size_t)16 * 512 * 4;
constexpr size_t WS_KF = al256(WS_CBIAS + 512 * 4);
constexpr size_t WS_BAR = WS_KF + (size_t)8 * 64 * S_ * 2;
constexpr size_t WS_END = WS_BAR + 16384;
constexpr int L_BARST = 155584;

#ifndef GREP
#define GREP 1
#endif
constexpr int LDS_BYTES = 155648;

DI unsigned f2bf(float f) { unsigned u = __builtin_bit_cast(unsigned, f); return (u + 0x7fffu + ((u >> 16) & 1u)) >> 16; }
DI unsigned pk2(float lo, float hi) { f32x2 f = {lo, hi}; bf16x2v r = __builtin_convertvector(f, bf16x2v); return __builtin_bit_cast(unsigned, r); }
DI float bf2f(unsigned short b) { return __builtin_bit_cast(float, (unsigned)b << 16); }
DI float bflo(unsigned w) { return __builtin_bit_cast(float, w << 16); }
DI float bfhi(unsigned w) { return __builtin_bit_cast(float, w & 0xffff0000u); }
DI float fexp2(float x) { return __builtin_amdgcn_exp2f(x); }
DI float sigmoidf_(float x) { return 1.0f / (1.0f + fexp2(-x * LOG2E)); }
DI float gelu_tanh(float x) { const float z = 0.7978845608028654f * (x + 0.044715f * x * x * x); return x / (1.0f + fexp2(-2.0f * LOG2E * z)); }
DI float shx(float v, int mask, int lane) { return __builtin_bit_cast(float, __builtin_amdgcn_ds_bpermute((lane ^ mask) << 2, __builtin_bit_cast(int, v))); }
DI u64 shx64(u64 v, int mask, int lane) { const int a = (lane ^ mask) << 2; const unsigned lo = (unsigned)__builtin_amdgcn_ds_bpermute(a, (int)(unsigned)v), hi = (unsigned)__builtin_amdgcn_ds_bpermute(a, (int)(unsigned)(v >> 32)); return ((u64)hi << 32) | lo; }
DI unsigned pk4_fp8(float a, float b, float c, float d) { int w = 0; w = __builtin_amdgcn_cvt_pk_fp8_f32(a, b, w, false); w = __builtin_amdgcn_cvt_pk_fp8_f32(c, d, w, true); return (unsigned)w; }
DI long mk64(unsigned lo, unsigned hi) { return (long)(((u64)hi << 32) | (u64)lo); }
DI int opaque_s(int v) { asm volatile("" : "+s"(v)); return v; }
DI float wave_sum(float v, int lane) {
#pragma unroll
    for (int o = 1; o < 64; o <<= 1) v += shx(v, o, lane);
    return v;
}

namespace pg8 {
constexpr int BM = 256, BK = 64, HALF = 128, HTB = HALF * BK * 2, STAGE_BYTES = 8 * HTB, NXCD = 8, WGM = 4;
__host__ __device__ __forceinline__ int lds_byte(int r, int c) { const int st = (r >> 4) * 2 + (c >> 5), rr = r & 15, cc = c & 31, ob = rr * 64 + cc * 2; return st * 1024 + (ob ^ (((ob >> 9) & 1) << 5)); }
__host__ __device__ __forceinline__ void stage_rc(int b, int& R, int& C) { const int st = b / 1024, sb = b % 1024, swz = sb ^ (((sb >> 9) & 1) << 5); R = (st >> 1) * 16 + swz / 64; C = (st & 1) * 32 + (swz % 64) / 2; }
__host__ __device__ __forceinline__ int perm32(int rho) { const int n = rho >> 4, i = rho & 15; return 8 * (i >> 2) + 4 * n + (i & 3); }

struct Unit { int pm, pn; unsigned aoff, boff; };
struct Gemm { const bf16_t* A; const bf16_t* Bt; int lda, ldb, K, kstepA, kstepB; };

struct Sched {
    int nM, nN, G, c, kind, mdiv; unsigned a0, sAm, sAn, b0, sBn, sBb;
    DI bool next(int i, Unit& u) const {
        const long L = (long)i * G + c; const int nwg = nM * nN; if (L >= nwg) return false;
        int wgid = (int)L; { const int q = nwg / NXCD, r = nwg % NXCD, xcd = wgid % NXCD, off = wgid / NXCD; wgid = (xcd < r ? xcd * (q + 1) : r * (q + 1) + (xcd - r) * q) + off; }
        const int nig = WGM * nN, gid = wgid / nig, fm = gid * WGM, gsz = (nM - fm) < WGM ? (nM - fm) : WGM;
        const int pm = fm + ((wgid % nig) % gsz), pn = (wgid % nig) / gsz;
        u.pm = pm; u.pn = pn;
        if (kind == 1) {
            const int j = pm >> 4, b = (pm >> 3) & 1, g = (pm >> 1) & 3, ch = pm & 1;
            u.aoff = (unsigned)(((b * S_ + ch * 4096) * LDP + C_KC + j * 256 + g * 64) * 2); u.boff = (unsigned)(j * 256 * 2048 * 2);
        } else { const unsigned bb = (unsigned)(pm / mdiv); u.aoff = a0 + (unsigned)pm * sAm + (unsigned)pn * sAn; u.boff = b0 + (unsigned)pn * sBn + bb * sBb; }
        return true;
    }
};

DI unsigned cvt_pk_bf16(float lo, float hi) { return pk2(lo, hi); }

struct EpiBf16 {
    static constexpr bool PERM = true;
    bf16_t* O; int ldc; int act; float scale; const float* bias; int oc0;
    DI void operator()(const f32x4 (&acc)[2][2][4][2], const Unit& u, int wr, int wc, int fr, int fq) const {
        const int row0 = u.pm * 256 + wr * 64 + fr, col0 = oc0 + u.pn * 256 + wc * 32 + 8 * fq, bc0 = (u.pm >> 4) * 256 + wc * 32 + 8 * fq;
#pragma unroll
        for (int ai = 0; ai < 2; ++ai)
#pragma unroll
            for (int m = 0; m < 4; ++m) { bf16_t* rowp = O + (size_t)(row0 + ai * HALF + m * 16) * ldc + col0;
#pragma unroll
                for (int bj = 0; bj < 2; ++bj) { f32x4 v0 = acc[ai][bj][m][0], v1 = acc[ai][bj][m][1];
                    if (act == 0) { v0 = v0 * scale; v1 = v1 * scale; }
                    else if (act == 1) {
#pragma unroll
                        for (int e = 0; e < 4; ++e) { const float a = fmaxf(v0[e], 0.f), b = fmaxf(v1[e], 0.f); v0[e] = a * a; v1[e] = b * b; } }
                    else { const f32x4 b0 = *(const f32x4*)(bias + bc0 + bj * HALF), b1 = *(const f32x4*)(bias + bc0 + bj * HALF + 4);
#pragma unroll
                        for (int e = 0; e < 4; ++e) { v0[e] = gelu_tanh(v0[e] + b0[e]); v1[e] = gelu_tanh(v1[e] + b1[e]); } }
                    u32x4 w; w.x = cvt_pk_bf16(v0[0], v0[1]); w.y = cvt_pk_bf16(v0[2], v0[3]); w.z = cvt_pk_bf16(v1[0], v1[1]); w.w = cvt_pk_bf16(v1[2], v1[3]);
                    *(u32x4*)(rowp + bj * HALF) = w; } }
    }
};
struct EpiF32 {
    static constexpr bool PERM = false;
    float* O; int ldc; int ncol;
    DI void operator()(const f32x4 (&acc)[2][2][4][2], const Unit& u, int wr, int wc, int fr, int fq) const {
        const int row0 = u.pm * 256 + wr * 64 + fr, col0 = u.pn * 256 + wc * 32 + 4 * fq;
#pragma unroll
        for (int ai = 0; ai < 2; ++ai)
#pragma unroll
            for (int m = 0; m < 4; ++m) { float* rowp = O + (size_t)(row0 + ai * HALF + m * 16) * ldc;
#pragma unroll
                for (int bj = 0; bj < 2; ++bj)
#pragma unroll
                    for (int n = 0; n < 2; ++n) { const int c = col0 + bj * HALF + n * 16; if (c < ncol) *(f32x4*)(rowp + c) = acc[ai][bj][m][n]; } }
    }
};
struct EpiMerge {
    static constexpr bool PERM = false;
    const bf16_t* gate; int ldg; float* M; bf16_t* Hout; int mode;
    DI void operator()(const f32x4 (&acc)[2][2][4][2], const Unit& u, int wr, int wc, int fr, int fq) const {
        const int row0 = u.pm * 256 + wr * 64 + fr, col0 = u.pn * 256 + wc * 32 + 4 * fq;
#pragma unroll
        for (int ai = 0; ai < 2; ++ai)
#pragma unroll
            for (int m = 0; m < 4; ++m) { const size_t r = (size_t)(row0 + ai * HALF + m * 16);
#pragma unroll
                for (int bj = 0; bj < 2; ++bj)
#pragma unroll
                    for (int n = 0; n < 2; ++n) { const int c = col0 + bj * HALF + n * 16;
                        const u32x2 gw = *(const u32x2*)(gate + r * ldg + c);
                        f32x4 g; g[0] = sigmoidf_(bflo(gw.x)); g[1] = sigmoidf_(bfhi(gw.x)); g[2] = sigmoidf_(bflo(gw.y)); g[3] = sigmoidf_(bfhi(gw.y));
                        f32x4 v = acc[ai][bj][m][n] * g;
                        float* mp = M + r * 1024 + c;
                        if (mode != 0) v = v + *(const f32x4*)mp;
                        if (mode != 2) *(f32x4*)mp = v;
                        else { u32x2 w; w.x = cvt_pk_bf16(v[0], v[1]); w.y = cvt_pk_bf16(v[2], v[3]); *(u32x2*)(Hout + r * 1024 + c) = w; } } }
    }
};

template <class Epi>
DI void gemm_phase(LAS unsigned char* lds, const Gemm g, const Sched& S, const Epi& E) {
    int tid = threadIdx.x; asm volatile("" : "+v"(tid));
    const int wid = __builtin_amdgcn_readfirstlane(tid >> 6), lane = tid & 63, wr = wid >> 2, wc = wid & 3, fr = lane & 15, fq = lane >> 4;
    const int nt = opaque_s(g.K / BK);
    unsigned voffA[2], voffB[2];
#pragma unroll
    for (int i = 0; i < 2; ++i) { int R, C; stage_rc(tid * 16 + i * 8192, R, C); const int Rb = Epi::PERM ? ((R & ~31) + perm32(R & 31)) : R;
        voffA[i] = (unsigned)(R * g.lda + C) * 2u; voffB[i] = (unsigned)(Rb * g.ldb + C) * 2u; }
    const size_t kstepA = (size_t)g.kstepA, kstepB = (size_t)g.kstepB;
    const size_t hstepA = (size_t)HALF * g.lda * 2, hstepB = (size_t)HALF * g.ldb * 2;
    const unsigned ldsw = (unsigned)wid * 1024u;
    const int aoff = lds_byte(wr * 64 + fr, fq * 8), boff = lds_byte(wc * 32 + fr, fq * 8);
#define PG8_SA(b, h) (((b) * 2 + (h)) * HTB)
#define PG8_SB(b, h) ((4 + (b) * 2 + (h)) * HTB)
#define PG8_STAGE(bufoff, gbase, voff) do { _Pragma("unroll") for (int _i = 0; _i < 2; ++_i) \
        __builtin_amdgcn_global_load_lds((const unsigned*)((const char*)(gbase) + (voff)[_i]), (LAS unsigned*)(lds + (bufoff) + ldsw + _i * 8192), 16, 0, 0); } while (0)
#define PG8_LDA(dst, b, h) do { _Pragma("unroll") for (int m = 0; m < 4; ++m) _Pragma("unroll") for (int k = 0; k < 2; ++k) dst[m][k] = *(const LAS bf16x8*)(lds + PG8_SA(b, h) + aoff + m * 2048 + k * 1024); } while (0)
#define PG8_LDB(dst, b, h) do { _Pragma("unroll") for (int n = 0; n < 2; ++n) _Pragma("unroll") for (int k = 0; k < 2; ++k) dst[n][k] = *(const LAS bf16x8*)(lds + PG8_SB(b, h) + boff + n * 2048 + k * 1024); } while (0)
#define PG8_MMA(ai, bj, At, Bt) do { __builtin_amdgcn_s_setprio(1); _Pragma("unroll") for (int m = 0; m < 4; ++m) _Pragma("unroll") for (int n = 0; n < 2; ++n) _Pragma("unroll") for (int k = 0; k < 2; ++k) \
        acc[ai][bj][m][n] = __builtin_amdgcn_mfma_f32_16x16x32_bf16(Bt[n][k], At[m][k], acc[ai][bj][m][n], 0, 0, 0); __builtin_amdgcn_s_setprio(0); } while (0)
#define PG8_WAIT_V(n) asm volatile("s_waitcnt vmcnt(" #n ")" ::: "memory")
#define PG8_WAIT_L(n) asm volatile("s_waitcnt lgkmcnt(" #n ")" ::: "memory")
#define PG8_BAR __builtin_amdgcn_s_barrier()
#define PG8_SCHED __builtin_amdgcn_sched_barrier(0)
    Unit cur, nxt; int ui = 0;
    if (!S.next(0, cur)) return;
    f32x4 acc[2][2][4][2];
#pragma unroll
    for (int a = 0; a < 2; ++a)
#pragma unroll
        for (int b = 0; b < 2; ++b)
#pragma unroll
            for (int m = 0; m < 4; ++m)
#pragma unroll
                for (int n = 0; n < 2; ++n) acc[a][b][m][n] = (f32x4){0.f, 0.f, 0.f, 0.f};
    bf16x8 At[4][2], B0[2][2], B1[2][2];
    const char* cA = (const char*)g.A + cur.aoff; const char* cB = (const char*)g.Bt + cur.boff;
    PG8_STAGE(PG8_SB(0, 0), cB, voffB); PG8_STAGE(PG8_SB(0, 1), cB + hstepB, voffB); PG8_STAGE(PG8_SA(0, 0), cA, voffA); PG8_STAGE(PG8_SA(0, 1), cA + hstepA, voffA);
    if (wr == 1) PG8_BAR;
    PG8_WAIT_V(2); PG8_BAR;
    PG8_STAGE(PG8_SB(1, 0), cB + kstepB, voffB); PG8_STAGE(PG8_SA(1, 0), cA + kstepA, voffA); PG8_STAGE(PG8_SB(1, 1), cB + hstepB + kstepB, voffB);
    PG8_WAIT_V(6); PG8_BAR;
    for (;;) {
        const bool has_next = S.next(ui + 1, nxt);
        const char* nA = has_next ? (const char*)g.A + nxt.aoff : cA; const char* nB = has_next ? (const char*)g.Bt + nxt.boff : cB;
        for (int t = 0; t < nt; t += 2) {
            const bool last = (t == nt - 2);
            const char* a1 = cA + (size_t)(t + 1) * kstepA;
            const char* a2 = last ? nA : cA + (size_t)(t + 2) * kstepA; const char* b2 = last ? nB : cB + (size_t)(t + 2) * kstepB;
            const char* a3 = a2 + kstepA; const char* b3 = b2 + kstepB;
            PG8_LDB(B0, 0, 0); PG8_LDB(B1, 0, 1); PG8_SCHED; PG8_LDA(At, 0, 0); PG8_STAGE(PG8_SA(1, 1), a1 + hstepA, voffA);
            PG8_WAIT_V(8); PG8_WAIT_L(0); PG8_BAR; PG8_MMA(0, 0, At, B0); PG8_MMA(0, 1, At, B1); PG8_BAR; PG8_SCHED;
            PG8_LDA(At, 0, 1); PG8_STAGE(PG8_SB(0, 0), b2, voffB); PG8_STAGE(PG8_SB(0, 1), b2 + hstepB, voffB); PG8_STAGE(PG8_SA(0, 0), a2, voffA);
            PG8_WAIT_V(8); PG8_WAIT_L(0); PG8_BAR; PG8_MMA(1, 0, At, B0); PG8_MMA(1, 1, At, B1); PG8_BAR; PG8_SCHED;
            PG8_LDB(B0, 1, 0); PG8_LDB(B1, 1, 1); PG8_SCHED; PG8_LDA(At, 1, 0); PG8_STAGE(PG8_SA(0, 1), a2 + hstepA, voffA);
            PG8_WAIT_V(8); PG8_WAIT_L(0); PG8_BAR; PG8_MMA(0, 0, At, B0); PG8_MMA(0, 1, At, B1); PG8_BAR; PG8_SCHED;
            PG8_LDA(At, 1, 1); PG8_STAGE(PG8_SB(1, 0), b3, voffB); PG8_STAGE(PG8_SB(1, 1), b3 + hstepB, voffB); PG8_STAGE(PG8_SA(1, 0), a3, voffA);
            PG8_WAIT_V(8); PG8_WAIT_L(0); PG8_BAR; PG8_MMA(1, 0, At, B0); PG8_MMA(1, 1, At, B1); PG8_BAR; PG8_SCHED;
        }
        if (wr == 0) PG8_BAR;
        E(acc, cur, wr, wc, fr, fq);
        if (!has_next) break;
#pragma unroll
        for (int a = 0; a < 2; ++a)
#pragma unroll
            for (int b = 0; b < 2; ++b)
#pragma unroll
                for (int m = 0; m < 4; ++m)
#pragma unroll
                    for (int n = 0; n < 2; ++n) acc[a][b][m][n] = (f32x4){0.f, 0.f, 0.f, 0.f};
        cur = nxt; cA = nA; cB = nB; ++ui;
        if (wr == 1) PG8_BAR;
    }
    PG8_WAIT_V(0);
    PG8_BAR;
#undef PG8_SA
#undef PG8_SB
#undef PG8_STAGE
#undef PG8_LDA
#undef PG8_LDB
#undef PG8_MMA
#undef PG8_WAIT_V
#undef PG8_WAIT_L
#undef PG8_BAR
#undef PG8_SCHED
}
}


#define XB_TMO      128
#define XB_XCNT(j)  (256  + 64 * (j))
#define XB_XSUB(j)  (1280 + 64 * (j))
#define XB_XGEN(j)  (2304 + 64 * (j))
#define XB_TOP      3328
#define XB_TOPGEN   3392
#define XCD_BAR_WORDS 3456
#define XB_SPIN_CAP (1u << 22)
DI unsigned xb_ld(unsigned* p)              { return __hip_atomic_load(p, __ATOMIC_RELAXED, __HIP_MEMORY_SCOPE_AGENT); }
DI unsigned xb_add(unsigned* p, unsigned v) { return __hip_atomic_fetch_add(p, v, __ATOMIC_RELAXED, __HIP_MEMORY_SCOPE_AGENT); }
DI unsigned xb_xcc_id() { return (unsigned)__builtin_amdgcn_s_getreg((3 << 11) | 20) & 0xFu; }
#define XB_SPIN(cond, bar) do { unsigned _sp = 0; while (cond) { __builtin_amdgcn_s_sleep(1); \
    if ((++_sp & 255u) == 0u) { if (xb_ld(&(bar)[XB_TMO])) break; if (_sp > XB_SPIN_CAP) { atomicAdd(&(bar)[XB_TMO], 1u); break; } } } } while (0)
DI void xcd_barrier_complete(unsigned* bar, unsigned x, unsigned& nloc, unsigned& nx) {
    const unsigned G = gridDim.x * gridDim.y * gridDim.z;
    unsigned sum, cnt, mine, sp = 0u;
    for (;;) {
        sum = 0u; cnt = 0u; mine = 0u;
#pragma unroll
        for (unsigned j = 0; j < 16; ++j) { const unsigned c = xb_ld(&bar[XB_XCNT(j)]); sum += c; cnt += (c > 0u) ? 1u : 0u; mine = (j == x) ? c : mine; }
        if (sum == G) break;
        __builtin_amdgcn_s_sleep(1);
        if ((++sp & 255u) == 0u) { if (xb_ld(&bar[XB_TMO])) break; if (sp > XB_SPIN_CAP) { atomicAdd(&bar[XB_TMO], 1u); break; } }
    }
    nloc = mine > 0u ? mine : 1u; nx = cnt > 0u ? cnt : 1u;
}
DI void xcd_barrier(unsigned* bar, volatile LAS unsigned* st) {
    asm volatile("s_waitcnt vmcnt(0)" ::: "memory");
    __syncthreads();
    if (threadIdx.x == 0) {
        __builtin_amdgcn_s_waitcnt(0);
        const unsigned x = xb_xcc_id();
        unsigned nloc = st[0], nx = st[1];
        if (nloc == 0u) { xcd_barrier_complete(bar, x, nloc, nx); st[0] = nloc; st[1] = nx; }
        const unsigned old = xb_add(&bar[XB_XSUB(x)], 1u);
        const unsigned gen = old / nloc;
        if (old + 1u == (gen + 1u) * nloc) {
            __builtin_amdgcn_fence(__ATOMIC_RELEASE, "agent");
            asm volatile("s_waitcnt vmcnt(0)" ::: "memory");
            const unsigned og = xb_add(&bar[XB_TOP], 1u);
            const unsigned tg = og / nx;
            if (og + 1u == (tg + 1u) * nx) xb_add(&bar[XB_TOPGEN], 1u);
            else XB_SPIN(xb_ld(&bar[XB_TOPGEN]) == tg, bar);
            __builtin_amdgcn_fence(__ATOMIC_ACQUIRE, "agent");
            xb_add(&bar[XB_XGEN(x)], 1u);
            asm volatile("s_waitcnt vmcnt(0)" ::: "memory");
        } else {
            XB_SPIN(xb_ld(&bar[XB_XGEN(x)]) == gen, bar);
            __builtin_amdgcn_fence(__ATOMIC_ACQUIRE, "agent");
            asm volatile("s_waitcnt vmcnt(0)" ::: "memory");
        }
    }
    __syncthreads();
}

struct Params {
    const float* x; const float* mem; const int* pos;
    const float* ln_mix_pre; const float* w_in; const float* conv_w; const float* conv_b;
    const float* lru_wr; const float* lru_br; const float* lru_wi; const float* lru_bi; const float* lru_lambda;
    const float* cmp_pe; const float* cmp_w1; const float* cmp_b1; const float* cmp_w2;
    const float* ln_mem; const float* w_mem_kv; const float* w_br_rnn; const float* w_br_nsa; const float* w_br_mem; const float* w_out;
    const float* ln_mix_post; const float* ln_mlp_pre; const float* mlp_w1; const float* mlp_w2; const float* ln_mlp_post;
    float* out; unsigned char* ws;
};
typedef const __attribute__((address_space(4))) Params* PP;
#define PPOPAQ() asm volatile("" : "+s"(pp))

DI void tr_item(const float* W, int ldw, int srccol, int valid, int k0, bf16_t* WT, int ldt, int drow0, LAS float* scr, int lane) {
    const int c32 = lane & 31;
    float vv[32];
    const float* wp = W + (size_t)(k0 + (lane >> 5)) * ldw + srccol + (c32 < valid ? c32 : 0);
#pragma unroll
    for (int i = 0; i < 32; ++i) vv[i] = wp[(size_t)(2 * i) * ldw];
#pragma unroll
    for (int i = 0; i < 32; ++i) scr[(2 * i + (lane >> 5)) * 33 + c32] = (c32 < valid) ? vv[i] : 0.f;
    __builtin_amdgcn_s_waitcnt(0xc07f); asm volatile("s_waitcnt lgkmcnt(0)" ::: "memory");
    const int c = lane & 7;
#pragma unroll
    for (int j = 0; j < 4; ++j) { const int n = (lane >> 3) + 8 * j; const LAS float* s = scr + (8 * c) * 33 + n;
        u32x4 o; o.x = pk2(s[0 * 33], s[1 * 33]); o.y = pk2(s[2 * 33], s[3 * 33]); o.z = pk2(s[4 * 33], s[5 * 33]); o.w = pk2(s[6 * 33], s[7 * 33]);
        *(u32x4*)(WT + (size_t)(drow0 + n) * ldt + k0 + 8 * c) = o; }
    asm volatile("s_waitcnt lgkmcnt(0)" ::: "memory");
}

DI void prep_phase(PP pp, int l, LAS unsigned char* lds) {
    PPOPAQ();
    int tid = threadIdx.x; asm volatile("" : "+v"(tid));
    const int lane = tid & 63, wave = __builtin_amdgcn_readfirstlane(tid >> 6);
    const int G_ = opaque_s((int)gridDim.x), bx_ = opaque_s((int)blockIdx.x);
    const int gw = bx_ * 8 + wave, NGW = G_ * 8, gtid = bx_ * 512 + tid, NT = G_ * 512;
    (void)lane; (void)wave; (void)gw; (void)NGW; (void)gtid; (void)NT;
    LAS float* scr = (LAS float*)(lds + wave * 8704);
    unsigned char* ws = pp->ws;
    const float* w_in = pp->w_in + (size_t)l * 1024 * 8752;
    constexpr int I_IN = 16 * 280, I_MKV = 16 * 64, I_BR = 16 * 32, I_M1 = 16 * 128, I_M2 = 64 * 32, I_C1 = 2 * 32 * 8, I_C2 = 2 * 4 * 8, I_LRU = 2 * 8 * 2 * 4;
    constexpr int NITEMS = I_IN + I_MKV + 4 * I_BR + I_M1 + I_M2 + I_C1 + I_C2 + I_LRU;
    for (int it = gw; it < NITEMS; it += NGW) {
        int r = it;
        if (r < I_IN) { const int kb = r / 280, nb = r % 280, n0 = 32 * nb; int src, valid = 32;
            if (n0 < 4608) src = n0; else if (n0 < 5632) src = n0 - 4608 + 4656; else if (n0 < 8704) src = n0 - 5632 + 5680;
            else { src = n0 - 8704 + 4608; valid = 48 - (n0 - 8704); valid = valid < 0 ? 0 : (valid > 32 ? 32 : valid); if (valid == 0) src = 0; }
            tr_item(w_in, 8752, src, valid, 64 * kb, (bf16_t*)(ws + WS_WIN), 1024, n0, scr, lane); continue; } r -= I_IN;
        if (r < I_MKV) { tr_item(pp->w_mem_kv + (size_t)l * 1024 * 2048, 2048, 32 * (r % 64), 32, 64 * (r / 64), (bf16_t*)(ws + WS_WMKV), 1024, 32 * (r % 64), scr, lane); continue; } r -= I_MKV;
        if (r < I_BR) { tr_item(pp->w_br_rnn + (size_t)l * 1024 * 1024, 1024, 32 * (r % 32), 32, 64 * (r / 32), (bf16_t*)(ws + WS_WBRA), 1024, 32 * (r % 32), scr, lane); continue; } r -= I_BR;
        if (r < I_BR) { tr_item(pp->w_br_nsa + (size_t)l * 1024 * 1024, 1024, 32 * (r % 32), 32, 64 * (r / 32), (bf16_t*)(ws + WS_WBRB), 1024, 32 * (r % 32), scr, lane); continue; } r -= I_BR;
        if (r < I_BR) { tr_item(pp->w_br_mem + (size_t)l * 1024 * 1024, 1024, 32 * (r % 32), 32, 64 * (r / 32), (bf16_t*)(ws + WS_WBRC), 1024, 32 * (r % 32), scr, lane); continue; } r -= I_BR;
        if (r < I_BR) { tr_item(pp->w_out + (size_t)l * 1024 * 1024, 1024, 32 * (r % 32), 32, 64 * (r / 32), (bf16_t*)(ws + WS_WOUT), 1024, 32 * (r % 32), scr, lane); continue; } r -= I_BR;
        if (r < I_M1) { tr_item(pp->mlp_w1 + (size_t)l * 1024 * 4096, 4096, 32 * (r % 128), 32, 64 * (r / 128), (bf16_t*)(ws + WS_WM1), 1024, 32 * (r % 128), scr, lane); continue; } r -= I_M1;
        if (r < I_M2) { tr_item(pp->mlp_w2 + (size_t)l * 4096 * 1024, 1024, 32 * (r % 32), 32, 64 * (r / 32), (bf16_t*)(ws + WS_WM2), 4096, 32 * (r % 32), scr, lane); continue; } r -= I_M2;
        if (r < I_C1) { const int j = r / 256, q = r % 256;
            tr_item(pp->cmp_w1 + ((size_t)l * 2 + j) * 2048 * 256, 256, 32 * (q % 8), 32, 64 * (q / 8), (bf16_t*)(ws + WS_WC1) + (size_t)j * 256 * 2048, 2048, 32 * (q % 8), scr, lane); continue; } r -= I_C1;
        if (r < I_C2) { const int j = r / 32, q = r % 32; const int n0 = 32 * (q % 8);
            tr_item(pp->cmp_w2 + ((size_t)l * 2 + j) * 256 * 64, 64, n0 < 64 ? n0 : 0, n0 < 64 ? 32 : 0, 64 * (q / 8), (bf16_t*)(ws + WS_WC2) + (size_t)j * 256 * 256, 256, n0, scr, lane); continue; } r -= I_C2;
        { const int ri = r / 64, q = r % 64, blk = q / 8, q2 = q % 8;
            const float* W = (ri == 0 ? pp->lru_wr : pp->lru_wi) + ((size_t)l * 8 + blk) * 128 * 128;
            tr_item(W, 128, 32 * (q2 % 4), 32, 64 * (q2 / 4), (bf16_t*)(ws + WS_WLRU), 128, blk * 256 + ri * 128 + 32 * (q2 % 4), scr, lane); }
    }
    for (int m = gw; m < 512; m += NGW) {
        const f32x4* xr = (const f32x4*)(pp->mem + (size_t)m * 1024) + lane; const f32x4* gr = (const f32x4*)(pp->ln_mem + (size_t)l * 1024) + lane;
        f32x4 v[4]; float s = 0.f;
#pragma unroll
        for (int j = 0; j < 4; ++j) { v[j] = xr[64 * j]; s += (v[j].x * v[j].x + v[j].y * v[j].y) + (v[j].z * v[j].z + v[j].w * v[j].w); }
        const float rs = 1.0f / sqrtf(wave_sum(s, lane) * (1.f / 1024.f) + EPS);
        u32x2* o8 = (u32x2*)((bf16_t*)(ws + WS_MEMN) + (size_t)m * 1024) + lane;
#pragma unroll
        for (int j = 0; j < 4; ++j) { const f32x4 g = gr[64 * j]; u32x2 w; w.x = pk2(v[j].x * rs * g.x, v[j].y * rs * g.y); w.y = pk2(v[j].z * rs * g.z, v[j].w * rs * g.w); o8[64 * j] = w; }
    }
    {
        const int gt = gw * 64 + lane;
        if (gt < 16 * 512) { const int prt = gt / 512, jn = gt % 512, j = jn / 256, n = jn % 256;
            const float* w1 = pp->cmp_w1 + ((size_t)l * 2 + j) * 2048 * 256 + n; const float* pe = pp->cmp_pe + ((size_t)l * 2 + j) * 2048;
            float s = 0.f;
            for (int k = prt * 128; k < prt * 128 + 128; ++k) s += pe[k] * w1[(size_t)k * 256];
            ((float*)(ws + WS_CBP))[gt] = s; }
    }
}

DI void row_phase(const float* xin, const float* y, const float* gpost, float* xout, const float* gnext, bf16_t* hout) {
    int tid = threadIdx.x; asm volatile("" : "+v"(tid));
    const int lane = tid & 63, wave = __builtin_amdgcn_readfirstlane(tid >> 6);
    const int G_ = opaque_s((int)gridDim.x), bx_ = opaque_s((int)blockIdx.x);
    const int gw = bx_ * 8 + wave, NGW = G_ * 8, gtid = bx_ * 512 + tid, NT = G_ * 512;
    (void)lane; (void)wave; (void)gw; (void)NGW; (void)gtid; (void)NT;
    for (int m = gw; m < T_; m += NGW) {
        const f32x4* xr = (const f32x4*)(xin + (size_t)m * 1024) + lane;
        f32x4 v[4];
#pragma unroll
        for (int j = 0; j < 4; ++j) v[j] = xr[64 * j];
        if (y) {
            const f32x4* yr = (const f32x4*)(y + (size_t)m * 1024) + lane; const f32x4* gr = (const f32x4*)gpost + lane;
            f32x4 w[4]; float s = 0.f;
#pragma unroll
            for (int j = 0; j < 4; ++j) { w[j] = yr[64 * j]; s += (w[j].x * w[j].x + w[j].y * w[j].y) + (w[j].z * w[j].z + w[j].w * w[j].w); }
            const float rs = 1.0f / sqrtf(wave_sum(s, lane) * (1.f / 1024.f) + EPS);
            f32x4* xo = (f32x4*)(xout + (size_t)m * 1024) + lane;
#pragma unroll
            for (int j = 0; j < 4; ++j) { v[j] = v[j] + w[j] * rs * gr[64 * j]; xo[64 * j] = v[j]; }
        }
        if (hout) {
            float s = 0.f;
#pragma unroll
            for (int j = 0; j < 4; ++j) s += (v[j].x * v[j].x + v[j].y * v[j].y) + (v[j].z * v[j].z + v[j].w * v[j].w);
            const float rs = 1.0f / sqrtf(wave_sum(s, lane) * (1.f / 1024.f) + EPS);
            const f32x4* gr = (const f32x4*)gnext + lane; u32x2* o8 = (u32x2*)(hout + (size_t)m * 1024) + lane;
#pragma unroll
            for (int j = 0; j < 4; ++j) { const f32x4 g = gr[64 * j]; u32x2 w; w.x = pk2(v[j].x * rs * g.x, v[j].y * rs * g.y); w.y = pk2(v[j].z * rs * g.z, v[j].w * rs * g.w); o8[64 * j] = w; }
        }
    }
}

DI void rope8(u32x4& lo, u32x4& hi, float pos, int d0, float scale) {
    unsigned* pl = (unsigned*)&lo; unsigned* ph = (unsigned*)&hi;
    float x1[8], x2[8];
#pragma unroll
    for (int e = 0; e < 4; ++e) { x1[2 * e] = bflo(pl[e]); x1[2 * e + 1] = bfhi(pl[e]); x2[2 * e] = bflo(ph[e]); x2[2 * e + 1] = bfhi(ph[e]); }
#pragma unroll
    for (int e = 0; e < 8; ++e) {
        const float inv = fexp2(-(float)(d0 + e) * 0.41524101186092029f);
        const float ang = pos * inv;
        const double rev = (double)ang * 0.15915494309189535; const float fr = (float)(rev - __builtin_rint(rev));
        const float sn = __builtin_amdgcn_sinf(fr), cs = __builtin_amdgcn_cosf(fr);
        const float a = (x1[e] * cs - x2[e] * sn) * scale, b = (x2[e] * cs + x1[e] * sn) * scale; x1[e] = a; x2[e] = b;
    }
#pragma unroll
    for (int e = 0; e < 4; ++e) { pl[e] = pk2(x1[2 * e], x1[2 * e + 1]); ph[e] = pk2(x2[2 * e], x2[2 * e + 1]); }
}

DI void postproj_phase(PP pp, int l) {
    PPOPAQ();
    if (opaque_s((int)blockIdx.x) < 32 && gridDim.x == 256) return;
    int tid = threadIdx.x; asm volatile("" : "+v"(tid));
    const int lane = tid & 63, wave = __builtin_amdgcn_readfirstlane(tid >> 6);
    const int G_ = opaque_s((int)gridDim.x), bx_ = opaque_s((int)blockIdx.x);
    const bool shr = (G_ == 256); const int gw = bx_ * 8 + wave, NGW = G_ * 8, gtid = (shr ? bx_ - 32 : bx_) * 512 + tid, NT = (shr ? G_ - 32 : G_) * 512;
    (void)lane; (void)wave; (void)gw; (void)NGW; (void)gtid; (void)NT;
    unsigned char* ws = pp->ws; bf16_t* PROJ = (bf16_t*)(ws + WS_PROJ);
    {
        const float* cw = pp->conv_w + (size_t)l * 4 * 1024; const float* cb = pp->conv_b + (size_t)l * 1024; bf16_t* XC = (bf16_t*)(ws + WS_XC);
        for (int i = gtid; i < (T_ / 8) * 128; i += NT) { const int tb8 = (i >> 7) * 8, c8 = (i & 127) * 8, ts0 = tb8 & (S_ - 1);
            u32x4 xr[11];
#pragma unroll
            for (int w = 0; w < 11; ++w) { const int tt = tb8 - 3 + w; const bool okr = ts0 - 3 + w >= 0; const u32x4 ld = *(const u32x4*)(PROJ + (size_t)(okr ? tt : tb8) * LDP + C_XR + c8);
                xr[w] = okr ? ld : (u32x4){0u, 0u, 0u, 0u}; }
            f32x4 kw[4][2];
#pragma unroll
            for (int w = 0; w < 4; ++w) { kw[w][0] = *(const f32x4*)(cw + w * 1024 + c8); kw[w][1] = *(const f32x4*)(cw + w * 1024 + c8 + 4); }
            const f32x4 b0 = *(const f32x4*)(cb + c8), b1 = *(const f32x4*)(cb + c8 + 4);
#pragma unroll
            for (int r = 0; r < 8; ++r) {
                float acc[8] = {b0.x, b0.y, b0.z, b0.w, b1.x, b1.y, b1.z, b1.w};
#pragma unroll
                for (int w = 0; w < 4; ++w) { const unsigned* xp = (const unsigned*)&xr[r + w]; const f32x4 k0 = kw[w][0], k1 = kw[w][1];
                    acc[0] += k0.x * bflo(xp[0]); acc[1] += k0.y * bfhi(xp[0]); acc[2] += k0.z * bflo(xp[1]); acc[3] += k0.w * bfhi(xp[1]);
                    acc[4] += k1.x * bflo(xp[2]); acc[5] += k1.y * bfhi(xp[2]); acc[6] += k1.z * bflo(xp[3]); acc[7] += k1.w * bfhi(xp[3]); }
                u32x4 o; o.x = pk2(acc[0], acc[1]); o.y = pk2(acc[2], acc[3]); o.z = pk2(acc[4], acc[5]); o.w = pk2(acc[6], acc[7]);
                *(u32x4*)(XC + (size_t)(tb8 + r) * 1024 + c8) = o; }
        }
    }
    for (int i = gtid; i < T_ * 20 * 4; i += NT) { const int t = i / 80, r = i % 80, hd = r >> 2, d0 = (r & 3) * 8;
        int col; float sc = 1.0f;
        if (hd < 16) { col = C_Q + hd * 64; sc = 0.125f * LOG2E; } else col = C_KW + (hd - 16) * 64;
        bf16_t* base = PROJ + (size_t)t * LDP + col + d0;
        u32x4 lo = *(const u32x4*)base, hi = *(const u32x4*)(base + 32);
        rope8(lo, hi, (float)pp->pos[t], d0, sc);
        *(u32x4*)base = lo; *(u32x4*)(base + 32) = hi; }
    for (int i = gtid; i < 8 * 128 * 4 * 64; i += NT) { const int ln = i & 63, sub = (i >> 6) & 3, j = (i >> 8) & 127, bg = i >> 15, b = bg >> 2, g = bg & 3;
        const int r16 = ln & 15, quad = ln >> 4, t = 64 * j + 16 * sub + r16, dl = 8 * quad;
        const bf16_t* base = PROJ + (size_t)(b * S_ + t) * LDP + C_KS + g * 64 + dl;
        u32x4 lo = *(const u32x4*)base, hi = *(const u32x4*)(base + 32);
        rope8(lo, hi, (float)pp->pos[b * S_ + t], dl, 1.0f);
        u32x4 outw;
        outw.x = pk4_fp8(bflo(lo.x), bfhi(lo.x), bflo(lo.y), bfhi(lo.y)); outw.y = pk4_fp8(bflo(lo.z), bfhi(lo.z), bflo(lo.w), bfhi(lo.w));
        outw.z = pk4_fp8(bflo(hi.x), bfhi(hi.x), bflo(hi.y), bfhi(hi.y)); outw.w = pk4_fp8(bflo(hi.z), bfhi(hi.z), bflo(hi.w), bfhi(hi.w));
        *(u32x4*)((unsigned char*)(ws + WS_KF) + (size_t)i * 16) = outw; }
    for (int i = gtid; i < 8 * 128 * 4 * 64; i += NT) { const int ln = i & 63, dsub = (i >> 6) & 3, j = (i >> 8) & 127, bg = i >> 15, b = bg >> 2, g = bg & 3;
        const int r16 = ln & 15, quad = ln >> 4;
        u32x4 outw;
#pragma unroll
        for (int kst = 0; kst < 2; ++kst) { const int key0 = 64 * j + 32 * kst + 4 * quad;
            const bf16_t* src = PROJ + (size_t)(b * S_ + key0) * LDP + C_VS + g * 64 + 16 * dsub + r16;
            float v[8];
#pragma unroll
            for (int e = 0; e < 8; ++e) v[e] = bf2f(src[(size_t)(e < 4 ? e : e + 12) * LDP]);
            const unsigned w0 = pk4_fp8(v[0], v[1], v[2], v[3]), w1 = pk4_fp8(v[4], v[5], v[6], v[7]);
            if (kst == 0) { outw.x = w0; outw.y = w1; } else { outw.z = w0; outw.w = w1; } }
        *(u32x4*)((unsigned char*)(ws + WS_VTS) + (size_t)i * 16) = outw; }
    for (int i = gtid; i < 2 * 4 * 1024 * 64; i += NT) { const int d = i & 63, t8 = (i >> 6) & 1023, g = (i >> 16) & 3, b = (i >> 18) & 1, which = 1;
        const bf16_t* src = PROJ + (size_t)(b * S_ + t8 * 8) * LDP + (which ? C_VW : C_VS) + g * 64 + d;
        unsigned short v[8];
#pragma unroll
        for (int e = 0; e < 8; ++e) v[e] = src[(size_t)e * LDP];
        u32x4 o; o.x = v[0] | ((unsigned)v[1] << 16); o.y = v[2] | ((unsigned)v[3] << 16); o.z = v[4] | ((unsigned)v[5] << 16); o.w = v[6] | ((unsigned)v[7] << 16);
        *(u32x4*)((bf16_t*)(ws + (which ? WS_VTW : WS_VTS)) + ((size_t)(b * 4 + g) * 64 + d) * S_ + t8 * 8) = o; }
}
DI void cbias_phase(PP pp, int l) {
    PPOPAQ();
    int tid = threadIdx.x; asm volatile("" : "+v"(tid));
    if (opaque_s((int)blockIdx.x) == 0) { unsigned char* ws = pp->ws; const float* part = (const float*)(ws + WS_CBP); float s = pp->cmp_b1[(size_t)l * 512 + tid];
        for (int q = 0; q < 16; ++q) s += part[q * 512 + tid];
        ((float*)(ws + WS_CBIAS))[tid] = s; }
}

DI void lru_ab(float rp, float ip, float xc, float cl, float& a, float& bb) {
    const float la = cl * sigmoidf_(rp);
    a = fexp2(la * LOG2E);
    const float x2 = 2.0f * la;
    float om;
    if (x2 > -0.1f) om = -x2 * (1.0f + x2 * (0.5f + x2 * (0.16666667f + x2 * (0.041666668f + x2 * 0.0083333338f)))); else om = 1.0f - a * a;
    bb = sqrtf(om) * sigmoidf_(ip) * xc;
}
DI void scan_phase(PP pp, int l, int pass) {
    PPOPAQ();
    int tid = threadIdx.x; asm volatile("" : "+v"(tid));
    const int G_ = opaque_s((int)gridDim.x), bx_ = opaque_s((int)blockIdx.x);
    unsigned char* ws = pp->ws; const bf16_t* __restrict__ RI = (const bf16_t*)(ws + WS_RI); bf16_t* XC = (bf16_t*)(ws + WS_XC); const bf16_t* __restrict__ PROJ = (const bf16_t*)(ws + WS_PROJ);
    f32x2* SA = (f32x2*)(ws + WS_SCA); f32x2* SH = (f32x2*)(ws + WS_SCH);
    const int ch = 2 * tid, blk = ch >> 7, cc = ch & 127, rcol = blk * 256 + cc;
    const f32x2 lam = *(const f32x2*)(pp->lru_lambda + (size_t)l * 1024 + ch), br = *(const f32x2*)(pp->lru_br + (size_t)l * 1024 + ch), bi = *(const f32x2*)(pp->lru_bi + (size_t)l * 1024 + ch);
    float cl[2];
#pragma unroll
    for (int e = 0; e < 2; ++e) { const float ex = fexp2(-lam[e] * LOG2E);
        const float sp = (ex < 0.05f) ? ex * (1.0f - ex * (0.5f - ex * (0.33333334f - ex * (0.25f - ex * (0.2f - ex * 0.16666667f))))) : ((-lam[e] > 20.f) ? -lam[e] : 0.6931471805599453f * __builtin_amdgcn_logf(1.0f + ex));
        cl[e] = -8.0f * sp; }
    for (int u = bx_; u < 256; u += G_) { const int b = u >> 7, k = u & 127;
        const size_t row0 = (size_t)b * S_ + k * 64;
        if (pass == 0) {
            float A0 = 1.f, H0 = 0.f, A1 = 1.f, H1 = 0.f;
            for (int s8 = 0; s8 < 64; s8 += 8) { unsigned rw[8], iw[8], xw[8];
#pragma unroll
                for (int e = 0; e < 8; ++e) { const size_t row = row0 + s8 + e; rw[e] = *(const unsigned*)(RI + row * 2048 + rcol); iw[e] = *(const unsigned*)(RI + row * 2048 + rcol + 128); xw[e] = *(const unsigned*)(XC + row * 1024 + ch); }
#pragma unroll
                for (int e = 0; e < 8; ++e) { float a, bb;
                    lru_ab(bflo(rw[e]) + br[0], bflo(iw[e]) + bi[0], bflo(xw[e]), cl[0], a, bb); A0 *= a; H0 = a * H0 + bb;
                    lru_ab(bfhi(rw[e]) + br[1], bfhi(iw[e]) + bi[1], bfhi(xw[e]), cl[1], a, bb); A1 *= a; H1 = a * H1 + bb; } }
            SA[((size_t)b * 128 + k) * 512 + tid] = (f32x2){A0, A1}; SH[((size_t)b * 128 + k) * 512 + tid] = (f32x2){H0, H1};
        } else {
            float h0 = 0.f, h1 = 0.f;
            const f32x2* __restrict__ sa = SA + (size_t)b * 128 * 512 + tid; const f32x2* __restrict__ sh = SH + (size_t)b * 128 * 512 + tid;
            for (int q0 = 0; q0 < k; q0 += 16) { f32x2 av[16], hv[16];
#pragma unroll
                for (int e = 0; e < 16; ++e) { const int qq = (q0 + e < k) ? q0 + e : q0; av[e] = sa[(size_t)qq * 512]; hv[e] = sh[(size_t)qq * 512]; }
#pragma unroll
                for (int e = 0; e < 16; ++e) if (q0 + e < k) { h0 = av[e][0] * h0 + hv[e][0]; h1 = av[e][1] * h1 + hv[e][1]; } }
            for (int s8 = 0; s8 < 64; s8 += 8) { unsigned rw[8], iw[8], xw[8], yw[8];
#pragma unroll
                for (int e = 0; e < 8; ++e) { const size_t row = row0 + s8 + e; rw[e] = *(const unsigned*)(RI + row * 2048 + rcol); iw[e] = *(const unsigned*)(RI + row * 2048 + rcol + 128); xw[e] = *(const unsigned*)(XC + row * 1024 + ch);
                    yw[e] = *(const unsigned*)(PROJ + row * LDP + C_YR + ch); }
#pragma unroll
                for (int e = 0; e < 8; ++e) { float a, bb;
                    lru_ab(bflo(rw[e]) + br[0], bflo(iw[e]) + bi[0], bflo(xw[e]), cl[0], a, bb); h0 = a * h0 + bb;
                    lru_ab(bfhi(rw[e]) + br[1], bfhi(iw[e]) + bi[1], bfhi(xw[e]), cl[1], a, bb); h1 = a * h1 + bb;
                    *(unsigned*)(XC + (row0 + s8 + e) * 1024 + ch) = pk2(h0 * gelu_tanh(bflo(yw[e])), h1 * gelu_tanh(bfhi(yw[e]))); } }
        }
    }
}

DI void memsoftmax_phase(PP pp) {
    PPOPAQ();
    int tid = threadIdx.x; asm volatile("" : "+v"(tid));
    const int lane = tid & 63, wave = __builtin_amdgcn_readfirstlane(tid >> 6);
    const int G_ = opaque_s((int)gridDim.x), bx_ = opaque_s((int)blockIdx.x);
    const int gw = bx_ * 8 + wave, NGW = G_ * 8, gtid = bx_ * 512 + tid, NT = G_ * 512;
    (void)lane; (void)wave; (void)gw; (void)NGW; (void)gtid; (void)NT;
    bf16_t* SP = (bf16_t*)(pp->ws + WS_H);
    for (int m0 = gw; m0 < T_; m0 += 4 * NGW) {
        u32x4 av[4], bv[4];
#pragma unroll
        for (int r = 0; r < 4; ++r) { const int m = (m0 + r * NGW < T_) ? m0 + r * NGW : m0; const u32x4* ptr = (const u32x4*)(SP + (size_t)m * 1024 + lane * 16); av[r] = ptr[0]; bv[r] = ptr[1]; }
#pragma unroll
        for (int r = 0; r < 4; ++r) {
            const unsigned* pa = (const unsigned*)&av[r]; const unsigned* pb = (const unsigned*)&bv[r];
            float v[16];
#pragma unroll
            for (int e = 0; e < 4; ++e) { v[2 * e] = bflo(pa[e]); v[2 * e + 1] = bfhi(pa[e]); v[8 + 2 * e] = bflo(pb[e]); v[8 + 2 * e + 1] = bfhi(pb[e]); }
            float mx = v[0];
#pragma unroll
            for (int e = 1; e < 16; ++e) mx = fmaxf(mx, v[e]);
#pragma unroll
            for (int o = 1; o < 16; o <<= 1) mx = fmaxf(mx, shx(mx, o, lane));
            float sm = 0.f;
#pragma unroll
            for (int e = 0; e < 16; ++e) { v[e] = fexp2(v[e] - mx); sm += v[e]; }
#pragma unroll
            for (int o = 1; o < 16; o <<= 1) sm += shx(sm, o, lane);
            const float inv = 1.0f / sm;
            u32x4 oa, ob; unsigned* qa = (unsigned*)&oa; unsigned* qb = (unsigned*)&ob;
#pragma unroll
            for (int e = 0; e < 4; ++e) { qa[e] = pk2(v[2 * e] * inv, v[2 * e + 1] * inv); qb[e] = pk2(v[8 + 2 * e] * inv, v[8 + 2 * e + 1] * inv); }
            if (m0 + r * NGW < T_) { u32x4* ptr = (u32x4*)(SP + (size_t)(m0 + r * NGW) * 1024 + lane * 16); ptr[0] = oa; ptr[1] = ob; }
        }
    }
}

DI void cmpfinal_phase(PP pp) {
    PPOPAQ();
    int tid = threadIdx.x; asm volatile("" : "+v"(tid));
    const int lane = tid & 63, wave = __builtin_amdgcn_readfirstlane(tid >> 6);
    const int G_ = opaque_s((int)gridDim.x), bx_ = opaque_s((int)blockIdx.x);
    const int gw = bx_ * 8 + wave, NGW = G_ * 8, gtid = bx_ * 512 + tid, NT = G_ * 512;
    (void)lane; (void)wave; (void)gw; (void)NGW; (void)gtid; (void)NT;
    unsigned char* ws = pp->ws; const float* CR = (const float*)(ws + WS_CRAW);
    for (int i = gtid; i < 2 * 4 * 512 * 32; i += NT) { const int d = i & 31, c = (i >> 5) & 511, bg = i >> 14, b = bg >> 2;
        const float* src = CR + ((size_t)bg * 512 + c) * 64; float x1 = src[d], x2 = src[d + 32];
        float o1 = 0.f, o2 = 0.f;
        if (c < 511) { const float pos = (float)pp->pos[b * S_ + 16 * c + 31]; const float inv = fexp2(-(float)d * 0.41524101186092029f); const float ang = pos * inv;
            const double rev = (double)ang * 0.15915494309189535; const float fr = (float)(rev - __builtin_rint(rev));
            const float sn = __builtin_amdgcn_sinf(fr), cs = __builtin_amdgcn_cosf(fr); o1 = x1 * cs - x2 * sn; o2 = x2 * cs + x1 * sn; }
        bf16_t* dst = (bf16_t*)(ws + WS_KCMP) + ((size_t)bg * 512 + c) * 64; dst[d] = (bf16_t)f2bf(o1); dst[d + 32] = (bf16_t)f2bf(o2); }
    for (int i = gtid; i < 2 * 4 * 64 * 512; i += NT) { const int c = i & 511, d = (i >> 9) & 63, bg = i >> 15;
        const float v = (c < 511) ? CR[((size_t)(8 + bg) * 512 + c) * 64 + d] : 0.f;
        ((bf16_t*)(ws + WS_VTCMP))[((size_t)bg * 64 + d) * 512 + c] = (bf16_t)f2bf(v); }
}

constexpr int KSTR = 144, VSTR = 136;
constexpr int L_K = 0, L_V = 2 * 64 * KSTR, L_IMP = L_V + 2 * 64 * VSTR, IMPSTR = 132, L_SEL = L_IMP + 64 * IMPSTR * 4, L_ATT_END = L_SEL + 64 * 16, L_OT = L_ATT_END, L_Q8 = L_OT + 65536, L_ML = L_Q8 + 16384, OSSTR = 272;
DI int crow(int r, int hi) { return (r & 3) + 8 * (r >> 2) + 4 * hi; }

struct TileSrc { const bf16_t* K; int kstr; const bf16_t* Vt; int vstr; };

template <int MODE>
DI void attn_loop(LAS unsigned char* lds, const TileSrc src, int j0, int j1, const bf16x8 (&qf)[4], f32x16 (&o)[2], float& m_run, float& l_run,
                  int tl, int t, int tb, u64 selLo, u64 selHi, int tid, int wave, int lane) {
    const int n = lane & 31, hh = lane >> 5;
    const int lrow = tid >> 3, lchunk = tid & 7;
    u32x4 kreg, vreg;
    kreg = *(const u32x4*)(src.K + (size_t)(64 * j0 + lrow) * src.kstr + lchunk * 8);
    vreg = *(const u32x4*)(src.Vt + (size_t)lrow * src.vstr + 64 * j0 + lchunk * 8);
    float carry = 0.f;
    int buf = 0;
    for (int j = j0; j <= j1; ++j) {
        LAS unsigned char* Kl = lds + L_K + buf * 64 * KSTR; LAS unsigned char* Vl = lds + L_V + buf * 64 * VSTR;
        *(LAS u32x4*)(Kl + lrow * KSTR + lchunk * 16) = kreg;
        *(LAS u32x2*)(Vl + lrow * VSTR + lchunk * 16) = (u32x2){vreg.x, vreg.y}; *(LAS u32x2*)(Vl + lrow * VSTR + lchunk * 16 + 8) = (u32x2){vreg.z, vreg.w};
        __syncthreads();
        if (j < j1) { kreg = *(const u32x4*)(src.K + (size_t)(64 * (j + 1) + lrow) * src.kstr + lchunk * 8);
                      vreg = *(const u32x4*)(src.Vt + (size_t)lrow * src.vstr + 64 * (j + 1) + lchunk * 8); }
        buf ^= 1;
        bool active = true;
        if (MODE == 2) { const bool bit = ((j < 64 ? selLo : selHi) >> (j & 63)) & 1ull; active = __ballot(bit) != 0ull; }
        if (!active) continue;
        f32x16 s[2];
#pragma unroll
        for (int u = 0; u < 2; ++u) {
#pragma unroll
            for (int e = 0; e < 16; ++e) s[u][e] = 0.f;
#pragma unroll
            for (int ks = 0; ks < 4; ++ks) { const bf16x8 kf = *(const LAS bf16x8*)(Kl + (32 * u + n) * KSTR + (ks * 16 + 8 * hh) * 2);
                s[u] = __builtin_amdgcn_mfma_f32_32x32x16_bf16(kf, qf[ks], s[u], 0, 0, 0); }
        }
        const float NEGINF = -__builtin_inff();
        if (MODE <= 1) { const int cmax = min(510, (t - 31) >> 4);
#pragma unroll
            for (int u = 0; u < 2; ++u)
#pragma unroll
                for (int e = 0; e < 16; ++e) { const int c = 64 * j + 32 * u + crow(e, hh); if (c > cmax) s[u][e] = NEGINF; }
        } else if (MODE == 2) { const bool bit = ((j < 64 ? selLo : selHi) >> (j & 63)) & 1ull; const int lim = (j == tb) ? tl : 64;
#pragma unroll
            for (int u = 0; u < 2; ++u)
#pragma unroll
                for (int e = 0; e < 16; ++e) { const int kk = 32 * u + crow(e, hh); if (!bit || kk > lim) s[u][e] = NEGINF; }
        } else {
#pragma unroll
            for (int u = 0; u < 2; ++u)
#pragma unroll
                for (int e = 0; e < 16; ++e) { const int df = t - (64 * j + 32 * u + crow(e, hh)); if ((unsigned)df >= 512u) s[u][e] = NEGINF; }
        }
        if (MODE == 1) {
            const float msafe = (m_run == NEGINF) ? 0.f : m_run;
#pragma unroll
            for (int u = 0; u < 2; ++u)
#pragma unroll
                for (int e = 0; e < 16; ++e) s[u][e] = fexp2(s[u][e] - msafe) * l_run;
            if (tb >= 16) {
                float w1[8], w2[8], pw2[8];
#pragma unroll
                for (int u = 0; u < 2; ++u)
#pragma unroll
                    for (int gi = 0; gi < 4; ++gi) { const float p0 = s[u][4 * gi], p1 = s[u][4 * gi + 1], p2 = s[u][4 * gi + 2], p3 = s[u][4 * gi + 3];
                        w1[u * 4 + gi] = p0 + p1 + p2 + 0.5f * p3; w2[u * 4 + gi] = 0.5f * p3; }
#pragma unroll
                for (int q = 0; q < 8; ++q) pw2[q] = shx(w2[q], 32, lane);
                float tot[8];
#pragma unroll
                for (int q = 0; q < 8; ++q) { const float prev = (q == 0) ? carry : pw2[q > 0 ? q - 1 : 0]; tot[q] = w1[q] + (hh ? pw2[q] : prev); }
                carry = pw2[7];
#pragma unroll
                for (int q = 0; q < 8; ++q) { float v = tot[q]; v += shx(v, 1, lane); v += shx(v, 2, lane); tot[q] = v; }
                if ((n & 3) == 0) { LAS float* imp = (LAS float*)(lds + L_IMP) + (8 * wave + (n >> 2)) * IMPSTR;
#pragma unroll
                    for (int q = 0; q < 8; ++q) { const int jj = 16 * j + 8 * (q >> 2) + 2 * (q & 3) + hh; if (jj < 128) imp[jj] = tot[q]; } }
            }
        } else {
            float mloc = s[0][0];
#pragma unroll
            for (int u = 0; u < 2; ++u)
#pragma unroll
                for (int e = 0; e < 16; ++e) mloc = fmaxf(mloc, s[u][e]);
            mloc = fmaxf(mloc, shx(mloc, 32, lane));
            const float mnew = fmaxf(m_run, mloc); const float msafe = (mnew == NEGINF) ? 0.f : mnew;
            const float alpha = fexp2(m_run - msafe);
            float ls = 0.f;
#pragma unroll
            for (int u = 0; u < 2; ++u)
#pragma unroll
                for (int e = 0; e < 16; ++e) { s[u][e] = fexp2(s[u][e] - msafe); ls += s[u][e]; }
            l_run = l_run * alpha + ls; m_run = mnew;
            if (MODE != 0) {
#pragma unroll
                for (int ds = 0; ds < 2; ++ds)
#pragma unroll
                    for (int e = 0; e < 16; ++e) o[ds][e] *= alpha;
            }
        }
        if (MODE != 0) {
#pragma unroll
            for (int u = 0; u < 2; ++u)
#pragma unroll
                for (int st = 0; st < 2; ++st) {
                    u32x4 pp; pp.x = pk2(s[u][8 * st], s[u][8 * st + 1]); pp.y = pk2(s[u][8 * st + 2], s[u][8 * st + 3]); pp.z = pk2(s[u][8 * st + 4], s[u][8 * st + 5]); pp.w = pk2(s[u][8 * st + 6], s[u][8 * st + 7]);
                    const bf16x8 pb = __builtin_bit_cast(bf16x8, pp);
#pragma unroll
                    for (int ds = 0; ds < 2; ++ds) { const LAS unsigned char* vp = Vl + (32 * ds + n) * VSTR + (32 * u + 16 * st + 4 * hh) * 2;
                        const u32x2 a0 = *(const LAS u32x2*)vp, a1 = *(const LAS u32x2*)(vp + 16);
                        const u32x4 av = {a0.x, a0.y, a1.x, a1.y};
                        o[ds] = __builtin_amdgcn_mfma_f32_32x32x16_bf16(__builtin_bit_cast(bf16x8, av), pb, o[ds], 0, 0, 0); }
                }
        }
    }
    __syncthreads();
}

typedef float f32x4v __attribute__((ext_vector_type(4)));
DI void sel_tile(const u32x4 (&kc)[4], const u32x4 (&vf)[4], int j, LAS unsigned char* OSw, const LAS unsigned char* Q8w, LAS float* MLw, u64 tmLo, u64 tmHi, int tb, int wave, int lane) {
    const int q = lane & 15, quad = lane >> 4, head = q & 3, slot = q >> 2;
    const float NEGINF = -__builtin_inff();
    const bool tbit = (((j < 64 ? tmLo : tmHi) >> (j & 63)) & 1ull) != 0ull && lane < 8;
    unsigned act = (unsigned)__ballot(tbit) & 0xffu;
    while (act != 0u) {
        const int t0 = __builtin_ctz(act); act &= act - 1u;
        int t1 = -1, t2 = -1, t3 = -1;
        if (act != 0u) { t1 = __builtin_ctz(act); act &= act - 1u; }
        if (act != 0u) { t2 = __builtin_ctz(act); act &= act - 1u; }
        if (act != 0u) { t3 = __builtin_ctz(act); act &= act - 1u; }
        const int tsel = slot == 0 ? t0 : (slot == 1 ? t1 : (slot == 2 ? t2 : t3));
        const bool valid = tsel >= 0; const int tk = valid ? tsel : t0; const int rho = 4 * tk + head;
        const long qa = *(const LAS long*)(Q8w + rho * 64 + 8 * quad), qb = *(const LAS long*)(Q8w + rho * 64 + 32 + 8 * quad);
        f32x4v s[4];
#pragma unroll
        for (int sub = 0; sub < 4; ++sub) { s[sub] = (f32x4v){0.f, 0.f, 0.f, 0.f};
            s[sub] = __builtin_amdgcn_mfma_f32_16x16x32_fp8_fp8(mk64(kc[sub].x, kc[sub].y), qa, s[sub], 0, 0, 0);
            s[sub] = __builtin_amdgcn_mfma_f32_16x16x32_fp8_fp8(mk64(kc[sub].z, kc[sub].w), qb, s[sub], 0, 0, 0); }
        if (j == tb) { const int tlk = 8 * wave + tk;
#pragma unroll
            for (int sub = 0; sub < 4; ++sub)
#pragma unroll
                for (int i = 0; i < 4; ++i) { const int kk = 16 * sub + 4 * quad + i; if (kk > tlk) s[sub][i] = NEGINF; } }
        float mloc = fmaxf(fmaxf(s[0][0], s[1][0]), fmaxf(s[2][0], s[3][0]));
#pragma unroll
        for (int i = 1; i < 4; ++i) mloc = fmaxf(mloc, fmaxf(fmaxf(s[0][i], s[1][i]), fmaxf(s[2][i], s[3][i])));
        mloc = fmaxf(mloc, shx(mloc, 16, lane)); mloc = fmaxf(mloc, shx(mloc, 32, lane));
        const float m_old = MLw[rho], l_old = MLw[32 + rho];
        const float mnew = fmaxf(m_old, mloc);
        const float msafe = (mnew == NEGINF) ? 0.f : mnew;
        const float alpha = fexp2(m_old - msafe);
        const float sb = valid ? msafe - 8.0f : __builtin_inff();
        float ls = 0.f;
#pragma unroll
        for (int sub = 0; sub < 4; ++sub)
#pragma unroll
            for (int i = 0; i < 4; ++i) { s[sub][i] = fexp2(s[sub][i] - sb); ls += s[sub][i]; }
        ls += shx(ls, 16, lane); ls += shx(ls, 32, lane);
        if (valid && quad == 0) { MLw[rho] = mnew; MLw[32 + rho] = l_old * alpha + ls; }
        const long pb0 = mk64(pk4_fp8(s[0][0], s[0][1], s[0][2], s[0][3]), pk4_fp8(s[1][0], s[1][1], s[1][2], s[1][3]));
        const long pb1 = mk64(pk4_fp8(s[2][0], s[2][1], s[2][2], s[2][3]), pk4_fp8(s[3][0], s[3][1], s[3][2], s[3][3]));
#pragma unroll
        for (int dsub = 0; dsub < 4; ++dsub) { LAS f32x4v* op = (LAS f32x4v*)(OSw + rho * OSSTR + (16 * dsub + 4 * quad) * 4);
            f32x4v oacc = *op * alpha;
            oacc = __builtin_amdgcn_mfma_f32_16x16x32_fp8_fp8(mk64(vf[dsub].x, vf[dsub].y), pb0, oacc, 0, 0, 0);
            oacc = __builtin_amdgcn_mfma_f32_16x16x32_fp8_fp8(mk64(vf[dsub].z, vf[dsub].w), pb1, oacc, 0, 0, 0);
            if (valid) *op = oacc; }
    }
}
DI int sg_pop(u64& uLo, u64& uHi) {
    int j = -1;
    if (uLo != 0ull) { j = __builtin_ctzll(uLo); uLo &= uLo - 1ull; } else if (uHi != 0ull) { j = 64 + __builtin_ctzll(uHi); uHi &= uHi - 1ull; }
    return j;
}
DI void sel_gather(const unsigned char* __restrict__ KFb, const unsigned char* __restrict__ VFb, u64 uLo, u64 uHi, LAS unsigned char* OSw, const LAS unsigned char* Q8w, LAS float* MLw,
                   u64 tmLo, u64 tmHi, int tb, int wave, int lane) {
    const unsigned char* kp = KFb + lane * 16;
    const unsigned char* vp = VFb + lane * 16;
    u32x4 kb0[4], kb1[4], kb2[4], kb3[4], vb0[4], vb1[4], vb2[4], vb3[4];
#define SG_LOAD(KB, VB, jj) do { _Pragma("unroll") for (int sub = 0; sub < 4; ++sub) { KB[sub] = *(const u32x4*)(kp + (size_t)(((jj) * 4 + sub) * 1024)); VB[sub] = *(const u32x4*)(vp + (size_t)(((jj) * 4 + sub) * 1024)); } } while (0)
#define SG_STEP(KC, VC, KL, VL) { const int j3 = sg_pop(uLo, uHi); { const int j3c = j3 < 0 ? 0 : j3; SG_LOAD(KL, VL, j3c); } sel_tile(KC, VC, j0, OSw, Q8w, MLw, tmLo, tmHi, tb, wave, lane); if (j1 < 0) break; j0 = j1; j1 = j2; j2 = j3; }
    int j0 = sg_pop(uLo, uHi), j1 = sg_pop(uLo, uHi), j2 = sg_pop(uLo, uHi);
    SG_LOAD(kb0, vb0, j0); { const int j1c = j1 < 0 ? 0 : j1, j2c = j2 < 0 ? 0 : j2; SG_LOAD(kb1, vb1, j1c); SG_LOAD(kb2, vb2, j2c); }
    for (;;) {
        SG_STEP(kb0, vb0, kb3, vb3)
        SG_STEP(kb1, vb1, kb0, vb0)
        SG_STEP(kb2, vb2, kb1, vb1)
        SG_STEP(kb3, vb3, kb2, vb2)
    }
#undef SG_LOAD
#undef SG_STEP
}

DI void attn_phase(PP pp, LAS unsigned char* lds, bool do_store) {
    PPOPAQ();
    int tid = threadIdx.x; asm volatile("" : "+v"(tid));
    const int lane = tid & 63, wave = __builtin_amdgcn_readfirstlane(tid >> 6);
    const int G_ = opaque_s((int)gridDim.x), bx_ = opaque_s((int)blockIdx.x);
    const int gw = bx_ * 8 + wave, NGW = G_ * 8, gtid = bx_ * 512 + tid, NT = G_ * 512;
    (void)lane; (void)wave; (void)gw; (void)NGW; (void)gtid; (void)NT;
    unsigned char* ws = pp->ws; bf16_t* PROJ = (bf16_t*)(ws + WS_PROJ);
    const int n = lane & 31, hh = lane >> 5, G = G_;
    for (int it = 0; it < 4; ++it) {
        int tb, bg;
        if (G == 256) { const int kx = bx_ >> 3; bg = bx_ & 7; tb = 127 - (it * 32 + ((it & 1) ? 31 - kx : kx)); }
        else { const int cc = (it & 1) ? (G - 1 - bx_) : bx_; const int rho = it * G + cc; if (rho >= 1024) continue; tb = 127 - (rho >> 3); bg = rho & 7; }
        const int b = bg >> 2, g = bg & 3;
        const int t0 = 64 * tb, tl = 8 * wave + (n >> 2), r = n & 3, t = t0 + tl;
        const size_t trow = (size_t)b * S_ + t;
        bf16_t* qptr = PROJ + trow * LDP + C_Q + (4 * g + r) * 64;
        bf16x8 qf[4];
#pragma unroll
        for (int ks = 0; ks < 4; ++ks) qf[ks] = *(const bf16x8*)(qptr + ks * 16 + 8 * hh);
        f32x16 o[2];
        LAS float* OT = (LAS float*)(lds + L_OT) + wave * 2048 + lane;
        for (int i = tid; i < 64 * IMPSTR; i += 512) ((LAS float*)(lds + L_IMP))[i] = 0.f;
        {
            TileSrc src{(const bf16_t*)(ws + WS_KCMP) + (size_t)bg * 512 * 64, 64, (const bf16_t*)(ws + WS_VTCMP) + (size_t)bg * 64 * 512, 512};
            int nvalid = (t0 + 32) / 16 + 1; if (nvalid > 511) nvalid = 511;
            const int j1 = (nvalid - 1) >> 6;
            float m = -__builtin_inff(), l = 0.f;
            attn_loop<0>(lds, src, 0, j1, qf, o, m, l, tl, t, tb, 0ull, 0ull, tid, wave, lane);
            l += shx(l, 32, lane);
            float inv = 1.0f / fmaxf(l, 1e-30f);
#pragma unroll
            for (int ds = 0; ds < 2; ++ds)
#pragma unroll
                for (int e = 0; e < 16; ++e) o[ds][e] = 0.f;
            attn_loop<1>(lds, src, 0, j1, qf, o, m, inv, tl, t, tb, 0ull, 0ull, tid, wave, lane);
#pragma unroll
            for (int ds = 0; ds < 2; ++ds)
#pragma unroll
                for (int e = 0; e < 16; ++e) OT[(ds * 16 + e) * 64] = o[ds][e];
        }
        {
            const int tok = tid >> 3, prt = tid & 7;
            unsigned mk[4] = {0u, 0u, 0u, 0u};
            if (tb < 16) { mk[0] = (tb == 31) ? 0xffffffffu : ((2u << tb) - 1u); }
            else {
                const LAS float* imp = (const LAS float*)(lds + L_IMP) + tok * IMPSTR + 16 * prt;
                unsigned keys[16];
#pragma unroll
                for (int e = 0; e < 16; ++e) { const int j = 16 * prt + e; const unsigned bits = __builtin_bit_cast(unsigned, imp[e]);
                    keys[e] = (j >= 1 && j <= tb - 1) ? ((bits & 0xffffff80u) | (unsigned)(127 - j)) : 0u; }
                mk[0] = 1u; mk[tb >> 5] |= 1u << (tb & 31);
                for (int round = 0; round < 14; ++round) {
                    unsigned best = keys[0];
#pragma unroll
                    for (int e = 1; e < 16; ++e) best = keys[e] > best ? keys[e] : best;
#pragma unroll
                    for (int o2 = 1; o2 < 8; o2 <<= 1) { const unsigned other = (unsigned)__builtin_amdgcn_ds_bpermute((lane ^ o2) << 2, (int)best); best = other > best ? other : best; }
                    if (best != 0u) { const int jw = 127 - (int)(best & 127u);
                        mk[0] |= (jw < 32) ? (1u << (jw & 31)) : 0u; mk[1] |= (jw >= 32 && jw < 64) ? (1u << (jw & 31)) : 0u;
                        mk[2] |= (jw >= 64 && jw < 96) ? (1u << (jw & 31)) : 0u; mk[3] |= (jw >= 96) ? (1u << (jw & 31)) : 0u; }
#pragma unroll
                    for (int e = 0; e < 16; ++e) if (keys[e] == best) keys[e] = 0u;
                }
            }
            if (prt == 0) { LAS unsigned* sm = (LAS unsigned*)(lds + L_SEL) + tok * 4; sm[0] = mk[0]; sm[1] = mk[1]; sm[2] = mk[2]; sm[3] = mk[3]; }
            __syncthreads();
        }
        {
            TileSrc src{PROJ + (size_t)b * S_ * LDP + C_KW + g * 64, LDP, (const bf16_t*)(ws + WS_VTW) + (size_t)bg * 64 * S_, S_};
            float m = -__builtin_inff(), l = 0.f;
#pragma unroll
            for (int ds = 0; ds < 2; ++ds)
#pragma unroll
                for (int e = 0; e < 16; ++e) o[ds][e] = 0.f;
            attn_loop<3>(lds, src, tb >= 8 ? tb - 8 : 0, tb, qf, o, m, l, tl, t, tb, 0ull, 0ull, tid, wave, lane);
            l += shx(l, 32, lane);
            const float f = sigmoidf_(bf2f(PROJ[((size_t)b * S_ + t) * LDP + C_GN + g * 12 + r * 3 + 2])) / (sigmoidf_(bf2f(PROJ[((size_t)b * S_ + t) * LDP + C_GN + g * 12 + r * 3])) * fmaxf(l, 1e-30f));
#pragma unroll
            for (int ds = 0; ds < 2; ++ds)
#pragma unroll
                for (int e = 0; e < 16; ++e) OT[(ds * 16 + e) * 64] += f * o[ds][e];
        }
        __syncthreads();
        {
            u64 uLo = 0ull, uHi = 0ull;
            { const LAS unsigned* sm = (const LAS unsigned*)(lds + L_SEL) + 8 * wave * 4;
#pragma unroll
              for (int i = 0; i < 8; ++i) { uLo |= (u64)sm[4 * i] | ((u64)sm[4 * i + 1] << 32); uHi |= (u64)sm[4 * i + 2] | ((u64)sm[4 * i + 3] << 32); } }
            uLo = ((u64)(unsigned)__builtin_amdgcn_readfirstlane((int)(unsigned)(uLo >> 32)) << 32) | (unsigned)__builtin_amdgcn_readfirstlane((int)(unsigned)uLo);
            uHi = ((u64)(unsigned)__builtin_amdgcn_readfirstlane((int)(unsigned)(uHi >> 32)) << 32) | (unsigned)__builtin_amdgcn_readfirstlane((int)(unsigned)uHi);
            u64 tmLo, tmHi;
            { const LAS unsigned* sm = (const LAS unsigned*)(lds + L_SEL) + (8 * wave + (lane & 7)) * 4; tmLo = (u64)sm[0] | ((u64)sm[1] << 32); tmHi = (u64)sm[2] | ((u64)sm[3] << 32); }
            LAS unsigned char* OSw = lds + wave * (32 * OSSTR); LAS unsigned char* Q8w = lds + L_Q8 + wave * 2048; LAS float* MLw = (LAS float*)(lds + L_ML) + wave * 64;
            for (int i = lane; i < 32 * OSSTR / 4; i += 64) ((LAS float*)OSw)[i] = 0.f;
            MLw[lane] = (lane < 32) ? -__builtin_inff() : 0.f;
#pragma unroll
            for (int ks = 0; ks < 4; ++ks) { const u32x4 w = __builtin_bit_cast(u32x4, qf[ks]);
                *(LAS long*)(Q8w + n * 64 + 16 * ks + 8 * hh) = mk64(pk4_fp8(bflo(w.x), bfhi(w.x), bflo(w.y), bfhi(w.y)), pk4_fp8(bflo(w.z), bfhi(w.z), bflo(w.w), bfhi(w.w))); }
            sel_gather((const unsigned char*)(ws + WS_KF) + (size_t)bg * 128 * 4096, (const unsigned char*)(ws + WS_VTS) + (size_t)bg * 128 * 4096, uLo, uHi, OSw, Q8w, MLw, tmLo, tmHi, tb, wave, lane);
        }
        if (do_store) {
            int ln2 = lane; asm volatile("" : "+v"(ln2));
            const int n2 = ln2 & 31, h2 = ln2 >> 5, t2 = t0 + 8 * wave + (n2 >> 2), r2 = n2 & 3;
            bf16_t* rowp = PROJ + ((size_t)b * S_ + t2) * LDP;
            const float gcv = sigmoidf_(bf2f(rowp[C_GN + g * 12 + r2 * 3]));
            const LAS float* MLw = (const LAS float*)(lds + L_ML) + wave * 64;
            const float fsel = sigmoidf_(bf2f(rowp[C_GN + g * 12 + r2 * 3 + 1])) / fmaxf(MLw[32 + n2], 1e-30f);
            const LAS unsigned char* OSr = lds + wave * (32 * OSSTR) + n2 * OSSTR;
            bf16_t* op = rowp + C_Q + (4 * g + r2) * 64 + 4 * h2;
#pragma unroll
            for (int ds = 0; ds < 2; ++ds)
#pragma unroll
                for (int gi = 0; gi < 4; ++gi) { const f32x4v os = *(const LAS f32x4v*)(OSr + (32 * ds + 8 * gi + 4 * h2) * 4);
                    u32x2 w; w.x = pk2(gcv * OT[(ds * 16 + 4 * gi) * 64] + fsel * os[0], gcv * OT[(ds * 16 + 4 * gi + 1) * 64] + fsel * os[1]);
                    w.y = pk2(gcv * OT[(ds * 16 + 4 * gi + 2) * 64] + fsel * os[2], gcv * OT[(ds * 16 + 4 * gi + 3) * 64] + fsel * os[3]);
                    *(u32x2*)(op + 32 * ds + 8 * gi) = w; }
        }
        __syncthreads();
    }
}

__global__ void __launch_bounds__(512, 2) fwd_megakernel(Params p) {
    extern __shared__ __attribute__((aligned(16))) unsigned char lds_raw[];
    LAS unsigned char* lds = (LAS unsigned char*)lds_raw;
    cg::grid_group grid = cg::this_grid();
    const int G = gridDim.x, bx = blockIdx.x;
    PP pp = (PP)__builtin_amdgcn_kernarg_segment_ptr();
    volatile LAS unsigned* barst = (volatile LAS unsigned*)(lds + L_BARST);
    if (threadIdx.x == 0) { barst[0] = 0u; barst[1] = 0u; (void)xb_add((unsigned*)(pp->ws + WS_BAR) + XB_XCNT(xb_xcc_id()), 1u); }
    __syncthreads();
#define GSYNC() xcd_barrier((unsigned*)(ws + WS_BAR), barst)
#define ws (pp->ws)
#define PROJ ((bf16_t*)(ws + WS_PROJ))
#define H ((bf16_t*)(ws + WS_H))
#define XC ((bf16_t*)(ws + WS_XC))
#define Y ((float*)(ws + WS_RI))
    const int BIG = 1 << 30;

#ifndef NO_PREP
    prep_phase(pp, 0, lds);
#endif
#ifndef NO_ROW
    row_phase(pp->x, nullptr, nullptr, nullptr, pp->ln_mix_pre, H);
#endif
    grid.sync();

    for (int l = 0; l < NLAYER; ++l) {
        PPOPAQ();
        using pg8::Gemm; using pg8::Sched; using pg8::EpiBf16; using pg8::EpiF32; using pg8::EpiMerge;
        cbias_phase(pp, l);
#ifndef NO_G1
        for (int r_ = 0; r_ < opaque_s(GREP); ++r_) {
        pg8::gemm_phase<EpiBf16>(lds, Gemm{H, (const bf16_t*)(ws + WS_WIN), 1024, 1024, 1024, 128, 128},
            Sched{64, 35, opaque_s(G), opaque_s(bx), 0, BIG, 0u, 256u * 1024 * 2, 0u, 0u, 256u * 1024 * 2, 0u}, EpiBf16{PROJ, LDP, 0, 1.0f, nullptr, 0});
        pg8::gemm_phase<EpiBf16>(lds, Gemm{(const bf16_t*)(ws + WS_MEMN), (const bf16_t*)(ws + WS_WMKV), 1024, 1024, 1024, 128, 128},
            Sched{2, 4, opaque_s(G), (opaque_s(bx) + 64) % opaque_s(G), 0, BIG, 0u, 256u * 1024 * 2, 0u, 0u, 256u * 1024 * 2, 0u}, EpiBf16{(bf16_t*)(ws + WS_KMEM), 1024, 0, 1.0f, nullptr, 0});
        pg8::gemm_phase<EpiBf16>(lds, Gemm{(const bf16_t*)(ws + WS_WMKV) + (size_t)1024 * 1024, (const bf16_t*)(ws + WS_MEMN), 1024, 1024, 1024, 128, 128},
            Sched{4, 2, opaque_s(G), (opaque_s(bx) + 48) % opaque_s(G), 0, BIG, 0u, 256u * 1024 * 2, 0u, 0u, 256u * 1024 * 2, 0u}, EpiBf16{(bf16_t*)(ws + WS_VTMEM), 512, 0, 1.0f, nullptr, 0});
        }
#endif
        GSYNC();
#ifndef NO_POST
        postproj_phase(pp, l);
#endif
#ifndef NO_G1
        if (opaque_s(G) == 256) {
        pg8::gemm_phase<EpiBf16>(lds, Gemm{PROJ, (const bf16_t*)(ws + WS_WC1), 16 * LDP, 2048, 2048, LDP * 2, 128},
            Sched{32, 1, opaque_s(G), opaque_s(bx), 1, BIG, 0u, 0u, 0u, 0u, 0u, 0u}, EpiBf16{(bf16_t*)(ws + WS_HID), 256, 2, 1.0f, (const float*)(ws + WS_CBIAS), 0});
        }
#endif
        GSYNC();
#ifndef NO_G1
        for (int r_ = 0; r_ < opaque_s(GREP); ++r_) {
        if (opaque_s(G) != 256) {
        pg8::gemm_phase<EpiBf16>(lds, Gemm{PROJ, (const bf16_t*)(ws + WS_WC1), 16 * LDP, 2048, 2048, LDP * 2, 128},
            Sched{32, 1, opaque_s(G), opaque_s(bx), 1, BIG, 0u, 0u, 0u, 0u, 0u, 0u}, EpiBf16{(bf16_t*)(ws + WS_HID), 256, 2, 1.0f, (const float*)(ws + WS_CBIAS), 0});
        }
        const int G224 = opaque_s(G), c224 = opaque_s(bx);
        pg8::gemm_phase<EpiBf16>(lds, Gemm{XC, (const bf16_t*)(ws + WS_WLRU), 1024, 128, 128, 128, 128},
            Sched{64, 8, G224, c224, 0, BIG, 0u, 256u * 1024 * 2, 128u * 2, 0u, 256u * 128 * 2, 0u}, EpiBf16{(bf16_t*)(ws + WS_RI), 2048, 0, 1.0f, nullptr, 0});
        pg8::gemm_phase<EpiBf16>(lds, Gemm{PROJ, (const bf16_t*)(ws + WS_KMEM), LDP, 1024, 256, 128, 128},
            Sched{64, 4, G224, c224, 0, 32, (unsigned)C_QM * 2, 256u * LDP * 2, 256u * 2, 0u, 256u * 2, 256u * 1024 * 2}, EpiBf16{H, 1024, 0, 0.0625f * LOG2E, nullptr, 0});
        }
#endif
        GSYNC();
#ifndef NO_SCAN
        scan_phase(pp, l, 0);
#if defined(DUP_SCAN0)
        scan_phase(pp, l, 0);
#endif
#endif
#ifndef NO_MSM
        memsoftmax_phase(pp);
#endif
#ifndef NO_G2
        for (int r_ = 0; r_ < opaque_s(GREP); ++r_) {
        pg8::gemm_phase<EpiF32>(lds, Gemm{(const bf16_t*)(ws + WS_HID), (const bf16_t*)(ws + WS_WC2), 256, 256, 256, 128, 128},
            Sched{32, 1, opaque_s(G), (opaque_s(bx) + 96) % opaque_s(G), 0, 16, 0u, 256u * 256 * 2, 0u, 0u, 0u, 256u * 256 * 2}, EpiF32{(float*)(ws + WS_CRAW), 64, 64});
        }
#endif
        GSYNC();
#ifndef NO_SCAN
        scan_phase(pp, l, 1);
#endif
#ifndef NO_CMPF
        cmpfinal_phase(pp);
#endif
#ifndef NO_G1
        for (int r_ = 0; r_ < opaque_s(GREP); ++r_) {
        pg8::gemm_phase<EpiBf16>(lds, Gemm{H, (const bf16_t*)(ws + WS_VTMEM), 1024, 512, 256, 128, 128},
            Sched{64, 4, opaque_s(G), opaque_s(bx), 0, 32, 0u, 256u * 1024 * 2, 256u * 2, 0u, 256u * 512 * 2, 256u * 2}, EpiBf16{PROJ, LDP, 0, 1.0f, nullptr, C_QM});
        }
#endif
        GSYNC();
#ifndef NO_ATT
#if defined(DUP_ATT)
        attn_phase(pp, lds, opaque_s(0) != 0);
        __syncthreads();
#endif
        attn_phase(pp, lds, true);
#endif
        GSYNC();
#ifndef NO_G3
        for (int r_ = 0; r_ < opaque_s(GREP); ++r_) {
        pg8::gemm_phase<EpiMerge>(lds, Gemm{XC, (const bf16_t*)(ws + WS_WBRA), 1024, 1024, 1024, 128, 128},
            Sched{64, 4, opaque_s(G), opaque_s(bx), 0, BIG, 0u, 256u * 1024 * 2, 0u, 0u, 256u * 1024 * 2, 0u}, EpiMerge{PROJ + C_GM, LDP, Y, H, 0});
        pg8::gemm_phase<EpiMerge>(lds, Gemm{PROJ + C_Q, (const bf16_t*)(ws + WS_WBRB), LDP, 1024, 1024, 128, 128},
            Sched{64, 4, opaque_s(G), opaque_s(bx), 0, BIG, 0u, 256u * LDP * 2, 0u, 0u, 256u * 1024 * 2, 0u}, EpiMerge{PROJ + C_GM + 1024, LDP, Y, H, 1});
        pg8::gemm_phase<EpiMerge>(lds, Gemm{PROJ + C_QM, (const bf16_t*)(ws + WS_WBRC), LDP, 1024, 1024, 128, 128},
            Sched{64, 4, opaque_s(G), opaque_s(bx), 0, BIG, 0u, 256u * LDP * 2, 0u, 0u, 256u * 1024 * 2, 0u}, EpiMerge{PROJ + C_GM + 2048, LDP, Y, H, 2});
        }
#endif
        GSYNC();
#ifndef NO_G2
        for (int r_ = 0; r_ < opaque_s(GREP); ++r_) {
        pg8::gemm_phase<EpiF32>(lds, Gemm{H, (const bf16_t*)(ws + WS_WOUT), 1024, 1024, 1024, 128, 128},
            Sched{64, 4, opaque_s(G), opaque_s(bx), 0, BIG, 0u, 256u * 1024 * 2, 0u, 0u, 256u * 1024 * 2, 0u}, EpiF32{Y, 1024, 1024});
        }
#endif
        GSYNC();
#ifndef NO_ROW
        row_phase((l == 0) ? pp->x : pp->out, Y, pp->ln_mix_post + (size_t)l * 1024, pp->out, pp->ln_mlp_pre + (size_t)l * 1024, H);
#endif
        GSYNC();
#ifndef NO_G1
        for (int r_ = 0; r_ < opaque_s(GREP); ++r_) {
        pg8::gemm_phase<EpiBf16>(lds, Gemm{H, (const bf16_t*)(ws + WS_WM1), 1024, 1024, 1024, 128, 128},
            Sched{64, 16, opaque_s(G), opaque_s(bx), 0, BIG, 0u, 256u * 1024 * 2, 0u, 0u, 256u * 1024 * 2, 0u}, EpiBf16{PROJ, FF_, 1, 1.0f, nullptr, 0});
        }
#endif
        GSYNC();
#ifndef NO_G2
        for (int r_ = 0; r_ < opaque_s(GREP); ++r_) {
        pg8::gemm_phase<EpiF32>(lds, Gemm{PROJ, (const bf16_t*)(ws + WS_WM2), FF_, FF_, FF_, 128, 128},
            Sched{64, 4, opaque_s(G), opaque_s(bx), 0, BIG, 0u, 256u * FF_ * 2, 0u, 0u, 256u * FF_ * 2, 0u}, EpiF32{Y, 1024, 1024});
        }
#endif
        GSYNC();
#ifndef NO_ROW
        row_phase(pp->out, Y, pp->ln_mlp_post + (size_t)l * 1024, pp->out, (l + 1 < NLAYER) ? pp->ln_mix_pre + (size_t)(l + 1) * 1024 : nullptr, (l + 1 < NLAYER) ? H : nullptr);
#endif
#ifndef NO_PREP
        if (l + 1 < NLAYER) prep_phase(pp, l + 1, lds);
#if defined(DUP_PREP)
        if (l + 1 < NLAYER) prep_phase(pp, l + 1, lds);
#endif
#endif
        GSYNC();
    }
#undef ws
#undef PROJ
#undef H
#undef XC
#undef Y
}

extern "C" void kernel_launch(void* const* d_in, const int* in_sizes, int n_in, void* d_out, int out_size, void* d_ws, size_t ws_size, hipStream_t stream) {
    static int grid = 0;
    if (grid == 0) {
        int dev = 0, cus = 0, per_cu = 0;
        hipGetDevice(&dev); hipDeviceGetAttribute(&cus, hipDeviceAttributeMultiprocessorCount, dev);
        hipFuncSetAttribute((const void*)fwd_megakernel, hipFuncAttributeMaxDynamicSharedMemorySize, LDS_BYTES);
        hipOccupancyMaxActiveBlocksPerMultiprocessor(&per_cu, (const void*)fwd_megakernel, 512, LDS_BYTES);
        if (per_cu < 1) per_cu = 1;
        (void)hipGetLastError();
        grid = cus * 1;
        if (ws_size < WS_END) { fprintf(stderr, "kernel_launch: workspace too small (%zu < %zu)\n", ws_size, (size_t)WS_END); grid = -1; }
    }
    if (grid < 0) return;
    Params p{};
    p.x = (const float*)d_in[0]; p.mem = (const float*)d_in[1]; p.pos = (const int*)d_in[2];
    p.ln_mix_pre = (const float*)d_in[3]; p.w_in = (const float*)d_in[4]; p.conv_w = (const float*)d_in[5]; p.conv_b = (const float*)d_in[6];
    p.lru_wr = (const float*)d_in[7]; p.lru_br = (const float*)d_in[8]; p.lru_wi = (const float*)d_in[9]; p.lru_bi = (const float*)d_in[10]; p.lru_lambda = (const float*)d_in[11];
    p.cmp_pe = (const float*)d_in[12]; p.cmp_w1 = (const float*)d_in[13]; p.cmp_b1 = (const float*)d_in[14]; p.cmp_w2 = (const float*)d_in[15];
    p.ln_mem = (const float*)d_in[16]; p.w_mem_kv = (const float*)d_in[17]; p.w_br_rnn = (const float*)d_in[18]; p.w_br_nsa = (const float*)d_in[19]; p.w_br_mem = (const float*)d_in[20]; p.w_out = (const float*)d_in[21];
    p.ln_mix_post = (const float*)d_in[22]; p.ln_mlp_pre = (const float*)d_in[23]; p.mlp_w1 = (const float*)d_in[24]; p.mlp_w2 = (const float*)d_in[25]; p.ln_mlp_post = (const float*)d_in[26];
    p.out = (float*)d_out; p.ws = (unsigned char*)d_ws;
    (void)hipMemsetAsync((unsigned char*)d_ws + WS_BAR, 0, 16384, stream);
    void* args[] = {&p};
    hipError_t e = hipLaunchCooperativeKernel((const void*)fwd_megakernel, dim3(grid), dim3(512), args, LDS_BYTES, stream);
    if (e != hipSuccess) fprintf(stderr, "cooperative launch failed: %s (grid %d)\n", hipGetErrorString(e), grid);
}
```

```cpp
#include <hip/hip_runtime.h>
#include <hip/hip_cooperative_groups.h>
#include <cstdint>
#include <cstdio>
namespace cg = cooperative_groups;

#define LAS __attribute__((address_space(3)))
#define DI __device__ __forceinline__
typedef unsigned short bf16_t;
typedef short bf16x8 __attribute__((ext_vector_type(8)));
typedef short s16x4 __attribute__((ext_vector_type(4)));
typedef float f32x4 __attribute__((ext_vector_type(4)));
typedef float f32x16 __attribute__((ext_vector_type(16)));
typedef float f32x2 __attribute__((ext_vector_type(2)));
typedef unsigned u32x4 __attribute__((ext_vector_type(4)));
typedef unsigned u32x2 __attribute__((ext_vector_type(2)));
typedef __bf16 bf16x2v __attribute__((ext_vector_type(2)));
typedef unsigned long long u64;

constexpr int T_ = 16384, S_ = 8192, D_ = 1024, FF_ = 4096, LDP = 8960, NLAYER = 4;
constexpr int C_XR = 0, C_YR = 1024, C_Q = 2048, C_KC = 3072, C_VC = 3328, C_KS = 3584, C_VS = 3840, C_KW = 4096, C_VW = 4352,
              C_QM = 4608, C_GM = 5632, C_GN = 8704;
constexpr float EPS = 1e-6f;
constexpr float LOG2E = 1.4426950408889634f;

constexpr size_t al256(size_t x) { return (x + 255) & ~(size_t)255; }
constexpr size_t WS_PROJ = 0;
constexpr size_t WS_WIN = al256(WS_PROJ + (size_t)(T_ + 64) * LDP * 2);
constexpr size_t WS_WMKV = WS_WIN + (size_t)LDP * 1024 * 2;
constexpr size_t WS_WBRA = WS_WMKV + (size_t)2048 * 1024 * 2;
constexpr size_t WS_WBRB = WS_WBRA + (size_t)1024 * 1024 * 2;
constexpr size_t WS_WBRC = WS_WBRB + (size_t)1024 * 1024 * 2;
constexpr size_t WS_WOUT = WS_WBRC + (size_t)1024 * 1024 * 2;
constexpr size_t WS_WM1 = WS_WOUT + (size_t)1024 * 1024 * 2;
constexpr size_t WS_WM2 = WS_WM1 + (size_t)4096 * 1024 * 2;
constexpr size_t WS_WC1 = WS_WM2 + (size_t)4096 * 1024 * 2;
constexpr size_t WS_WC2 = WS_WC1 + (size_t)2 * 256 * 2048 * 2;
constexpr size_t WS_WLRU = WS_WC2 + (size_t)2 * 256 * 256 * 2;
constexpr size_t WS_H = WS_WLRU + (size_t)2048 * 128 * 2;
constexpr size_t WS_VTS = WS_H + (size_t)T_ * 1024 * 2;
constexpr size_t WS_VTW = WS_VTS + (size_t)8 * 64 * S_ * 2;
constexpr size_t WS_XC = WS_VTW + (size_t)8 * 64 * S_ * 2;
constexpr size_t WS_RI = WS_XC + (size_t)T_ * 1024 * 2;
constexpr size_t WS_HID = WS_RI + (size_t)T_ * 2048 * 2;
constexpr size_t WS_CRAW = WS_HID + (size_t)8192 * 256 * 2;
constexpr size_t WS_KCMP = WS_CRAW + (size_t)8192 * 64 * 4;
constexpr size_t WS_VTCMP = WS_KCMP + (size_t)8 * 512 * 64 * 2;
constexpr size_t WS_MEMN = WS_VTCMP + (size_t)8 * 512 * 64 * 2;
constexpr size_t WS_KMEM = WS_MEMN + (size_t)512 * 1024 * 2;
constexpr size_t WS_VTMEM = WS_KMEM + (size_t)512 * 1024 * 2;
constexpr size_t WS_SCA = WS_VTMEM + (size_t)512 * 1024 * 2;
constexpr size_t WS_SCH = WS_SCA + (size_t)2 * 128 * 1024 * 4;
constexpr size_t WS_CBP = WS_SCH + (size_t)2 * 128 * 1024 * 4;
constexpr size_t WS_CBIAS = WS_CBP + (size_t)16 * 512 * 4;
constexpr size_t WS_KF = al256(WS_CBIAS + 512 * 4);
constexpr size_t WS_BAR = WS_KF + (size_t)8 * 64 * S_ * 2;
constexpr size_t WS_END = WS_BAR + 16384;
constexpr int L_BARST = 155584;

#ifndef GREP
#define GREP 1
#endif
constexpr int LDS_BYTES = 155648;

DI unsigned f2bf(float f) { unsigned u = __builtin_bit_cast(unsigned, f); return (u + 0x7fffu + ((u >> 16) & 1u)) >> 16; }
DI unsigned pk2(float lo, float hi) { f32x2 f = {lo, hi}; bf16x2v r = __builtin_convertvector(f, bf16x2v); return __builtin_bit_cast(unsigned, r); }
DI float bf2f(unsigned short b) { return __builtin_bit_cast(float, (unsigned)b << 16); }
DI float bflo(unsigned w) { return __builtin_bit_cast(float, w << 16); }
DI float bfhi(unsigned w) { return __builtin_bit_cast(float, w & 0xffff0000u); }
DI float fexp2(float x) { return __builtin_amdgcn_exp2f(x); }
DI float sigmoidf_(float x) { return __builtin_amdgcn_rcpf(1.0f + fexp2(-x * LOG2E)); }
DI float gelu_tanh(float x) { const float z = 0.7978845608028654f * (x + 0.044715f * x * x * x); return x * __builtin_amdgcn_rcpf(1.0f + fexp2(-2.0f * LOG2E * z)); }
DI float shx(float v, int mask, int lane) { return __builtin_bit_cast(float, __builtin_amdgcn_ds_bpermute((lane ^ mask) << 2, __builtin_bit_cast(int, v))); }
DI u64 shx64(u64 v, int mask, int lane) { const int a = (lane ^ mask) << 2; const unsigned lo = (unsigned)__builtin_amdgcn_ds_bpermute(a, (int)(unsigned)v), hi = (unsigned)__builtin_amdgcn_ds_bpermute(a, (int)(unsigned)(v >> 32)); return ((u64)hi << 32) | lo; }
DI unsigned pk4_fp8(float a, float b, float c, float d) { int w = 0; w = __builtin_amdgcn_cvt_pk_fp8_f32(a, b, w, false); w = __builtin_amdgcn_cvt_pk_fp8_f32(c, d, w, true); return (unsigned)w; }
DI long mk64(unsigned lo, unsigned hi) { return (long)(((u64)hi << 32) | (u64)lo); }
DI int opaque_s(int v) { asm volatile("" : "+s"(v)); return v; }
DI float wave_sum(float v, int lane) {
#pragma unroll
    for (int o = 1; o < 64; o <<= 1) v += shx(v, o, lane);
    return v;
}

namespace pg8 {
constexpr int BM = 256, BK = 64, HALF = 128, HTB = HALF * BK * 2, STAGE_BYTES = 8 * HTB, NXCD = 8, WGM = 4;
__host__ __device__ __forceinline__ int lds_byte(int r, int c) { const int st = (r >> 4) * 2 + (c >> 5), rr = r & 15, cc = c & 31, ob = rr * 64 + cc * 2; return st * 1024 + (ob ^ (((ob >> 9) & 1) << 5)); }
__host__ __device__ __forceinline__ void stage_rc(int b, int& R, int& C) { const int st = b / 1024, sb = b % 1024, swz = sb ^ (((sb >> 9) & 1) << 5); R = (st >> 1) * 16 + swz / 64; C = (st & 1) * 32 + (swz % 64) / 2; }
__host__ __device__ __forceinline__ int perm32(int rho) { const int n = rho >> 4, i = rho & 15; return 8 * (i >> 2) + 4 * n + (i & 3); }

struct Unit { int pm, pn; unsigned aoff, boff; };
struct Gemm { const bf16_t* A; const bf16_t* Bt; int lda, ldb, K, kstepA, kstepB; };

struct Sched {
    int nM, nN, G, c, kind, mdiv; unsigned a0, sAm, sAn, b0, sBn, sBb;
    DI bool next(int i, Unit& u) const {
        const long L = (long)i * G + c; const int nwg = nM * nN; if (L >= nwg) return false;
        int wgid = (int)L; { const int q = nwg / NXCD, r = nwg % NXCD, xcd = wgid % NXCD, off = wgid / NXCD; wgid = (xcd < r ? xcd * (q + 1) : r * (q + 1) + (xcd - r) * q) + off; }
        const int nig = WGM * nN, gid = wgid / nig, fm = gid * WGM, gsz = (nM - fm) < WGM ? (nM - fm) : WGM;
        const int pm = fm + ((wgid % nig) % gsz), pn = (wgid % nig) / gsz;
        u.pm = pm; u.pn = pn;
        if (kind == 1) {
            const int j = pm >> 4, b = (pm >> 3) & 1, g = (pm >> 1) & 3, ch = pm & 1;
            u.aoff = (unsigned)(((b * S_ + ch * 4096) * LDP + C_KC + j * 256 + g * 64) * 2); u.boff = (unsigned)(j * 256 * 2048 * 2);
        } else { const unsigned bb = (unsigned)(pm / mdiv); u.aoff = a0 + (unsigned)pm * sAm + (unsigned)pn * sAn; u.boff = b0 + (unsigned)pn * sBn + bb * sBb; }
        return true;
    }
};

DI unsigned cvt_pk_bf16(float lo, float hi) { return pk2(lo, hi); }

struct EpiBf16 {
    static constexpr bool PERM = true;
    bf16_t* O; int ldc; int act; float scale; const float* bias; int oc0;
    DI void operator()(const f32x4 (&acc)[2][2][4][2], const Unit& u, int wr, int wc, int fr, int fq) const {
        const int row0 = u.pm * 256 + wr * 64 + fr, col0 = oc0 + u.pn * 256 + wc * 32 + 8 * fq, bc0 = (u.pm >> 4) * 256 + wc * 32 + 8 * fq;
#pragma unroll
        for (int ai = 0; ai < 2; ++ai)
#pragma unroll
            for (int m = 0; m < 4; ++m) { bf16_t* rowp = O + (size_t)(row0 + ai * HALF + m * 16) * ldc + col0;
#pragma unroll
                for (int bj = 0; bj < 2; ++bj) { f32x4 v0 = acc[ai][bj][m][0], v1 = acc[ai][bj][m][1];
                    if (act == 0) { v0 = v0 * scale; v1 = v1 * scale; }
                    else if (act == 1) {
#pragma unroll
                        for (int e = 0; e < 4; ++e) { const float a = fmaxf(v0[e], 0.f), b = fmaxf(v1[e], 0.f); v0[e] = a * a; v1[e] = b * b; } }
                    else { const f32x4 b0 = *(const f32x4*)(bias + bc0 + bj * HALF), b1 = *(const f32x4*)(bias + bc0 + bj * HALF + 4);
#pragma unroll
                        for (int e = 0; e < 4; ++e) { v0[e] = gelu_tanh(v0[e] + b0[e]); v1[e] = gelu_tanh(v1[e] + b1[e]); } }
                    u32x4 w; w.x = cvt_pk_bf16(v0[0], v0[1]); w.y = cvt_pk_bf16(v0[2], v0[3]); w.z = cvt_pk_bf16(v1[0], v1[1]); w.w = cvt_pk_bf16(v1[2], v1[3]);
                    *(u32x4*)(rowp + bj * HALF) = w; } }
    }
};
struct EpiF32 {
    static constexpr bool PERM = false;
    float* O; int ldc; int ncol;
    DI void operator()(const f32x4 (&acc)[2][2][4][2], const Unit& u, int wr, int wc, int fr, int fq) const {
        const int row0 = u.pm * 256 + wr * 64 + fr, col0 = u.pn * 256 + wc * 32 + 4 * fq;
#pragma unroll
        for (int ai = 0; ai < 2; ++ai)
#pragma unroll
            for (int m = 0; m < 4; ++m) { float* rowp = O + (size_t)(row0 + ai * HALF + m * 16) * ldc;
#pragma unroll
                for (int bj = 0; bj < 2; ++bj)
#pragma unroll
                    for (int n = 0; n < 2; ++n) { const int c = col0 + bj * HALF + n * 16; if (c < ncol) *(f32x4*)(rowp + c) = acc[ai][bj][m][n]; } }
    }
};
struct EpiMerge {
    static constexpr bool PERM = false;
    const bf16_t* gate; int ldg; float* M; bf16_t* Hout; int mode;
    DI void operator()(const f32x4 (&acc)[2][2][4][2], const Unit& u, int wr, int wc, int fr, int fq) const {
        const int row0 = u.pm * 256 + wr * 64 + fr, col0 = u.pn * 256 + wc * 32 + 4 * fq;
#pragma unroll
        for (int ai = 0; ai < 2; ++ai)
#pragma unroll
            for (int m = 0; m < 4; ++m) { const size_t r = (size_t)(row0 + ai * HALF + m * 16);
#pragma unroll
                for (int bj = 0; bj < 2; ++bj)
#pragma unroll
                    for (int n = 0; n < 2; ++n) { const int c = col0 + bj * HALF + n * 16;
                        const u32x2 gw = *(const u32x2*)(gate + r * ldg + c);
                        f32x4 g; g[0] = sigmoidf_(bflo(gw.x)); g[1] = sigmoidf_(bfhi(gw.x)); g[2] = sigmoidf_(bflo(gw.y)); g[3] = sigmoidf_(bfhi(gw.y));
                        f32x4 v = acc[ai][bj][m][n] * g;
                        float* mp = M + r * 1024 + c;
                        if (mode != 0) v = v + *(const f32x4*)mp;
                        if (mode != 2) *(f32x4*)mp = v;
                        else { u32x2 w; w.x = cvt_pk_bf16(v[0], v[1]); w.y = cvt_pk_bf16(v[2], v[3]); *(u32x2*)(Hout + r * 1024 + c) = w; } } }
    }
};

template <class Epi>
DI void gemm_phase(LAS unsigned char* lds, const Gemm g, const Sched& S, const Epi& E) {
    int tid = threadIdx.x; asm volatile("" : "+v"(tid));
    const int wid = __builtin_amdgcn_readfirstlane(tid >> 6), lane = tid & 63, wr = wid >> 2, wc = wid & 3, fr = lane & 15, fq = lane >> 4;
    const int nt = opaque_s(g.K / BK);
    unsigned voffA[2], voffB[2];
#pragma unroll
    for (int i = 0; i < 2; ++i) { int R, C; stage_rc(tid * 16 + i * 8192, R, C); const int Rb = Epi::PERM ? ((R & ~31) + perm32(R & 31)) : R;
        voffA[i] = (unsigned)(R * g.lda + C) * 2u; voffB[i] = (unsigned)(Rb * g.ldb + C) * 2u; }
    const size_t kstepA = (size_t)g.kstepA, kstepB = (size_t)g.kstepB;
    const size_t hstepA = (size_t)HALF * g.lda * 2, hstepB = (size_t)HALF * g.ldb * 2;
    const unsigned ldsw = (unsigned)wid * 1024u;
    const int aoff = lds_byte(wr * 64 + fr, fq * 8), boff = lds_byte(wc * 32 + fr, fq * 8);
#define PG8_SA(b, h) (((b) * 2 + (h)) * HTB)
#define PG8_SB(b, h) ((4 + (b) * 2 + (h)) * HTB)
#define PG8_STAGE(bufoff, gbase, voff) do { _Pragma("unroll") for (int _i = 0; _i < 2; ++_i) \
        __builtin_amdgcn_global_load_lds((const unsigned*)((const char*)(gbase) + (voff)[_i]), (LAS unsigned*)(lds + (bufoff) + ldsw + _i * 8192), 16, 0, 0); } while (0)
#define PG8_LDA(dst, b, h) do { _Pragma("unroll") for (int m = 0; m < 4; ++m) _Pragma("unroll") for (int k = 0; k < 2; ++k) dst[m][k] = *(const LAS bf16x8*)(lds + PG8_SA(b, h) + aoff + m * 2048 + k * 1024); } while (0)
#define PG8_LDB(dst, b, h) do { _Pragma("unroll") for (int n = 0; n < 2; ++n) _Pragma("unroll") for (int k = 0; k < 2; ++k) dst[n][k] = *(const LAS bf16x8*)(lds + PG8_SB(b, h) + boff + n * 2048 + k * 1024); } while (0)
#define PG8_MMA(ai, bj, At, Bt) do { __builtin_amdgcn_s_setprio(1); _Pragma("unroll") for (int m = 0; m < 4; ++m) _Pragma("unroll") for (int n = 0; n < 2; ++n) _Pragma("unroll") for (int k = 0; k < 2; ++k) \
        acc[ai][bj][m][n] = __builtin_amdgcn_mfma_f32_16x16x32_bf16(Bt[n][k], At[m][k], acc[ai][bj][m][n], 0, 0, 0); __builtin_amdgcn_s_setprio(0); } while (0)
#define PG8_WAIT_V(n) asm volatile("s_waitcnt vmcnt(" #n ")" ::: "memory")
#define PG8_WAIT_L(n) asm volatile("s_waitcnt lgkmcnt(" #n ")" ::: "memory")
#define PG8_BAR __builtin_amdgcn_s_barrier()
#define PG8_SCHED __builtin_amdgcn_sched_barrier(0)
    Unit cur, nxt; int ui = 0;
    if (!S.next(0, cur)) return;
    f32x4 acc[2][2][4][2];
#pragma unroll
    for (int a = 0; a < 2; ++a)
#pragma unroll
        for (int b = 0; b < 2; ++b)
#pragma unroll
            for (int m = 0; m < 4; ++m)
#pragma unroll
                for (int n = 0; n < 2; ++n) acc[a][b][m][n] = (f32x4){0.f, 0.f, 0.f, 0.f};
    bf16x8 At[4][2], B0[2][2], B1[2][2];
    const char* cA = (const char*)g.A + cur.aoff; const char* cB = (const char*)g.Bt + cur.boff;
    PG8_STAGE(PG8_SB(0, 0), cB, voffB); PG8_STAGE(PG8_SB(0, 1), cB + hstepB, voffB); PG8_STAGE(PG8_SA(0, 0), cA, voffA); PG8_STAGE(PG8_SA(0, 1), cA + hstepA, voffA);
    if (wr == 1) PG8_BAR;
    PG8_WAIT_V(2); PG8_BAR;
    PG8_STAGE(PG8_SB(1, 0), cB + kstepB, voffB); PG8_STAGE(PG8_SA(1, 0), cA + kstepA, voffA); PG8_STAGE(PG8_SB(1, 1), cB + hstepB + kstepB, voffB);
    PG8_WAIT_V(6); PG8_BAR;
    for (;;) {
        const bool has_next = S.next(ui + 1, nxt);
        const char* nA = has_next ? (const char*)g.A + nxt.aoff : cA; const char* nB = has_next ? (const char*)g.Bt + nxt.boff : cB;
        for (int t = 0; t < nt; t += 2) {
            const bool last = (t == nt - 2);
            const char* a1 = cA + (size_t)(t + 1) * kstepA;
            const char* a2 = last ? nA : cA + (size_t)(t + 2) * kstepA; const char* b2 = last ? nB : cB + (size_t)(t + 2) * kstepB;
            const char* a3 = a2 + kstepA; const char* b3 = b2 + kstepB;
            PG8_LDB(B0, 0, 0); PG8_LDB(B1, 0, 1); PG8_SCHED; PG8_LDA(At, 0, 0); PG8_STAGE(PG8_SA(1, 1), a1 + hstepA, voffA);
            PG8_WAIT_V(8); PG8_WAIT_L(0); PG8_BAR; PG8_MMA(0, 0, At, B0); PG8_MMA(0, 1, At, B1); PG8_BAR; PG8_SCHED;
            PG8_LDA(At, 0, 1); PG8_STAGE(PG8_SB(0, 0), b2, voffB); PG8_STAGE(PG8_SB(0, 1), b2 + hstepB, voffB); PG8_STAGE(PG8_SA(0, 0), a2, voffA);
            PG8_WAIT_V(8); PG8_WAIT_L(0); PG8_BAR; PG8_MMA(1, 0, At, B0); PG8_MMA(1, 1, At, B1); PG8_BAR; PG8_SCHED;
            PG8_LDB(B0, 1, 0); PG8_LDB(B1, 1, 1); PG8_SCHED; PG8_LDA(At, 1, 0); PG8_STAGE(PG8_SA(0, 1), a2 + hstepA, voffA);
            PG8_WAIT_V(8); PG8_WAIT_L(0); PG8_BAR; PG8_MMA(0, 0, At, B0); PG8_MMA(0, 1, At, B1); PG8_BAR; PG8_SCHED;
            PG8_LDA(At, 1, 1); PG8_STAGE(PG8_SB(1, 0), b3, voffB); PG8_STAGE(PG8_SB(1, 1), b3 + hstepB, voffB); PG8_STAGE(PG8_SA(1, 0), a3, voffA);
            PG8_WAIT_V(8); PG8_WAIT_L(0); PG8_BAR; PG8_MMA(1, 0, At, B0); PG8_MMA(1, 1, At, B1); PG8_BAR; PG8_SCHED;
        }
        if (wr == 0) PG8_BAR;
        E(acc, cur, wr, wc, fr, fq);
        if (!has_next) break;
#pragma unroll
        for (int a = 0; a < 2; ++a)
#pragma unroll
            for (int b = 0; b < 2; ++b)
#pragma unroll
                for (int m = 0; m < 4; ++m)
#pragma unroll
                    for (int n = 0; n < 2; ++n) acc[a][b][m][n] = (f32x4){0.f, 0.f, 0.f, 0.f};
        cur = nxt; cA = nA; cB = nB; ++ui;
        if (wr == 1) PG8_BAR;
    }
    PG8_WAIT_V(0);
    PG8_BAR;
#undef PG8_SA
#undef PG8_SB
#undef PG8_STAGE
#undef PG8_LDA
#undef PG8_LDB
#undef PG8_MMA
#undef PG8_WAIT_V
#undef PG8_WAIT_L
#undef PG8_BAR
#undef PG8_SCHED
}
}


#define XB_TMO      128
#define XB_XCNT(j)  (256  + 64 * (j))
#define XB_XSUB(j)  (1280 + 64 * (j))
#define XB_XGEN(j)  (2304 + 64 * (j))
#define XB_TOP      3328
#define XB_TOPGEN   3392
#define XCD_BAR_WORDS 3456
#define XB_SPIN_CAP (1u << 22)
DI unsigned xb_ld(unsigned* p)              { return __hip_atomic_load(p, __ATOMIC_RELAXED, __HIP_MEMORY_SCOPE_AGENT); }
DI unsigned xb_add(unsigned* p, unsigned v) { return __hip_atomic_fetch_add(p, v, __ATOMIC_RELAXED, __HIP_MEMORY_SCOPE_AGENT); }
DI unsigned xb_xcc_id() { return (unsigned)__builtin_amdgcn_s_getreg((3 << 11) | 20) & 0xFu; }
#define XB_SPIN(cond, bar) do { unsigned _sp = 0; while (cond) { __builtin_amdgcn_s_sleep(1); \
    if ((++_sp & 255u) == 0u) { if (xb_ld(&(bar)[XB_TMO])) break; if (_sp > XB_SPIN_CAP) { atomicAdd(&(bar)[XB_TMO], 1u); break; } } } } while (0)
DI void xcd_barrier_complete(unsigned* bar, unsigned x, unsigned& nloc, unsigned& nx) {
    const unsigned G = gridDim.x * gridDim.y * gridDim.z;
    unsigned sum, cnt, mine, sp = 0u;
    for (;;) {
        sum = 0u; cnt = 0u; mine = 0u;
#pragma unroll
        for (unsigned j = 0; j < 16; ++j) { const unsigned c = xb_ld(&bar[XB_XCNT(j)]); sum += c; cnt += (c > 0u) ? 1u : 0u; mine = (j == x) ? c : mine; }
        if (sum == G) break;
        __builtin_amdgcn_s_sleep(1);
        if ((++sp & 255u) == 0u) { if (xb_ld(&bar[XB_TMO])) break; if (sp > XB_SPIN_CAP) { atomicAdd(&bar[XB_TMO], 1u); break; } }
    }
    nloc = mine > 0u ? mine : 1u; nx = cnt > 0u ? cnt : 1u;
}
DI void xcd_barrier(unsigned* bar, volatile LAS unsigned* st) {
    asm volatile("s_waitcnt vmcnt(0)" ::: "memory");
    __syncthreads();
    if (threadIdx.x == 0) {
        __builtin_amdgcn_s_waitcnt(0);
        const unsigned x = xb_xcc_id();
        unsigned nloc = st[0], nx = st[1];
        if (nloc == 0u) { xcd_barrier_complete(bar, x, nloc, nx); st[0] = nloc; st[1] = nx; }
        const unsigned old = xb_add(&bar[XB_XSUB(x)], 1u);
        const unsigned gen = old / nloc;
        if (old + 1u == (gen + 1u) * nloc) {
            __builtin_amdgcn_fence(__ATOMIC_RELEASE, "agent");
            asm volatile("s_waitcnt vmcnt(0)" ::: "memory");
            const unsigned og = xb_add(&bar[XB_TOP], 1u);
            const unsigned tg = og / nx;
            if (og + 1u == (tg + 1u) * nx) xb_add(&bar[XB_TOPGEN], 1u);
            else XB_SPIN(xb_ld(&bar[XB_TOPGEN]) == tg, bar);
            __builtin_amdgcn_fence(__ATOMIC_ACQUIRE, "agent");
            xb_add(&bar[XB_XGEN(x)], 1u);
            asm volatile("s_waitcnt vmcnt(0)" ::: "memory");
        } else {
            XB_SPIN(xb_ld(&bar[XB_XGEN(x)]) == gen, bar);
            __builtin_amdgcn_fence(__ATOMIC_ACQUIRE, "agent");
            asm volatile("s_waitcnt vmcnt(0)" ::: "memory");
        }
    }
    __syncthreads();
}

struct Params {
    const float* x; const float* mem; const int* pos;
    const float* ln_mix_pre; const float* w_in; const float* conv_w; const float* conv_b;
    const float* lru_wr; const float* lru_br; const float* lru_wi; const float* lru_bi; const float* lru_lambda;
    const float* cmp_pe; const float* cmp_w1; const float* cmp_b1; const float* cmp_w2;
    const float* ln_mem; const float* w_mem_kv; const float* w_br_rnn; const float* w_br_nsa; const float* w_br_mem; const float* w_out;
    const float* ln_mix_post; const float* ln_mlp_pre; const float* mlp_w1; const float* mlp_w2; const float* ln_mlp_post;
    float* out; unsigned char* ws;
};
typedef const __attribute__((address_space(4))) Params* PP;
#define PPOPAQ() asm volatile("" : "+s"(pp))

DI void tr_item(const float* W, int ldw, int srccol, int valid, int k0, bf16_t* WT, int ldt, int drow0, LAS float* scr, int lane) {
    const int c32 = lane & 31;
    float vv[32];
    const float* wp = W + (size_t)(k0 + (lane >> 5)) * ldw + srccol + (c32 < valid ? c32 : 0);
#pragma unroll
    for (int i = 0; i < 32; ++i) vv[i] = wp[(size_t)(2 * i) * ldw];
#pragma unroll
    for (int i = 0; i < 32; ++i) scr[(2 * i + (lane >> 5)) * 33 + c32] = (c32 < valid) ? vv[i] : 0.f;
    __builtin_amdgcn_s_waitcnt(0xc07f); asm volatile("s_waitcnt lgkmcnt(0)" ::: "memory");
    const int c = lane & 7;
#pragma unroll
    for (int j = 0; j < 4; ++j) { const int n = (lane >> 3) + 8 * j; const LAS float* s = scr + (8 * c) * 33 + n;
        u32x4 o; o.x = pk2(s[0 * 33], s[1 * 33]); o.y = pk2(s[2 * 33], s[3 * 33]); o.z = pk2(s[4 * 33], s[5 * 33]); o.w = pk2(s[6 * 33], s[7 * 33]);
        *(u32x4*)(WT + (size_t)(drow0 + n) * ldt + k0 + 8 * c) = o; }
    asm volatile("s_waitcnt lgkmcnt(0)" ::: "memory");
}

DI void prep_phase(PP pp, int l, LAS unsigned char* lds) {
    PPOPAQ();
    int tid = threadIdx.x; asm volatile("" : "+v"(tid));
    const int lane = tid & 63, wave = __builtin_amdgcn_readfirstlane(tid >> 6);
    const int G_ = opaque_s((int)gridDim.x), bx_ = opaque_s((int)blockIdx.x);
    const int gw = bx_ * 8 + wave, NGW = G_ * 8, gtid = bx_ * 512 + tid, NT = G_ * 512;
    (void)lane; (void)wave; (void)gw; (void)NGW; (void)gtid; (void)NT;
    LAS float* scr = (LAS float*)(lds + wave * 8704);
    unsigned char* ws = pp->ws;
    const float* w_in = pp->w_in + (size_t)l * 1024 * 8752;
    constexpr int I_IN = 16 * 280, I_MKV = 16 * 64, I_BR = 16 * 32, I_M1 = 16 * 128, I_M2 = 64 * 32, I_C1 = 2 * 32 * 8, I_C2 = 2 * 4 * 8, I_LRU = 2 * 8 * 2 * 4;
    constexpr int NITEMS = I_IN + I_MKV + 4 * I_BR + I_M1 + I_M2 + I_C1 + I_C2 + I_LRU;
    for (int it = gw; it < NITEMS; it += NGW) {
        int r = it;
        if (r < I_IN) { const int kb = r / 280, nb = r % 280, n0 = 32 * nb; int src, valid = 32;
            if (n0 < 4608) src = n0; else if (n0 < 5632) src = n0 - 4608 + 4656; else if (n0 < 8704) src = n0 - 5632 + 5680;
            else { src = n0 - 8704 + 4608; valid = 48 - (n0 - 8704); valid = valid < 0 ? 0 : (valid > 32 ? 32 : valid); if (valid == 0) src = 0; }
            tr_item(w_in, 8752, src, valid, 64 * kb, (bf16_t*)(ws + WS_WIN), 1024, n0, scr, lane); continue; } r -= I_IN;
        if (r < I_MKV) { tr_item(pp->w_mem_kv + (size_t)l * 1024 * 2048, 2048, 32 * (r % 64), 32, 64 * (r / 64), (bf16_t*)(ws + WS_WMKV), 1024, 32 * (r % 64), scr, lane); continue; } r -= I_MKV;
        if (r < I_BR) { tr_item(pp->w_br_rnn + (size_t)l * 1024 * 1024, 1024, 32 * (r % 32), 32, 64 * (r / 32), (bf16_t*)(ws + WS_WBRA), 1024, 32 * (r % 32), scr, lane); continue; } r -= I_BR;
        if (r < I_BR) { tr_item(pp->w_br_nsa + (size_t)l * 1024 * 1024, 1024, 32 * (r % 32), 32, 64 * (r / 32), (bf16_t*)(ws + WS_WBRB), 1024, 32 * (r % 32), scr, lane); continue; } r -= I_BR;
        if (r < I_BR) { tr_item(pp->w_br_mem + (size_t)l * 1024 * 1024, 1024, 32 * (r % 32), 32, 64 * (r / 32), (bf16_t*)(ws + WS_WBRC), 1024, 32 * (r % 32), scr, lane); continue; } r -= I_BR;
        if (r < I_BR) { tr_item(pp->w_out + (size_t)l * 1024 * 1024, 1024, 32 * (r % 32), 32, 64 * (r / 32), (bf16_t*)(ws + WS_WOUT), 1024, 32 * (r % 32), scr, lane); continue; } r -= I_BR;
        if (r < I_M1) { tr_item(pp->mlp_w1 + (size_t)l * 1024 * 4096, 4096, 32 * (r % 128), 32, 64 * (r / 128), (bf16_t*)(ws + WS_WM1), 1024, 32 * (r % 128), scr, lane); continue; } r -= I_M1;
        if (r < I_M2) { tr_item(pp->mlp_w2 + (size_t)l * 4096 * 1024, 1024, 32 * (r % 32), 32, 64 * (r / 32), (bf16_t*)(ws + WS_WM2), 4096, 32 * (r % 32), scr, lane); continue; } r -= I_M2;
        if (r < I_C1) { const int j = r / 256, q = r % 256;
            tr_item(pp->cmp_w1 + ((size_t)l * 2 + j) * 2048 * 256, 256, 32 * (q % 8), 32, 64 * (q / 8), (bf16_t*)(ws + WS_WC1) + (size_t)j * 256 * 2048, 2048, 32 * (q % 8), scr, lane); continue; } r -= I_C1;
        if (r < I_C2) { const int j = r / 32, q = r % 32; const int n0 = 32 * (q % 8);
            tr_item(pp->cmp_w2 + ((size_t)l * 2 + j) * 256 * 64, 64, n0 < 64 ? n0 : 0, n0 < 64 ? 32 : 0, 64 * (q / 8), (bf16_t*)(ws + WS_WC2) + (size_t)j * 256 * 256, 256, n0, scr, lane); continue; } r -= I_C2;
        { const int ri = r / 64, q = r % 64, blk = q / 8, q2 = q % 8;
            const float* W = (ri == 0 ? pp->lru_wr : pp->lru_wi) + ((size_t)l * 8 + blk) * 128 * 128;
            tr_item(W, 128, 32 * (q2 % 4), 32, 64 * (q2 / 4), (bf16_t*)(ws + WS_WLRU), 128, blk * 256 + ri * 128 + 32 * (q2 % 4), scr, lane); }
    }
    for (int m = gw; m < 512; m += NGW) {
        const f32x4* xr = (const f32x4*)(pp->mem + (size_t)m * 1024) + lane; const f32x4* gr = (const f32x4*)(pp->ln_mem + (size_t)l * 1024) + lane;
        f32x4 v[4]; float s = 0.f;
#pragma unroll
        for (int j = 0; j < 4; ++j) { v[j] = xr[64 * j]; s += (v[j].x * v[j].x + v[j].y * v[j].y) + (v[j].z * v[j].z + v[j].w * v[j].w); }
        const float rs = 1.0f / sqrtf(wave_sum(s, lane) * (1.f / 1024.f) + EPS);
        u32x2* o8 = (u32x2*)((bf16_t*)(ws + WS_MEMN) + (size_t)m * 1024) + lane;
#pragma unroll
        for (int j = 0; j < 4; ++j) { const f32x4 g = gr[64 * j]; u32x2 w; w.x = pk2(v[j].x * rs * g.x, v[j].y * rs * g.y); w.y = pk2(v[j].z * rs * g.z, v[j].w * rs * g.w); o8[64 * j] = w; }
    }
    {
        const int gt = gw * 64 + lane;
        if (gt < 16 * 512) { const int prt = gt / 512, jn = gt % 512, j = jn / 256, n = jn % 256;
            const float* w1 = pp->cmp_w1 + ((size_t)l * 2 + j) * 2048 * 256 + n; const float* pe = pp->cmp_pe + ((size_t)l * 2 + j) * 2048;
            float s = 0.f;
            for (int k = prt * 128; k < prt * 128 + 128; ++k) s += pe[k] * w1[(size_t)k * 256];
            ((float*)(ws + WS_CBP))[gt] = s; }
    }
}

DI void row_phase(const float* xin, const float* y, const float* gpost, float* xout, const float* gnext, bf16_t* hout) {
    int tid = threadIdx.x; asm volatile("" : "+v"(tid));
    const int lane = tid & 63, wave = __builtin_amdgcn_readfirstlane(tid >> 6);
    const int G_ = opaque_s((int)gridDim.x), bx_ = opaque_s((int)blockIdx.x);
    const int gw = bx_ * 8 + wave, NGW = G_ * 8, gtid = bx_ * 512 + tid, NT = G_ * 512;
    (void)lane; (void)wave; (void)gw; (void)NGW; (void)gtid; (void)NT;
    for (int m = gw; m < T_; m += NGW) {
        const f32x4* xr = (const f32x4*)(xin + (size_t)m * 1024) + lane;
        f32x4 v[4];
#pragma unroll
        for (int j = 0; j < 4; ++j) v[j] = xr[64 * j];
        if (y) {
            const f32x4* yr = (const f32x4*)(y + (size_t)m * 1024) + lane; const f32x4* gr = (const f32x4*)gpost + lane;
            f32x4 w[4]; float s = 0.f;
#pragma unroll
            for (int j = 0; j < 4; ++j) { w[j] = yr[64 * j]; s += (w[j].x * w[j].x + w[j].y * w[j].y) + (w[j].z * w[j].z + w[j].w * w[j].w); }
            const float rs = 1.0f / sqrtf(wave_sum(s, lane) * (1.f / 1024.f) + EPS);
            f32x4* xo = (f32x4*)(xout + (size_t)m * 1024) + lane;
#pragma unroll
            for (int j = 0; j < 4; ++j) { v[j] = v[j] + w[j] * rs * gr[64 * j]; xo[64 * j] = v[j]; }
        }
        if (hout) {
            float s = 0.f;
#pragma unroll
            for (int j = 0; j < 4; ++j) s += (v[j].x * v[j].x + v[j].y * v[j].y) + (v[j].z * v[j].z + v[j].w * v[j].w);
            const float rs = 1.0f / sqrtf(wave_sum(s, lane) * (1.f / 1024.f) + EPS);
            const f32x4* gr = (const f32x4*)gnext + lane; u32x2* o8 = (u32x2*)(hout + (size_t)m * 1024) + lane;
#pragma unroll
            for (int j = 0; j < 4; ++j) { const f32x4 g = gr[64 * j]; u32x2 w; w.x = pk2(v[j].x * rs * g.x, v[j].y * rs * g.y); w.y = pk2(v[j].z * rs * g.z, v[j].w * rs * g.w); o8[64 * j] = w; }
        }
    }
}

DI void rope8(u32x4& lo, u32x4& hi, float pos, int d0, float scale) {
    unsigned* pl = (unsigned*)&lo; unsigned* ph = (unsigned*)&hi;
    float x1[8], x2[8];
#pragma unroll
    for (int e = 0; e < 4; ++e) { x1[2 * e] = bflo(pl[e]); x1[2 * e + 1] = bfhi(pl[e]); x2[2 * e] = bflo(ph[e]); x2[2 * e + 1] = bfhi(ph[e]); }
#pragma unroll
    for (int e = 0; e < 8; ++e) {
        const float inv = fexp2(-(float)(d0 + e) * 0.41524101186092029f);
        const float ang = pos * inv;
        const double rev = (double)ang * 0.15915494309189535; const float fr = (float)(rev - __builtin_rint(rev));
        const float sn = __builtin_amdgcn_sinf(fr), cs = __builtin_amdgcn_cosf(fr);
        const float a = (x1[e] * cs - x2[e] * sn) * scale, b = (x2[e] * cs + x1[e] * sn) * scale; x1[e] = a; x2[e] = b;
    }
#pragma unroll
    for (int e = 0; e < 4; ++e) { pl[e] = pk2(x1[2 * e], x1[2 * e + 1]); ph[e] = pk2(x2[2 * e], x2[2 * e + 1]); }
}

DI void postproj_phase(PP pp, int l) {
    PPOPAQ();
    if (opaque_s((int)blockIdx.x) < 32 && gridDim.x == 256) return;
    int tid = threadIdx.x; asm volatile("" : "+v"(tid));
    const int lane = tid & 63, wave = __builtin_amdgcn_readfirstlane(tid >> 6);
    const int G_ = opaque_s((int)gridDim.x), bx_ = opaque_s((int)blockIdx.x);
    const bool shr = (G_ == 256); const int gw = bx_ * 8 + wave, NGW = G_ * 8, gtid = (shr ? bx_ - 32 : bx_) * 512 + tid, NT = (shr ? G_ - 32 : G_) * 512;
    (void)lane; (void)wave; (void)gw; (void)NGW; (void)gtid; (void)NT;
    unsigned char* ws = pp->ws; bf16_t* PROJ = (bf16_t*)(ws + WS_PROJ);
    {
        const float* cw = pp->conv_w + (size_t)l * 4 * 1024; const float* cb = pp->conv_b + (size_t)l * 1024; bf16_t* XC = (bf16_t*)(ws + WS_XC);
        for (int i = gtid; i < (T_ / 8) * 128; i += NT) { const int tb8 = (i >> 7) * 8, c8 = (i & 127) * 8, ts0 = tb8 & (S_ - 1);
            u32x4 xr[11];
#pragma unroll
            for (int w = 0; w < 11; ++w) { const int tt = tb8 - 3 + w; const bool okr = ts0 - 3 + w >= 0; const u32x4 ld = *(const u32x4*)(PROJ + (size_t)(okr ? tt : tb8) * LDP + C_XR + c8);
                xr[w] = okr ? ld : (u32x4){0u, 0u, 0u, 0u}; }
            f32x4 kw[4][2];
#pragma unroll
            for (int w = 0; w < 4; ++w) { kw[w][0] = *(const f32x4*)(cw + w * 1024 + c8); kw[w][1] = *(const f32x4*)(cw + w * 1024 + c8 + 4); }
            const f32x4 b0 = *(const f32x4*)(cb + c8), b1 = *(const f32x4*)(cb + c8 + 4);
#pragma unroll
            for (int r = 0; r < 8; ++r) {
                float acc[8] = {b0.x, b0.y, b0.z, b0.w, b1.x, b1.y, b1.z, b1.w};
#pragma unroll
                for (int w = 0; w < 4; ++w) { const unsigned* xp = (const unsigned*)&xr[r + w]; const f32x4 k0 = kw[w][0], k1 = kw[w][1];
                    acc[0] += k0.x * bflo(xp[0]); acc[1] += k0.y * bfhi(xp[0]); acc[2] += k0.z * bflo(xp[1]); acc[3] += k0.w * bfhi(xp[1]);
                    acc[4] += k1.x * bflo(xp[2]); acc[5] += k1.y * bfhi(xp[2]); acc[6] += k1.z * bflo(xp[3]); acc[7] += k1.w * bfhi(xp[3]); }
                u32x4 o; o.x = pk2(acc[0], acc[1]); o.y = pk2(acc[2], acc[3]); o.z = pk2(acc[4], acc[5]); o.w = pk2(acc[6], acc[7]);
                *(u32x4*)(XC + (size_t)(tb8 + r) * 1024 + c8) = o; }
        }
    }
    for (int i = gtid; i < T_ * 20 * 4; i += NT) { const int t = i / 80, r = i % 80, hd = r >> 2, d0 = (r & 3) * 8;
        int col; float sc = 1.0f;
        if (hd < 16) { col = C_Q + hd * 64; sc = 0.125f * LOG2E; } else col = C_KW + (hd - 16) * 64;
        bf16_t* base = PROJ + (size_t)t * LDP + col + d0;
        u32x4 lo = *(const u32x4*)base, hi = *(const u32x4*)(base + 32);
        rope8(lo, hi, (float)pp->pos[t], d0, sc);
        *(u32x4*)base = lo; *(u32x4*)(base + 32) = hi; }
    for (int i = gtid; i < 8 * 128 * 4 * 64; i += NT) { const int ln = i & 63, sub = (i >> 6) & 3, j = (i >> 8) & 127, bg = i >> 15, b = bg >> 2, g = bg & 3;
        const int r16 = ln & 15, quad = ln >> 4, t = 64 * j + 16 * sub + r16, dl = 8 * quad;
        const bf16_t* base = PROJ + (size_t)(b * S_ + t) * LDP + C_KS + g * 64 + dl;
        u32x4 lo = *(const u32x4*)base, hi = *(const u32x4*)(base + 32);
        rope8(lo, hi, (float)pp->pos[b * S_ + t], dl, 1.0f);
        u32x4 outw;
        outw.x = pk4_fp8(bflo(lo.x), bfhi(lo.x), bflo(lo.y), bfhi(lo.y)); outw.y = pk4_fp8(bflo(lo.z), bfhi(lo.z), bflo(lo.w), bfhi(lo.w));
        outw.z = pk4_fp8(bflo(hi.x), bfhi(hi.x), bflo(hi.y), bfhi(hi.y)); outw.w = pk4_fp8(bflo(hi.z), bfhi(hi.z), bflo(hi.w), bfhi(hi.w));
        *(u32x4*)((unsigned char*)(ws + WS_KF) + (size_t)i * 16) = outw; }
    for (int i = gtid; i < 8 * 128 * 4 * 64; i += NT) { const int ln = i & 63, dsub = (i >> 6) & 3, j = (i >> 8) & 127, bg = i >> 15, b = bg >> 2, g = bg & 3;
        const int r16 = ln & 15, quad = ln >> 4;
        u32x4 outw;
#pragma unroll
        for (int kst = 0; kst < 2; ++kst) { const int key0 = 64 * j + 32 * kst + 4 * quad;
            const bf16_t* src = PROJ + (size_t)(b * S_ + key0) * LDP + C_VS + g * 64 + 16 * dsub + r16;
            float v[8];
#pragma unroll
            for (int e = 0; e < 8; ++e) v[e] = bf2f(src[(size_t)(e < 4 ? e : e + 12) * LDP]);
            const unsigned w0 = pk4_fp8(v[0], v[1], v[2], v[3]), w1 = pk4_fp8(v[4], v[5], v[6], v[7]);
            if (kst == 0) { outw.x = w0; outw.y = w1; } else { outw.z = w0; outw.w = w1; } }
        *(u32x4*)((unsigned char*)(ws + WS_VTS) + (size_t)i * 16) = outw; }
    for (int i = gtid; i < 2 * 4 * 1024 * 64; i += NT) { const int d = i & 63, t8 = (i >> 6) & 1023, g = (i >> 16) & 3, b = (i >> 18) & 1, which = 1;
        const bf16_t* src = PROJ + (size_t)(b * S_ + t8 * 8) * LDP + (which ? C_VW : C_VS) + g * 64 + d;
        unsigned short v[8];
#pragma unroll
        for (int e = 0; e < 8; ++e) v[e] = src[(size_t)e * LDP];
        u32x4 o; o.x = v[0] | ((unsigned)v[1] << 16); o.y = v[2] | ((unsigned)v[3] << 16); o.z = v[4] | ((unsigned)v[5] << 16); o.w = v[6] | ((unsigned)v[7] << 16);
        *(u32x4*)((bf16_t*)(ws + (which ? WS_VTW : WS_VTS)) + ((size_t)(b * 4 + g) * 64 + d) * S_ + t8 * 8) = o; }
}
DI void cbias_phase(PP pp, int l) {
    PPOPAQ();
    int tid = threadIdx.x; asm volatile("" : "+v"(tid));
    if (opaque_s((int)blockIdx.x) == 0) { unsigned char* ws = pp->ws; const float* part = (const float*)(ws + WS_CBP); float s = pp->cmp_b1[(size_t)l * 512 + tid];
        for (int q = 0; q < 16; ++q) s += part[q * 512 + tid];
        ((float*)(ws + WS_CBIAS))[tid] = s; }
}

DI void lru_ab(float rp, float ip, float xc, float cl, float& a, float& bb) {
    const float la = cl * sigmoidf_(rp);
    a = fexp2(la * LOG2E);
    const float x2 = 2.0f * la;
    float om;
    if (x2 > -0.1f) om = -x2 * (1.0f + x2 * (0.5f + x2 * (0.16666667f + x2 * (0.041666668f + x2 * 0.0083333338f)))); else om = 1.0f - a * a;
    bb = __builtin_amdgcn_sqrtf(om) * sigmoidf_(ip) * xc;
}
DI void scan_phase(PP pp, int l, int pass) {
    PPOPAQ();
    int tid = threadIdx.x; asm volatile("" : "+v"(tid));
    const int G_ = opaque_s((int)gridDim.x), bx_ = opaque_s((int)blockIdx.x);
    unsigned char* ws = pp->ws; const bf16_t* __restrict__ RI = (const bf16_t*)(ws + WS_RI); bf16_t* XC = (bf16_t*)(ws + WS_XC); const bf16_t* __restrict__ PROJ = (const bf16_t*)(ws + WS_PROJ);
    f32x2* SA = (f32x2*)(ws + WS_SCA); f32x2* SH = (f32x2*)(ws + WS_SCH);
    const int ch = 2 * tid, blk = ch >> 7, cc = ch & 127, rcol = blk * 256 + cc;
    const f32x2 lam = *(const f32x2*)(pp->lru_lambda + (size_t)l * 1024 + ch), br = *(const f32x2*)(pp->lru_br + (size_t)l * 1024 + ch), bi = *(const f32x2*)(pp->lru_bi + (size_t)l * 1024 + ch);
    float cl[2];
#pragma unroll
    for (int e = 0; e < 2; ++e) { const float ex = fexp2(-lam[e] * LOG2E);
        const float sp = (ex < 0.05f) ? ex * (1.0f - ex * (0.5f - ex * (0.33333334f - ex * (0.25f - ex * (0.2f - ex * 0.16666667f))))) : ((-lam[e] > 20.f) ? -lam[e] : 0.6931471805599453f * __builtin_amdgcn_logf(1.0f + ex));
        cl[e] = -8.0f * sp; }
    for (int u = bx_; u < 256; u += G_) { const int b = u >> 7, k = u & 127;
        const size_t row0 = (size_t)b * S_ + k * 64;
        if (pass == 0) {
            float A0 = 1.f, H0 = 0.f, A1 = 1.f, H1 = 0.f;
            for (int s8 = 0; s8 < 64; s8 += 8) { unsigned rw[8], iw[8], xw[8];
#pragma unroll
                for (int e = 0; e < 8; ++e) { const size_t row = row0 + s8 + e; rw[e] = *(const unsigned*)(RI + row * 2048 + rcol); iw[e] = *(const unsigned*)(RI + row * 2048 + rcol + 128); xw[e] = *(const unsigned*)(XC + row * 1024 + ch); }
#pragma unroll
                for (int e = 0; e < 8; ++e) { float a, bb;
                    lru_ab(bflo(rw[e]) + br[0], bflo(iw[e]) + bi[0], bflo(xw[e]), cl[0], a, bb); A0 *= a; H0 = a * H0 + bb;
                    lru_ab(bfhi(rw[e]) + br[1], bfhi(iw[e]) + bi[1], bfhi(xw[e]), cl[1], a, bb); A1 *= a; H1 = a * H1 + bb; } }
            SA[((size_t)b * 128 + k) * 512 + tid] = (f32x2){A0, A1}; SH[((size_t)b * 128 + k) * 512 + tid] = (f32x2){H0, H1};
        } else {
            float h0 = 0.f, h1 = 0.f;
            const f32x2* __restrict__ sa = SA + (size_t)b * 128 * 512 + tid; const f32x2* __restrict__ sh = SH + (size_t)b * 128 * 512 + tid;
            for (int q0 = 0; q0 < k; q0 += 16) { f32x2 av[16], hv[16];
#pragma unroll
                for (int e = 0; e < 16; ++e) { const int qq = (q0 + e < k) ? q0 + e : q0; av[e] = sa[(size_t)qq * 512]; hv[e] = sh[(size_t)qq * 512]; }
#pragma unroll
                for (int e = 0; e < 16; ++e) if (q0 + e < k) { h0 = av[e][0] * h0 + hv[e][0]; h1 = av[e][1] * h1 + hv[e][1]; } }
            for (int s8 = 0; s8 < 64; s8 += 8) { unsigned rw[8], iw[8], xw[8], yw[8];
#pragma unroll
                for (int e = 0; e < 8; ++e) { const size_t row = row0 + s8 + e; rw[e] = *(const unsigned*)(RI + row * 2048 + rcol); iw[e] = *(const unsigned*)(RI + row * 2048 + rcol + 128); xw[e] = *(const unsigned*)(XC + row * 1024 + ch);
                    yw[e] = *(const unsigned*)(PROJ + row * LDP + C_YR + ch); }
#pragma unroll
                for (int e = 0; e < 8; ++e) { float a, bb;
                    lru_ab(bflo(rw[e]) + br[0], bflo(iw[e]) + bi[0], bflo(xw[e]), cl[0], a, bb); h0 = a * h0 + bb;
                    lru_ab(bfhi(rw[e]) + br[1], bfhi(iw[e]) + bi[1], bfhi(xw[e]), cl[1], a, bb); h1 = a * h1 + bb;
                    *(unsigned*)(XC + (row0 + s8 + e) * 1024 + ch) = pk2(h0 * gelu_tanh(bflo(yw[e])), h1 * gelu_tanh(bfhi(yw[e]))); } }
        }
    }
}

DI void memsoftmax_phase(PP pp) {
    PPOPAQ();
    int tid = threadIdx.x; asm volatile("" : "+v"(tid));
    const int lane = tid & 63, wave = __builtin_amdgcn_readfirstlane(tid >> 6);
    const int G_ = opaque_s((int)gridDim.x), bx_ = opaque_s((int)blockIdx.x);
    const int gw = bx_ * 8 + wave, NGW = G_ * 8, gtid = bx_ * 512 + tid, NT = G_ * 512;
    (void)lane; (void)wave; (void)gw; (void)NGW; (void)gtid; (void)NT;
    bf16_t* SP = (bf16_t*)(pp->ws + WS_H);
    for (int m0 = gw; m0 < T_; m0 += 4 * NGW) {
        u32x4 av[4], bv[4];
#pragma unroll
        for (int r = 0; r < 4; ++r) { const int m = (m0 + r * NGW < T_) ? m0 + r * NGW : m0; const u32x4* ptr = (const u32x4*)(SP + (size_t)m * 1024 + lane * 16); av[r] = ptr[0]; bv[r] = ptr[1]; }
#pragma unroll
        for (int r = 0; r < 4; ++r) {
            const unsigned* pa = (const unsigned*)&av[r]; const unsigned* pb = (const unsigned*)&bv[r];
            float v[16];
#pragma unroll
            for (int e = 0; e < 4; ++e) { v[2 * e] = bflo(pa[e]); v[2 * e + 1] = bfhi(pa[e]); v[8 + 2 * e] = bflo(pb[e]); v[8 + 2 * e + 1] = bfhi(pb[e]); }
            float mx = v[0];
#pragma unroll
            for (int e = 1; e < 16; ++e) mx = fmaxf(mx, v[e]);
#pragma unroll
            for (int o = 1; o < 16; o <<= 1) mx = fmaxf(mx, shx(mx, o, lane));
            float sm = 0.f;
#pragma unroll
            for (int e = 0; e < 16; ++e) { v[e] = fexp2(v[e] - mx); sm += v[e]; }
#pragma unroll
            for (int o = 1; o < 16; o <<= 1) sm += shx(sm, o, lane);
            const float inv = 1.0f / sm;
            u32x4 oa, ob; unsigned* qa = (unsigned*)&oa; unsigned* qb = (unsigned*)&ob;
#pragma unroll
            for (int e = 0; e < 4; ++e) { qa[e] = pk2(v[2 * e] * inv, v[2 * e + 1] * inv); qb[e] = pk2(v[8 + 2 * e] * inv, v[8 + 2 * e + 1] * inv); }
            if (m0 + r * NGW < T_) { u32x4* ptr = (u32x4*)(SP + (size_t)(m0 + r * NGW) * 1024 + lane * 16); ptr[0] = oa; ptr[1] = ob; }
        }
    }
}

DI void cmpfinal_phase(PP pp) {
    PPOPAQ();
    int tid = threadIdx.x; asm volatile("" : "+v"(tid));
    const int lane = tid & 63, wave = __builtin_amdgcn_readfirstlane(tid >> 6);
    const int G_ = opaque_s((int)gridDim.x), bx_ = opaque_s((int)blockIdx.x);
    const int gw = bx_ * 8 + wave, NGW = G_ * 8, gtid = bx_ * 512 + tid, NT = G_ * 512;
    (void)lane; (void)wave; (void)gw; (void)NGW; (void)gtid; (void)NT;
    unsigned char* ws = pp->ws; const float* CR = (const float*)(ws + WS_CRAW);
    for (int i = gtid; i < 2 * 4 * 512 * 32; i += NT) { const int d = i & 31, c = (i >> 5) & 511, bg = i >> 14, b = bg >> 2;
        const float* src = CR + ((size_t)bg * 512 + c) * 64; float x1 = src[d], x2 = src[d + 32];
        float o1 = 0.f, o2 = 0.f;
        if (c < 511) { const float pos = (float)pp->pos[b * S_ + 16 * c + 31]; const float inv = fexp2(-(float)d * 0.41524101186092029f); const float ang = pos * inv;
            const double rev = (double)ang * 0.15915494309189535; const float fr = (float)(rev - __builtin_rint(rev));
            const float sn = __builtin_amdgcn_sinf(fr), cs = __builtin_amdgcn_cosf(fr); o1 = x1 * cs - x2 * sn; o2 = x2 * cs + x1 * sn; }
        bf16_t* dst = (bf16_t*)(ws + WS_KCMP) + ((size_t)bg * 512 + c) * 64; dst[d] = (bf16_t)f2bf(o1); dst[d + 32] = (bf16_t)f2bf(o2); }
    for (int i = gtid; i < 2 * 4 * 64 * 512; i += NT) { const int c = i & 511, d = (i >> 9) & 63, bg = i >> 15;
        const float v = (c < 511) ? CR[((size_t)(8 + bg) * 512 + c) * 64 + d] : 0.f;
        ((bf16_t*)(ws + WS_VTCMP))[((size_t)bg * 64 + d) * 512 + c] = (bf16_t)f2bf(v); }
}

constexpr int KSTR = 144, VSTR = 136;
constexpr int L_K = 0, L_V = 2 * 64 * KSTR, L_IMP = L_V + 2 * 64 * VSTR, IMPSTR = 132, L_SEL = L_IMP + 64 * IMPSTR * 4, L_ATT_END = L_SEL + 64 * 16, L_OT = L_ATT_END, L_Q8 = L_OT + 65536, L_ML = L_Q8 + 16384, OSSTR = 272;
DI int crow(int r, int hi) { return (r & 3) + 8 * (r >> 2) + 4 * hi; }

struct TileSrc { const bf16_t* K; int kstr; const bf16_t* Vt; int vstr; };

template <int MODE>
DI void attn_loop(LAS unsigned char* lds, const TileSrc src, int j0, int j1, const bf16x8 (&qf)[4], f32x16 (&o)[2], float& m_run, float& l_run,
                  int tl, int t, int tb, u64 selLo, u64 selHi, int tid, int wave, int lane) {
    const int n = lane & 31, hh = lane >> 5;
    const int lrow = tid >> 3, lchunk = tid & 7;
    u32x4 kreg, vreg;
    kreg = *(const u32x4*)(src.K + (size_t)(64 * j0 + lrow) * src.kstr + lchunk * 8);
    vreg = *(const u32x4*)(src.Vt + (size_t)lrow * src.vstr + 64 * j0 + lchunk * 8);
    float carry = 0.f;
    int buf = 0;
    for (int j = j0; j <= j1; ++j) {
        LAS unsigned char* Kl = lds + L_K + buf * 64 * KSTR; LAS unsigned char* Vl = lds + L_V + buf * 64 * VSTR;
        *(LAS u32x4*)(Kl + lrow * KSTR + lchunk * 16) = kreg;
        *(LAS u32x2*)(Vl + lrow * VSTR + lchunk * 16) = (u32x2){vreg.x, vreg.y}; *(LAS u32x2*)(Vl + lrow * VSTR + lchunk * 16 + 8) = (u32x2){vreg.z, vreg.w};
        __syncthreads();
        if (j < j1) { kreg = *(const u32x4*)(src.K + (size_t)(64 * (j + 1) + lrow) * src.kstr + lchunk * 8);
                      vreg = *(const u32x4*)(src.Vt + (size_t)lrow * src.vstr + 64 * (j + 1) + lchunk * 8); }
        buf ^= 1;
        bool active = true;
        if (MODE == 2) { const bool bit = ((j < 64 ? selLo : selHi) >> (j & 63)) & 1ull; active = __ballot(bit) != 0ull; }
        if (!active) continue;
        f32x16 s[2];
#pragma unroll
        for (int u = 0; u < 2; ++u) {
#pragma unroll
            for (int e = 0; e < 16; ++e) s[u][e] = 0.f;
#pragma unroll
            for (int ks = 0; ks < 4; ++ks) { const bf16x8 kf = *(const LAS bf16x8*)(Kl + (32 * u + n) * KSTR + (ks * 16 + 8 * hh) * 2);
                s[u] = __builtin_amdgcn_mfma_f32_32x32x16_bf16(kf, qf[ks], s[u], 0, 0, 0); }
        }
        const float NEGINF = -__builtin_inff();
        if (MODE <= 1) { const int cmax = min(510, (t - 31) >> 4);
#pragma unroll
            for (int u = 0; u < 2; ++u)
#pragma unroll
                for (int e = 0; e < 16; ++e) { const int c = 64 * j + 32 * u + crow(e, hh); if (c > cmax) s[u][e] = NEGINF; }
        } else if (MODE == 2) { const bool bit = ((j < 64 ? selLo : selHi) >> (j & 63)) & 1ull; const int lim = (j == tb) ? tl : 64;
#pragma unroll
            for (int u = 0; u < 2; ++u)
#pragma unroll
                for (int e = 0; e < 16; ++e) { const int kk = 32 * u + crow(e, hh); if (!bit || kk > lim) s[u][e] = NEGINF; }
        } else {
#pragma unroll
            for (int u = 0; u < 2; ++u)
#pragma unroll
                for (int e = 0; e < 16; ++e) { const int df = t - (64 * j + 32 * u + crow(e, hh)); if ((unsigned)df >= 512u) s[u][e] = NEGINF; }
        }
        if (MODE == 1) {
            const float msafe = (m_run == NEGINF) ? 0.f : m_run;
#pragma unroll
            for (int u = 0; u < 2; ++u)
#pragma unroll
                for (int e = 0; e < 16; ++e) s[u][e] = fexp2(s[u][e] - msafe) * l_run;
            if (tb >= 16) {
                float w1[8], w2[8], pw2[8];
#pragma unroll
                for (int u = 0; u < 2; ++u)
#pragma unroll
                    for (int gi = 0; gi < 4; ++gi) { const float p0 = s[u][4 * gi], p1 = s[u][4 * gi + 1], p2 = s[u][4 * gi + 2], p3 = s[u][4 * gi + 3];
                        w1[u * 4 + gi] = p0 + p1 + p2 + 0.5f * p3; w2[u * 4 + gi] = 0.5f * p3; }
#pragma unroll
                for (int q = 0; q < 8; ++q) pw2[q] = shx(w2[q], 32, lane);
                float tot[8];
#pragma unroll
                for (int q = 0; q < 8; ++q) { const float prev = (q == 0) ? carry : pw2[q > 0 ? q - 1 : 0]; tot[q] = w1[q] + (hh ? pw2[q] : prev); }
                carry = pw2[7];
#pragma unroll
                for (int q = 0; q < 8; ++q) { float v = tot[q]; v += shx(v, 1, lane); v += shx(v, 2, lane); tot[q] = v; }
                if ((n & 3) == 0) { LAS float* imp = (LAS float*)(lds + L_IMP) + (8 * wave + (n >> 2)) * IMPSTR;
#pragma unroll
                    for (int q = 0; q < 8; ++q) { const int jj = 16 * j + 8 * (q >> 2) + 2 * (q & 3) + hh; if (jj < 128) imp[jj] = tot[q]; } }
            }
        } else {
            float mloc = s[0][0];
#pragma unroll
            for (int u = 0; u < 2; ++u)
#pragma unroll
                for (int e = 0; e < 16; ++e) mloc = fmaxf(mloc, s[u][e]);
            mloc = fmaxf(mloc, shx(mloc, 32, lane));
            const float mnew = fmaxf(m_run, mloc); const float msafe = (mnew == NEGINF) ? 0.f : mnew;
            const float alpha = fexp2(m_run - msafe);
            float ls = 0.f;
#pragma unroll
            for (int u = 0; u < 2; ++u)
#pragma unroll
                for (int e = 0; e < 16; ++e) { s[u][e] = fexp2(s[u][e] - msafe); ls += s[u][e]; }
            l_run = l_run * alpha + ls; m_run = mnew;
            if (MODE != 0) {
#pragma unroll
                for (int ds = 0; ds < 2; ++ds)
#pragma unroll
                    for (int e = 0; e < 16; ++e) o[ds][e] *= alpha;
            }
        }
        if (MODE != 0) {
#pragma unroll
            for (int u = 0; u < 2; ++u)
#pragma unroll
                for (int st = 0; st < 2; ++st) {
                    u32x4 pp; pp.x = pk2(s[u][8 * st], s[u][8 * st + 1]); pp.y = pk2(s[u][8 * st + 2], s[u][8 * st + 3]); pp.z = pk2(s[u][8 * st + 4], s[u][8 * st + 5]); pp.w = pk2(s[u][8 * st + 6], s[u][8 * st + 7]);
                    const bf16x8 pb = __builtin_bit_cast(bf16x8, pp);
#pragma unroll
                    for (int ds = 0; ds < 2; ++ds) { const LAS unsigned char* vp = Vl + (32 * ds + n) * VSTR + (32 * u + 16 * st + 4 * hh) * 2;
                        const u32x2 a0 = *(const LAS u32x2*)vp, a1 = *(const LAS u32x2*)(vp + 16);
                        const u32x4 av = {a0.x, a0.y, a1.x, a1.y};
                        o[ds] = __builtin_amdgcn_mfma_f32_32x32x16_bf16(__builtin_bit_cast(bf16x8, av), pb, o[ds], 0, 0, 0); }
                }
        }
    }
    __syncthreads();
}

typedef float f32x4v __attribute__((ext_vector_type(4)));
DI void sel_tile(const u32x4 (&kc)[4], const u32x4 (&vf)[4], int j, LAS unsigned char* OSw, const LAS unsigned char* Q8w, LAS float* MLw, u64 tmLo, u64 tmHi, int tb, int wave, int lane) {
    const int q = lane & 15, quad = lane >> 4, head = q & 3, slot = q >> 2;
    const float NEGINF = -__builtin_inff();
    const bool tbit = (((j < 64 ? tmLo : tmHi) >> (j & 63)) & 1ull) != 0ull && lane < 8;
    unsigned act = (unsigned)__ballot(tbit) & 0xffu;
    while (act != 0u) {
        const int t0 = __builtin_ctz(act); act &= act - 1u;
        int t1 = -1, t2 = -1, t3 = -1;
        if (act != 0u) { t1 = __builtin_ctz(act); act &= act - 1u; }
        if (act != 0u) { t2 = __builtin_ctz(act); act &= act - 1u; }
        if (act != 0u) { t3 = __builtin_ctz(act); act &= act - 1u; }
        const int tsel = slot == 0 ? t0 : (slot == 1 ? t1 : (slot == 2 ? t2 : t3));
        const bool valid = tsel >= 0; const int tk = valid ? tsel : t0; const int rho = 4 * tk + head;
        const long qa = *(const LAS long*)(Q8w + rho * 64 + 8 * quad), qb = *(const LAS long*)(Q8w + rho * 64 + 32 + 8 * quad);
        f32x4v s[4];
#pragma unroll
        for (int sub = 0; sub < 4; ++sub) { s[sub] = (f32x4v){0.f, 0.f, 0.f, 0.f};
            s[sub] = __builtin_amdgcn_mfma_f32_16x16x32_fp8_fp8(mk64(kc[sub].x, kc[sub].y), qa, s[sub], 0, 0, 0);
            s[sub] = __builtin_amdgcn_mfma_f32_16x16x32_fp8_fp8(mk64(kc[sub].z, kc[sub].w), qb, s[sub], 0, 0, 0); }
        if (j == tb) { const int tlk = 8 * wave + tk;
#pragma unroll
            for (int sub = 0; sub < 4; ++sub)
#pragma unroll
                for (int i = 0; i < 4; ++i) { const int kk = 16 * sub + 4 * quad + i; if (kk > tlk) s[sub][i] = NEGINF; } }
        float mloc = fmaxf(fmaxf(s[0][0], s[1][0]), fmaxf(s[2][0], s[3][0]));
#pragma unroll
        for (int i = 1; i < 4; ++i) mloc = fmaxf(mloc, fmaxf(fmaxf(s[0][i], s[1][i]), fmaxf(s[2][i], s[3][i])));
        mloc = fmaxf(mloc, shx(mloc, 16, lane)); mloc = fmaxf(mloc, shx(mloc, 32, lane));
        const float m_old = MLw[rho], l_old = MLw[32 + rho];
        const float mnew = fmaxf(m_old, mloc);
        const float msafe = (mnew == NEGINF) ? 0.f : mnew;
        const float alpha = fexp2(m_old - msafe);
        const float sb = valid ? msafe - 8.0f : __builtin_inff();
        float ls = 0.f;
#pragma unroll
        for (int sub = 0; sub < 4; ++sub)
#pragma unroll
            for (int i = 0; i < 4; ++i) { s[sub][i] = fexp2(s[sub][i] - sb); ls += s[sub][i]; }
        ls += shx(ls, 16, lane); ls += shx(ls, 32, lane);
        if (valid && quad == 0) { MLw[rho] = mnew; MLw[32 + rho] = l_old * alpha + ls; }
        const long pb0 = mk64(pk4_fp8(s[0][0], s[0][1], s[0][2], s[0][3]), pk4_fp8(s[1][0], s[1][1], s[1][2], s[1][3]));
        const long pb1 = mk64(pk4_fp8(s[2][0], s[2][1], s[2][2], s[2][3]), pk4_fp8(s[3][0], s[3][1], s[3][2], s[3][3]));
#pragma unroll
        for (int dsub = 0; dsub < 4; ++dsub) { LAS f32x4v* op = (LAS f32x4v*)(OSw + rho * OSSTR + (16 * dsub + 4 * quad) * 4);
            f32x4v oacc = *op * alpha;
            oacc = __builtin_amdgcn_mfma_f32_16x16x32_fp8_fp8(mk64(vf[dsub].x, vf[dsub].y), pb0, oacc, 0, 0, 0);
            oacc = __builtin_amdgcn_mfma_f32_16x16x32_fp8_fp8(mk64(vf[dsub].z, vf[dsub].w), pb1, oacc, 0, 0, 0);
            if (valid) *op = oacc; }
    }
}
DI int sg_pop(u64& uLo, u64& uHi) {
    int j = -1;
    if (uLo != 0ull) { j = __builtin_ctzll(uLo); uLo &= uLo - 1ull; } else if (uHi != 0ull) { j = 64 + __builtin_ctzll(uHi); uHi &= uHi - 1ull; }
    return j;
}
DI void sel_gather(const unsigned char* __restrict__ KFb, const unsigned char* __restrict__ VFb, u64 uLo, u64 uHi, LAS unsigned char* OSw, const LAS unsigned char* Q8w, LAS float* MLw,
                   u64 tmLo, u64 tmHi, int tb, int wave, int lane) {
    const unsigned char* kp = KFb + lane * 16;
    const unsigned char* vp = VFb + lane * 16;
    u32x4 kb0[4], kb1[4], kb2[4], kb3[4], vb0[4], vb1[4], vb2[4], vb3[4];
#define SG_LOAD(KB, VB, jj) do { _Pragma("unroll") for (int sub = 0; sub < 4; ++sub) { KB[sub] = *(const u32x4*)(kp + (size_t)(((jj) * 4 + sub) * 1024)); VB[sub] = *(const u32x4*)(vp + (size_t)(((jj) * 4 + sub) * 1024)); } } while (0)
#define SG_STEP(KC, VC, KL, VL) { const int j3 = sg_pop(uLo, uHi); { const int j3c = j3 < 0 ? 0 : j3; SG_LOAD(KL, VL, j3c); } sel_tile(KC, VC, j0, OSw, Q8w, MLw, tmLo, tmHi, tb, wave, lane); if (j1 < 0) break; j0 = j1; j1 = j2; j2 = j3; }
    int j0 = sg_pop(uLo, uHi), j1 = sg_pop(uLo, uHi), j2 = sg_pop(uLo, uHi);
    SG_LOAD(kb0, vb0, j0); { const int j1c = j1 < 0 ? 0 : j1, j2c = j2 < 0 ? 0 : j2; SG_LOAD(kb1, vb1, j1c); SG_LOAD(kb2, vb2, j2c); }
    for (;;) {
        SG_STEP(kb0, vb0, kb3, vb3)
        SG_STEP(kb1, vb1, kb0, vb0)
        SG_STEP(kb2, vb2, kb1, vb1)
        SG_STEP(kb3, vb3, kb2, vb2)
    }
#undef SG_LOAD
#undef SG_STEP
}

DI void attn_phase(PP pp, LAS unsigned char* lds, bool do_store) {
    PPOPAQ();
    int tid = threadIdx.x; asm volatile("" : "+v"(tid));
    const int lane = tid & 63, wave = __builtin_amdgcn_readfirstlane(tid >> 6);
    const int G_ = opaque_s((int)gridDim.x), bx_ = opaque_s((int)blockIdx.x);
    const int gw = bx_ * 8 + wave, NGW = G_ * 8, gtid = bx_ * 512 + tid, NT = G_ * 512;
    (void)lane; (void)wave; (void)gw; (void)NGW; (void)gtid; (void)NT;
    unsigned char* ws = pp->ws; bf16_t* PROJ = (bf16_t*)(ws + WS_PROJ);
    const int n = lane & 31, hh = lane >> 5, G = G_;
    for (int it = 0; it < 4; ++it) {
        int tb, bg;
        if (G == 256) { const int kx = bx_ >> 3; bg = bx_ & 7; tb = 127 - (it * 32 + ((it & 1) ? 31 - kx : kx)); }
        else { const int cc = (it & 1) ? (G - 1 - bx_) : bx_; const int rho = it * G + cc; if (rho >= 1024) continue; tb = 127 - (rho >> 3); bg = rho & 7; }
        const int b = bg >> 2, g = bg & 3;
        const int t0 = 64 * tb, tl = 8 * wave + (n >> 2), r = n & 3, t = t0 + tl;
        const size_t trow = (size_t)b * S_ + t;
        bf16_t* qptr = PROJ + trow * LDP + C_Q + (4 * g + r) * 64;
        bf16x8 qf[4];
#pragma unroll
        for (int ks = 0; ks < 4; ++ks) qf[ks] = *(const bf16x8*)(qptr + ks * 16 + 8 * hh);
        f32x16 o[2];
        LAS float* OT = (LAS float*)(lds + L_OT) + wave * 2048 + lane;
        for (int i = tid; i < 64 * IMPSTR; i += 512) ((LAS float*)(lds + L_IMP))[i] = 0.f;
        {
            TileSrc src{(const bf16_t*)(ws + WS_KCMP) + (size_t)bg * 512 * 64, 64, (const bf16_t*)(ws + WS_VTCMP) + (size_t)bg * 64 * 512, 512};
            int nvalid = (t0 + 32) / 16 + 1; if (nvalid > 511) nvalid = 511;
            const int j1 = (nvalid - 1) >> 6;
            float m = -__builtin_inff(), l = 0.f;
            attn_loop<0>(lds, src, 0, j1, qf, o, m, l, tl, t, tb, 0ull, 0ull, tid, wave, lane);
            l += shx(l, 32, lane);
            float inv = 1.0f / fmaxf(l, 1e-30f);
#pragma unroll
            for (int ds = 0; ds < 2; ++ds)
#pragma unroll
                for (int e = 0; e < 16; ++e) o[ds][e] = 0.f;
            attn_loop<1>(lds, src, 0, j1, qf, o, m, inv, tl, t, tb, 0ull, 0ull, tid, wave, lane);
#pragma unroll
            for (int ds = 0; ds < 2; ++ds)
#pragma unroll
                for (int e = 0; e < 16; ++e) OT[(ds * 16 + e) * 64] = o[ds][e];
        }
        {
            const int tok = tid >> 3, prt = tid & 7;
            unsigned mk[4] = {0u, 0u, 0u, 0u};
            if (tb < 16) { mk[0] = (tb == 31) ? 0xffffffffu : ((2u << tb) - 1u); }
            else {
                const LAS float* imp = (const LAS float*)(lds + L_IMP) + tok * IMPSTR + 16 * prt;
                unsigned keys[16];
#pragma unroll
                for (int e = 0; e < 16; ++e) { const int j = 16 * prt + e; const unsigned bits = __builtin_bit_cast(unsigned, imp[e]);
                    keys[e] = (j >= 1 && j <= tb - 1) ? ((bits & 0xffffff80u) | (unsigned)(127 - j)) : 0u; }
                mk[0] = 1u; mk[tb >> 5] |= 1u << (tb & 31);
                for (int round = 0; round < 14; ++round) {
                    unsigned best = keys[0];
#pragma unroll
                    for (int e = 1; e < 16; ++e) best = keys[e] > best ? keys[e] : best;
#pragma unroll
                    for (int o2 = 1; o2 < 8; o2 <<= 1) { const unsigned other = (unsigned)__builtin_amdgcn_ds_bpermute((lane ^ o2) << 2, (int)best); best = other > best ? other : best; }
                    if (best != 0u) { const int jw = 127 - (int)(best & 127u);
                        mk[0] |= (jw < 32) ? (1u << (jw & 31)) : 0u; mk[1] |= (jw >= 32 && jw < 64) ? (1u << (jw & 31)) : 0u;
                        mk[2] |= (jw >= 64 && jw < 96) ? (1u << (jw & 31)) : 0u; mk[3] |= (jw >= 96) ? (1u << (jw & 31)) : 0u; }
#pragma unroll
                    for (int e = 0; e < 16; ++e) if (keys[e] == best) keys[e] = 0u;
                }
            }
            if (prt == 0) { LAS unsigned* sm = (LAS unsigned*)(lds + L_SEL) + tok * 4; sm[0] = mk[0]; sm[1] = mk[1]; sm[2] = mk[2]; sm[3] = mk[3]; }
            __syncthreads();
        }
        {
            TileSrc src{PROJ + (size_t)b * S_ * LDP + C_KW + g * 64, LDP, (const bf16_t*)(ws + WS_VTW) + (size_t)bg * 64 * S_, S_};
            float m = -__builtin_inff(), l = 0.f;
#pragma unroll
            for (int ds = 0; ds < 2; ++ds)
#pragma unroll
                for (int e = 0; e < 16; ++e) o[ds][e] = 0.f;
            attn_loop<3>(lds, src, tb >= 8 ? tb - 8 : 0, tb, qf, o, m, l, tl, t, tb, 0ull, 0ull, tid, wave, lane);
            l += shx(l, 32, lane);
            const float f = sigmoidf_(bf2f(PROJ[((size_t)b * S_ + t) * LDP + C_GN + g * 12 + r * 3 + 2])) / (sigmoidf_(bf2f(PROJ[((size_t)b * S_ + t) * LDP + C_GN + g * 12 + r * 3])) * fmaxf(l, 1e-30f));
#pragma unroll
            for (int ds = 0; ds < 2; ++ds)
#pragma unroll
                for (int e = 0; e < 16; ++e) OT[(ds * 16 + e) * 64] += f * o[ds][e];
        }
        __syncthreads();
        {
            u64 uLo = 0ull, uHi = 0ull;
            { const LAS unsigned* sm = (const LAS unsigned*)(lds + L_SEL) + 8 * wave * 4;
#pragma unroll
              for (int i = 0; i < 8; ++i) { uLo |= (u64)sm[4 * i] | ((u64)sm[4 * i + 1] << 32); uHi |= (u64)sm[4 * i + 2] | ((u64)sm[4 * i + 3] << 32); } }
            uLo = ((u64)(unsigned)__builtin_amdgcn_readfirstlane((int)(unsigned)(uLo >> 32)) << 32) | (unsigned)__builtin_amdgcn_readfirstlane((int)(unsigned)uLo);
            uHi = ((u64)(unsigned)__builtin_amdgcn_readfirstlane((int)(unsigned)(uHi >> 32)) << 32) | (unsigned)__builtin_amdgcn_readfirstlane((int)(unsigned)uHi);
            u64 tmLo, tmHi;
            { const LAS unsigned* sm = (const LAS unsigned*)(lds + L_SEL) + (8 * wave + (lane & 7)) * 4; tmLo = (u64)sm[0] | ((u64)sm[1] << 32); tmHi = (u64)sm[2] | ((u64)sm[3] << 32); }
            LAS unsigned char* OSw = lds + wave * (32 * OSSTR); LAS unsigned char* Q8w = lds + L_Q8 + wave * 2048; LAS float* MLw = (LAS float*)(lds + L_ML) + wave * 64;
            for (int i = lane; i < 32 * OSSTR / 4; i += 64) ((LAS float*)OSw)[i] = 0.f;
            MLw[lane] = (lane < 32) ? -__builtin_inff() : 0.f;
#pragma unroll
            for (int ks = 0; ks < 4; ++ks) { const u32x4 w = __builtin_bit_cast(u32x4, qf[ks]);
                *(LAS long*)(Q8w + n * 64 + 16 * ks + 8 * hh) = mk64(pk4_fp8(bflo(w.x), bfhi(w.x), bflo(w.y), bfhi(w.y)), pk4_fp8(bflo(w.z), bfhi(w.z), bflo(w.w), bfhi(w.w))); }
            sel_gather((const unsigned char*)(ws + WS_KF) + (size_t)bg * 128 * 4096, (const unsigned char*)(ws + WS_VTS) + (size_t)bg * 128 * 4096, uLo, uHi, OSw, Q8w, MLw, tmLo, tmHi, tb, wave, lane);
        }
        if (do_store) {
            int ln2 = lane; asm volatile("" : "+v"(ln2));
            const int n2 = ln2 & 31, h2 = ln2 >> 5, t2 = t0 + 8 * wave + (n2 >> 2), r2 = n2 & 3;
            bf16_t* rowp = PROJ + ((size_t)b * S_ + t2) * LDP;
            const float gcv = sigmoidf_(bf2f(rowp[C_GN + g * 12 + r2 * 3]));
            const LAS float* MLw = (const LAS float*)(lds + L_ML) + wave * 64;
            const float fsel = sigmoidf_(bf2f(rowp[C_GN + g * 12 + r2 * 3 + 1])) / fmaxf(MLw[32 + n2], 1e-30f);
            const LAS unsigned char* OSr = lds + wave * (32 * OSSTR) + n2 * OSSTR;
            bf16_t* op = rowp + C_Q + (4 * g + r2) * 64 + 4 * h2;
#pragma unroll
            for (int ds = 0; ds < 2; ++ds)
#pragma unroll
                for (int gi = 0; gi < 4; ++gi) { const f32x4v os = *(const LAS f32x4v*)(OSr + (32 * ds + 8 * gi + 4 * h2) * 4);
                    u32x2 w; w.x = pk2(gcv * OT[(ds * 16 + 4 * gi) * 64] + fsel * os[0], gcv * OT[(ds * 16 + 4 * gi + 1) * 64] + fsel * os[1]);
                    w.y = pk2(gcv * OT[(ds * 16 + 4 * gi + 2) * 64] + fsel * os[2], gcv * OT[(ds * 16 + 4 * gi + 3) * 64] + fsel * os[3]);
                    *(u32x2*)(op + 32 * ds + 8 * gi) = w; }
        }
        __syncthreads();
    }
}

__global__ void __launch_bounds__(512, 2) fwd_megakernel(Params p) {
    extern __shared__ __attribute__((aligned(16))) unsigned char lds_raw[];
    LAS unsigned char* lds = (LAS unsigned char*)lds_raw;
    cg::grid_group grid = cg::this_grid();
    const int G = gridDim.x, bx = blockIdx.x;
    PP pp = (PP)__builtin_amdgcn_kernarg_segment_ptr();
    volatile LAS unsigned* barst = (volatile LAS unsigned*)(lds + L_BARST);
    if (threadIdx.x == 0) { barst[0] = 0u; barst[1] = 0u; (void)xb_add((unsigned*)(pp->ws + WS_BAR) + XB_XCNT(xb_xcc_id()), 1u); }
    __syncthreads();
#define GSYNC() xcd_barrier((unsigned*)(ws + WS_BAR), barst)
#define ws (pp->ws)
#define PROJ ((bf16_t*)(ws + WS_PROJ))
#define H ((bf16_t*)(ws + WS_H))
#define XC ((bf16_t*)(ws + WS_XC))
#define Y ((float*)(ws + WS_RI))
    const int BIG = 1 << 30;

#ifndef NO_PREP
    prep_phase(pp, 0, lds);
#endif
#ifndef NO_ROW
    row_phase(pp->x, nullptr, nullptr, nullptr, pp->ln_mix_pre, H);
#endif
    grid.sync();

    for (int l = 0; l < NLAYER; ++l) {
        PPOPAQ();
        using pg8::Gemm; using pg8::Sched; using pg8::EpiBf16; using pg8::EpiF32; using pg8::EpiMerge;
        cbias_phase(pp, l);
#ifndef NO_G1
        for (int r_ = 0; r_ < opaque_s(GREP); ++r_) {
        pg8::gemm_phase<EpiBf16>(lds, Gemm{H, (const bf16_t*)(ws + WS_WIN), 1024, 1024, 1024, 128, 128},
            Sched{64, 35, opaque_s(G), opaque_s(bx), 0, BIG, 0u, 256u * 1024 * 2, 0u, 0u, 256u * 1024 * 2, 0u}, EpiBf16{PROJ, LDP, 0, 1.0f, nullptr, 0});
        pg8::gemm_phase<EpiBf16>(lds, Gemm{(const bf16_t*)(ws + WS_MEMN), (const bf16_t*)(ws + WS_WMKV), 1024, 1024, 1024, 128, 128},
            Sched{2, 4, opaque_s(G), (opaque_s(bx) + 64) % opaque_s(G), 0, BIG, 0u, 256u * 1024 * 2, 0u, 0u, 256u * 1024 * 2, 0u}, EpiBf16{(bf16_t*)(ws + WS_KMEM), 1024, 0, 1.0f, nullptr, 0});
        pg8::gemm_phase<EpiBf16>(lds, Gemm{(const bf16_t*)(ws + WS_WMKV) + (size_t)1024 * 1024, (const bf16_t*)(ws + WS_MEMN), 1024, 1024, 1024, 128, 128},
            Sched{4, 2, opaque_s(G), (opaque_s(bx) + 48) % opaque_s(G), 0, BIG, 0u, 256u * 1024 * 2, 0u, 0u, 256u * 1024 * 2, 0u}, EpiBf16{(bf16_t*)(ws + WS_VTMEM), 512, 0, 1.0f, nullptr, 0});
        }
#endif
        GSYNC();
#ifndef NO_POST
        postproj_phase(pp, l);
#endif
#ifndef NO_G1
        if (opaque_s(G) == 256) {
        pg8::gemm_phase<EpiBf16>(lds, Gemm{PROJ, (const bf16_t*)(ws + WS_WC1), 16 * LDP, 2048, 2048, LDP * 2, 128},
            Sched{32, 1, opaque_s(G), opaque_s(bx), 1, BIG, 0u, 0u, 0u, 0u, 0u, 0u}, EpiBf16{(bf16_t*)(ws + WS_HID), 256, 2, 1.0f, (const float*)(ws + WS_CBIAS), 0});
        }
#endif
        GSYNC();
#ifndef NO_G1
        for (int r_ = 0; r_ < opaque_s(GREP); ++r_) {
        if (opaque_s(G) != 256) {
        pg8::gemm_phase<EpiBf16>(lds, Gemm{PROJ, (const bf16_t*)(ws + WS_WC1), 16 * LDP, 2048, 2048, LDP * 2, 128},
            Sched{32, 1, opaque_s(G), opaque_s(bx), 1, BIG, 0u, 0u, 0u, 0u, 0u, 0u}, EpiBf16{(bf16_t*)(ws + WS_HID), 256, 2, 1.0f, (const float*)(ws + WS_CBIAS), 0});
        }
        const int G224 = opaque_s(G), c224 = opaque_s(bx);
        pg8::gemm_phase<EpiBf16>(lds, Gemm{XC, (const bf16_t*)(ws + WS_WLRU), 1024, 128, 128, 128, 128},
            Sched{64, 8, G224, c224, 0, BIG, 0u, 256u * 1024 * 2, 128u * 2, 0u, 256u * 128 * 2, 0u}, EpiBf16{(bf16_t*)(ws + WS_RI), 2048, 0, 1.0f, nullptr, 0});
        pg8::gemm_phase<EpiBf16>(lds, Gemm{PROJ, (const bf16_t*)(ws + WS_KMEM), LDP, 1024, 256, 128, 128},
            Sched{64, 4, G224, c224, 0, 32, (unsigned)C_QM * 2, 256u * LDP * 2, 256u * 2, 0u, 256u * 2, 256u * 1024 * 2}, EpiBf16{H, 1024, 0, 0.0625f * LOG2E, nullptr, 0});
        }
#endif
        GSYNC();
#ifndef NO_SCAN
        scan_phase(pp, l, 0);
#if defined(DUP_SCAN0)
        scan_phase(pp, l, 0);
#endif
#endif
#ifndef NO_MSM
        memsoftmax_phase(pp);
#endif
#ifndef NO_G2
        for (int r_ = 0; r_ < opaque_s(GREP); ++r_) {
        pg8::gemm_phase<EpiF32>(lds, Gemm{(const bf16_t*)(ws + WS_HID), (const bf16_t*)(ws + WS_WC2), 256, 256, 256, 128, 128},
            Sched{32, 1, opaque_s(G), (opaque_s(bx) + 96) % opaque_s(G), 0, 16, 0u, 256u * 256 * 2, 0u, 0u, 0u, 256u * 256 * 2}, EpiF32{(float*)(ws + WS_CRAW), 64, 64});
        }
#endif
        GSYNC();
#ifndef NO_SCAN
        scan_phase(pp, l, 1);
#endif
#ifndef NO_CMPF
        cmpfinal_phase(pp);
#endif
#ifndef NO_G1
        for (int r_ = 0; r_ < opaque_s(GREP); ++r_) {
        pg8::gemm_phase<EpiBf16>(lds, Gemm{H, (const bf16_t*)(ws + WS_VTMEM), 1024, 512, 256, 128, 128},
            Sched{64, 4, opaque_s(G), opaque_s(bx), 0, 32, 0u, 256u * 1024 * 2, 256u * 2, 0u, 256u * 512 * 2, 256u * 2}, EpiBf16{PROJ, LDP, 0, 1.0f, nullptr, C_QM});
        }
#endif
        GSYNC();
#ifndef NO_ATT
#if defined(DUP_ATT)
        attn_phase(pp, lds, opaque_s(0) != 0);
        __syncthreads();
#endif
        attn_phase(pp, lds, true);
#endif
        GSYNC();
#ifndef NO_G3
        for (int r_ = 0; r_ < opaque_s(GREP); ++r_) {
        pg8::gemm_phase<EpiMerge>(lds, Gemm{XC, (const bf16_t*)(ws + WS_WBRA), 1024, 1024, 1024, 128, 128},
            Sched{64, 4, opaque_s(G), opaque_s(bx), 0, BIG, 0u, 256u * 1024 * 2, 0u, 0u, 256u * 1024 * 2, 0u}, EpiMerge{PROJ + C_GM, LDP, Y, H, 0});
        pg8::gemm_phase<EpiMerge>(lds, Gemm{PROJ + C_Q, (const bf16_t*)(ws + WS_WBRB), LDP, 1024, 1024, 128, 128},
            Sched{64, 4, opaque_s(G), opaque_s(bx), 0, BIG, 0u, 256u * LDP * 2, 0u, 0u, 256u * 1024 * 2, 0u}, EpiMerge{PROJ + C_GM + 1024, LDP, Y, H, 1});
        pg8::gemm_phase<EpiMerge>(lds, Gemm{PROJ + C_QM, (const bf16_t*)(ws + WS_WBRC), LDP, 1024, 1024, 128, 128},
            Sched{64, 4, opaque_s(G), opaque_s(bx), 0, BIG, 0u, 256u * LDP * 2, 0u, 0u, 256u * 1024 * 2, 0u}, EpiMerge{PROJ + C_GM + 2048, LDP, Y, H, 2});
        }
#endif
        GSYNC();
#ifndef NO_G2
        for (int r_ = 0; r_ < opaque_s(GREP); ++r_) {
        pg8::gemm_phase<EpiF32>(lds, Gemm{H, (const bf16_t*)(ws + WS_WOUT), 1024, 1024, 1024, 128, 128},
            Sched{64, 4, opaque_s(G), opaque_s(bx), 0, BIG, 0u, 256u * 1024 * 2, 0u, 0u, 256u * 1024 * 2, 0u}, EpiF32{Y, 1024, 1024});
        }
#endif
        GSYNC();
#ifndef NO_ROW
        row_phase((l == 0) ? pp->x : pp->out, Y, pp->ln_mix_post + (size_t)l * 1024, pp->out, pp->ln_mlp_pre + (size_t)l * 1024, H);
#endif
        GSYNC();
#ifndef NO_G1
        for (int r_ = 0; r_ < opaque_s(GREP); ++r_) {
        pg8::gemm_phase<EpiBf16>(lds, Gemm{H, (const bf16_t*)(ws + WS_WM1), 1024, 1024, 1024, 128, 128},
            Sched{64, 16, opaque_s(G), opaque_s(bx), 0, BIG, 0u, 256u * 1024 * 2, 0u, 0u, 256u * 1024 * 2, 0u}, EpiBf16{PROJ, FF_, 1, 1.0f, nullptr, 0});
        }
#endif
        GSYNC();
#ifndef NO_G2
        for (int r_ = 0; r_ < opaque_s(GREP); ++r_) {
        pg8::gemm_phase<EpiF32>(lds, Gemm{PROJ, (const bf16_t*)(ws + WS_WM2), FF_, FF_, FF_, 128, 128},
            Sched{64, 4, opaque_s(G), opaque_s(bx), 0, BIG, 0u, 256u * FF_ * 2, 0u, 0u, 256u * FF_ * 2, 0u}, EpiF32{Y, 1024, 1024});
        }
#endif
        GSYNC();
#ifndef NO_ROW
        row_phase(pp->out, Y, pp->ln_mlp_post + (size_t)l * 1024, pp->out, (l + 1 < NLAYER) ? pp->ln_mix_pre + (size_t)(l + 1) * 1024 : nullptr, (l + 1 < NLAYER) ? H : nullptr);
#endif
#ifndef NO_PREP
        if (l + 1 < NLAYER) prep_phase(pp, l + 1, lds);
#if defined(DUP_PREP)
        if (l + 1 < NLAYER) prep_phase(pp, l + 1, lds);
#endif
#endif
        GSYNC();
    }
#undef ws
#undef PROJ
#undef H
#undef XC
#undef Y
}

extern "C" void kernel_launch(void* const* d_in, const int* in_sizes, int n_in, void* d_out, int out_size, void* d_ws, size_t ws_size, hipStream_t stream) {
    static int grid = 0;
    if (grid == 0) {
        int dev = 0, cus = 0, per_cu = 0;
        hipGetDevice(&dev); hipDeviceGetAttribute(&cus, hipDeviceAttributeMultiprocessorCount, dev);
        hipFuncSetAttribute((const void*)fwd_megakernel, hipFuncAttributeMaxDynamicSharedMemorySize, LDS_BYTES);
        hipOccupancyMaxActiveBlocksPerMultiprocessor(&per_cu, (const void*)fwd_megakernel, 512, LDS_BYTES);
        if (per_cu < 1) per_cu = 1;
        (void)hipGetLastError();
        grid = cus * 1;
        if (ws_size < WS_END) { fprintf(stderr, "kernel_launch: workspace too small (%zu < %zu)\n", ws_size, (size_t)WS_END); grid = -1; }
    }
    if (grid < 0) return;
    Params p{};
    p.x = (const float*)d_in[0]; p.mem = (const float*)d_in[1]; p.pos = (const int*)d_in[2];
    p.ln_mix_pre = (const float*)d_in[3]; p.w_in = (const float*)d_in[4]; p.conv_w = (const float*)d_in[5]; p.conv_b = (const float*)d_in[6];
    p.lru_wr = (const float*)d_in[7]; p.lru_br = (const float*)d_in[8]; p.lru_wi = (const float*)d_in[9]; p.lru_bi = (const float*)d_in[10]; p.lru_lambda = (const float*)d_in[11];
    p.cmp_pe = (const float*)d_in[12]; p.cmp_w1 = (const float*)d_in[13]; p.cmp_b1 = (const float*)d_in[14]; p.cmp_w2 = (const float*)d_in[15];
    p.ln_mem = (const float*)d_in[16]; p.w_mem_kv = (const float*)d_in[17]; p.w_br_rnn = (const float*)d_in[18]; p.w_br_nsa = (const float*)d_in[19]; p.w_br_mem = (const float*)d_in[20]; p.w_out = (const float*)d_in[21];
    p.ln_mix_post = (const float*)d_in[22]; p.ln_mlp_pre = (const float*)d_in[23]; p.mlp_w1 = (const float*)d_in[24]; p.mlp_w2 = (const float*)d_in[25]; p.ln_mlp_post = (const float*)d_in[26];
    p.out = (float*)d_out; p.ws = (unsigned char*)d_ws;
    (void)hipMemsetAsync((unsigned char*)d_ws + WS_BAR, 0, 16384, stream);
    void* args[] = {&p};
    hipError_t e = hipLaunchCooperativeKernel((const void*)fwd_megakernel, dim3(grid), dim3(512), args, LDS_BYTES, stream);
    if (e != hipSuccess) fprintf(stderr, "cooperative launch failed: %s (grid %d)\n", hipGetErrorString(e), grid);
}
```

```cpp
#include <hip/hip_runtime.h>
#include <hip/hip_cooperative_groups.h>
#include <cstdint>
#include <cstdio>
namespace cg = cooperative_groups;

#define LAS __attribute__((address_space(3)))
#define DI __device__ __forceinline__
typedef unsigned short bf16_t;
typedef short bf16x8 __attribute__((ext_vector_type(8)));
typedef short s16x4 __attribute__((ext_vector_type(4)));
typedef float f32x4 __attribute__((ext_vector_type(4)));
typedef float f32x16 __attribute__((ext_vector_type(16)));
typedef float f32x2 __attribute__((ext_vector_type(2)));
typedef unsigned u32x4 __attribute__((ext_vector_type(4)));
typedef unsigned u32x2 __attribute__((ext_vector_type(2)));
typedef __bf16 bf16x2v __attribute__((ext_vector_type(2)));
typedef unsigned long long u64;

constexpr int T_ = 16384, S_ = 8192, D_ = 1024, FF_ = 4096, LDP = 8960, NLAYER = 4;
constexpr int C_XR = 0, C_YR = 1024, C_Q = 2048, C_KC = 3072, C_VC = 3328, C_KS = 3584, C_VS = 3840, C_KW = 4096, C_VW = 4352,
              C_QM = 4608, C_GM = 5632, C_GN = 8704;
constexpr float EPS = 1e-6f;
constexpr float LOG2E = 1.4426950408889634f;

constexpr size_t al256(size_t x) { return (x + 255) & ~(size_t)255; }
constexpr size_t WS_PROJ = 0;
constexpr size_t WS_WIN = al256(WS_PROJ + (size_t)(T_ + 64) * LDP * 2);
constexpr size_t WS_WMKV = WS_WIN + (size_t)LDP * 1024 * 2;
constexpr size_t WS_WBRA = WS_WMKV + (size_t)2048 * 1024 * 2;
constexpr size_t WS_WBRB = WS_WBRA + (size_t)1024 * 1024 * 2;
constexpr size_t WS_WBRC = WS_WBRB + (size_t)1024 * 1024 * 2;
constexpr size_t WS_WOUT = WS_WBRC + (size_t)1024 * 1024 * 2;
constexpr size_t WS_WM1 = WS_WOUT + (size_t)1024 * 1024 * 2;
constexpr size_t WS_WM2 = WS_WM1 + (size_t)4096 * 1024 * 2;
constexpr size_t WS_WC1 = WS_WM2 + (size_t)4096 * 1024 * 2;
constexpr size_t WS_WC2 = WS_WC1 + (size_t)2 * 256 * 2048 * 2;
constexpr size_t WS_WLRU = WS_WC2 + (size_t)2 * 256 * 256 * 2;
constexpr size_t WS_H = WS_WLRU + (size_t)2048 * 128 * 2;
constexpr size_t WS_VTS = WS_H + (size_t)T_ * 1024 * 2;
constexpr size_t WS_VTW = WS_VTS + (size_t)8 * 64 * S_ * 2;
constexpr size_t WS_XC = WS_VTW + (size_t)8 * 64 * S_ * 2;
constexpr size_t WS_RI = WS_XC + (size_t)T_ * 1024 * 2;
constexpr size_t WS_HID = WS_RI + (size_t)T_ * 2048 * 2;
constexpr size_t WS_CRAW = WS_HID + (size_t)8192 * 256 * 2;
constexpr size_t WS_KCMP = WS_CRAW + (size_t)8192 * 64 * 4;
constexpr size_t WS_VTCMP = WS_KCMP + (size_t)8 * 512 * 64 * 2;
constexpr size_t WS_MEMN = WS_VTCMP + (size_t)8 * 512 * 64 * 2;
constexpr size_t WS_KMEM = WS_MEMN + (size_t)512 * 1024 * 2;
constexpr size_t WS_VTMEM = WS_KMEM + (size_t)512 * 1024 * 2;
constexpr size_t WS_SCA = WS_VTMEM + (size_t)512 * 1024 * 2;
constexpr size_t WS_SCH = WS_SCA + (size_t)2 * 128 * 1024 * 4;
constexpr size_t WS_CBP = WS_SCH + (size_t)2 * 128 * 1024 * 4;
constexpr size_t WS_CBIAS = WS_CBP + (size_t)16 * 512 * 4;
constexpr size_t WS_KF = al256(WS_CBIAS + 512 * 4);
constexpr size_t WS_BAR = WS_KF + (size_t)8 * 64 * S_ * 2;
constexpr size_t WS_END = WS_BAR + 16384;
constexpr int L_BARST = 155584;

#ifndef GREP
#define GREP 1
#endif
constexpr int LDS_BYTES = 155648;

DI unsigned f2bf(float f) { unsigned u = __builtin_bit_cast(unsigned, f); return (u + 0x7fffu + ((u >> 16) & 1u)) >> 16; }
DI unsigned pk2(float lo, float hi) { f32x2 f = {lo, hi}; bf16x2v r = __builtin_convertvector(f, bf16x2v); return __builtin_bit_cast(unsigned, r); }
DI float bf2f(unsigned short b) { return __builtin_bit_cast(float, (unsigned)b << 16); }
DI float bflo(unsigned w) { return __builtin_bit_cast(float, w << 16); }
DI float bfhi(unsigned w) { return __builtin_bit_cast(float, w & 0xffff0000u); }
DI float fexp2(float x) { return __builtin_amdgcn_exp2f(x); }
DI float sigmoidf_(float x) { return __builtin_amdgcn_rcpf(1.0f + fexp2(-x * LOG2E)); }
DI float gelu_tanh(float x) { const float z = 0.7978845608028654f * (x + 0.044715f * x * x * x); return x * __builtin_amdgcn_rcpf(1.0f + fexp2(-2.0f * LOG2E * z)); }
DI float shx(float v, int mask, int lane) { return __builtin_bit_cast(float, __builtin_amdgcn_ds_bpermute((lane ^ mask) << 2, __builtin_bit_cast(int, v))); }
DI u64 shx64(u64 v, int mask, int lane) { const int a = (lane ^ mask) << 2; const unsigned lo = (unsigned)__builtin_amdgcn_ds_bpermute(a, (int)(unsigned)v), hi = (unsigned)__builtin_amdgcn_ds_bpermute(a, (int)(unsigned)(v >> 32)); return ((u64)hi << 32) | lo; }
DI unsigned pk4_fp8(float a, float b, float c, float d) { int w = 0; w = __builtin_amdgcn_cvt_pk_fp8_f32(a, b, w, false); w = __builtin_amdgcn_cvt_pk_fp8_f32(c, d, w, true); return (unsigned)w; }
DI long mk64(unsigned lo, unsigned hi) { return (long)(((u64)hi << 32) | (u64)lo); }
DI int opaque_s(int v) { asm volatile("" : "+s"(v)); return v; }
DI float wave_sum(float v, int lane) {
#pragma unroll
    for (int o = 1; o < 64; o <<= 1) v += shx(v, o, lane);
    return v;
}

namespace pg8 {
constexpr int BM = 256, BK = 64, HALF = 128, HTB = HALF * BK * 2, STAGE_BYTES = 8 * HTB, NXCD = 8, WGM = 4;
__host__ __device__ __forceinline__ int lds_byte(int r, int c) { const int st = (r >> 4) * 2 + (c >> 5), rr = r & 15, cc = c & 31, ob = rr * 64 + cc * 2; return st * 1024 + (ob ^ (((ob >> 9) & 1) << 5)); }
__host__ __device__ __forceinline__ void stage_rc(int b, int& R, int& C) { const int st = b / 1024, sb = b % 1024, swz = sb ^ (((sb >> 9) & 1) << 5); R = (st >> 1) * 16 + swz / 64; C = (st & 1) * 32 + (swz % 64) / 2; }
__host__ __device__ __forceinline__ int perm32(int rho) { const int n = rho >> 4, i = rho & 15; return 8 * (i >> 2) + 4 * n + (i & 3); }

struct Unit { int pm, pn; unsigned aoff, boff; };
struct Gemm { const bf16_t* A; const bf16_t* Bt; int lda, ldb, K, kstepA, kstepB; };

struct Sched {
    int nM, nN, G, c, kind, mdiv; unsigned a0, sAm, sAn, b0, sBn, sBb;
    DI bool next(int i, Unit& u) const {
        const long L = (long)i * G + c; const int nwg = nM * nN; if (L >= nwg) return false;
        int wgid = (int)L; { const int q = nwg / NXCD, r = nwg % NXCD, xcd = wgid % NXCD, off = wgid / NXCD; wgid = (xcd < r ? xcd * (q + 1) : r * (q + 1) + (xcd - r) * q) + off; }
        const int nig = WGM * nN, gid = wgid / nig, fm = gid * WGM, gsz = (nM - fm) < WGM ? (nM - fm) : WGM;
        const int pm = fm + ((wgid % nig) % gsz), pn = (wgid % nig) / gsz;
        u.pm = pm; u.pn = pn;
        if (kind == 1) {
            const int j = pm >> 4, b = (pm >> 3) & 1, g = (pm >> 1) & 3, ch = pm & 1;
            u.aoff = (unsigned)(((b * S_ + ch * 4096) * LDP + C_KC + j * 256 + g * 64) * 2); u.boff = (unsigned)(j * 256 * 2048 * 2);
        } else { const unsigned bb = (unsigned)(pm / mdiv); u.aoff = a0 + (unsigned)pm * sAm + (unsigned)pn * sAn; u.boff = b0 + (unsigned)pn * sBn + bb * sBb; }
        return true;
    }
};

DI unsigned cvt_pk_bf16(float lo, float hi) { return pk2(lo, hi); }

struct EpiBf16 {
    static constexpr bool PERM = true;
    bf16_t* O; int ldc; int act; float scale; const float* bias; int oc0;
    DI void operator()(const f32x4 (&acc)[2][2][4][2], const Unit& u, int wr, int wc, int fr, int fq) const {
        const int row0 = u.pm * 256 + wr * 64 + fr, col0 = oc0 + u.pn * 256 + wc * 32 + 8 * fq, bc0 = (u.pm >> 4) * 256 + wc * 32 + 8 * fq;
#pragma unroll
        for (int ai = 0; ai < 2; ++ai)
#pragma unroll
            for (int m = 0; m < 4; ++m) { bf16_t* rowp = O + (size_t)(row0 + ai * HALF + m * 16) * ldc + col0;
#pragma unroll
                for (int bj = 0; bj < 2; ++bj) { f32x4 v0 = acc[ai][bj][m][0], v1 = acc[ai][bj][m][1];
                    if (act == 0) { v0 = v0 * scale; v1 = v1 * scale; }
                    else if (act == 1) {
#pragma unroll
                        for (int e = 0; e < 4; ++e) { const float a = fmaxf(v0[e], 0.f), b = fmaxf(v1[e], 0.f); v0[e] = a * a; v1[e] = b * b; } }
                    else { const f32x4 b0 = *(const f32x4*)(bias + bc0 + bj * HALF), b1 = *(const f32x4*)(bias + bc0 + bj * HALF + 4);
#pragma unroll
                        for (int e = 0; e < 4; ++e) { v0[e] = gelu_tanh(v0[e] + b0[e]); v1[e] = gelu_tanh(v1[e] + b1[e]); } }
                    u32x4 w; w.x = cvt_pk_bf16(v0[0], v0[1]); w.y = cvt_pk_bf16(v0[2], v0[3]); w.z = cvt_pk_bf16(v1[0], v1[1]); w.w = cvt_pk_bf16(v1[2], v1[3]);
                    *(u32x4*)(rowp + bj * HALF) = w; } }
    }
};
struct EpiF32 {
    static constexpr bool PERM = false;
    float* O; int ldc; int ncol;
    DI void operator()(const f32x4 (&acc)[2][2][4][2], const Unit& u, int wr, int wc, int fr, int fq) const {
        const int row0 = u.pm * 256 + wr * 64 + fr, col0 = u.pn * 256 + wc * 32 + 4 * fq;
#pragma unroll
        for (int ai = 0; ai < 2; ++ai)
#pragma unroll
            for (int m = 0; m < 4; ++m) { float* rowp = O + (size_t)(row0 + ai * HALF + m * 16) * ldc;
#pragma unroll
                for (int bj = 0; bj < 2; ++bj)
#pragma unroll
                    for (int n = 0; n < 2; ++n) { const int c = col0 + bj * HALF + n * 16; if (c < ncol) *(f32x4*)(rowp + c) = acc[ai][bj][m][n]; } }
    }
};
struct EpiMerge {
    static constexpr bool PERM = false;
    const bf16_t* gate; int ldg; float* M; bf16_t* Hout; int mode;
    DI void operator()(const f32x4 (&acc)[2][2][4][2], const Unit& u, int wr, int wc, int fr, int fq) const {
        const int row0 = u.pm * 256 + wr * 64 + fr, col0 = u.pn * 256 + wc * 32 + 4 * fq;
#pragma unroll
        for (int ai = 0; ai < 2; ++ai)
#pragma unroll
            for (int m = 0; m < 4; ++m) { const size_t r = (size_t)(row0 + ai * HALF + m * 16);
#pragma unroll
                for (int bj = 0; bj < 2; ++bj)
#pragma unroll
                    for (int n = 0; n < 2; ++n) { const int c = col0 + bj * HALF + n * 16;
                        const u32x2 gw = *(const u32x2*)(gate + r * ldg + c);
                        f32x4 g; g[0] = sigmoidf_(bflo(gw.x)); g[1] = sigmoidf_(bfhi(gw.x)); g[2] = sigmoidf_(bflo(gw.y)); g[3] = sigmoidf_(bfhi(gw.y));
                        f32x4 v = acc[ai][bj][m][n] * g;
                        float* mp = M + r * 1024 + c;
                        if (mode != 0) v = v + *(const f32x4*)mp;
                        if (mode != 2) *(f32x4*)mp = v;
                        else { u32x2 w; w.x = cvt_pk_bf16(v[0], v[1]); w.y = cvt_pk_bf16(v[2], v[3]); *(u32x2*)(Hout + r * 1024 + c) = w; } } }
    }
};

template <class Epi>
DI void gemm_phase(LAS unsigned char* lds, const Gemm g, const Sched& S, const Epi& E) {
    int tid = threadIdx.x; asm volatile("" : "+v"(tid));
    const int wid = __builtin_amdgcn_readfirstlane(tid >> 6), lane = tid & 63, wr = wid >> 2, wc = wid & 3, fr = lane & 15, fq = lane >> 4;
    const int nt = opaque_s(g.K / BK);
    unsigned voffA[2], voffB[2];
#pragma unroll
    for (int i = 0; i < 2; ++i) { int R, C; stage_rc(tid * 16 + i * 8192, R, C); const int Rb = Epi::PERM ? ((R & ~31) + perm32(R & 31)) : R;
        voffA[i] = (unsigned)(R * g.lda + C) * 2u; voffB[i] = (unsigned)(Rb * g.ldb + C) * 2u; }
    const size_t kstepA = (size_t)g.kstepA, kstepB = (size_t)g.kstepB;
    const size_t hstepA = (size_t)HALF * g.lda * 2, hstepB = (size_t)HALF * g.ldb * 2;
    const unsigned ldsw = (unsigned)wid * 1024u;
    const int aoff = lds_byte(wr * 64 + fr, fq * 8), boff = lds_byte(wc * 32 + fr, fq * 8);
#define PG8_SA(b, h) (((b) * 2 + (h)) * HTB)
#define PG8_SB(b, h) ((4 + (b) * 2 + (h)) * HTB)
#define PG8_STAGE(bufoff, gbase, voff) do { _Pragma("unroll") for (int _i = 0; _i < 2; ++_i) \
        __builtin_amdgcn_global_load_lds((const unsigned*)((const char*)(gbase) + (voff)[_i]), (LAS unsigned*)(lds + (bufoff) + ldsw + _i * 8192), 16, 0, 0); } while (0)
#define PG8_LDA(dst, b, h) do { _Pragma("unroll") for (int m = 0; m < 4; ++m) _Pragma("unroll") for (int k = 0; k < 2; ++k) dst[m][k] = *(const LAS bf16x8*)(lds + PG8_SA(b, h) + aoff + m * 2048 + k * 1024); } while (0)
#define PG8_LDB(dst, b, h) do { _Pragma("unroll") for (int n = 0; n < 2; ++n) _Pragma("unroll") for (int k = 0; k < 2; ++k) dst[n][k] = *(const LAS bf16x8*)(lds + PG8_SB(b, h) + boff + n * 2048 + k * 1024); } while (0)
#define PG8_MMA(ai, bj, At, Bt) do { __builtin_amdgcn_s_setprio(1); _Pragma("unroll") for (int m = 0; m < 4; ++m) _Pragma("unroll") for (int n = 0; n < 2; ++n) _Pragma("unroll") for (int k = 0; k < 2; ++k) \
        acc[ai][bj][m][n] = __builtin_amdgcn_mfma_f32_16x16x32_bf16(Bt[n][k], At[m][k], acc[ai][bj][m][n], 0, 0, 0); __builtin_amdgcn_s_setprio(0); } while (0)
#define PG8_WAIT_V(n) asm volatile("s_waitcnt vmcnt(" #n ")" ::: "memory")
#define PG8_WAIT_L(n) asm volatile("s_waitcnt lgkmcnt(" #n ")" ::: "memory")
#define PG8_BAR __builtin_amdgcn_s_barrier()
#define PG8_SCHED __builtin_amdgcn_sched_barrier(0)
    Unit cur, nxt; int ui = 0;
    if (!S.next(0, cur)) return;
    f32x4 acc[2][2][4][2];
#pragma unroll
    for (int a = 0; a < 2; ++a)
#pragma unroll
        for (int b = 0; b < 2; ++b)
#pragma unroll
            for (int m = 0; m < 4; ++m)
#pragma unroll
                for (int n = 0; n < 2; ++n) acc[a][b][m][n] = (f32x4){0.f, 0.f, 0.f, 0.f};
    bf16x8 At[4][2], B0[2][2], B1[2][2];
    const char* cA = (const char*)g.A + cur.aoff; const char* cB = (const char*)g.Bt + cur.boff;
    PG8_STAGE(PG8_SB(0, 0), cB, voffB); PG8_STAGE(PG8_SB(0, 1), cB + hstepB, voffB); PG8_STAGE(PG8_SA(0, 0), cA, voffA); PG8_STAGE(PG8_SA(0, 1), cA + hstepA, voffA);
    if (wr == 1) PG8_BAR;
    PG8_WAIT_V(2); PG8_BAR;
    PG8_STAGE(PG8_SB(1, 0), cB + kstepB, voffB); PG8_STAGE(PG8_SA(1, 0), cA + kstepA, voffA); PG8_STAGE(PG8_SB(1, 1), cB + hstepB + kstepB, voffB);
    PG8_WAIT_V(6); PG8_BAR;
    for (;;) {
        const bool has_next = S.next(ui + 1, nxt);
        const char* nA = has_next ? (const char*)g.A + nxt.aoff : cA; const char* nB = has_next ? (const char*)g.Bt + nxt.boff : cB;
        for (int t = 0; t < nt; t += 2) {
            const bool last = (t == nt - 2);
            const char* a1 = cA + (size_t)(t + 1) * kstepA;
            const char* a2 = last ? nA : cA + (size_t)(t + 2) * kstepA; const char* b2 = last ? nB : cB + (size_t)(t + 2) * kstepB;
            const char* a3 = a2 + kstepA; const char* b3 = b2 + kstepB;
            PG8_LDB(B0, 0, 0); PG8_LDB(B1, 0, 1); PG8_SCHED; PG8_LDA(At, 0, 0); PG8_STAGE(PG8_SA(1, 1), a1 + hstepA, voffA);
            PG8_WAIT_V(8); PG8_WAIT_L(0); PG8_BAR; PG8_MMA(0, 0, At, B0); PG8_MMA(0, 1, At, B1); PG8_BAR; PG8_SCHED;
            PG8_LDA(At, 0, 1); PG8_STAGE(PG8_SB(0, 0), b2, voffB); PG8_STAGE(PG8_SB(0, 1), b2 + hstepB, voffB); PG8_STAGE(PG8_SA(0, 0), a2, voffA);
            PG8_WAIT_V(8); PG8_WAIT_L(0); PG8_BAR; PG8_MMA(1, 0, At, B0); PG8_MMA(1, 1, At, B1); PG8_BAR; PG8_SCHED;
            PG8_LDB(B0, 1, 0); PG8_LDB(B1, 1, 1); PG8_SCHED; PG8_LDA(At, 1, 0); PG8_STAGE(PG8_SA(0, 1), a2 + hstepA, voffA);
            PG8_WAIT_V(8); PG8_WAIT_L(0); PG8_BAR; PG8_MMA(0, 0, At, B0); PG8_MMA(0, 1, At, B1); PG8_BAR; PG8_SCHED;
            PG8_LDA(At, 1, 1); PG8_STAGE(PG8_SB(1, 0), b3, voffB); PG8_STAGE(PG8_SB(1, 1), b3 + hstepB, voffB); PG8_STAGE(PG8_SA(1, 0), a3, voffA);
            PG8_WAIT_V(8); PG8_WAIT_L(0); PG8_BAR; PG8_MMA(1, 0, At, B0); PG8_MMA(1, 1, At, B1); PG8_BAR; PG8_SCHED;
        }
        if (wr == 0) PG8_BAR;
        E(acc, cur, wr, wc, fr, fq);
        if (!has_next) break;
#pragma unroll
        for (int a = 0; a < 2; ++a)
#pragma unroll
            for (int b = 0; b < 2; ++b)
#pragma unroll
                for (int m = 0; m < 4; ++m)
#pragma unroll
                    for (int n = 0; n < 2; ++n) acc[a][b][m][n] = (f32x4){0.f, 0.f, 0.f, 0.f};
        cur = nxt; cA = nA; cB = nB; ++ui;
        if (wr == 1) PG8_BAR;
    }
    PG8_WAIT_V(0);
    PG8_BAR;
#undef PG8_SA
#undef PG8_SB
#undef PG8_STAGE
#undef PG8_LDA
#undef PG8_LDB
#undef PG8_MMA
#undef PG8_WAIT_V
#undef PG8_WAIT_L
#undef PG8_BAR
#undef PG8_SCHED
}
}


#define XB_TMO      128
#define XB_XCNT(j)  (256  + 64 * (j))
#define XB_XSUB(j)  (1280 + 64 * (j))
#define XB_XGEN(j)  (2304 + 64 * (j))
#define XB_TOP      3328
#define XB_TOPGEN   3392
#define XCD_BAR_WORDS 3456
#define XB_SPIN_CAP (1u << 22)
DI unsigned xb_ld(unsigned* p)              { return __hip_atomic_load(p, __ATOMIC_RELAXED, __HIP_MEMORY_SCOPE_AGENT); }
DI unsigned xb_add(unsigned* p, unsigned v) { return __hip_atomic_fetch_add(p, v, __ATOMIC_RELAXED, __HIP_MEMORY_SCOPE_AGENT); }
DI unsigned xb_xcc_id() { return (unsigned)__builtin_amdgcn_s_getreg((3 << 11) | 20) & 0xFu; }
#define XB_SPIN(cond, bar) do { unsigned _sp = 0; while (cond) { __builtin_amdgcn_s_sleep(1); \
    if ((++_sp & 255u) == 0u) { if (xb_ld(&(bar)[XB_TMO])) break; if (_sp > XB_SPIN_CAP) { atomicAdd(&(bar)[XB_TMO], 1u); break; } } } } while (0)
DI void xcd_barrier_complete(unsigned* bar, unsigned x, unsigned& nloc, unsigned& nx) {
    const unsigned G = gridDim.x * gridDim.y * gridDim.z;
    unsigned sum, cnt, mine, sp = 0u;
    for (;;) {
        sum = 0u; cnt = 0u; mine = 0u;
#pragma unroll
        for (unsigned j = 0; j < 16; ++j) { const unsigned c = xb_ld(&bar[XB_XCNT(j)]); sum += c; cnt += (c > 0u) ? 1u : 0u; mine = (j == x) ? c : mine; }
        if (sum == G) break;
        __builtin_amdgcn_s_sleep(1);
        if ((++sp & 255u) == 0u) { if (xb_ld(&bar[XB_TMO])) break; if (sp > XB_SPIN_CAP) { atomicAdd(&bar[XB_TMO], 1u); break; } }
    }
    nloc = mine > 0u ? mine : 1u; nx = cnt > 0u ? cnt : 1u;
}
DI void xcd_barrier(unsigned* bar, volatile LAS unsigned* st) {
    asm volatile("s_waitcnt vmcnt(0)" ::: "memory");
    __syncthreads();
    if (threadIdx.x == 0) {
        __builtin_amdgcn_s_waitcnt(0);
        const unsigned x = xb_xcc_id();
        unsigned nloc = st[0], nx = st[1];
        if (nloc == 0u) { xcd_barrier_complete(bar, x, nloc, nx); st[0] = nloc; st[1] = nx; }
        const unsigned old = xb_add(&bar[XB_XSUB(x)], 1u);
        const unsigned gen = old / nloc;
        if (old + 1u == (gen + 1u) * nloc) {
            __builtin_amdgcn_fence(__ATOMIC_RELEASE, "agent");
            asm volatile("s_waitcnt vmcnt(0)" ::: "memory");
            const unsigned og = xb_add(&bar[XB_TOP], 1u);
            const unsigned tg = og / nx;
            if (og + 1u == (tg + 1u) * nx) xb_add(&bar[XB_TOPGEN], 1u);
            else XB_SPIN(xb_ld(&bar[XB_TOPGEN]) == tg, bar);
            __builtin_amdgcn_fence(__ATOMIC_ACQUIRE, "agent");
            xb_add(&bar[XB_XGEN(x)], 1u);
            asm volatile("s_waitcnt vmcnt(0)" ::: "memory");
        } else {
            XB_SPIN(xb_ld(&bar[XB_XGEN(x)]) == gen, bar);
            __builtin_amdgcn_fence(__ATOMIC_ACQUIRE, "agent");
            asm volatile("s_waitcnt vmcnt(0)" ::: "memory");
        }
    }
    __syncthreads();
}

struct Params {
    const float* x; const float* mem; const int* pos;
    const float* ln_mix_pre; const float* w_in; const float* conv_w; const float* conv_b;
    const float* lru_wr; const float* lru_br; const float* lru_wi; const float* lru_bi; const float* lru_lambda;
    const float* cmp_pe; const float* cmp_w1; const float* cmp_b1; const float* cmp_w2;
    const float* ln_mem; const float* w_mem_kv; const float* w_br_rnn; const float* w_br_nsa; const float* w_br_mem; const float* w_out;
    const float* ln_mix_post; const float* ln_mlp_pre; const float* mlp_w1; const float* mlp_w2; const float* ln_mlp_post;
    float* out; unsigned char* ws;
};
typedef const __attribute__((address_space(4))) Params* PP;
#define PPOPAQ() asm volatile("" : "+s"(pp))

DI void tr_item(const float* W, int ldw, int srccol, int valid, int k0, bf16_t* WT, int ldt, int drow0, LAS float* scr, int lane) {
    const int c32 = lane & 31;
    float vv[32];
    const float* wp = W + (size_t)(k0 + (lane >> 5)) * ldw + srccol + (c32 < valid ? c32 : 0);
#pragma unroll
    for (int i = 0; i < 32; ++i) vv[i] = wp[(size_t)(2 * i) * ldw];
#pragma unroll
    for (int i = 0; i < 32; ++i) scr[(2 * i + (lane >> 5)) * 33 + c32] = (c32 < valid) ? vv[i] : 0.f;
    __builtin_amdgcn_s_waitcnt(0xc07f); asm volatile("s_waitcnt lgkmcnt(0)" ::: "memory");
    const int c = lane & 7;
#pragma unroll
    for (int j = 0; j < 4; ++j) { const int n = (lane >> 3) + 8 * j; const LAS float* s = scr + (8 * c) * 33 + n;
        u32x4 o; o.x = pk2(s[0 * 33], s[1 * 33]); o.y = pk2(s[2 * 33], s[3 * 33]); o.z = pk2(s[4 * 33], s[5 * 33]); o.w = pk2(s[6 * 33], s[7 * 33]);
        *(u32x4*)(WT + (size_t)(drow0 + n) * ldt + k0 + 8 * c) = o; }
    asm volatile("s_waitcnt lgkmcnt(0)" ::: "memory");
}

DI void prep_phase(PP pp, int l, LAS unsigned char* lds) {
    PPOPAQ();
    int tid = threadIdx.x; asm volatile("" : "+v"(tid));
    const int lane = tid & 63, wave = __builtin_amdgcn_readfirstlane(tid >> 6);
    const int G_ = opaque_s((int)gridDim.x), bx_ = opaque_s((int)blockIdx.x);
    const int gw = bx_ * 8 + wave, NGW = G_ * 8, gtid = bx_ * 512 + tid, NT = G_ * 512;
    (void)lane; (void)wave; (void)gw; (void)NGW; (void)gtid; (void)NT;
    LAS float* scr = (LAS float*)(lds + wave * 8704);
    unsigned char* ws = pp->ws;
    const float* w_in = pp->w_in + (size_t)l * 1024 * 8752;
    constexpr int I_IN = 16 * 280, I_MKV = 16 * 64, I_BR = 16 * 32, I_M1 = 16 * 128, I_M2 = 64 * 32, I_C1 = 2 * 32 * 8, I_C2 = 2 * 4 * 8, I_LRU = 2 * 8 * 2 * 4;
    constexpr int NITEMS = I_IN + I_MKV + 4 * I_BR + I_M1 + I_M2 + I_C1 + I_C2 + I_LRU;
    for (int it = gw; it < NITEMS; it += NGW) {
        int r = it;
        if (r < I_IN) { const int kb = r / 280, nb = r % 280, n0 = 32 * nb; int src, valid = 32;
            if (n0 < 4608) src = n0; else if (n0 < 5632) src = n0 - 4608 + 4656; else if (n0 < 8704) src = n0 - 5632 + 5680;
            else { src = n0 - 8704 + 4608; valid = 48 - (n0 - 8704); valid = valid < 0 ? 0 : (valid > 32 ? 32 : valid); if (valid == 0) src = 0; }
            tr_item(w_in, 8752, src, valid, 64 * kb, (bf16_t*)(ws + WS_WIN), 1024, n0, scr, lane); continue; } r -= I_IN;
        if (r < I_MKV) { tr_item(pp->w_mem_kv + (size_t)l * 1024 * 2048, 2048, 32 * (r % 64), 32, 64 * (r / 64), (bf16_t*)(ws + WS_WMKV), 1024, 32 * (r % 64), scr, lane); continue; } r -= I_MKV;
        if (r < I_BR) { tr_item(pp->w_br_rnn + (size_t)l * 1024 * 1024, 1024, 32 * (r % 32), 32, 64 * (r / 32), (bf16_t*)(ws + WS_WBRA), 1024, 32 * (r % 32), scr, lane); continue; } r -= I_BR;
        if (r < I_BR) { tr_item(pp->w_br_nsa + (size_t)l * 1024 * 1024, 1024, 32 * (r % 32), 32, 64 * (r / 32), (bf16_t*)(ws + WS_WBRB), 1024, 32 * (r % 32), scr, lane); continue; } r -= I_BR;
        if (r < I_BR) { tr_item(pp->w_br_mem + (size_t)l * 1024 * 1024, 1024, 32 * (r % 32), 32, 64 * (r / 32), (bf16_t*)(ws + WS_WBRC), 1024, 32 * (r % 32), scr, lane); continue; } r -= I_BR;
        if (r < I_BR) { tr_item(pp->w_out + (size_t)l * 1024 * 1024, 1024, 32 * (r % 32), 32, 64 * (r / 32), (bf16_t*)(ws + WS_WOUT), 1024, 32 * (r % 32), scr, lane); continue; } r -= I_BR;
        if (r < I_M1) { tr_item(pp->mlp_w1 + (size_t)l * 1024 * 4096, 4096, 32 * (r % 128), 32, 64 * (r / 128), (bf16_t*)(ws + WS_WM1), 1024, 32 * (r % 128), scr, lane); continue; } r -= I_M1;
        if (r < I_M2) { tr_item(pp->mlp_w2 + (size_t)l * 4096 * 1024, 1024, 32 * (r % 32), 32, 64 * (r / 32), (bf16_t*)(ws + WS_WM2), 4096, 32 * (r % 32), scr, lane); continue; } r -= I_M2;
        if (r < I_C1) { const int j = r / 256, q = r % 256;
            tr_item(pp->cmp_w1 + ((size_t)l * 2 + j) * 2048 * 256, 256, 32 * (q % 8), 32, 64 * (q / 8), (bf16_t*)(ws + WS_WC1) + (size_t)j * 256 * 2048, 2048, 32 * (q % 8), scr, lane); continue; } r -= I_C1;
        if (r < I_C2) { const int j = r / 32, q = r % 32; const int n0 = 32 * (q % 8);
            tr_item(pp->cmp_w2 + ((size_t)l * 2 + j) * 256 * 64, 64, n0 < 64 ? n0 : 0, n0 < 64 ? 32 : 0, 64 * (q / 8), (bf16_t*)(ws + WS_WC2) + (size_t)j * 256 * 256, 256, n0, scr, lane); continue; } r -= I_C2;
        { const int ri = r / 64, q = r % 64, blk = q / 8, q2 = q % 8;
            const float* W = (ri == 0 ? pp->lru_wr : pp->lru_wi) + ((size_t)l * 8 + blk) * 128 * 128;
            tr_item(W, 128, 32 * (q2 % 4), 32, 64 * (q2 / 4), (bf16_t*)(ws + WS_WLRU), 128, blk * 256 + ri * 128 + 32 * (q2 % 4), scr, lane); }
    }
    for (int m = gw; m < 512; m += NGW) {
        const f32x4* xr = (const f32x4*)(pp->mem + (size_t)m * 1024) + lane; const f32x4* gr = (const f32x4*)(pp->ln_mem + (size_t)l * 1024) + lane;
        f32x4 v[4]; float s = 0.f;
#pragma unroll
        for (int j = 0; j < 4; ++j) { v[j] = xr[64 * j]; s += (v[j].x * v[j].x + v[j].y * v[j].y) + (v[j].z * v[j].z + v[j].w * v[j].w); }
        const float rs = 1.0f / sqrtf(wave_sum(s, lane) * (1.f / 1024.f) + EPS);
        u32x2* o8 = (u32x2*)((bf16_t*)(ws + WS_MEMN) + (size_t)m * 1024) + lane;
#pragma unroll
        for (int j = 0; j < 4; ++j) { const f32x4 g = gr[64 * j]; u32x2 w; w.x = pk2(v[j].x * rs * g.x, v[j].y * rs * g.y); w.y = pk2(v[j].z * rs * g.z, v[j].w * rs * g.w); o8[64 * j] = w; }
    }
    {
        const int gt = gw * 64 + lane;
        if (gt < 16 * 512) { const int prt = gt / 512, jn = gt % 512, j = jn / 256, n = jn % 256;
            const float* w1 = pp->cmp_w1 + ((size_t)l * 2 + j) * 2048 * 256 + n; const float* pe = pp->cmp_pe + ((size_t)l * 2 + j) * 2048;
            float s = 0.f;
            for (int k = prt * 128; k < prt * 128 + 128; ++k) s += pe[k] * w1[(size_t)k * 256];
            ((float*)(ws + WS_CBP))[gt] = s; }
    }
}

DI void row_phase(const float* xin, const float* y, const float* gpost, float* xout, const float* gnext, bf16_t* hout) {
    int tid = threadIdx.x; asm volatile("" : "+v"(tid));
    const int lane = tid & 63, wave = __builtin_amdgcn_readfirstlane(tid >> 6);
    const int G_ = opaque_s((int)gridDim.x), bx_ = opaque_s((int)blockIdx.x);
    const int gw = bx_ * 8 + wave, NGW = G_ * 8, gtid = bx_ * 512 + tid, NT = G_ * 512;
    (void)lane; (void)wave; (void)gw; (void)NGW; (void)gtid; (void)NT;
    for (int m = gw; m < T_; m += NGW) {
        const f32x4* xr = (const f32x4*)(xin + (size_t)m * 1024) + lane;
        f32x4 v[4];
#pragma unroll
        for (int j = 0; j < 4; ++j) v[j] = xr[64 * j];
        if (y) {
            const f32x4* yr = (const f32x4*)(y + (size_t)m * 1024) + lane; const f32x4* gr = (const f32x4*)gpost + lane;
            f32x4 w[4]; float s = 0.f;
#pragma unroll
            for (int j = 0; j < 4; ++j) { w[j] = yr[64 * j]; s += (w[j].x * w[j].x + w[j].y * w[j].y) + (w[j].z * w[j].z + w[j].w * w[j].w); }
            const float rs = 1.0f / sqrtf(wave_sum(s, lane) * (1.f / 1024.f) + EPS);
            f32x4* xo = (f32x4*)(xout + (size_t)m * 1024) + lane;
#pragma unroll
            for (int j = 0; j < 4; ++j) { v[j] = v[j] + w[j] * rs * gr[64 * j]; xo[64 * j] = v[j]; }
        }
        if (hout) {
            float s = 0.f;
#pragma unroll
            for (int j = 0; j < 4; ++j) s += (v[j].x * v[j].x + v[j].y * v[j].y) + (v[j].z * v[j].z + v[j].w * v[j].w);
            const float rs = 1.0f / sqrtf(wave_sum(s, lane) * (1.f / 1024.f) + EPS);
            const f32x4* gr = (const f32x4*)gnext + lane; u32x2* o8 = (u32x2*)(hout + (size_t)m * 1024) + lane;
#pragma unroll
            for (int j = 0; j < 4; ++j) { const f32x4 g = gr[64 * j]; u32x2 w; w.x = pk2(v[j].x * rs * g.x, v[j].y * rs * g.y); w.y = pk2(v[j].z * rs * g.z, v[j].w * rs * g.w); o8[64 * j] = w; }
        }
    }
}

DI void rope8(u32x4& lo, u32x4& hi, float pos, int d0, float scale) {
    unsigned* pl = (unsigned*)&lo; unsigned* ph = (unsigned*)&hi;
    float x1[8], x2[8];
#pragma unroll
    for (int e = 0; e < 4; ++e) { x1[2 * e] = bflo(pl[e]); x1[2 * e + 1] = bfhi(pl[e]); x2[2 * e] = bflo(ph[e]); x2[2 * e + 1] = bfhi(ph[e]); }
#pragma unroll
    for (int e = 0; e < 8; ++e) {
        const float inv = fexp2(-(float)(d0 + e) * 0.41524101186092029f);
        const float ang = pos * inv;
        const float rev = ang * 0.15915494309189535f; const float fr = rev - __builtin_rintf(rev);
        const float sn = __builtin_amdgcn_sinf(fr), cs = __builtin_amdgcn_cosf(fr);
        const float a = (x1[e] * cs - x2[e] * sn) * scale, b = (x2[e] * cs + x1[e] * sn) * scale; x1[e] = a; x2[e] = b;
    }
#pragma unroll
    for (int e = 0; e < 4; ++e) { pl[e] = pk2(x1[2 * e], x1[2 * e + 1]); ph[e] = pk2(x2[2 * e], x2[2 * e + 1]); }
}

DI void postproj_phase(PP pp, int l) {
    PPOPAQ();
    if (opaque_s((int)blockIdx.x) < 32 && gridDim.x == 256) return;
    int tid = threadIdx.x; asm volatile("" : "+v"(tid));
    const int lane = tid & 63, wave = __builtin_amdgcn_readfirstlane(tid >> 6);
    const int G_ = opaque_s((int)gridDim.x), bx_ = opaque_s((int)blockIdx.x);
    const bool shr = (G_ == 256); const int gw = bx_ * 8 + wave, NGW = G_ * 8, gtid = (shr ? bx_ - 32 : bx_) * 512 + tid, NT = (shr ? G_ - 32 : G_) * 512;
    (void)lane; (void)wave; (void)gw; (void)NGW; (void)gtid; (void)NT;
    unsigned char* ws = pp->ws; bf16_t* PROJ = (bf16_t*)(ws + WS_PROJ);
    {
        const float* cw = pp->conv_w + (size_t)l * 4 * 1024; const float* cb = pp->conv_b + (size_t)l * 1024; bf16_t* XC = (bf16_t*)(ws + WS_XC);
        for (int i = gtid; i < (T_ / 8) * 128; i += NT) { const int tb8 = (i >> 7) * 8, c8 = (i & 127) * 8, ts0 = tb8 & (S_ - 1);
            u32x4 xr[11];
#pragma unroll
            for (int w = 0; w < 11; ++w) { const int tt = tb8 - 3 + w; const bool okr = ts0 - 3 + w >= 0; const u32x4 ld = *(const u32x4*)(PROJ + (size_t)(okr ? tt : tb8) * LDP + C_XR + c8);
                xr[w] = okr ? ld : (u32x4){0u, 0u, 0u, 0u}; }
            f32x4 kw[4][2];
#pragma unroll
            for (int w = 0; w < 4; ++w) { kw[w][0] = *(const f32x4*)(cw + w * 1024 + c8); kw[w][1] = *(const f32x4*)(cw + w * 1024 + c8 + 4); }
            const f32x4 b0 = *(const f32x4*)(cb + c8), b1 = *(const f32x4*)(cb + c8 + 4);
#pragma unroll
            for (int r = 0; r < 8; ++r) {
                float acc[8] = {b0.x, b0.y, b0.z, b0.w, b1.x, b1.y, b1.z, b1.w};
#pragma unroll
                for (int w = 0; w < 4; ++w) { const unsigned* xp = (const unsigned*)&xr[r + w]; const f32x4 k0 = kw[w][0], k1 = kw[w][1];
                    acc[0] += k0.x * bflo(xp[0]); acc[1] += k0.y * bfhi(xp[0]); acc[2] += k0.z * bflo(xp[1]); acc[3] += k0.w * bfhi(xp[1]);
                    acc[4] += k1.x * bflo(xp[2]); acc[5] += k1.y * bfhi(xp[2]); acc[6] += k1.z * bflo(xp[3]); acc[7] += k1.w * bfhi(xp[3]); }
                u32x4 o; o.x = pk2(acc[0], acc[1]); o.y = pk2(acc[2], acc[3]); o.z = pk2(acc[4], acc[5]); o.w = pk2(acc[6], acc[7]);
                *(u32x4*)(XC + (size_t)(tb8 + r) * 1024 + c8) = o; }
        }
    }
    for (int i = gtid; i < T_ * 20 * 4; i += NT) { const int t = i / 80, r = i % 80, hd = r >> 2, d0 = (r & 3) * 8;
        int col; float sc = 1.0f;
        if (hd < 16) { col = C_Q + hd * 64; sc = 0.125f * LOG2E; } else col = C_KW + (hd - 16) * 64;
        bf16_t* base = PROJ + (size_t)t * LDP + col + d0;
        u32x4 lo = *(const u32x4*)base, hi = *(const u32x4*)(base + 32);
        rope8(lo, hi, (float)pp->pos[t], d0, sc);
        *(u32x4*)base = lo; *(u32x4*)(base + 32) = hi; }
    for (int i = gtid; i < 8 * 128 * 4 * 64; i += NT) { const int ln = i & 63, sub = (i >> 6) & 3, j = (i >> 8) & 127, bg = i >> 15, b = bg >> 2, g = bg & 3;
        const int r16 = ln & 15, quad = ln >> 4, t = 64 * j + 16 * sub + r16, dl = 8 * quad;
        const bf16_t* base = PROJ + (size_t)(b * S_ + t) * LDP + C_KS + g * 64 + dl;
        u32x4 lo = *(const u32x4*)base, hi = *(const u32x4*)(base + 32);
        rope8(lo, hi, (float)pp->pos[b * S_ + t], dl, 1.0f);
        u32x4 outw;
        outw.x = pk4_fp8(bflo(lo.x), bfhi(lo.x), bflo(lo.y), bfhi(lo.y)); outw.y = pk4_fp8(bflo(lo.z), bfhi(lo.z), bflo(lo.w), bfhi(lo.w));
        outw.z = pk4_fp8(bflo(hi.x), bfhi(hi.x), bflo(hi.y), bfhi(hi.y)); outw.w = pk4_fp8(bflo(hi.z), bfhi(hi.z), bflo(hi.w), bfhi(hi.w));
        *(u32x4*)((unsigned char*)(ws + WS_KF) + (size_t)i * 16) = outw; }
    for (int i = gtid; i < 8 * 128 * 4 * 64; i += NT) { const int ln = i & 63, dsub = (i >> 6) & 3, j = (i >> 8) & 127, bg = i >> 15, b = bg >> 2, g = bg & 3;
        const int r16 = ln & 15, quad = ln >> 4;
        u32x4 outw;
#pragma unroll
        for (int kst = 0; kst < 2; ++kst) { const int key0 = 64 * j + 32 * kst + 4 * quad;
            const bf16_t* src = PROJ + (size_t)(b * S_ + key0) * LDP + C_VS + g * 64 + 16 * dsub + r16;
            float v[8];
#pragma unroll
            for (int e = 0; e < 8; ++e) v[e] = bf2f(src[(size_t)(e < 4 ? e : e + 12) * LDP]);
            const unsigned w0 = pk4_fp8(v[0], v[1], v[2], v[3]), w1 = pk4_fp8(v[4], v[5], v[6], v[7]);
            if (kst == 0) { outw.x = w0; outw.y = w1; } else { outw.z = w0; outw.w = w1; } }
        *(u32x4*)((unsigned char*)(ws + WS_VTS) + (size_t)i * 16) = outw; }
    for (int i = gtid; i < 2 * 4 * 1024 * 64; i += NT) { const int d = i & 63, t8 = (i >> 6) & 1023, g = (i >> 16) & 3, b = (i >> 18) & 1, which = 1;
        const bf16_t* src = PROJ + (size_t)(b * S_ + t8 * 8) * LDP + (which ? C_VW : C_VS) + g * 64 + d;
        unsigned short v[8];
#pragma unroll
        for (int e = 0; e < 8; ++e) v[e] = src[(size_t)e * LDP];
        u32x4 o; o.x = v[0] | ((unsigned)v[1] << 16); o.y = v[2] | ((unsigned)v[3] << 16); o.z = v[4] | ((unsigned)v[5] << 16); o.w = v[6] | ((unsigned)v[7] << 16);
        *(u32x4*)((bf16_t*)(ws + (which ? WS_VTW : WS_VTS)) + ((size_t)(b * 4 + g) * 64 + d) * S_ + t8 * 8) = o; }
}
DI void cbias_phase(PP pp, int l) {
    PPOPAQ();
    int tid = threadIdx.x; asm volatile("" : "+v"(tid));
    if (opaque_s((int)blockIdx.x) == 0) { unsigned char* ws = pp->ws; const float* part = (const float*)(ws + WS_CBP); float s = pp->cmp_b1[(size_t)l * 512 + tid];
        for (int q = 0; q < 16; ++q) s += part[q * 512 + tid];
        ((float*)(ws + WS_CBIAS))[tid] = s; }
}

DI void lru_ab(float rp, float ip, float xc, float cl, float& a, float& bb) {
    const float la = cl * sigmoidf_(rp);
    a = fexp2(la * LOG2E);
    const float x2 = 2.0f * la;
    float om;
    if (x2 > -0.1f) om = -x2 * (1.0f + x2 * (0.5f + x2 * (0.16666667f + x2 * (0.041666668f + x2 * 0.0083333338f)))); else om = 1.0f - a * a;
    bb = __builtin_amdgcn_sqrtf(om) * sigmoidf_(ip) * xc;
}
DI void scan_phase(PP pp, int l, int pass) {
    PPOPAQ();
    int tid = threadIdx.x; asm volatile("" : "+v"(tid));
    const int G_ = opaque_s((int)gridDim.x), bx_ = opaque_s((int)blockIdx.x);
    unsigned char* ws = pp->ws; const bf16_t* __restrict__ RI = (const bf16_t*)(ws + WS_RI); bf16_t* XC = (bf16_t*)(ws + WS_XC); const bf16_t* __restrict__ PROJ = (const bf16_t*)(ws + WS_PROJ);
    f32x2* SA = (f32x2*)(ws + WS_SCA); f32x2* SH = (f32x2*)(ws + WS_SCH);
    const int ch = 2 * tid, blk = ch >> 7, cc = ch & 127, rcol = blk * 256 + cc;
    const f32x2 lam = *(const f32x2*)(pp->lru_lambda + (size_t)l * 1024 + ch), br = *(const f32x2*)(pp->lru_br + (size_t)l * 1024 + ch), bi = *(const f32x2*)(pp->lru_bi + (size_t)l * 1024 + ch);
    float cl[2];
#pragma unroll
    for (int e = 0; e < 2; ++e) { const float ex = fexp2(-lam[e] * LOG2E);
        const float sp = (ex < 0.05f) ? ex * (1.0f - ex * (0.5f - ex * (0.33333334f - ex * (0.25f - ex * (0.2f - ex * 0.16666667f))))) : ((-lam[e] > 20.f) ? -lam[e] : 0.6931471805599453f * __builtin_amdgcn_logf(1.0f + ex));
        cl[e] = -8.0f * sp; }
    for (int u = bx_; u < 256; u += G_) { const int b = u >> 7, k = u & 127;
        const size_t row0 = (size_t)b * S_ + k * 64;
        if (pass == 0) {
            float A0 = 1.f, H0 = 0.f, A1 = 1.f, H1 = 0.f;
            for (int s8 = 0; s8 < 64; s8 += 8) { unsigned rw[8], iw[8], xw[8];
#pragma unroll
                for (int e = 0; e < 8; ++e) { const size_t row = row0 + s8 + e; rw[e] = *(const unsigned*)(RI + row * 2048 + rcol); iw[e] = *(const unsigned*)(RI + row * 2048 + rcol + 128); xw[e] = *(const unsigned*)(XC + row * 1024 + ch); }
#pragma unroll
                for (int e = 0; e < 8; ++e) { float a, bb;
                    lru_ab(bflo(rw[e]) + br[0], bflo(iw[e]) + bi[0], bflo(xw[e]), cl[0], a, bb); A0 *= a; H0 = a * H0 + bb;
                    lru_ab(bfhi(rw[e]) + br[1], bfhi(iw[e]) + bi[1], bfhi(xw[e]), cl[1], a, bb); A1 *= a; H1 = a * H1 + bb; } }
            SA[((size_t)b * 128 + k) * 512 + tid] = (f32x2){A0, A1}; SH[((size_t)b * 128 + k) * 512 + tid] = (f32x2){H0, H1};
        } else {
            float h0 = 0.f, h1 = 0.f;
            const f32x2* __restrict__ sa = SA + (size_t)b * 128 * 512 + tid; const f32x2* __restrict__ sh = SH + (size_t)b * 128 * 512 + tid;
            for (int q0 = 0; q0 < k; q0 += 16) { f32x2 av[16], hv[16];
#pragma unroll
                for (int e = 0; e < 16; ++e) { const int qq = (q0 + e < k) ? q0 + e : q0; av[e] = sa[(size_t)qq * 512]; hv[e] = sh[(size_t)qq * 512]; }
#pragma unroll
                for (int e = 0; e < 16; ++e) if (q0 + e < k) { h0 = av[e][0] * h0 + hv[e][0]; h1 = av[e][1] * h1 + hv[e][1]; } }
            for (int s8 = 0; s8 < 64; s8 += 8) { unsigned rw[8], iw[8], xw[8], yw[8];
#pragma unroll
                for (int e = 0; e < 8; ++e) { const size_t row = row0 + s8 + e; rw[e] = *(const unsigned*)(RI + row * 2048 + rcol); iw[e] = *(const unsigned*)(RI + row * 2048 + rcol + 128); xw[e] = *(const unsigned*)(XC + row * 1024 + ch);
                    yw[e] = *(const unsigned*)(PROJ + row * LDP + C_YR + ch); }
#pragma unroll
                for (int e = 0; e < 8; ++e) { float a, bb;
                    lru_ab(bflo(rw[e]) + br[0], bflo(iw[e]) + bi[0], bflo(xw[e]), cl[0], a, bb); h0 = a * h0 + bb;
                    lru_ab(bfhi(rw[e]) + br[1], bfhi(iw[e]) + bi[1], bfhi(xw[e]), cl[1], a, bb); h1 = a * h1 + bb;
                    *(unsigned*)(XC + (row0 + s8 + e) * 1024 + ch) = pk2(h0 * gelu_tanh(bflo(yw[e])), h1 * gelu_tanh(bfhi(yw[e]))); } }
        }
    }
}

DI void memsoftmax_phase(PP pp) {
    PPOPAQ();
    int tid = threadIdx.x; asm volatile("" : "+v"(tid));
    const int lane = tid & 63, wave = __builtin_amdgcn_readfirstlane(tid >> 6);
    const int G_ = opaque_s((int)gridDim.x), bx_ = opaque_s((int)blockIdx.x);
    const int gw = bx_ * 8 + wave, NGW = G_ * 8, gtid = bx_ * 512 + tid, NT = G_ * 512;
    (void)lane; (void)wave; (void)gw; (void)NGW; (void)gtid; (void)NT;
    bf16_t* SP = (bf16_t*)(pp->ws + WS_H);
    for (int m0 = gw; m0 < T_; m0 += 4 * NGW) {
        u32x4 av[4], bv[4];
#pragma unroll
        for (int r = 0; r < 4; ++r) { const int m = (m0 + r * NGW < T_) ? m0 + r * NGW : m0; const u32x4* ptr = (const u32x4*)(SP + (size_t)m * 1024 + lane * 16); av[r] = ptr[0]; bv[r] = ptr[1]; }
#pragma unroll
        for (int r = 0; r < 4; ++r) {
            const unsigned* pa = (const unsigned*)&av[r]; const unsigned* pb = (const unsigned*)&bv[r];
            float v[16];
#pragma unroll
            for (int e = 0; e < 4; ++e) { v[2 * e] = bflo(pa[e]); v[2 * e + 1] = bfhi(pa[e]); v[8 + 2 * e] = bflo(pb[e]); v[8 + 2 * e + 1] = bfhi(pb[e]); }
            float mx = v[0];
#pragma unroll
            for (int e = 1; e < 16; ++e) mx = fmaxf(mx, v[e]);
#pragma unroll
            for (int o = 1; o < 16; o <<= 1) mx = fmaxf(mx, shx(mx, o, lane));
            float sm = 0.f;
#pragma unroll
            for (int e = 0; e < 16; ++e) { v[e] = fexp2(v[e] - mx); sm += v[e]; }
#pragma unroll
            for (int o = 1; o < 16; o <<= 1) sm += shx(sm, o, lane);
            const float inv = 1.0f / sm;
            u32x4 oa, ob; unsigned* qa = (unsigned*)&oa; unsigned* qb = (unsigned*)&ob;
#pragma unroll
            for (int e = 0; e < 4; ++e) { qa[e] = pk2(v[2 * e] * inv, v[2 * e + 1] * inv); qb[e] = pk2(v[8 + 2 * e] * inv, v[8 + 2 * e + 1] * inv); }
            if (m0 + r * NGW < T_) { u32x4* ptr = (u32x4*)(SP + (size_t)(m0 + r * NGW) * 1024 + lane * 16); ptr[0] = oa; ptr[1] = ob; }
        }
    }
}

DI void cmpfinal_phase(PP pp) {
    PPOPAQ();
    int tid = threadIdx.x; asm volatile("" : "+v"(tid));
    const int lane = tid & 63, wave = __builtin_amdgcn_readfirstlane(tid >> 6);
    const int G_ = opaque_s((int)gridDim.x), bx_ = opaque_s((int)blockIdx.x);
    const int gw = bx_ * 8 + wave, NGW = G_ * 8, gtid = bx_ * 512 + tid, NT = G_ * 512;
    (void)lane; (void)wave; (void)gw; (void)NGW; (void)gtid; (void)NT;
    unsigned char* ws = pp->ws; const float* CR = (const float*)(ws + WS_CRAW);
    for (int i = gtid; i < 2 * 4 * 512 * 32; i += NT) { const int d = i & 31, c = (i >> 5) & 511, bg = i >> 14, b = bg >> 2;
        const float* src = CR + ((size_t)bg * 512 + c) * 64; float x1 = src[d], x2 = src[d + 32];
        float o1 = 0.f, o2 = 0.f;
        if (c < 511) { const float pos = (float)pp->pos[b * S_ + 16 * c + 31]; const float inv = fexp2(-(float)d * 0.41524101186092029f); const float ang = pos * inv;
            const float rev = ang * 0.15915494309189535f; const float fr = rev - __builtin_rintf(rev);
            const float sn = __builtin_amdgcn_sinf(fr), cs = __builtin_amdgcn_cosf(fr); o1 = x1 * cs - x2 * sn; o2 = x2 * cs + x1 * sn; }
        bf16_t* dst = (bf16_t*)(ws + WS_KCMP) + ((size_t)bg * 512 + c) * 64; dst[d] = (bf16_t)f2bf(o1); dst[d + 32] = (bf16_t)f2bf(o2); }
    for (int i = gtid; i < 2 * 4 * 64 * 512; i += NT) { const int c = i & 511, d = (i >> 9) & 63, bg = i >> 15;
        const float v = (c < 511) ? CR[((size_t)(8 + bg) * 512 + c) * 64 + d] : 0.f;
        ((bf16_t*)(ws + WS_VTCMP))[((size_t)bg * 64 + d) * 512 + c] = (bf16_t)f2bf(v); }
}

constexpr int KSTR = 144, VSTR = 136;
constexpr int L_K = 0, L_V = 2 * 64 * KSTR, L_IMP = L_V + 2 * 64 * VSTR, IMPSTR = 132, L_SEL = L_IMP + 64 * IMPSTR * 4, L_ATT_END = L_SEL + 64 * 16, L_OT = L_ATT_END, L_Q8 = L_OT + 65536, L_ML = L_Q8 + 16384, OSSTR = 272;
DI int crow(int r, int hi) { return (r & 3) + 8 * (r >> 2) + 4 * hi; }

struct TileSrc { const bf16_t* K; int kstr; const bf16_t* Vt; int vstr; };

template <int MODE>
DI void attn_loop(LAS unsigned char* lds, const TileSrc src, int j0, int j1, const bf16x8 (&qf)[4], f32x16 (&o)[2], float& m_run, float& l_run,
                  int tl, int t, int tb, u64 selLo, u64 selHi, int tid, int wave, int lane) {
    const int n = lane & 31, hh = lane >> 5;
    const int lrow = tid >> 3, lchunk = tid & 7;
    u32x4 kreg, vreg;
    kreg = *(const u32x4*)(src.K + (size_t)(64 * j0 + lrow) * src.kstr + lchunk * 8);
    vreg = *(const u32x4*)(src.Vt + (size_t)lrow * src.vstr + 64 * j0 + lchunk * 8);
    float carry = 0.f;
    int buf = 0;
    for (int j = j0; j <= j1; ++j) {
        LAS unsigned char* Kl = lds + L_K + buf * 64 * KSTR; LAS unsigned char* Vl = lds + L_V + buf * 64 * VSTR;
        *(LAS u32x4*)(Kl + lrow * KSTR + lchunk * 16) = kreg;
        *(LAS u32x2*)(Vl + lrow * VSTR + lchunk * 16) = (u32x2){vreg.x, vreg.y}; *(LAS u32x2*)(Vl + lrow * VSTR + lchunk * 16 + 8) = (u32x2){vreg.z, vreg.w};
        __syncthreads();
        if (j < j1) { kreg = *(const u32x4*)(src.K + (size_t)(64 * (j + 1) + lrow) * src.kstr + lchunk * 8);
                      vreg = *(const u32x4*)(src.Vt + (size_t)lrow * src.vstr + 64 * (j + 1) + lchunk * 8); }
        buf ^= 1;
        bool active = true;
        if (MODE == 2) { const bool bit = ((j < 64 ? selLo : selHi) >> (j & 63)) & 1ull; active = __ballot(bit) != 0ull; }
        if (!active) continue;
        f32x16 s[2];
#pragma unroll
        for (int u = 0; u < 2; ++u) {
#pragma unroll
            for (int e = 0; e < 16; ++e) s[u][e] = 0.f;
#pragma unroll
            for (int ks = 0; ks < 4; ++ks) { const bf16x8 kf = *(const LAS bf16x8*)(Kl + (32 * u + n) * KSTR + (ks * 16 + 8 * hh) * 2);
                s[u] = __builtin_amdgcn_mfma_f32_32x32x16_bf16(kf, qf[ks], s[u], 0, 0, 0); }
        }
        const float NEGINF = -__builtin_inff();
        if (MODE <= 1) { const int cmax = min(510, (t - 31) >> 4);
#pragma unroll
            for (int u = 0; u < 2; ++u)
#pragma unroll
                for (int e = 0; e < 16; ++e) { const int c = 64 * j + 32 * u + crow(e, hh); if (c > cmax) s[u][e] = NEGINF; }
        } else if (MODE == 2) { const bool bit = ((j < 64 ? selLo : selHi) >> (j & 63)) & 1ull; const int lim = (j == tb) ? tl : 64;
#pragma unroll
            for (int u = 0; u < 2; ++u)
#pragma unroll
                for (int e = 0; e < 16; ++e) { const int kk = 32 * u + crow(e, hh); if (!bit || kk > lim) s[u][e] = NEGINF; }
        } else {
#pragma unroll
            for (int u = 0; u < 2; ++u)
#pragma unroll
                for (int e = 0; e < 16; ++e) { const int df = t - (64 * j + 32 * u + crow(e, hh)); if ((unsigned)df >= 512u) s[u][e] = NEGINF; }
        }
        if (MODE == 1) {
            const float msafe = (m_run == NEGINF) ? 0.f : m_run;
#pragma unroll
            for (int u = 0; u < 2; ++u)
#pragma unroll
                for (int e = 0; e < 16; ++e) s[u][e] = fexp2(s[u][e] - msafe) * l_run;
            if (tb >= 16) {
                float w1[8], w2[8], pw2[8];
#pragma unroll
                for (int u = 0; u < 2; ++u)
#pragma unroll
                    for (int gi = 0; gi < 4; ++gi) { const float p0 = s[u][4 * gi], p1 = s[u][4 * gi + 1], p2 = s[u][4 * gi + 2], p3 = s[u][4 * gi + 3];
                        w1[u * 4 + gi] = p0 + p1 + p2 + 0.5f * p3; w2[u * 4 + gi] = 0.5f * p3; }
#pragma unroll
                for (int q = 0; q < 8; ++q) pw2[q] = shx(w2[q], 32, lane);
                float tot[8];
#pragma unroll
                for (int q = 0; q < 8; ++q) { const float prev = (q == 0) ? carry : pw2[q > 0 ? q - 1 : 0]; tot[q] = w1[q] + (hh ? pw2[q] : prev); }
                carry = pw2[7];
#pragma unroll
                for (int q = 0; q < 8; ++q) { float v = tot[q]; v += shx(v, 1, lane); v += shx(v, 2, lane); tot[q] = v; }
                if ((n & 3) == 0) { LAS float* imp = (LAS float*)(lds + L_IMP) + (8 * wave + (n >> 2)) * IMPSTR;
#pragma unroll
                    for (int q = 0; q < 8; ++q) { const int jj = 16 * j + 8 * (q >> 2) + 2 * (q & 3) + hh; if (jj < 128) imp[jj] = tot[q]; } }
            }
        } else {
            float mloc = s[0][0];
#pragma unroll
            for (int u = 0; u < 2; ++u)
#pragma unroll
                for (int e = 0; e < 16; ++e) mloc = fmaxf(mloc, s[u][e]);
            mloc = fmaxf(mloc, shx(mloc, 32, lane));
            const float mnew = fmaxf(m_run, mloc); const float msafe = (mnew == NEGINF) ? 0.f : mnew;
            const float alpha = fexp2(m_run - msafe);
            float ls = 0.f;
#pragma unroll
            for (int u = 0; u < 2; ++u)
#pragma unroll
                for (int e = 0; e < 16; ++e) { s[u][e] = fexp2(s[u][e] - msafe); ls += s[u][e]; }
            l_run = l_run * alpha + ls; m_run = mnew;
            if (MODE != 0) {
#pragma unroll
                for (int ds = 0; ds < 2; ++ds)
#pragma unroll
                    for (int e = 0; e < 16; ++e) o[ds][e] *= alpha;
            }
        }
        if (MODE != 0) {
#pragma unroll
            for (int u = 0; u < 2; ++u)
#pragma unroll
                for (int st = 0; st < 2; ++st) {
                    u32x4 pp; pp.x = pk2(s[u][8 * st], s[u][8 * st + 1]); pp.y = pk2(s[u][8 * st + 2], s[u][8 * st + 3]); pp.z = pk2(s[u][8 * st + 4], s[u][8 * st + 5]); pp.w = pk2(s[u][8 * st + 6], s[u][8 * st + 7]);
                    const bf16x8 pb = __builtin_bit_cast(bf16x8, pp);
#pragma unroll
                    for (int ds = 0; ds < 2; ++ds) { const LAS unsigned char* vp = Vl + (32 * ds + n) * VSTR + (32 * u + 16 * st + 4 * hh) * 2;
                        const u32x2 a0 = *(const LAS u32x2*)vp, a1 = *(const LAS u32x2*)(vp + 16);
                        const u32x4 av = {a0.x, a0.y, a1.x, a1.y};
                        o[ds] = __builtin_amdgcn_mfma_f32_32x32x16_bf16(__builtin_bit_cast(bf16x8, av), pb, o[ds], 0, 0, 0); }
                }
        }
    }
    __syncthreads();
}

typedef float f32x4v __attribute__((ext_vector_type(4)));
DI void sel_tile(const u32x4 (&kc)[4], const u32x4 (&vf)[4], int j, LAS unsigned char* OSw, const LAS unsigned char* Q8w, LAS float* MLw, u64 tmLo, u64 tmHi, int tb, int wave, int lane) {
    const int q = lane & 15, quad = lane >> 4, head = q & 3, slot = q >> 2;
    const float NEGINF = -__builtin_inff();
    const bool tbit = (((j < 64 ? tmLo : tmHi) >> (j & 63)) & 1ull) != 0ull && lane < 8;
    unsigned act = (unsigned)__ballot(tbit) & 0xffu;
    while (act != 0u) {
        const int t0 = __builtin_ctz(act); act &= act - 1u;
        int t1 = -1, t2 = -1, t3 = -1;
        if (act != 0u) { t1 = __builtin_ctz(act); act &= act - 1u; }
        if (act != 0u) { t2 = __builtin_ctz(act); act &= act - 1u; }
        if (act != 0u) { t3 = __builtin_ctz(act); act &= act - 1u; }
        const int tsel = slot == 0 ? t0 : (slot == 1 ? t1 : (slot == 2 ? t2 : t3));
        const bool valid = tsel >= 0; const int tk = valid ? tsel : t0; const int rho = 4 * tk + head;
        const long qa = *(const LAS long*)(Q8w + rho * 64 + 8 * quad), qb = *(const LAS long*)(Q8w + rho * 64 + 32 + 8 * quad);
        f32x4v s[4];
#pragma unroll
        for (int sub = 0; sub < 4; ++sub) { s[sub] = (f32x4v){0.f, 0.f, 0.f, 0.f};
            s[sub] = __builtin_amdgcn_mfma_f32_16x16x32_fp8_fp8(mk64(kc[sub].x, kc[sub].y), qa, s[sub], 0, 0, 0);
            s[sub] = __builtin_amdgcn_mfma_f32_16x16x32_fp8_fp8(mk64(kc[sub].z, kc[sub].w), qb, s[sub], 0, 0, 0); }
        if (j == tb) { const int tlk = 8 * wave + tk;
#pragma unroll
            for (int sub = 0; sub < 4; ++sub)
#pragma unroll
                for (int i = 0; i < 4; ++i) { const int kk = 16 * sub + 4 * quad + i; if (kk > tlk) s[sub][i] = NEGINF; } }
        float mloc = fmaxf(fmaxf(s[0][0], s[1][0]), fmaxf(s[2][0], s[3][0]));
#pragma unroll
        for (int i = 1; i < 4; ++i) mloc = fmaxf(mloc, fmaxf(fmaxf(s[0][i], s[1][i]), fmaxf(s[2][i], s[3][i])));
        mloc = fmaxf(mloc, shx(mloc, 16, lane)); mloc = fmaxf(mloc, shx(mloc, 32, lane));
        const float m_old = MLw[rho], l_old = MLw[32 + rho];
        const float mnew = fmaxf(m_old, mloc);
        const float msafe = (mnew == NEGINF) ? 0.f : mnew;
        const float alpha = fexp2(m_old - msafe);
        const float sb = valid ? msafe - 8.0f : __builtin_inff();
        float ls = 0.f;
#pragma unroll
        for (int sub = 0; sub < 4; ++sub)
#pragma unroll
            for (int i = 0; i < 4; ++i) { s[sub][i] = fexp2(s[sub][i] - sb); ls += s[sub][i]; }
        ls += shx(ls, 16, lane); ls += shx(ls, 32, lane);
        if (valid && quad == 0) { MLw[rho] = mnew; MLw[32 + rho] = l_old * alpha + ls; }
        const long pb0 = mk64(pk4_fp8(s[0][0], s[0][1], s[0][2], s[0][3]), pk4_fp8(s[1][0], s[1][1], s[1][2], s[1][3]));
        const long pb1 = mk64(pk4_fp8(s[2][0], s[2][1], s[2][2], s[2][3]), pk4_fp8(s[3][0], s[3][1], s[3][2], s[3][3]));
#pragma unroll
        for (int dsub = 0; dsub < 4; ++dsub) { LAS f32x4v* op = (LAS f32x4v*)(OSw + rho * OSSTR + (16 * dsub + 4 * quad) * 4);
            f32x4v oacc = *op * alpha;
            oacc = __builtin_amdgcn_mfma_f32_16x16x32_fp8_fp8(mk64(vf[dsub].x, vf[dsub].y), pb0, oacc, 0, 0, 0);
            oacc = __builtin_amdgcn_mfma_f32_16x16x32_fp8_fp8(mk64(vf[dsub].z, vf[dsub].w), pb1, oacc, 0, 0, 0);
            if (valid) *op = oacc; }
    }
}
DI int sg_pop(u64& uLo, u64& uHi) {
    int j = -1;
    if (uLo != 0ull) { j = __builtin_ctzll(uLo); uLo &= uLo - 1ull; } else if (uHi != 0ull) { j = 64 + __builtin_ctzll(uHi); uHi &= uHi - 1ull; }
    return j;
}
DI void sel_gather(const unsigned char* __restrict__ KFb, const unsigned char* __restrict__ VFb, u64 uLo, u64 uHi, LAS unsigned char* OSw, const LAS unsigned char* Q8w, LAS float* MLw,
                   u64 tmLo, u64 tmHi, int tb, int wave, int lane) {
    const unsigned char* kp = KFb + lane * 16;
    const unsigned char* vp = VFb + lane * 16;
    u32x4 kb0[4], kb1[4], kb2[4], kb3[4], vb0[4], vb1[4], vb2[4], vb3[4];
#define SG_LOAD(KB, VB, jj) do { _Pragma("unroll") for (int sub = 0; sub < 4; ++sub) { KB[sub] = *(const u32x4*)(kp + (size_t)(((jj) * 4 + sub) * 1024)); VB[sub] = *(const u32x4*)(vp + (size_t)(((jj) * 4 + sub) * 1024)); } } while (0)
#define SG_STEP(KC, VC, KL, VL) { const int j3 = sg_pop(uLo, uHi); { const int j3c = j3 < 0 ? 0 : j3; SG_LOAD(KL, VL, j3c); } sel_tile(KC, VC, j0, OSw, Q8w, MLw, tmLo, tmHi, tb, wave, lane); if (j1 < 0) break; j0 = j1; j1 = j2; j2 = j3; }
    int j0 = sg_pop(uLo, uHi), j1 = sg_pop(uLo, uHi), j2 = sg_pop(uLo, uHi);
    SG_LOAD(kb0, vb0, j0); { const int j1c = j1 < 0 ? 0 : j1, j2c = j2 < 0 ? 0 : j2; SG_LOAD(kb1, vb1, j1c); SG_LOAD(kb2, vb2, j2c); }
    for (;;) {
        SG_STEP(kb0, vb0, kb3, vb3)
        SG_STEP(kb1, vb1, kb0, vb0)
        SG_STEP(kb2, vb2, kb1, vb1)
        SG_STEP(kb3, vb3, kb2, vb2)
    }
#undef SG_LOAD
#undef SG_STEP
}

DI void attn_phase(PP pp, LAS unsigned char* lds, bool do_store) {
    PPOPAQ();
    int tid = threadIdx.x; asm volatile("" : "+v"(tid));
    const int lane = tid & 63, wave = __builtin_amdgcn_readfirstlane(tid >> 6);
    const int G_ = opaque_s((int)gridDim.x), bx_ = opaque_s((int)blockIdx.x);
    const int gw = bx_ * 8 + wave, NGW = G_ * 8, gtid = bx_ * 512 + tid, NT = G_ * 512;
    (void)lane; (void)wave; (void)gw; (void)NGW; (void)gtid; (void)NT;
    unsigned char* ws = pp->ws; bf16_t* PROJ = (bf16_t*)(ws + WS_PROJ);
    const int n = lane & 31, hh = lane >> 5, G = G_;
    for (int it = 0; it < 4; ++it) {
        int tb, bg;
        if (G == 256) { const int kx = bx_ >> 3; bg = bx_ & 7; tb = 127 - (it * 32 + ((it & 1) ? 31 - kx : kx)); }
        else { const int cc = (it & 1) ? (G - 1 - bx_) : bx_; const int rho = it * G + cc; if (rho >= 1024) continue; tb = 127 - (rho >> 3); bg = rho & 7; }
        const int b = bg >> 2, g = bg & 3;
        const int t0 = 64 * tb, tl = 8 * wave + (n >> 2), r = n & 3, t = t0 + tl;
        const size_t trow = (size_t)b * S_ + t;
        bf16_t* qptr = PROJ + trow * LDP + C_Q + (4 * g + r) * 64;
        bf16x8 qf[4];
#pragma unroll
        for (int ks = 0; ks < 4; ++ks) qf[ks] = *(const bf16x8*)(qptr + ks * 16 + 8 * hh);
        f32x16 o[2];
        LAS float* OT = (LAS float*)(lds + L_OT) + wave * 2048 + lane;
        for (int i = tid; i < 64 * IMPSTR; i += 512) ((LAS float*)(lds + L_IMP))[i] = 0.f;
        {
            TileSrc src{(const bf16_t*)(ws + WS_KCMP) + (size_t)bg * 512 * 64, 64, (const bf16_t*)(ws + WS_VTCMP) + (size_t)bg * 64 * 512, 512};
            int nvalid = (t0 + 32) / 16 + 1; if (nvalid > 511) nvalid = 511;
            const int j1 = (nvalid - 1) >> 6;
            float m = -__builtin_inff(), l = 0.f;
            attn_loop<0>(lds, src, 0, j1, qf, o, m, l, tl, t, tb, 0ull, 0ull, tid, wave, lane);
            l += shx(l, 32, lane);
            float inv = 1.0f / fmaxf(l, 1e-30f);
#pragma unroll
            for (int ds = 0; ds < 2; ++ds)
#pragma unroll
                for (int e = 0; e < 16; ++e) o[ds][e] = 0.f;
            attn_loop<1>(lds, src, 0, j1, qf, o, m, inv, tl, t, tb, 0ull, 0ull, tid, wave, lane);
#pragma unroll
            for (int ds = 0; ds < 2; ++ds)
#pragma unroll
                for (int e = 0; e < 16; ++e) OT[(ds * 16 + e) * 64] = o[ds][e];
        }
        {
            const int tok = tid >> 3, prt = tid & 7;
            unsigned mk[4] = {0u, 0u, 0u, 0u};
            if (tb < 16) { mk[0] = (tb == 31) ? 0xffffffffu : ((2u << tb) - 1u); }
            else {
                const LAS float* imp = (const LAS float*)(lds + L_IMP) + tok * IMPSTR + 16 * prt;
                unsigned keys[16];
#pragma unroll
                for (int e = 0; e < 16; ++e) { const int j = 16 * prt + e; const unsigned bits = __builtin_bit_cast(unsigned, imp[e]);
                    keys[e] = (j >= 1 && j <= tb - 1) ? ((bits & 0xffffff80u) | (unsigned)(127 - j)) : 0u; }
                mk[0] = 1u; mk[tb >> 5] |= 1u << (tb & 31);
                for (int round = 0; round < 14; ++round) {
                    unsigned best = keys[0];
#pragma unroll
                    for (int e = 1; e < 16; ++e) best = keys[e] > best ? keys[e] : best;
#pragma unroll
                    for (int o2 = 1; o2 < 8; o2 <<= 1) { const unsigned other = (unsigned)__builtin_amdgcn_ds_bpermute((lane ^ o2) << 2, (int)best); best = other > best ? other : best; }
                    if (best != 0u) { const int jw = 127 - (int)(best & 127u);
                        mk[0] |= (jw < 32) ? (1u << (jw & 31)) : 0u; mk[1] |= (jw >= 32 && jw < 64) ? (1u << (jw & 31)) : 0u;
                        mk[2] |= (jw >= 64 && jw < 96) ? (1u << (jw & 31)) : 0u; mk[3] |= (jw >= 96) ? (1u << (jw & 31)) : 0u; }
#pragma unroll
                    for (int e = 0; e < 16; ++e) if (keys[e] == best) keys[e] = 0u;
                }
            }
            if (prt == 0) { LAS unsigned* sm = (LAS unsigned*)(lds + L_SEL) + tok * 4; sm[0] = mk[0]; sm[1] = mk[1]; sm[2] = mk[2]; sm[3] = mk[3]; }
            __syncthreads();
        }
        {
            TileSrc src{PROJ + (size_t)b * S_ * LDP + C_KW + g * 64, LDP, (const bf16_t*)(ws + WS_VTW) + (size_t)bg * 64 * S_, S_};
            float m = -__builtin_inff(), l = 0.f;
#pragma unroll
            for (int ds = 0; ds < 2; ++ds)
#pragma unroll
                for (int e = 0; e < 16; ++e) o[ds][e] = 0.f;
            attn_loop<3>(lds, src, tb >= 8 ? tb - 8 : 0, tb, qf, o, m, l, tl, t, tb, 0ull, 0ull, tid, wave, lane);
            l += shx(l, 32, lane);
            const float f = sigmoidf_(bf2f(PROJ[((size_t)b * S_ + t) * LDP + C_GN + g * 12 + r * 3 + 2])) / (sigmoidf_(bf2f(PROJ[((size_t)b * S_ + t) * LDP + C_GN + g * 12 + r * 3])) * fmaxf(l, 1e-30f));
#pragma unroll
            for (int ds = 0; ds < 2; ++ds)
#pragma unroll
                for (int e = 0; e < 16; ++e) OT[(ds * 16 + e) * 64] += f * o[ds][e];
        }
        __syncthreads();
        {
            u64 uLo = 0ull, uHi = 0ull;
            { const LAS unsigned* sm = (const LAS unsigned*)(lds + L_SEL) + 8 * wave * 4;
#pragma unroll
              for (int i = 0; i < 8; ++i) { uLo |= (u64)sm[4 * i] | ((u64)sm[4 * i + 1] << 32); uHi |= (u64)sm[4 * i + 2] | ((u64)sm[4 * i + 3] << 32); } }
            uLo = ((u64)(unsigned)__builtin_amdgcn_readfirstlane((int)(unsigned)(uLo >> 32)) << 32) | (unsigned)__builtin_amdgcn_readfirstlane((int)(unsigned)uLo);
            uHi = ((u64)(unsigned)__builtin_amdgcn_readfirstlane((int)(unsigned)(uHi >> 32)) << 32) | (unsigned)__builtin_amdgcn_readfirstlane((int)(unsigned)uHi);
            u64 tmLo, tmHi;
            { const LAS unsigned* sm = (const LAS unsigned*)(lds + L_SEL) + (8 * wave + (lane & 7)) * 4; tmLo = (u64)sm[0] | ((u64)sm[1] << 32); tmHi = (u64)sm[2] | ((u64)sm[3] << 32); }
            LAS unsigned char* OSw = lds + wave * (32 * OSSTR); LAS unsigned char* Q8w = lds + L_Q8 + wave * 2048; LAS float* MLw = (LAS float*)(lds + L_ML) + wave * 64;
            for (int i = lane; i < 32 * OSSTR / 4; i += 64) ((LAS float*)OSw)[i] = 0.f;
            MLw[lane] = (lane < 32) ? -__builtin_inff() : 0.f;
#pragma unroll
            for (int ks = 0; ks < 4; ++ks) { const u32x4 w = __builtin_bit_cast(u32x4, qf[ks]);
                *(LAS long*)(Q8w + n * 64 + 16 * ks + 8 * hh) = mk64(pk4_fp8(bflo(w.x), bfhi(w.x), bflo(w.y), bfhi(w.y)), pk4_fp8(bflo(w.z), bfhi(w.z), bflo(w.w), bfhi(w.w))); }
            sel_gather((const unsigned char*)(ws + WS_KF) + (size_t)bg * 128 * 4096, (const unsigned char*)(ws + WS_VTS) + (size_t)bg * 128 * 4096, uLo, uHi, OSw, Q8w, MLw, tmLo, tmHi, tb, wave, lane);
        }
        if (do_store) {
            int ln2 = lane; asm volatile("" : "+v"(ln2));
            const int n2 = ln2 & 31, h2 = ln2 >> 5, t2 = t0 + 8 * wave + (n2 >> 2), r2 = n2 & 3;
            bf16_t* rowp = PROJ + ((size_t)b * S_ + t2) * LDP;
            const float gcv = sigmoidf_(bf2f(rowp[C_GN + g * 12 + r2 * 3]));
            const LAS float* MLw = (const LAS float*)(lds + L_ML) + wave * 64;
            const float fsel = sigmoidf_(bf2f(rowp[C_GN + g * 12 + r2 * 3 + 1])) / fmaxf(MLw[32 + n2], 1e-30f);
            const LAS unsigned char* OSr = lds + wave * (32 * OSSTR) + n2 * OSSTR;
            bf16_t* op = rowp + C_Q + (4 * g + r2) * 64 + 4 * h2;
#pragma unroll
            for (int ds = 0; ds < 2; ++ds)
#pragma unroll
                for (int gi = 0; gi < 4; ++gi) { const f32x4v os = *(const LAS f32x4v*)(OSr + (32 * ds + 8 * gi + 4 * h2) * 4);
                    u32x2 w; w.x = pk2(gcv * OT[(ds * 16 + 4 * gi) * 64] + fsel * os[0], gcv * OT[(ds * 16 + 4 * gi + 1) * 64] + fsel * os[1]);
                    w.y = pk2(gcv * OT[(ds * 16 + 4 * gi + 2) * 64] + fsel * os[2], gcv * OT[(ds * 16 + 4 * gi + 3) * 64] + fsel * os[3]);
                    *(u32x2*)(op + 32 * ds + 8 * gi) = w; }
        }
        __syncthreads();
    }
}

__global__ void __launch_bounds__(512, 2) fwd_megakernel(Params p) {
    extern __shared__ __attribute__((aligned(16))) unsigned char lds_raw[];
    LAS unsigned char* lds = (LAS unsigned char*)lds_raw;
    cg::grid_group grid = cg::this_grid();
    const int G = gridDim.x, bx = blockIdx.x;
    PP pp = (PP)__builtin_amdgcn_kernarg_segment_ptr();
    volatile LAS unsigned* barst = (volatile LAS unsigned*)(lds + L_BARST);
    if (threadIdx.x == 0) { barst[0] = 0u; barst[1] = 0u; (void)xb_add((unsigned*)(pp->ws + WS_BAR) + XB_XCNT(xb_xcc_id()), 1u); }
    __syncthreads();
#define GSYNC() xcd_barrier((unsigned*)(ws + WS_BAR), barst)
#define ws (pp->ws)
#define PROJ ((bf16_t*)(ws + WS_PROJ))
#define H ((bf16_t*)(ws + WS_H))
#define XC ((bf16_t*)(ws + WS_XC))
#define Y ((float*)(ws + WS_RI))
    const int BIG = 1 << 30;

#ifndef NO_PREP
    prep_phase(pp, 0, lds);
#endif
#ifndef NO_ROW
    row_phase(pp->x, nullptr, nullptr, nullptr, pp->ln_mix_pre, H);
#endif
    grid.sync();

    for (int l = 0; l < NLAYER; ++l) {
        PPOPAQ();
        using pg8::Gemm; using pg8::Sched; using pg8::EpiBf16; using pg8::EpiF32; using pg8::EpiMerge;
        cbias_phase(pp, l);
#ifndef NO_G1
        for (int r_ = 0; r_ < opaque_s(GREP); ++r_) {
        pg8::gemm_phase<EpiBf16>(lds, Gemm{H, (const bf16_t*)(ws + WS_WIN), 1024, 1024, 1024, 128, 128},
            Sched{64, 35, opaque_s(G), opaque_s(bx), 0, BIG, 0u, 256u * 1024 * 2, 0u, 0u, 256u * 1024 * 2, 0u}, EpiBf16{PROJ, LDP, 0, 1.0f, nullptr, 0});
        pg8::gemm_phase<EpiBf16>(lds, Gemm{(const bf16_t*)(ws + WS_MEMN), (const bf16_t*)(ws + WS_WMKV), 1024, 1024, 1024, 128, 128},
            Sched{2, 4, opaque_s(G), (opaque_s(bx) + 64) % opaque_s(G), 0, BIG, 0u, 256u * 1024 * 2, 0u, 0u, 256u * 1024 * 2, 0u}, EpiBf16{(bf16_t*)(ws + WS_KMEM), 1024, 0, 1.0f, nullptr, 0});
        pg8::gemm_phase<EpiBf16>(lds, Gemm{(const bf16_t*)(ws + WS_WMKV) + (size_t)1024 * 1024, (const bf16_t*)(ws + WS_MEMN), 1024, 1024, 1024, 128, 128},
            Sched{4, 2, opaque_s(G), (opaque_s(bx) + 48) % opaque_s(G), 0, BIG, 0u, 256u * 1024 * 2, 0u, 0u, 256u * 1024 * 2, 0u}, EpiBf16{(bf16_t*)(ws + WS_VTMEM), 512, 0, 1.0f, nullptr, 0});
        }
#endif
        GSYNC();
#ifndef NO_POST
        postproj_phase(pp, l);
#endif
#ifndef NO_G1
        if (opaque_s(G) == 256) {
        pg8::gemm_phase<EpiBf16>(lds, Gemm{PROJ, (const bf16_t*)(ws + WS_WC1), 16 * LDP, 2048, 2048, LDP * 2, 128},
            Sched{32, 1, opaque_s(G), opaque_s(bx), 1, BIG, 0u, 0u, 0u, 0u, 0u, 0u}, EpiBf16{(bf16_t*)(ws + WS_HID), 256, 2, 1.0f, (const float*)(ws + WS_CBIAS), 0});
        }
#endif
        GSYNC();
#ifndef NO_G1
        for (int r_ = 0; r_ < opaque_s(GREP); ++r_) {
        if (opaque_s(G) != 256) {
        pg8::gemm_phase<EpiBf16>(lds, Gemm{PROJ, (const bf16_t*)(ws + WS_WC1), 16 * LDP, 2048, 2048, LDP * 2, 128},
            Sched{32, 1, opaque_s(G), opaque_s(bx), 1, BIG, 0u, 0u, 0u, 0u, 0u, 0u}, EpiBf16{(bf16_t*)(ws + WS_HID), 256, 2, 1.0f, (const float*)(ws + WS_CBIAS), 0});
        }
        const int G224 = opaque_s(G), c224 = opaque_s(bx);
        pg8::gemm_phase<EpiBf16>(lds, Gemm{XC, (const bf16_t*)(ws + WS_WLRU), 1024, 128, 128, 128, 128},
            Sched{64, 8, G224, c224, 0, BIG, 0u, 256u * 1024 * 2, 128u * 2, 0u, 256u * 128 * 2, 0u}, EpiBf16{(bf16_t*)(ws + WS_RI), 2048, 0, 1.0f, nullptr, 0});
        pg8::gemm_phase<EpiBf16>(lds, Gemm{PROJ, (const bf16_t*)(ws + WS_KMEM), LDP, 1024, 256, 128, 128},
            Sched{64, 4, G224, c224, 0, 32, (unsigned)C_QM * 2, 256u * LDP * 2, 256u * 2, 0u, 256u * 2, 256u * 1024 * 2}, EpiBf16{H, 1024, 0, 0.0625f * LOG2E, nullptr, 0});
        }
#endif
        GSYNC();
#ifndef NO_SCAN
        scan_phase(pp, l, 0);
#if defined(DUP_SCAN0)
        scan_phase(pp, l, 0);
#endif
#endif
#ifndef NO_MSM
        memsoftmax_phase(pp);
#endif
#ifndef NO_G2
        for (int r_ = 0; r_ < opaque_s(GREP); ++r_) {
        pg8::gemm_phase<EpiF32>(lds, Gemm{(const bf16_t*)(ws + WS_HID), (const bf16_t*)(ws + WS_WC2), 256, 256, 256, 128, 128},
            Sched{32, 1, opaque_s(G), (opaque_s(bx) + 96) % opaque_s(G), 0, 16, 0u, 256u * 256 * 2, 0u, 0u, 0u, 256u * 256 * 2}, EpiF32{(float*)(ws + WS_CRAW), 64, 64});
        }
#endif
        GSYNC();
#ifndef NO_SCAN
        scan_phase(pp, l, 1);
#endif
#ifndef NO_CMPF
        cmpfinal_phase(pp);
#endif
#ifndef NO_G1
        for (int r_ = 0; r_ < opaque_s(GREP); ++r_) {
        pg8::gemm_phase<EpiBf16>(lds, Gemm{H, (const bf16_t*)(ws + WS_VTMEM), 1024, 512, 256, 128, 128},
            Sched{64, 4, opaque_s(G), opaque_s(bx), 0, 32, 0u, 256u * 1024 * 2, 256u * 2, 0u, 256u * 512 * 2, 256u * 2}, EpiBf16{PROJ, LDP, 0, 1.0f, nullptr, C_QM});
        }
#endif
        GSYNC();
#ifndef NO_ATT
#if defined(DUP_ATT)
        attn_phase(pp, lds, opaque_s(0) != 0);
        __syncthreads();
#endif
        attn_phase(pp, lds, true);
#endif
        GSYNC();
#ifndef NO_G3
        for (int r_ = 0; r_ < opaque_s(GREP); ++r_) {
        pg8::gemm_phase<EpiMerge>(lds, Gemm{XC, (const bf16_t*)(ws + WS_WBRA), 1024, 1024, 1024, 128, 128},
            Sched{64, 4, opaque_s(G), opaque_s(bx), 0, BIG, 0u, 256u * 1024 * 2, 0u, 0u, 256u * 1024 * 2, 0u}, EpiMerge{PROJ + C_GM, LDP, Y, H, 0});
        pg8::gemm_phase<EpiMerge>(lds, Gemm{PROJ + C_Q, (const bf16_t*)(ws + WS_WBRB), LDP, 1024, 1024, 128, 128},
            Sched{64, 4, opaque_s(G), opaque_s(bx), 0, BIG, 0u, 256u * LDP * 2, 0u, 0u, 256u * 1024 * 2, 0u}, EpiMerge{PROJ + C_GM + 1024, LDP, Y, H, 1});
        pg8::gemm_phase<EpiMerge>(lds, Gemm{PROJ + C_QM, (const bf16_t*)(ws + WS_WBRC), LDP, 1024, 1024, 128, 128},
            Sched{64, 4, opaque_s(G), opaque_s(bx), 0, BIG, 0u, 256u * LDP * 2, 0u, 0u, 256u * 1024 * 2, 0u}, EpiMerge{PROJ + C_GM + 2048, LDP, Y, H, 2});
        }
#endif
        GSYNC();
#ifndef NO_G2
        for (int r_ = 0; r_ < opaque_s(GREP); ++r_) {
        pg8::gemm_phase<EpiF32>(lds, Gemm{H, (const bf16_t*)(ws + WS_WOUT), 1024, 1024, 1024, 128, 128},
            Sched{64, 4, opaque_s(G), opaque_s(bx), 0, BIG, 0u, 256u * 1024 * 2, 0u, 0u, 256u * 1024 * 2, 0u}, EpiF32{Y, 1024, 1024});
        }
#endif
        GSYNC();
#ifndef NO_ROW
        row_phase((l == 0) ? pp->x : pp->out, Y, pp->ln_mix_post + (size_t)l * 1024, pp->out, pp->ln_mlp_pre + (size_t)l * 1024, H);
#endif
        GSYNC();
#ifndef NO_G1
        for (int r_ = 0; r_ < opaque_s(GREP); ++r_) {
        pg8::gemm_phase<EpiBf16>(lds, Gemm{H, (const bf16_t*)(ws + WS_WM1), 1024, 1024, 1024, 128, 128},
            Sched{64, 16, opaque_s(G), opaque_s(bx), 0, BIG, 0u, 256u * 1024 * 2, 0u, 0u, 256u * 1024 * 2, 0u}, EpiBf16{PROJ, FF_, 1, 1.0f, nullptr, 0});
        }
#endif
        GSYNC();
#ifndef NO_G2
        for (int r_ = 0; r_ < opaque_s(GREP); ++r_) {
        pg8::gemm_phase<EpiF32>(lds, Gemm{PROJ, (const bf16_t*)(ws + WS_WM2), FF_, FF_, FF_, 128, 128},
            Sched{64, 4, opaque_s(G), opaque_s(bx), 0, BIG, 0u, 256u * FF_ * 2, 0u, 0u, 256u * FF_ * 2, 0u}, EpiF32{Y, 1024, 1024});
        }
#endif
        GSYNC();
#ifndef NO_ROW
        row_phase(pp->out, Y, pp->ln_mlp_post + (size_t)l * 1024, pp->out, (l + 1 < NLAYER) ? pp->ln_mix_pre + (size_t)(l + 1) * 1024 : nullptr, (l + 1 < NLAYER) ? H : nullptr);
#endif
#ifndef NO_PREP
        if (l + 1 < NLAYER) prep_phase(pp, l + 1, lds);
#if defined(DUP_PREP)
        if (l + 1 < NLAYER) prep_phase(pp, l + 1, lds);
#endif
#endif
        GSYNC();
    }
#undef ws
#undef PROJ
#undef H
#undef XC
#undef Y
}

extern "C" void kernel_launch(void* const* d_in, const int* in_sizes, int n_in, void* d_out, int out_size, void* d_ws, size_t ws_size, hipStream_t stream) {
    static int grid = 0;
    if (grid == 0) {
        int dev = 0, cus = 0, per_cu = 0;
        hipGetDevice(&dev); hipDeviceGetAttribute(&cus, hipDeviceAttributeMultiprocessorCount, dev);
        hipFuncSetAttribute((const void*)fwd_megakernel, hipFuncAttributeMaxDynamicSharedMemorySize, LDS_BYTES);
        hipOccupancyMaxActiveBlocksPerMultiprocessor(&per_cu, (const void*)fwd_megakernel, 512, LDS_BYTES);
        if (per_cu < 1) per_cu = 1;
        (void)hipGetLastError();
        grid = cus * 1;
        if (ws_size < WS_END) { fprintf(stderr, "kernel_launch: workspace too small (%zu < %zu)\n", ws_size, (size_t)WS_END); grid = -1; }
    }
    if (grid < 0) return;
    Params p{};
    p.x = (const float*)d_in[0]; p.mem = (const float*)d_in[1]; p.pos = (const int*)d_in[2];
    p.ln_mix_pre = (const float*)d_in[3]; p.w_in = (const float*)d_in[4]; p.conv_w = (const float*)d_in[5]; p.conv_b = (const float*)d_in[6];
    p.lru_wr = (const float*)d_in[7]; p.lru_br = (const float*)d_in[8]; p.lru_wi = (const float*)d_in[9]; p.lru_bi = (const float*)d_in[10]; p.lru_lambda = (const float*)d_in[11];
    p.cmp_pe = (const float*)d_in[12]; p.cmp_w1 = (const float*)d_in[13]; p.cmp_b1 = (const float*)d_in[14]; p.cmp_w2 = (const float*)d_in[15];
    p.ln_mem = (const float*)d_in[16]; p.w_mem_kv = (const float*)d_in[17]; p.w_br_rnn = (const float*)d_in[18]; p.w_br_nsa = (const float*)d_in[19]; p.w_br_mem = (const float*)d_in[20]; p.w_out = (const float*)d_in[21];
    p.ln_mix_post = (const float*)d_in[22]; p.ln_mlp_pre = (const float*)d_in[23]; p.mlp_w1 = (const float*)d_in[24]; p.mlp_w2 = (const float*)d_in[25]; p.ln_mlp_post = (const float*)d_in[26];
    p.out = (float*)d_out; p.ws = (unsigned char*)d_ws;
    (void)hipMemsetAsync((unsigned char*)d_ws + WS_BAR, 0, 16384, stream);
    void* args[] = {&p};
    hipError_t e = hipLaunchCooperativeKernel((const void*)fwd_megakernel, dim3(grid), dim3(512), args, LDS_BYTES, stream);
    if (e != hipSuccess) fprintf(stderr, "cooperative launch failed: %s (grid %d)\n", hipGetErrorString(e), grid);
}
```
